# Optimizing an MI355X kernel written in HIP

```python
import math
import jax, jax.numpy as jnp
from jax import lax
import numpy as np

D_MODEL = 1024
BATCH = 8
SEQ = 2048
DEPTH = 2

MLA_HEADS = 8
Q_LORA = 384
KV_LORA = 256
QK_NOPE = 64
QK_ROPE = 32
QK_HEAD = QK_NOPE + QK_ROPE
V_HEAD = 64
MLA_WIDTH = MLA_HEADS * V_HEAD
ROPE_BASE = 10000.0
Q_BLOCK = 128
POOL_WINDOWS = (2, 4, 8, 16)
POOL_GROUPS = len(POOL_WINDOWS)
POOL_WIDTH = 512
POOL_GC = POOL_WIDTH // POOL_GROUPS
N_BRANCHES = 2
IN_SPLITS = (Q_LORA, KV_LORA, QK_ROPE, POOL_WIDTH, N_BRANCHES * D_MODEL)
IN_WIDTH = sum(IN_SPLITS)
PEER_HEADS = 8
N_KEYS = 128
N_EXPERTS = N_KEYS * N_KEYS
PEER_KEY_DIM = 256
PEER_HALF = PEER_KEY_DIM // 2
PEER_TOPK = 16
PEER_CHUNK = 128
RMS_EPS = 1e-6

kernel_name = "hybrid_mla_pool_peer_encoder"


def rms_norm(x, g):
    xf = x.astype(jnp.float32)
    y = xf * lax.rsqrt(jnp.mean(xf * xf, axis=-1, keepdims=True) + RMS_EPS)
    return (y * g.astype(jnp.float32)).astype(x.dtype)


def rope_cos_sin(positions):
    inv = ROPE_BASE ** (-jnp.arange(0, QK_ROPE, 2, dtype=jnp.float32) / QK_ROPE)
    ang = positions.astype(jnp.float32)[..., None] * inv
    return jnp.cos(ang), jnp.sin(ang)


def apply_rope(x, cos, sin):
    cos = cos.astype(x.dtype)
    sin = sin.astype(x.dtype)
    x1, x2 = jnp.split(x, 2, axis=-1)
    return jnp.concatenate([x1 * cos - x2 * sin, x1 * sin + x2 * cos], axis=-1)


def block_attention(q, k, v):
    B, S, H, Dh = q.shape
    nb = S // Q_BLOCK
    scale = 1.0 / math.sqrt(Dh)
    qb = q.reshape(B, nb, Q_BLOCK, H, Dh).transpose(1, 0, 2, 3, 4)

    def one(qblk):
        s = jnp.einsum('bqhd,bkhd->bhqk', qblk, k).astype(jnp.float32) * scale
        p = jax.nn.softmax(s, axis=-1).astype(v.dtype)
        return jnp.einsum('bhqk,bkhd->bqhd', p, v)

    o = lax.map(one, qb)
    return o.transpose(1, 0, 2, 3, 4).reshape(B, S, H * V_HEAD)


def mla_branch(c_q, c_kv, k_pe, cos, sin, q_lora_g, kv_lora_g, w_uq, w_ukv, q_head_g, k_head_g, w_o):
    B, S, _ = c_q.shape
    q = (rms_norm(c_q, q_lora_g) @ w_uq).reshape(B, S, MLA_HEADS, QK_HEAD)
    q_nope, q_pe = q[..., :QK_NOPE], q[..., QK_NOPE:]
    q_pe = apply_rope(q_pe, cos[:, :, None, :], sin[:, :, None, :])
    kv = (rms_norm(c_kv, kv_lora_g) @ w_ukv).reshape(B, S, MLA_HEADS, QK_NOPE + V_HEAD)
    k_nope, v = kv[..., :QK_NOPE], kv[..., QK_NOPE:]
    k_pe = apply_rope(k_pe, cos, sin)
    k_pe = jnp.broadcast_to(k_pe[:, :, None, :], (B, S, MLA_HEADS, QK_ROPE))
    q = rms_norm(jnp.concatenate([q_nope, q_pe], axis=-1), q_head_g)
    k = rms_norm(jnp.concatenate([k_nope, k_pe], axis=-1), k_head_g)
    o = block_attention(q, k, v)
    return o @ w_o


def pool_branch(p, pool_w, pool_scale, w_pool_out):
    B, S, _ = p.shape
    pf = p.reshape(B, S, POOL_GROUPS, POOL_GC).astype(jnp.float32)
    cs = jnp.concatenate([jnp.zeros((B, 1, POOL_GROUPS, POOL_GC), jnp.float32),
                          jnp.cumsum(pf, axis=1)], axis=1)
    half = jnp.array(POOL_WINDOWS, dtype=jnp.int32) // 2
    t = jnp.arange(S, dtype=jnp.int32)[:, None]
    lo = jnp.clip(t - half[None, :], 0, S)
    hi = jnp.clip(t + half[None, :], 0, S)
    gidx = jnp.arange(POOL_GROUPS, dtype=jnp.int32)[None, :]
    win_sum = cs[:, hi, gidx] - cs[:, lo, gidx]
    count = (hi - lo).astype(jnp.float32)[None, :, :, None]
    mixed = (win_sum / count - pf).astype(p.dtype)
    y = jnp.einsum('bsgc,gcd->bsgd', mixed, pool_w).reshape(B, S, POOL_WIDTH) * pool_scale
    return y @ w_pool_out


def peer_ffn(xn, wq, sub_keys, expert_u, expert_v):
    B, S, D = xn.shape
    xc = xn.reshape((B * S) // PEER_CHUNK, PEER_CHUNK, D)
    K = PEER_TOPK

    def one(x):
        C = x.shape[0]
        q = (x @ wq).reshape(C, PEER_HEADS, 2, PEER_HALF)
        s = jnp.einsum('chpk,hpnk->chpn', q, sub_keys).astype(jnp.float32)
        top_s, top_i = lax.top_k(s, K)
        cand = top_s[:, :, 0, :, None] + top_s[:, :, 1, None, :]
        best_s, best_j = lax.top_k(cand.reshape(C, PEER_HEADS, K * K), K)
        i1 = jnp.take_along_axis(top_i[:, :, 0], best_j // K, axis=-1)
        i2 = jnp.take_along_axis(top_i[:, :, 1], best_j % K, axis=-1)
        e = i1 * N_KEYS + i2
        g = jax.nn.softmax(best_s, axis=-1).astype(x.dtype)
        u = jnp.take(expert_u, e, axis=0)
        h = jax.nn.gelu(jnp.einsum('cd,chkd->chk', x, u))
        v = jnp.take(expert_v, e, axis=0)
        return jnp.einsum('chk,chkd->cd', g * h, v)

    return lax.map(one, xc).reshape(B, S, D)


def setup_inputs(seed: int = 0) -> dict:
    key = jax.random.key(seed)
    ks = jax.random.split(key, 24)
    f32 = jnp.float32

    def nrm(k, shape, scale):
        return jax.random.normal(k, shape, f32) * scale

    def gain(k, shape):
        return 1.0 + 0.1 * jax.random.normal(k, shape, f32)

    L = DEPTH
    x = jax.random.normal(ks[0], (BATCH, SEQ, D_MODEL), f32)
    offsets = jax.random.randint(ks[1], (BATCH, 1), 0, 4096, dtype=jnp.int32)
    positions = jnp.arange(SEQ, dtype=jnp.int32)[None, :] + offsets
    return {
        "x": x,
        "positions": positions,
        "norm1_g": gain(ks[2], (L, D_MODEL)),
        "w_in": nrm(ks[3], (L, D_MODEL, IN_WIDTH), D_MODEL ** -0.5),
        "q_lora_g": gain(ks[4], (L, Q_LORA)),
        "kv_lora_g": gain(ks[5], (L, KV_LORA)),
        "w_uq": nrm(ks[6], (L, Q_LORA, MLA_HEADS * QK_HEAD), Q_LORA ** -0.5),
        "w_ukv": nrm(ks[7], (L, KV_LORA, MLA_HEADS * (QK_NOPE + V_HEAD)), KV_LORA ** -0.5),
        "q_head_g": gain(ks[8], (L, QK_HEAD)),
        "k_head_g": gain(ks[9], (L, QK_HEAD)),
        "w_o_mla": nrm(ks[10], (L, MLA_WIDTH, D_MODEL), MLA_WIDTH ** -0.5),
        "pool_w": nrm(ks[11], (L, POOL_GROUPS, POOL_GC, POOL_GC), POOL_GC ** -0.5),
        "pool_scale": gain(ks[12], (L, POOL_WIDTH)),
        "w_pool_out": nrm(ks[13], (L, POOL_WIDTH, D_MODEL), POOL_WIDTH ** -0.5),
        "gate_bias": nrm(ks[14], (L, N_BRANCHES, D_MODEL), 0.1),
        "w_out": nrm(ks[15], (L, D_MODEL, D_MODEL), D_MODEL ** -0.5),
        "norm2_g": gain(ks[16], (L, D_MODEL)),
        "peer_wq": nrm(ks[17], (L, D_MODEL, PEER_HEADS * PEER_KEY_DIM), D_MODEL ** -0.5),
        "peer_keys": nrm(ks[18], (L, PEER_HEADS, 2, N_KEYS, PEER_HALF), PEER_HALF ** -0.5),
        "peer_u": nrm(ks[19], (L, N_EXPERTS, D_MODEL), D_MODEL ** -0.5),
        "peer_v": nrm(ks[20], (L, N_EXPERTS, D_MODEL), PEER_HEADS ** -0.5),
    }


def reference(x, positions, norm1_g, w_in, q_lora_g, kv_lora_g, w_uq, w_ukv, q_head_g, k_head_g,
              w_o_mla, pool_w, pool_scale, w_pool_out, gate_bias, w_out, norm2_g,
              peer_wq, peer_keys, peer_u, peer_v):
    B, S, D = x.shape
    cos, sin = rope_cos_sin(positions)
    cuts = list(np.cumsum(IN_SPLITS)[:-1])
    for l in range(DEPTH):
        xn = rms_norm(x, norm1_g[l])
        c_q, c_kv, k_pe, p, g_logits = jnp.split(xn @ w_in[l], cuts, axis=-1)
        a = mla_branch(c_q, c_kv, k_pe, cos, sin, q_lora_g[l], kv_lora_g[l], w_uq[l], w_ukv[l],
                       q_head_g[l], k_head_g[l], w_o_mla[l])
        b = pool_branch(p, pool_w[l], pool_scale[l], w_pool_out[l])
        gates = jax.nn.sigmoid((g_logits.reshape(B, S, N_BRANCHES, D) + gate_bias[l]).astype(jnp.float32)).astype(x.dtype)
        mix = gates[:, :, 0] * a + gates[:, :, 1] * b
        x = x + mix @ w_out[l]
        x = x + peer_ffn(rms_norm(x, norm2_g[l]), peer_wq[l], peer_keys[l], peer_u[l], peer_v[l])
    return x
```

```cpp
#include <hip/hip_runtime.h>
#include <hip/hip_cooperative_groups.h>
#include <cstdio>
#include <cstdint>
namespace cg = cooperative_groups;
namespace pg8 {
#define PG8_LAS __attribute__((address_space(3)))
typedef unsigned short bf16_t;
typedef short bf16x8 __attribute__((ext_vector_type(8)));
typedef float f32x4 __attribute__((ext_vector_type(4)));
typedef unsigned u32x4 __attribute__((ext_vector_type(4)));
constexpr int BM = 256, BK = 64, HALF = 128, HTB = HALF * BK * 2  , STAGE_BYTES = 8 * HTB, NXCD = 8, WGM = 8;

__host__ __device__ __forceinline__ int lds_byte(int r, int c) { const int st = (r >> 4) * 2 + (c >> 5), rr = r & 15, cc = c & 31, ob = rr * 64 + cc * 2; return st * 1024 + (ob ^ (((ob >> 9) & 1) << 5)); }
__host__ __device__ __forceinline__ void stage_rc(int b, int& R, int& C) { const int st = b / 1024, sb = b % 1024, swz = sb ^ (((sb >> 9) & 1) << 5); R = (st >> 1) * 16 + swz / 64; C = (st & 1) * 32 + (swz % 64) / 2; }
__host__ __device__ __forceinline__ int perm32(int rho) { const int n = rho >> 4, i = rho & 15; return 8 * (i >> 2) + 4 * n + (i & 3); }

struct Unit { int pm, pn; };
struct Gemm { const bf16_t* A; const bf16_t* Bt; int M, N, K; };

struct StaticOrder {
    int nM, nN, nwg, G, c;
    __host__ __device__ void init(int M, int N, int G_, int c_) { nM = M / BM; nN = N / BM; nwg = nM * nN; G = G_; c = c_; }
    __host__ __device__ bool next(int i, Unit& u) const {
        const long L = (long)i * G + c; if (L >= nwg) return false;
        int wgid = (int)L; { const int q = nwg / NXCD, r = nwg % NXCD, xcd = wgid % NXCD, off = wgid / NXCD; wgid = (xcd < r ? xcd * (q + 1) : r * (q + 1) + (xcd - r) * q) + off; }
        const int nig = WGM * nN, gid = wgid / nig, fm = gid * WGM, gsz = (nM - fm) < WGM ? (nM - fm) : WGM;
        u.pm = fm + ((wgid % nig) % gsz); u.pn = (wgid % nig) / gsz; return true;
    }
    __device__ __forceinline__ void a_ready(const Unit&) const {}
    __device__ __forceinline__ void done(const Unit&) const {}
};

__device__ __forceinline__ unsigned cvt_pk_bf16(float lo, float hi) { unsigned r; asm volatile("v_cvt_pk_bf16_f32 %0, %1, %2" : "=v"(r) : "v"(lo), "v"(hi)); return r; }
typedef float f32x2 __attribute__((ext_vector_type(2)));
__device__ __forceinline__ f32x2 gelu_pk(f32x2 v) {
    const f32x2 av = __builtin_elementwise_abs(v), d = av * 0.2316418882f + 1.0f;
    f32x2 t; t.x = __builtin_amdgcn_rcpf(d.x); t.y = __builtin_amdgcn_rcpf(d.y);
    f32x2 q = t * 0.5307027145f + (-0.7265760135f); q = q * t + 0.7107068705f; q = q * t + (-0.142248368f); q = q * t + 0.127414796f; q = q * t;
    const f32x2 s = (v * v) * (-0.72134752044f);
    f32x2 e; e.x = __builtin_amdgcn_exp2f(s.x); e.y = __builtin_amdgcn_exp2f(s.y);
    const f32x2 m = v * (q * e), r = v - m;
    f32x2 o; o.x = v.x < 0.f ? m.x : r.x; o.y = v.y < 0.f ? m.y : r.y; return o;
}

template <int ACT  > struct EpiBf16 {
    static constexpr bool PERM = true, AFTER_DRAIN = false; static_assert(ACT == 0 || ACT == 1, "EpiBf16: ACT is 0 (none) or 1 (gelu_pk)");
    bf16_t* O; int ldc; const float* bias; int split_cols; size_t split_stride; float scale0;
    __device__ __forceinline__ void operator()(const f32x4 (&acc)[2][2][4][2], const Unit& u, int wr, int wc, int fr, int fq) const {
        const int row0 = u.pm * BM + wr * 64 + fr; int colt = u.pn * BM; bf16_t* base = O;
        float sc = 1.f; if (split_cols) { const int t = colt / split_cols; base += (size_t)t * split_stride; colt -= t * split_cols; if (t == 0) sc = scale0; }
        const int col0 = colt + wc * 32 + 8 * fq, bcol0 = u.pn * BM + wc * 32 + 8 * fq;
        f32x4 bv[2][2];
#pragma unroll
        for (int bj = 0; bj < 2; ++bj)
#pragma unroll
            for (int n = 0; n < 2; ++n) bv[bj][n] = bias ? *(const f32x4*)(bias + bcol0 + bj * HALF + 4 * n) : (f32x4){0.f, 0.f, 0.f, 0.f};
#pragma unroll
        for (int ai = 0; ai < 2; ++ai)
#pragma unroll
            for (int m = 0; m < 4; ++m) { bf16_t* rowp = base + (size_t)(row0 + ai * HALF + m * 16) * ldc + col0;
#pragma unroll
                for (int bj = 0; bj < 2; ++bj) { f32x4 v0 = acc[ai][bj][m][0] + bv[bj][0], v1 = acc[ai][bj][m][1] + bv[bj][1];
                    if (ACT == 1) { f32x2 a = gelu_pk((f32x2){v0[0], v0[1]}), b = gelu_pk((f32x2){v0[2], v0[3]}), c = gelu_pk((f32x2){v1[0], v1[1]}), d = gelu_pk((f32x2){v1[2], v1[3]});
                        v0 = (f32x4){a.x, a.y, b.x, b.y}; v1 = (f32x4){c.x, c.y, d.x, d.y}; }
                    v0 = v0 * sc; v1 = v1 * sc; u32x4 w; w.x = cvt_pk_bf16(v0[0], v0[1]); w.y = cvt_pk_bf16(v0[2], v0[3]); w.z = cvt_pk_bf16(v1[0], v1[1]); w.w = cvt_pk_bf16(v1[2], v1[3]);
                    *(u32x4*)(rowp + bj * HALF) = w; } }
    }
};
__device__ __forceinline__ int fresh_lane() { int l; asm volatile("v_mbcnt_lo_u32_b32 %0, -1, 0\n\tv_mbcnt_hi_u32_b32 %0, -1, %0" : "=v"(l)); return l; }
__device__ __forceinline__ float bflo(unsigned w) { return __builtin_bit_cast(float, w << 16); }
__device__ __forceinline__ float bfhi(unsigned w) { return __builtin_bit_cast(float, w & 0xffff0000u); }
__device__ __forceinline__ float sigmoid_f(float x) { return __builtin_amdgcn_rcpf(1.0f + __builtin_amdgcn_exp2f(-1.4426950408889634f * x)); }

struct EpiIn {
    static constexpr bool PERM = true, AFTER_DRAIN = false;
    bf16_t* gates; const float* gbias; bf16_t* cq; bf16_t* ckv; bf16_t* kpep; const float* ssqn;
    __device__ __forceinline__ void operator()(const f32x4 (&acc)[2][2][4][2], const Unit& u, int wr, int wc, int fr, int fq) const {
        const int row0 = u.pm * BM + wr * 64 + fr;
        float rs[2][4];
#pragma unroll
        for (int ai = 0; ai < 2; ++ai)
#pragma unroll
            for (int m = 0; m < 4; ++m) { const f32x4* sp = (const f32x4*)(ssqn + (size_t)(row0 + ai * HALF + m * 16) * 8); const f32x4 a = sp[0], b = sp[1];
                rs[ai][m] = 1.0f / sqrtf(((a[0] + a[1]) + (a[2] + a[3]) + (b[0] + b[1]) + (b[2] + b[3])) * (1.0f / 1024.0f) + 1e-6f); }
#pragma unroll
        for (int bj = 0; bj < 2; ++bj) {
            const int colw = u.pn * BM + bj * HALF + wc * 32;
            bf16_t* dst; int ld; bool gate = false;
            if (colw < 2048) { dst = gates + colw; ld = 2048; gate = true; }
            else { const int pc = colw - 2048;
                if (pc < 384) { dst = cq + pc; ld = 384; }
                else if (pc < 640) { dst = ckv + (pc - 384); ld = 256; }
                else if (pc < 1184) { dst = kpep + (pc - 640); ld = 544; }
                else continue; }
            dst += 8 * fq;
            f32x4 b0 = (f32x4){0.f, 0.f, 0.f, 0.f}, b1 = b0;
            if (gate) { b0 = *(const f32x4*)(gbias + colw + 8 * fq); b1 = *(const f32x4*)(gbias + colw + 8 * fq + 4); }
#pragma unroll
            for (int ai = 0; ai < 2; ++ai)
#pragma unroll
                for (int m = 0; m < 4; ++m) {
                    f32x4 v0 = acc[ai][bj][m][0] * rs[ai][m] + b0, v1 = acc[ai][bj][m][1] * rs[ai][m] + b1;
                    if (gate) {
#pragma unroll
                        for (int j = 0; j < 4; ++j) { v0[j] = sigmoid_f(v0[j]); v1[j] = sigmoid_f(v1[j]); }
                    }
                    if (gate) {
                        typedef unsigned u32x2g __attribute__((ext_vector_type(2)));
                        u32x2g w;
                        w.x = (unsigned)(v0[0] * 255.0f + 0.5f) | ((unsigned)(v0[1] * 255.0f + 0.5f) << 8) | ((unsigned)(v0[2] * 255.0f + 0.5f) << 16) | ((unsigned)(v0[3] * 255.0f + 0.5f) << 24);
                        w.y = (unsigned)(v1[0] * 255.0f + 0.5f) | ((unsigned)(v1[1] * 255.0f + 0.5f) << 8) | ((unsigned)(v1[2] * 255.0f + 0.5f) << 16) | ((unsigned)(v1[3] * 255.0f + 0.5f) << 24);
                        *(u32x2g*)((unsigned char*)gates + (size_t)(row0 + ai * HALF + m * 16) * 2048 + colw + 8 * fq) = w;
                    } else {
                    u32x4 w; w.x = cvt_pk_bf16(v0[0], v0[1]); w.y = cvt_pk_bf16(v0[2], v0[3]); w.z = cvt_pk_bf16(v1[0], v1[1]); w.w = cvt_pk_bf16(v1[2], v1[3]);
                    *(u32x4*)(dst + (size_t)(row0 + ai * HALF + m * 16) * ld) = w; }
                }
        }
    }
};

struct EpiMix {
    static constexpr bool PERM = true, AFTER_DRAIN = false;
    const bf16_t* a; const bf16_t* gates; bf16_t* mix;
    __device__ __forceinline__ void operator()(const f32x4 (&acc)[2][2][4][2], const Unit& u, int wr, int wc, int fr, int fq) const {
        const int row0 = u.pm * BM + wr * 64 + fr, col0 = u.pn * BM + wc * 32 + 8 * fq;
#pragma unroll
        for (int ai = 0; ai < 2; ++ai)
#pragma unroll
            for (int m = 0; m < 4; ++m) {
                const size_t row = (size_t)(row0 + ai * HALF + m * 16);
#pragma unroll
                for (int bj = 0; bj < 2; ++bj) {
                    const int c = col0 + bj * HALF;
                    const u32x4 av = *(const u32x4*)(a + row * 1024 + c);
                    typedef unsigned u32x2g __attribute__((ext_vector_type(2)));
                    const u32x2g g0 = *(const u32x2g*)((const unsigned char*)gates + row * 2048 + c);
                    const u32x2g g1 = *(const u32x2g*)((const unsigned char*)gates + row * 2048 + 1024 + c);
                    const float k = 1.0f / 255.0f;
                    const f32x4 v0 = acc[ai][bj][m][0] * k, v1 = acc[ai][bj][m][1] * k;
#define GB(W, B) ((float)(((W) >> (8 * (B))) & 0xffu))
                    u32x4 w;
                    w.x = cvt_pk_bf16(GB(g0.x, 0) * k * bflo(av.x) + GB(g1.x, 0) * v0[0], GB(g0.x, 1) * k * bfhi(av.x) + GB(g1.x, 1) * v0[1]);
                    w.y = cvt_pk_bf16(GB(g0.x, 2) * k * bflo(av.y) + GB(g1.x, 2) * v0[2], GB(g0.x, 3) * k * bfhi(av.y) + GB(g1.x, 3) * v0[3]);
                    w.z = cvt_pk_bf16(GB(g0.y, 0) * k * bflo(av.z) + GB(g1.y, 0) * v1[0], GB(g0.y, 1) * k * bfhi(av.z) + GB(g1.y, 1) * v1[1]);
                    w.w = cvt_pk_bf16(GB(g0.y, 2) * k * bflo(av.w) + GB(g1.y, 2) * v1[2], GB(g0.y, 3) * k * bfhi(av.w) + GB(g1.y, 3) * v1[3]);
#undef GB
                    *(u32x4*)(mix + row * 1024 + c) = w;
                }
            }
    }
};

struct EpiRes {
    static constexpr bool PERM = false, AFTER_DRAIN = false;
    const bf16_t* xin; bf16_t* xout; float* ssq;
    __device__ __forceinline__ void operator()(const f32x4 (&acc)[2][2][4][2], const Unit& u, int wr, int wc, int fr, int fq) const {
        const int row0 = u.pm * BM + wr * 64 + fr, col0 = u.pn * BM + wc * 32 + 4 * fq;
        typedef unsigned u32x2 __attribute__((ext_vector_type(2)));
#pragma unroll
        for (int ai = 0; ai < 2; ++ai)
#pragma unroll
            for (int m = 0; m < 4; ++m) {
                const size_t row = (size_t)(row0 + ai * HALF + m * 16); float s = 0.f;
#pragma unroll
                for (int bj = 0; bj < 2; ++bj)
#pragma unroll
                    for (int n = 0; n < 2; ++n) {
                        const size_t off = row * 1024 + col0 + bj * HALF + n * 16;
                        const u32x2 xi = *(const u32x2*)(xin + off);
                        const f32x4 xo = (f32x4){bflo(xi.x), bfhi(xi.x), bflo(xi.y), bfhi(xi.y)} + acc[ai][bj][m][n];
                        s += (xo[0] * xo[0] + xo[1] * xo[1]) + (xo[2] * xo[2] + xo[3] * xo[3]);
                        u32x2 w; w.x = cvt_pk_bf16(xo[0], xo[1]); w.y = cvt_pk_bf16(xo[2], xo[3]);
                        *(u32x2*)(xout + off) = w;
                    }
                s += __shfl_xor(s, 16); s += __shfl_xor(s, 32);
                if (fq == 0) ssq[row * 16 + u.pn * 4 + wc] = s;
            }
    }
};
template <class Epi, class Sched, bool ALIGN_EPI = false, bool SP2 = false>
__device__ __forceinline__ void gemm_phase(PG8_LAS unsigned char* lds, const Gemm g, const Sched& S, const Epi& E, const int wave_id) {
    const int wid = wave_id, lane = fresh_lane(), tid = (wid << 6) | lane, wr = wid >> 2, wc = wid & 3, fr = lane & 15, fq = lane >> 4;
    const int K = g.K, nt = K / BK;
    unsigned voffA[2], voffB[2];
#pragma unroll
    for (int i = 0; i < 2; ++i) { int R, C; stage_rc(tid * 16 + i * 8192, R, C); const int Rb = Epi::PERM ? ((R & ~31) + perm32(R & 31)) : R;
        voffA[i] = (unsigned)(R * K + C) * 2u; voffB[i] = (unsigned)(Rb * K + C) * 2u; }
    const size_t kstep = (size_t)(BK * 2);
    const size_t hstep = (size_t)HALF * K * 2;
    const size_t tstep = 2 * hstep;
    const unsigned ldsw = (unsigned)wid * 1024u;
    const int aoff = lds_byte(wr * 64 + fr, fq * 8), boff = lds_byte(wc * 32 + fr, fq * 8);
#define PG8_SA(b, h) (((b) * 2 + (h)) * HTB)
#define PG8_SB(b, h) ((4 + (b) * 2 + (h)) * HTB)
#define PG8_STAGE(bufoff, gbase, voff) do { _Pragma("unroll") for (int _i = 0; _i < 2; ++_i) \
        __builtin_amdgcn_global_load_lds((const unsigned*)((const char*)(gbase) + (voff)[_i]), (PG8_LAS unsigned*)(lds + (bufoff) + ldsw + _i * 8192), 16, 0, 0); } while (0)
#define PG8_LDA(dst, b, h) do { _Pragma("unroll") for (int m = 0; m < 4; ++m) _Pragma("unroll") for (int k = 0; k < 2; ++k) dst[m][k] = *(const PG8_LAS bf16x8*)(lds + PG8_SA(b, h) + aoff + m * 2048 + k * 1024); } while (0)
#define PG8_LDB(dst, b, h) do { _Pragma("unroll") for (int n = 0; n < 2; ++n) _Pragma("unroll") for (int k = 0; k < 2; ++k) dst[n][k] = *(const PG8_LAS bf16x8*)(lds + PG8_SB(b, h) + boff + n * 2048 + k * 1024); } while (0)
#define PG8_MMA(ai, bj, At, Bt) do { __builtin_amdgcn_s_setprio(1); _Pragma("unroll") for (int m = 0; m < 4; ++m) _Pragma("unroll") for (int n = 0; n < 2; ++n) _Pragma("unroll") for (int k = 0; k < 2; ++k) \
        acc[ai][bj][m][n] = __builtin_amdgcn_mfma_f32_16x16x32_bf16(Bt[n][k], At[m][k], acc[ai][bj][m][n], 0, 0, 0); __builtin_amdgcn_s_setprio(0); } while (0)
#define PG8_WAIT_V(n) asm volatile("s_waitcnt vmcnt(" #n ")" ::: "memory")
#define PG8_WAIT_L(n) asm volatile("s_waitcnt lgkmcnt(" #n ")" ::: "memory")
#define PG8_BAR __builtin_amdgcn_s_barrier()
#define PG8_SCHED __builtin_amdgcn_sched_barrier(0)
    Unit cur, nxt; int ui = 0;
    if (!S.next(0, cur)) return;
    f32x4 acc[2][2][4][2];
#pragma unroll
    for (int a = 0; a < 2; ++a)
#pragma unroll
        for (int b = 0; b < 2; ++b)
#pragma unroll
            for (int m = 0; m < 4; ++m)
#pragma unroll
                for (int n = 0; n < 2; ++n) acc[a][b][m][n] = (f32x4){0.f, 0.f, 0.f, 0.f};
    bf16x8 At[4][2], B0[2][2], B1[2][2];
    const char* cA = (const char*)g.A + (size_t)cur.pm * tstep; const char* cB = (const char*)g.Bt + (size_t)cur.pn * tstep;
    S.a_ready(cur);
    if constexpr (SP2) {
        PG8_STAGE(PG8_SB(0, 0), cB, voffB); PG8_STAGE(PG8_SB(0, 1), cB + hstep, voffB); PG8_STAGE(PG8_SA(0, 0), cA, voffA); PG8_STAGE(PG8_SA(0, 1), cA + hstep, voffA);
        if (wr == 1) PG8_BAR;
        PG8_WAIT_V(2); PG8_BAR;
        PG8_STAGE(PG8_SB(1, 0), cB + kstep, voffB); PG8_STAGE(PG8_SA(1, 0), cA + kstep, voffA); PG8_STAGE(PG8_SB(1, 1), cB + hstep + kstep, voffB);
        PG8_WAIT_V(6); PG8_BAR;
    } else {
        PG8_STAGE(PG8_SB(0, 0), cB, voffB); PG8_STAGE(PG8_SA(0, 0), cA, voffA); PG8_STAGE(PG8_SB(0, 1), cB + hstep, voffB); PG8_STAGE(PG8_SA(0, 1), cA + hstep, voffA);
        if (wr == 1) PG8_BAR;
        PG8_WAIT_V(4); PG8_BAR;
        PG8_STAGE(PG8_SB(1, 0), cB + kstep, voffB); PG8_STAGE(PG8_SA(1, 0), cA + kstep, voffA); PG8_STAGE(PG8_SB(1, 1), cB + hstep + kstep, voffB);
        PG8_WAIT_V(6); PG8_BAR;
    }
    for (;;) {
        const bool has_next = S.next(ui + 1, nxt);
        const char* nA = has_next ? (const char*)g.A + (size_t)nxt.pm * tstep : cA; const char* nB = has_next ? (const char*)g.Bt + (size_t)nxt.pn * tstep : cB;
        for (int t = 0; t < nt; t += 2) {
            const bool last = (t == nt - 2);
            const char* a1 = cA + (size_t)(t + 1) * kstep;
            const char* a2 = last ? nA : cA + (size_t)(t + 2) * kstep; const char* b2 = last ? nB : cB + (size_t)(t + 2) * kstep;
            const char* a3 = a2 + kstep; const char* b3 = b2 + kstep;
            if (last && has_next) S.a_ready(nxt);
            if constexpr (SP2) {
            PG8_LDB(B0, 0, 0); PG8_LDB(B1, 0, 1); PG8_SCHED; PG8_LDA(At, 0, 0); PG8_STAGE(PG8_SA(1, 1), a1 + hstep, voffA);
            PG8_WAIT_V(8); PG8_WAIT_L(0); PG8_BAR; PG8_MMA(0, 0, At, B0); PG8_MMA(0, 1, At, B1); PG8_BAR; PG8_SCHED;
            PG8_LDA(At, 0, 1); PG8_STAGE(PG8_SB(0, 0), b2, voffB); PG8_STAGE(PG8_SB(0, 1), b2 + hstep, voffB); PG8_STAGE(PG8_SA(0, 0), a2, voffA);
            PG8_WAIT_V(8); PG8_WAIT_L(0); PG8_BAR; PG8_MMA(1, 0, At, B0); PG8_MMA(1, 1, At, B1); PG8_BAR; PG8_SCHED;
            PG8_LDB(B0, 1, 0); PG8_LDB(B1, 1, 1); PG8_SCHED; PG8_LDA(At, 1, 0); PG8_STAGE(PG8_SA(0, 1), a2 + hstep, voffA);
            PG8_WAIT_V(8); PG8_WAIT_L(0); PG8_BAR; PG8_MMA(0, 0, At, B0); PG8_MMA(0, 1, At, B1); PG8_BAR; PG8_SCHED;
            PG8_LDA(At, 1, 1); PG8_STAGE(PG8_SB(1, 0), b3, voffB); PG8_STAGE(PG8_SB(1, 1), b3 + hstep, voffB); PG8_STAGE(PG8_SA(1, 0), a3, voffA);
            PG8_WAIT_V(8); PG8_WAIT_L(0); PG8_BAR; PG8_MMA(1, 0, At, B0); PG8_MMA(1, 1, At, B1); PG8_BAR; PG8_SCHED;
            } else {
            PG8_LDB(B0, 0, 0); PG8_SCHED; PG8_LDA(At, 0, 0); PG8_STAGE(PG8_SA(1, 1), a1 + hstep, voffA);
            PG8_WAIT_L(8); PG8_BAR; PG8_WAIT_L(0); PG8_MMA(0, 0, At, B0); PG8_BAR; PG8_SCHED;
            PG8_LDB(B1, 0, 1); PG8_STAGE(PG8_SB(0, 0), b2, voffB);
            PG8_BAR; PG8_WAIT_L(0); PG8_MMA(0, 1, At, B1); PG8_BAR;
            PG8_LDA(At, 0, 1); PG8_STAGE(PG8_SA(0, 0), a2, voffA);
            PG8_BAR; PG8_WAIT_L(0); PG8_MMA(1, 0, At, B0); PG8_BAR; PG8_SCHED;
            PG8_STAGE(PG8_SB(0, 1), b2 + hstep, voffB);
            PG8_WAIT_V(6); PG8_BAR; PG8_MMA(1, 1, At, B1); PG8_BAR;
            PG8_LDB(B0, 1, 0); PG8_SCHED; PG8_LDA(At, 1, 0); PG8_STAGE(PG8_SA(0, 1), a2 + hstep, voffA);
            PG8_WAIT_L(8); PG8_BAR; PG8_WAIT_L(0); PG8_MMA(0, 0, At, B0); PG8_BAR; PG8_SCHED;
            PG8_LDB(B1, 1, 1); PG8_STAGE(PG8_SB(1, 0), b3, voffB);
            PG8_BAR; PG8_WAIT_L(0); PG8_MMA(0, 1, At, B1); PG8_BAR;
            PG8_LDA(At, 1, 1); PG8_STAGE(PG8_SA(1, 0), a3, voffA);
            PG8_BAR; PG8_WAIT_L(0); PG8_MMA(1, 0, At, B0); PG8_BAR; PG8_SCHED;
            PG8_STAGE(PG8_SB(1, 1), b3 + hstep, voffB);
            PG8_WAIT_V(6); PG8_BAR; PG8_MMA(1, 1, At, B1); PG8_BAR;
            }
        }
        if constexpr (ALIGN_EPI) { if (wr == 0) PG8_BAR; }
        if constexpr (!Epi::AFTER_DRAIN) { E(acc, cur, wr, wc, fr, fq); S.done(cur); }
        if (!has_next) break;
#pragma unroll
        for (int a = 0; a < 2; ++a)
#pragma unroll
            for (int b = 0; b < 2; ++b)
#pragma unroll
                for (int m = 0; m < 4; ++m)
#pragma unroll
                    for (int n = 0; n < 2; ++n) acc[a][b][m][n] = (f32x4){0.f, 0.f, 0.f, 0.f};
        cur = nxt; cA = nA; cB = nB; ++ui;
        if constexpr (ALIGN_EPI) { if (wr == 1) PG8_BAR; }
    }
    PG8_WAIT_V(0);
    if constexpr (!ALIGN_EPI) { if (wr == 0) PG8_BAR; }
    PG8_BAR;
    if constexpr (Epi::AFTER_DRAIN) { E.fused(acc, cur, wr, wc, fr, fq, lds, wid, lane); S.done(cur); }
#undef PG8_SA
#undef PG8_SB
#undef PG8_STAGE
#undef PG8_LDA
#undef PG8_LDB
#undef PG8_MMA
#undef PG8_WAIT_V
#undef PG8_WAIT_L
#undef PG8_BAR
#undef PG8_SCHED
}
}
namespace att {
typedef unsigned short bf16;
using bf16x8 = __attribute__((ext_vector_type(8))) short;
using s16x4  = __attribute__((ext_vector_type(4))) short;
using f32x16 = __attribute__((ext_vector_type(16))) float;
using u32x4  = __attribute__((ext_vector_type(4))) unsigned;
constexpr int   DQ = 96, DV = 64, NW = 8, QBLK = 32, KVBLK = 64;
constexpr int   ND0 = DQ / 16;
constexpr int   NDV = DV / 32;
constexpr float SCALE = 0.10206207261596575f;
constexpr float THR = 8.f;
constexpr int   LDQ = 768, LDK = 768, LDV = 512, LDO = 512;
constexpr size_t SHM_V = KVBLK * 128 * 2, SHM_K = KVBLK * 128 * 2, SHM_ATTN = 2 * SHM_V + 2 * SHM_K + NW * 64 * 4;
#define KSWZ(row, colB) ((row) * 256 + ((colB) ^ (((row) & 7) << 4)))
#define SBAR() __builtin_amdgcn_sched_barrier(0)
__device__ __forceinline__ int crow(int r, int hi) { return (r & 3) + 8 * (r >> 2) + 4 * hi; }
__device__ __forceinline__ unsigned cvtpk(float lo, float hi) { unsigned r; asm volatile("v_cvt_pk_bf16_f32 %0, %1, %2" : "=v"(r) : "v"(lo), "v"(hi)); return r; }

__device__ __forceinline__ void partialSM(f32x16& p0, f32x16& p1, float& m_reg, float& mn, float& alpha) {
  constexpr float C = SCALE * 1.4426950408889634f;
  float pmax = p0[0];
#pragma unroll
  for (int r = 1; r < 16; ++r) pmax = fmaxf(pmax, p0[r]);
#pragma unroll
  for (int r = 0; r < 16; ++r) pmax = fmaxf(pmax, p1[r]);
  { auto rr = __builtin_amdgcn_permlane32_swap(__float_as_uint(pmax), __float_as_uint(pmax), false, false);
    pmax = fmaxf(__uint_as_float(rr[0]), __uint_as_float(rr[1])); }
  if (__builtin_expect(__all(pmax - m_reg <= THR / SCALE), 1)) { mn = m_reg; alpha = 1.f; }
  else { mn = fmaxf(m_reg, pmax); alpha = __builtin_amdgcn_exp2f((m_reg - mn) * C); m_reg = mn; }
  float mnC = -mn * C;
#pragma unroll
  for (int r = 0; r < 16; ++r) p0[r] = fmaf(p0[r], C, mnC);
#pragma unroll
  for (int r = 0; r < 16; ++r) p1[r] = fmaf(p1[r], C, mnC);
#pragma unroll
  for (int r = 0; r < 16; ++r) p0[r] = __builtin_amdgcn_exp2f(p0[r]);
}
__device__ __forceinline__ void finishSM(f32x16& p0, f32x16& p1, float alpha, float& l_reg, bf16x8& pa0, bf16x8& pa1, bf16x8& pa2, bf16x8& pa3) {
#pragma unroll
  for (int r = 0; r < 16; ++r) p1[r] = __builtin_amdgcn_exp2f(p1[r]);
  float ps = 0;
#pragma unroll
  for (int r = 0; r < 16; ++r) ps += p0[r];
#pragma unroll
  for (int r = 0; r < 16; ++r) ps += p1[r];
  { auto rr = __builtin_amdgcn_permlane32_swap(__float_as_uint(ps), __float_as_uint(ps), false, false);
    ps = __uint_as_float(rr[0]) + __uint_as_float(rr[1]); }
  l_reg = l_reg * alpha + ps;
#define PK4(P, BASE, OUT) do { unsigned a0 = cvtpk(P[BASE + 0], P[BASE + 1]), a1 = cvtpk(P[BASE + 2], P[BASE + 3]);   \
    unsigned b0 = cvtpk(P[BASE + 4], P[BASE + 5]), b1 = cvtpk(P[BASE + 6], P[BASE + 7]);                              \
    auto r0 = __builtin_amdgcn_permlane32_swap(a0, b0, false, false); auto r1 = __builtin_amdgcn_permlane32_swap(a1, b1, false, false); \
    u32x4 w = {r0[0], r1[0], r0[1], r1[1]}; OUT = *reinterpret_cast<bf16x8*>(&w); } while (0)
  PK4(p0, 0, pa0); PK4(p0, 8, pa1); PK4(p1, 0, pa2); PK4(p1, 8, pa3);
#undef PK4
}
__device__ __forceinline__ void qkt(f32x16& p0, f32x16& p1, const bf16* Ks, const bf16x8* qr, int r32, int hi) {
  p0 = f32x16{}; p1 = f32x16{};
#pragma unroll
  for (int d0 = 0; d0 < ND0; ++d0) { int cb = (d0 * 16 + hi * 8) * 2;
    bf16x8 b0 = *reinterpret_cast<const bf16x8*>((const char*)Ks + KSWZ(r32, cb));
    bf16x8 b1 = *reinterpret_cast<const bf16x8*>((const char*)Ks + KSWZ(32 + r32, cb));
    p0 = __builtin_amdgcn_mfma_f32_32x32x16_bf16(b0, qr[d0], p0, 0, 0, 0);
    p1 = __builtin_amdgcn_mfma_f32_32x32x16_bf16(b1, qr[d0], p1, 0, 0, 0); }
}
__device__ __forceinline__ int v_st(int k, int c) { const int kk = (k & ~0xC) | ((k & 4) << 1) | ((k & 8) >> 1); return ((kk >> 3) * 4 + (c >> 5)) * 512 + ((kk & 7) * 32 + (c & 31)) * 2; }
__device__ __forceinline__ int v_rd_base(int lane) { return ((lane & 3) << 3) | (((lane >> 2) & 3) << 6) | (((lane >> 4) & 1) << 5) | (((lane >> 5) & 1) << 8); }
constexpr int v_rd_off(int d0, int ks, int half) { return d0 * 512 + ks * 4096 + half * 2048; }
template <int OFF> __device__ __forceinline__ s16x4 tr_read(int vb) {
  s16x4 r; asm volatile("ds_read_b64_tr_b16 %0, %1 offset:%2" : "=&v"(r) : "v"(vb), "i"(OFF) : "memory"); return r;
}
template <int D0> __device__ __forceinline__ void pv_one(f32x16& od, int vb, bf16x8 pa0, bf16x8 pa1, bf16x8 pa2, bf16x8 pa3) {
  const s16x4 l0 = tr_read<v_rd_off(D0, 0, 0)>(vb), h0 = tr_read<v_rd_off(D0, 0, 1)>(vb), l1 = tr_read<v_rd_off(D0, 1, 0)>(vb), h1 = tr_read<v_rd_off(D0, 1, 1)>(vb);
  const s16x4 l2 = tr_read<v_rd_off(D0, 2, 0)>(vb), h2 = tr_read<v_rd_off(D0, 2, 1)>(vb), l3 = tr_read<v_rd_off(D0, 3, 0)>(vb), h3 = tr_read<v_rd_off(D0, 3, 1)>(vb);
  asm volatile("s_waitcnt lgkmcnt(0)" ::: "memory"); SBAR();
#define PK(L, H) (bf16x8){L[0], L[1], L[2], L[3], H[0], H[1], H[2], H[3]}
  od = __builtin_amdgcn_mfma_f32_32x32x16_bf16(pa0, PK(l0, h0), od, 0, 0, 0);
  od = __builtin_amdgcn_mfma_f32_32x32x16_bf16(pa1, PK(l1, h1), od, 0, 0, 0);
  od = __builtin_amdgcn_mfma_f32_32x32x16_bf16(pa2, PK(l2, h2), od, 0, 0, 0);
  od = __builtin_amdgcn_mfma_f32_32x32x16_bf16(pa3, PK(l3, h3), od, 0, 0, 0);
#undef PK
}
__device__ __forceinline__ void pv_d0(f32x16* o, int vb, bf16x8 pa0, bf16x8 pa1, bf16x8 pa2, bf16x8 pa3) {
  pv_one<0>(o[0], vb, pa0, pa1, pa2, pa3); pv_one<1>(o[1], vb, pa0, pa1, pa2, pa3);
}

__device__ __forceinline__ void attn_dense_body(const bf16* __restrict__ Qb, const bf16* __restrict__ Kh, const bf16* __restrict__ Vh,
                                                bf16* __restrict__ Ob, int seq, char* lds, const int wave_id) {
  const int wid = wave_id, lane = pg8::fresh_lane(), tid = (wid << 6) | lane, r32 = lane & 31, hi = lane >> 5;
  bf16* V_lds = (bf16*)lds; bf16* K_lds = (bf16*)(lds + 2 * SHM_V);
  float* ws = (float*)(lds + 2 * SHM_V + 2 * SHM_K) + wid * 64; float* li_l = ws; float* al_l = ws + 32;
  float m_reg = -1e30f, l_reg = 0; f32x16 o[NDV] = {}; bf16x8 qr[ND0];
  const bf16* Qw = Qb + (long)(wid * QBLK + r32) * LDQ + hi * 8;
#pragma unroll
  for (int d0 = 0; d0 < ND0; ++d0) qr[d0] = *reinterpret_cast<const bf16x8*>(Qw + d0 * 16);
  const int kr0 = tid / 12, kc0 = tid - kr0 * 12, kr1 = (512 + tid) / 12, kc1 = (512 + tid) - kr1 * 12, vr0 = tid >> 3, vc0 = tid & 7;
  const int kst0 = KSWZ(kr0, kc0 * 16), kst1 = KSWZ(kr1, kc1 * 16), vst0 = v_st(vr0, vc0 * 8);
  const bool k2 = wid < 4;
  const int vb0 = (int)(uintptr_t)V_lds + v_rd_base(lane);
  struct { bf16x8 vs0, ks0, ks1; } sr_[2];
#define SLOAD(i, k0) do { sr_[i].vs0 = *reinterpret_cast<const bf16x8*>(&Vh[(long)((k0) + vr0) * LDV + vc0 * 8]); \
    sr_[i].ks0 = *reinterpret_cast<const bf16x8*>(&Kh[(long)((k0) + kr0) * LDK + kc0 * 8]); \
    if (k2) sr_[i].ks1 = *reinterpret_cast<const bf16x8*>(&Kh[(long)((k0) + kr1) * LDK + kc1 * 8]); } while (0)
#define SWRITE(b, i) do { *(bf16x8*)((char*)V_lds + (b) * SHM_V + vst0) = sr_[i].vs0;          \
    *(bf16x8*)((char*)K_lds + (b) * SHM_K + kst0) = sr_[i].ks0;                       \
    if (k2) *(bf16x8*)((char*)K_lds + (b) * SHM_K + kst1) = sr_[i].ks1; } while (0)
#define SWAIT() do { if (k2) asm volatile("s_waitcnt vmcnt(3)" ::: "memory"); else asm volatile("s_waitcnt vmcnt(2)" ::: "memory"); } while (0)
#define RESC(a) do { if (__any((a) < 1.f)) { if (hi == 0) al_l[r32] = (a); asm volatile("s_waitcnt lgkmcnt(0)" ::: "memory"); \
    _Pragma("unroll") for (int d = 0; d < NDV; ++d) _Pragma("unroll") for (int r = 0; r < 16; ++r) o[d][r] *= al_l[crow(r, hi)]; } } while (0)
  f32x16 pA0, pA1, pB0, pB1; float mnA, mnB, alA, alB; bf16x8 pa0, pa1, pa2, pa3; const int NT = seq / KVBLK;
  constexpr int SE = 0, SO = 1;
  SLOAD(SE, 0); asm volatile("s_waitcnt vmcnt(0)" ::: "memory"); SWRITE(0, SE); __syncthreads();
  qkt(pA0, pA1, K_lds, qr, r32, hi); partialSM(pA0, pA1, m_reg, mnA, alA);
  SLOAD(SO, KVBLK); if (2 < NT) SLOAD(SE, 2 * KVBLK);
  SWAIT(); SWRITE(1, SO); __syncthreads();
  for (int j = 1; j + 1 < NT; j += 2) {
    SBAR(); qkt(pB0, pB1, (bf16*)((char*)K_lds + SHM_K), qr, r32, hi);
    finishSM(pA0, pA1, alA, l_reg, pa0, pa1, pa2, pa3); SBAR();
    SLOAD(SO, (j + 2) * KVBLK); SBAR();
    pv_d0(o, vb0, pa0, pa1, pa2, pa3); partialSM(pB0, pB1, m_reg, mnB, alB);
    __syncthreads(); SWAIT(); SWRITE(0, SE);
    RESC(alB); __syncthreads();
    SBAR(); qkt(pA0, pA1, K_lds, qr, r32, hi);
    finishSM(pB0, pB1, alB, l_reg, pa0, pa1, pa2, pa3); SBAR();
    if (j + 3 < NT) SLOAD(SE, (j + 3) * KVBLK); SBAR();
    pv_d0(o, vb0 + (int)SHM_V, pa0, pa1, pa2, pa3); partialSM(pA0, pA1, m_reg, mnA, alA);
    __syncthreads(); SWAIT(); SWRITE(1, SO);
    RESC(alA); __syncthreads();
  }
  SBAR(); qkt(pB0, pB1, (bf16*)((char*)K_lds + SHM_K), qr, r32, hi);
  finishSM(pA0, pA1, alA, l_reg, pa0, pa1, pa2, pa3); SBAR();
  pv_d0(o, vb0, pa0, pa1, pa2, pa3); partialSM(pB0, pB1, m_reg, mnB, alB);
  __syncthreads(); RESC(alB);
  finishSM(pB0, pB1, alB, l_reg, pa0, pa1, pa2, pa3); SBAR();
  pv_d0(o, vb0 + (int)SHM_V, pa0, pa1, pa2, pa3);
  if (hi == 0) li_l[r32] = l_reg; asm volatile("s_waitcnt lgkmcnt(0)" ::: "memory");
  float rli[16];
#pragma unroll
  for (int r = 0; r < 16; ++r) rli[r] = __builtin_amdgcn_rcpf(li_l[crow(r, hi)]);
  bf16* Ow = Ob + (long)(wid * QBLK) * LDO;
#pragma unroll
  for (int r = 0; r < 16; ++r) { int orow = crow(r, hi);
#pragma unroll
    for (int d0 = 0; d0 < NDV; ++d0) Ow[(long)orow * LDO + d0 * 32 + r32] = (bf16)(cvtpk(o[d0][r] * rli[r], 0.f) & 0xffffu); }
#undef SLOAD
#undef SWRITE
#undef SWAIT
#undef RESC
}
#undef KSWZ
#undef SBAR
}
constexpr int NWAVES = 8;
#ifndef MK_ONE_LAUNCH
#define MK_ONE_LAUNCH 1
#endif
constexpr int NB = 8, SEQ = 2048, DM = 1024, MTOK = NB * SEQ, DEPTH = 2;
constexpr int NH = 8, QL = 384, KVL = 256, NOPE = 64, ROPE = 32, QKH = 96, VHD = 64;
constexpr int PW = 512, INW = 3232, INWP = 3328, KPEPW = 544;
constexpr int NKEY = 128, NEXP = 16384, TOPK = 16;
constexpr float RMS_EPS = 1e-6f;
constexpr size_t MiB = 1u << 20;
constexpr size_t WS_CTL = 0;
constexpr size_t WS_W = 1 * MiB, W_STRIDE = 18 * MiB;
constexpr size_t WO_WIN = 0, WO_WUQ = 6656 * 1024, WO_WUKV = 7424 * 1024, WO_WO = 8 * MiB, WO_WC = 9 * MiB, WO_WOUT = 10 * MiB, WO_WQ = 12 * MiB, WO_KEYS = 16 * MiB;
constexpr size_t WS_U = 40 * MiB, WS_V = 72 * MiB, UV_STRIDE = 16 * MiB;
constexpr size_t WS_SU = 512 * 1024, WS_SV = 768 * 1024, SC_STRIDE = 64 * 1024;
constexpr size_t WS_XB = 168 * MiB;
constexpr size_t WS_GATES = 232 * MiB, WS_QP = 232 * MiB;
constexpr size_t WS_CQ = 296 * MiB, WS_CKV = 308 * MiB, WS_KPEP = 316 * MiB, WS_QRAW = 333 * MiB, WS_KVRAW = 357 * MiB;
constexpr size_t WS_ABUF = 296 * MiB, WS_MIX = 328 * MiB;
constexpr size_t WS_MIXED = 389 * MiB;
constexpr size_t WS_Q = 405 * MiB, WS_K = 429 * MiB, WS_VV = 453 * MiB;
constexpr size_t WS_E = 405 * MiB, WS_G = 413 * MiB, WS_XQ = 429 * MiB, WS_WF = 445 * MiB, WS_HPI = 232 * MiB;
constexpr size_t WS_O = 469 * MiB, WS_SSQ = 485 * MiB, WS_RR = 486 * MiB, WS_SX = WS_RR + 65536, WS_WSUM = WS_RR + 131072, WS_SSQN = WS_RR + 262144, WS_END = 487 * MiB;
static_assert(WO_WUQ >= (size_t)INWP * DM * 2 && WO_WUKV >= WO_WUQ + 768 * 384 * 2 && WO_WO >= WO_WUKV + 1024 * 256 * 2, "weight map");
static_assert(WS_KPEP + (size_t)MTOK * KPEPW * 2 <= WS_QRAW && WS_QRAW + (size_t)MTOK * 768 * 2 <= WS_KVRAW && WS_KVRAW + (size_t)MTOK * 1024 * 2 <= WS_MIXED, "ws map");

constexpr int LDS_BYTES = 147456;

#define GAS __attribute__((address_space(1)))
#define LAS __attribute__((address_space(3)))
typedef unsigned short bf16;
typedef unsigned v4u __attribute__((ext_vector_type(4)));
typedef unsigned v2u __attribute__((ext_vector_type(2)));
typedef float f32x4 __attribute__((ext_vector_type(4)));
typedef float f32x16 __attribute__((ext_vector_type(16)));
typedef short bf16x8 __attribute__((ext_vector_type(8)));
#define LDS_WAIT() asm volatile("s_waitcnt lgkmcnt(0)" ::: "memory")
__device__ __forceinline__ unsigned f2bf(float f) { unsigned u = __builtin_bit_cast(unsigned, f); return (u + 0x7fffu + ((u >> 16) & 1u)) >> 16; }
__device__ __forceinline__ unsigned pk2(float lo, float hi) { return f2bf(lo) | (f2bf(hi) << 16); }
__device__ __forceinline__ float blo(unsigned w) { return __builtin_bit_cast(float, w << 16); }
__device__ __forceinline__ float bhi(unsigned w) { return __builtin_bit_cast(float, w & 0xffff0000u); }
__device__ __forceinline__ float wave_sum(float v) {
#pragma unroll
    for (int o = 1; o < 64; o <<= 1) v += __shfl_xor(v, o);
    return v;
}

#define XB_TMO      128
#define XB_XCNT(j)  (256  + 64 * (j))
#define XB_XSUB(j)  (1280 + 64 * (j))
#define XB_XGEN(j)  (2304 + 64 * (j))
#define XB_TOP      3328
#define XB_TOPGEN   3392
#define XCD_BAR_WORDS 3456
#define XB_SPIN_CAP (1u << 18)

__device__ __forceinline__ unsigned xb_ld(unsigned* p)              { return __hip_atomic_load(p, __ATOMIC_RELAXED, __HIP_MEMORY_SCOPE_AGENT); }
__device__ __forceinline__ unsigned xb_add(unsigned* p, unsigned v) { return __hip_atomic_fetch_add(p, v, __ATOMIC_RELAXED, __HIP_MEMORY_SCOPE_AGENT); }
__device__ __forceinline__ unsigned xb_xcc_id() { return (unsigned)__builtin_amdgcn_s_getreg((3 << 11) | 20) & 0xFu; }
#define XB_SPIN(cond, bar) do { unsigned _sp = 0; while (cond) { __builtin_amdgcn_s_sleep(1); \
    if ((++_sp & 255u) == 0u) { if (xb_ld(&(bar)[XB_TMO])) break; if (_sp > XB_SPIN_CAP) { atomicAdd(&(bar)[XB_TMO], 1u); break; } } } } while (0)

struct XcdBarrier {
    unsigned* bar; unsigned x;
    volatile LAS unsigned* st;
};

__device__ __forceinline__ XcdBarrier xcd_barrier_post(unsigned* bar, volatile LAS unsigned* st) {
    XcdBarrier b; b.bar = bar; b.x = xb_xcc_id(); b.st = st;
    if (threadIdx.x == 0) (void)xb_add(&bar[XB_XCNT(b.x)], 1u);
    return b;
}
__device__ __forceinline__ void xcd_barrier_complete(unsigned* bar, unsigned x, unsigned& nloc, unsigned& nx) {
    const unsigned G = gridDim.x * gridDim.y * gridDim.z;
    unsigned sum, cnt, mine, sp = 0u;
    for (;;) {
        sum = 0u; cnt = 0u; mine = 0u;
#pragma unroll
        for (unsigned j = 0; j < 16; ++j) { const unsigned c = xb_ld(&bar[XB_XCNT(j)]); sum += c; cnt += (c > 0u) ? 1u : 0u; mine = (j == x) ? c : mine; }
        if (sum == G) break;
        __builtin_amdgcn_s_sleep(1);
        if ((++sp & 255u) == 0u) { if (xb_ld(&bar[XB_TMO])) break; if (sp > XB_SPIN_CAP) { atomicAdd(&bar[XB_TMO], 1u); break; } }
    }
    nloc = mine > 0u ? mine : 1u; nx = cnt > 0u ? cnt : 1u;
}

__device__ __forceinline__ void xcd_barrier(const XcdBarrier& b) {
    asm volatile("s_waitcnt vmcnt(0)" ::: "memory");
    __syncthreads();
    if (threadIdx.x == 0) {
        unsigned* bar = b.bar;
        __builtin_amdgcn_s_waitcnt(0);
        unsigned nloc = b.st[0], nx = b.st[1];
        if (nloc == 0u) { xcd_barrier_complete(bar, b.x, nloc, nx); b.st[0] = nloc; b.st[1] = nx; }
        const unsigned old = xb_add(&bar[XB_XSUB(b.x)], 1u);
        const unsigned gen = old / nloc;
        if (old + 1u == (gen + 1u) * nloc) {
            __builtin_amdgcn_fence(__ATOMIC_RELEASE, "agent");
            asm volatile("s_waitcnt vmcnt(0)" ::: "memory");
            const unsigned og = xb_add(&bar[XB_TOP], 1u);
            const unsigned tg = og / nx;
            if (og + 1u == (tg + 1u) * nx) xb_add(&bar[XB_TOPGEN], 1u);
            else XB_SPIN(xb_ld(&bar[XB_TOPGEN]) == tg, bar);
            __builtin_amdgcn_fence(__ATOMIC_ACQUIRE, "agent");
            xb_add(&bar[XB_XGEN(b.x)], 1u);
            asm volatile("s_waitcnt vmcnt(0)" ::: "memory");
        } else {
            XB_SPIN(xb_ld(&bar[XB_XGEN(b.x)]) == gen, bar);
            __builtin_amdgcn_fence(__ATOMIC_ACQUIRE, "agent");
            asm volatile("s_waitcnt vmcnt(0)" ::: "memory");
        }
    }
    __syncthreads();
}

constexpr int MISC_OFF = 131072 + 320;
constexpr size_t CTL_ZERO_BYTES = 65536;

struct Args { const void* in[21]; float* out; unsigned char* ws; int ph_lo, ph_hi; };
static_assert(sizeof(Args) == 23 * 8 + 8, "Args has no padding");


typedef const char __attribute__((address_space(4)))* kseg_t;
__device__ __forceinline__ const void* karg_ptr(int i) {
    kseg_t base = (kseg_t)__builtin_amdgcn_kernarg_segment_ptr();
    asm volatile("" : "+s"(base));
    return *(const void* const __attribute__((address_space(4)))*)(base + 8 * i);
}
__device__ __forceinline__ int karg_int(int byte_off) {
    kseg_t base = (kseg_t)__builtin_amdgcn_kernarg_segment_ptr();
    asm volatile("" : "+s"(base));
    return *(const int __attribute__((address_space(4)))*)(base + byte_off);
}
#define KIN(i) karg_ptr(i)
#define KOUT ((float*)karg_ptr(21))
#define KWS ((unsigned char*)karg_ptr(22))

struct Frame {
    LAS unsigned char* lds;
    int wave, vcu, G, gw, NGW;
};

__device__ __forceinline__ void transpose_item(const float* W, int ldw, int n_begin, int nblk, const float* gain, bf16* WT, int K, int row_off, LAS float* scr, int item, int lane) {
    const int kb = item / nblk, nb = item % nblk, k0 = 64 * kb, n0 = 32 * nb;
    float tv[32];
#pragma unroll
    for (int i = 0; i < 32; ++i) tv[i] = W[(size_t)(k0 + 2 * i + (lane >> 5)) * ldw + n_begin + n0 + (lane & 31)];
    if (gain) {
#pragma unroll
        for (int i = 0; i < 32; ++i) tv[i] *= gain[k0 + 2 * i + (lane >> 5)]; }
#pragma unroll
    for (int i = 0; i < 32; ++i) scr[(2 * i + (lane >> 5)) * 33 + (lane & 31)] = tv[i];
    LDS_WAIT(); asm volatile("" ::: "memory");
    const int c = lane & 7;
#pragma unroll
    for (int j = 0; j < 4; ++j) { const int n = (lane >> 3) + 8 * j; const LAS float* s = scr + (8 * c) * 33 + n;
        v4u o; o.x = pk2(s[0 * 33], s[1 * 33]); o.y = pk2(s[2 * 33], s[3 * 33]); o.z = pk2(s[4 * 33], s[5 * 33]); o.w = pk2(s[6 * 33], s[7 * 33]);
        *(GAS v4u*)(WT + (size_t)(row_off + n0 + n) * K + k0 + 8 * c) = o; }
    LDS_WAIT(); asm volatile("" ::: "memory");
}
__device__ __forceinline__ void rms_row_to_bf16(const float* xrow, const float* g, bf16* orow, int lane) {
    const f32x4* xr = (const f32x4*)xrow + lane; const f32x4* gr = (const f32x4*)g + lane;
    f32x4 v[4]; float s = 0.f;
#pragma unroll
    for (int j = 0; j < 4; ++j) { v[j] = xr[64 * j]; s += (v[j].x * v[j].x + v[j].y * v[j].y) + (v[j].z * v[j].z + v[j].w * v[j].w); }
    const float r = 1.0f / sqrtf(wave_sum(s) * (1.f / DM) + RMS_EPS);
    v2u* o8 = (v2u*)orow + lane;
#pragma unroll
    for (int j = 0; j < 4; ++j) { const f32x4 gv = gr[64 * j]; v2u w; w.x = pk2(v[j].x * r * gv.x, v[j].y * r * gv.y); w.y = pk2(v[j].z * r * gv.z, v[j].w * r * gv.w); o8[64 * j] = w; }
}
__device__ __forceinline__ void cvt8(const float* src, bf16* dst, size_t i8) {
    const f32x4 a = *(const f32x4*)(src + i8 * 8), b = *(const f32x4*)(src + i8 * 8 + 4);
    v4u o; o.x = pk2(a.x, a.y); o.y = pk2(a.z, a.w); o.z = pk2(b.x, b.y); o.w = pk2(b.z, b.w);
    *(v4u*)(dst + i8 * 8) = o;
}

__device__ __forceinline__ void convert_tables(int l, int cw, int ncw) {
    const int lane = pg8::fresh_lane();
    constexpr int NR = 8;
    for (int it0 = cw * NR; it0 < 2 * NEXP; it0 += ncw * NR) {
        f32x4 va[NR][4]; float m[NR];
#pragma unroll
        for (int r = 0; r < NR; ++r) { const int it = it0 + r, tab = it / NEXP, row = l * NEXP + it % NEXP;
            const f32x4* src = (const f32x4*)((const float*)(tab ? KIN(20) : KIN(19)) + (size_t)row * DM) + lane;
#pragma unroll
            for (int j = 0; j < 4; ++j) va[r][j] = __builtin_nontemporal_load(src + 64 * j); }
#pragma unroll
        for (int r = 0; r < NR; ++r) { float mm = 0.f;
#pragma unroll
            for (int j = 0; j < 4; ++j) mm = fmaxf(mm, fmaxf(fmaxf(fabsf(va[r][j].x), fabsf(va[r][j].y)), fmaxf(fabsf(va[r][j].z), fabsf(va[r][j].w))));
            m[r] = mm; }
#pragma unroll
        for (int o = 1; o < 64; o <<= 1)
#pragma unroll
            for (int r = 0; r < NR; ++r) m[r] = fmaxf(m[r], __shfl_xor(m[r], o));
#pragma unroll
        for (int r = 0; r < NR; ++r) { const int it = it0 + r, tab = it / NEXP, row = l * NEXP + it % NEXP;
            const float inv = m[r] > 0.f ? 127.0f / m[r] : 0.f;
#define Q8(x) ((unsigned)((int)rintf((x) * inv) & 255))
            unsigned char* dstb = KWS + (tab ? WS_V : WS_U) + (size_t)l * UV_STRIDE + (size_t)(it % NEXP) * 128 + ((4 * lane) & 127);
#pragma unroll
            for (int j = 0; j < 4; ++j) *(unsigned*)(dstb + (size_t)(2 * j + (lane >> 5)) * (NEXP * 128)) = Q8(va[r][j].x) | (Q8(va[r][j].y) << 8) | (Q8(va[r][j].z) << 16) | (Q8(va[r][j].w) << 24);
#undef Q8
            if (lane == 0) ((float*)(KWS + WS_SU))[2 * row + tab] = m[r] * (1.0f / 127.0f); }
    }
}

__device__ __forceinline__ void ph_prologue(Frame& F) {
    LAS float* scr = (LAS float*)(F.lds + F.wave * 16384);
    const int gw = F.gw, NGW = F.NGW, lane = pg8::fresh_lane();
    constexpr int I_G = 16 * 64, I_P = 16 * 37, I_UQ = 6 * 24, I_UKV = 4 * 32, I_O = 8 * 32, I_OUT = 16 * 32, I_WQ = 16 * 64;
    constexpr int I_L = I_G + I_P + I_UQ + I_UKV + I_O + I_OUT + I_WQ;
    for (int it = gw; it < DEPTH * I_L; it += NGW) {
        const int l = it / I_L; int r = it % I_L;
        unsigned char* wb = KWS + WS_W + (size_t)l * W_STRIDE;
        const float* w_in = (const float*)KIN(3) + (size_t)l * DM * INW;
        const float* g1 = (const float*)KIN(2) + (size_t)l * DM;
        if (r < I_G) { transpose_item(w_in, INW, 1184, 64, g1, (bf16*)(wb + WO_WIN), DM, 0, scr, r, lane); continue; } r -= I_G;
        if (r < I_P) { transpose_item(w_in, INW, 0, 37, g1, (bf16*)(wb + WO_WIN), DM, 2048, scr, r, lane); continue; } r -= I_P;
        if (r < I_UQ) { transpose_item((const float*)KIN(6) + (size_t)l * QL * 768, 768, 0, 24, (const float*)KIN(4) + l * QL, (bf16*)(wb + WO_WUQ), QL, 0, scr, r, lane); continue; } r -= I_UQ;
        if (r < I_UKV) { transpose_item((const float*)KIN(7) + (size_t)l * KVL * 1024, 1024, 0, 32, (const float*)KIN(5) + l * KVL, (bf16*)(wb + WO_WUKV), KVL, 0, scr, r, lane); continue; } r -= I_UKV;
        if (r < I_O) { transpose_item((const float*)KIN(10) + (size_t)l * 512 * DM, DM, 0, 32, nullptr, (bf16*)(wb + WO_WO), 512, 0, scr, r, lane); continue; } r -= I_O;
        if (r < I_OUT) { transpose_item((const float*)KIN(15) + (size_t)l * DM * DM, DM, 0, 32, nullptr, (bf16*)(wb + WO_WOUT), DM, 0, scr, r, lane); continue; } r -= I_OUT;
        transpose_item((const float*)KIN(17) + (size_t)l * DM * 2048, 2048, 0, 64, (const float*)KIN(16) + (size_t)l * DM, (bf16*)(wb + WO_WQ), DM, 0, scr, r, lane);
    }
    for (int i = gw * 64 + lane; i < DEPTH * 96 * DM / 8; i += NGW * 64) {
        const int l = i / (96 * DM / 8), r = i % (96 * DM / 8);
        *(v4u*)((bf16*)(KWS + WS_W + (size_t)l * W_STRIDE + WO_WIN) + (size_t)INW * DM + (size_t)r * 8) = (v4u){0u, 0u, 0u, 0u};
    }
    for (int it = gw; it < DEPTH * 16 * 32; it += NGW) {
        const int l = it >> 9, cb = (it >> 5) & 15, db = it & 31, g = cb >> 2, r32 = lane & 31, hi = lane >> 5;
        const float* pw = (const float*)KIN(11) + (size_t)l * 4 * 128 * 128 + (size_t)(cb * 32 + r32) * 128 + 64 * hi;
        const float* ps = (const float*)KIN(12) + (size_t)l * 512 + g * 128 + 64 * hi;
        const float* wp = (const float*)KIN(13) + (size_t)l * 512 * DM + (size_t)(g * 128 + 64 * hi) * DM + db * 32 + r32;
        float av[64], bv[64];
#pragma unroll
        for (int j = 0; j < 16; ++j) { const f32x4 v = *(const f32x4*)(pw + 4 * j); av[4 * j] = v.x; av[4 * j + 1] = v.y; av[4 * j + 2] = v.z; av[4 * j + 3] = v.w; }
#pragma unroll
        for (int j = 0; j < 64; ++j) bv[j] = wp[(size_t)j * DM];
#pragma unroll
        for (int j = 0; j < 16; ++j) { const f32x4 s4 = *(const f32x4*)(ps + 4 * j); bv[4 * j] *= s4.x; bv[4 * j + 1] *= s4.y; bv[4 * j + 2] *= s4.z; bv[4 * j + 3] *= s4.w; }
        f32x16 acc = f32x16{};
#pragma unroll
        for (int s = 0; s < 64; ++s) acc = __builtin_amdgcn_mfma_f32_32x32x2f32(av[s], bv[s], acc, 0, 0, 0);
        bf16* dst = (bf16*)(KWS + WS_W + (size_t)l * W_STRIDE + WO_WC) + (size_t)(db * 32 + r32) * 512 + cb * 32 + 4 * hi;
#pragma unroll
        for (int q = 0; q < 4; ++q) { v2u o; o.x = pk2(acc[4 * q], acc[4 * q + 1]); o.y = pk2(acc[4 * q + 2], acc[4 * q + 3]); *(v2u*)(dst + 8 * q) = o; }
    }
    for (int i = gw * 64 + lane; i < DEPTH * 16 * 128 * 128 / 8; i += NGW * 64) {
        const int l = i / (16 * 128 * 128 / 8), r = i % (16 * 128 * 128 / 8);
        cvt8((const float*)KIN(18) + (size_t)l * 16 * 128 * 128, (bf16*)(KWS + WS_W + (size_t)l * W_STRIDE + WO_KEYS), (size_t)r);
    }
    for (int m0 = gw; m0 < MTOK; m0 += 2 * NGW) {
        f32x4 v[2][4]; float s[2];
#pragma unroll
        for (int u = 0; u < 2; ++u) { const int m = (m0 + u * NGW < MTOK) ? m0 + u * NGW : m0; const f32x4* xr = (const f32x4*)((const float*)KIN(0) + (size_t)m * DM) + lane;
#pragma unroll
            for (int j = 0; j < 4; ++j) v[u][j] = xr[64 * j]; }
#pragma unroll
        for (int u = 0; u < 2; ++u) { float ss = 0.f;
#pragma unroll
            for (int j = 0; j < 4; ++j) ss += (v[u][j].x * v[u][j].x + v[u][j].y * v[u][j].y) + (v[u][j].z * v[u][j].z + v[u][j].w * v[u][j].w);
            s[u] = ss; }
#pragma unroll
        for (int o = 1; o < 64; o <<= 1) { s[0] += __shfl_xor(s[0], o); s[1] += __shfl_xor(s[1], o); }
#pragma unroll
        for (int u = 0; u < 2; ++u) { const int m = m0 + u * NGW; if (m < MTOK) {
            v2u* o8 = (v2u*)((bf16*)(KWS + WS_XB) + (size_t)m * DM) + lane;
#pragma unroll
            for (int j = 0; j < 4; ++j) { v2u w; w.x = pk2(v[u][j].x, v[u][j].y); w.y = pk2(v[u][j].z, v[u][j].w); o8[64 * j] = w; }
            if (lane == 0) { f32x4* sp = (f32x4*)((float*)(KWS + WS_SSQN) + (size_t)m * 8); sp[0] = (f32x4){s[u], 0.f, 0.f, 0.f}; sp[1] = (f32x4){0.f, 0.f, 0.f, 0.f}; } } }
    }
}

__device__ __forceinline__ void ph_pool(Frame& F) {
    const bf16* KP = (const bf16*)(KWS + WS_KPEP); bf16* MX = (bf16*)(KWS + WS_MIXED);
    const int lane = pg8::fresh_lane(), g = lane >> 4, half = 1 << g, c0 = lane * 8;
#define POOL_ACC(W, SGN) do { sum[0] += SGN blo(W.x); sum[1] += SGN bhi(W.x); sum[2] += SGN blo(W.y); sum[3] += SGN bhi(W.y); sum[4] += SGN blo(W.z); sum[5] += SGN bhi(W.z); sum[6] += SGN blo(W.w); sum[7] += SGN bhi(W.w); } while (0)
    for (int run = F.gw; run < MTOK / 8; run += F.NGW) {
        const int t0 = run * 8, s0 = t0 & (SEQ - 1);
        v4u row[23];
#pragma unroll
        for (int k = 0; k < 23; ++k) { const int d = k - 8; const bool ok = (d >= -half) && (d < 8 + half - 1 + 1) && (s0 + d >= 0) && (s0 + d < SEQ);
            row[k] = ok ? *(const v4u*)(KP + (size_t)(t0 + d) * KPEPW + 32 + c0) : (v4u){0u, 0u, 0u, 0u}; }
        float sum[8];
#pragma unroll
        for (int j = 0; j < 8; ++j) sum[j] = 0.f;
        int cnt = 0;
#pragma unroll
        for (int d = -8; d < 8; ++d) { const bool ok = (d >= -half) && (d < half) && (s0 + d >= 0) && (s0 + d < SEQ); if (ok) { POOL_ACC(row[d + 8], +); ++cnt; } }
#pragma unroll
        for (int i = 0; i < 8; ++i) {
            const int t = t0 + i, s = s0 + i;
            if (i > 0) {
                const bool lv_ok = (s - 1 - half >= 0), ev_ok = (s + half - 1 < SEQ);
#define POOL_CASE(H) do { if (half == (H)) { if ((i - 1 - (H) + 8) >= 0) { if (lv_ok) { POOL_ACC(row[(i - 1 - (H) + 8) >= 0 ? (i - 1 - (H) + 8) : 0], -); } } if (ev_ok) { POOL_ACC(row[i + (H) - 1 + 8], +); } } } while (0)
                POOL_CASE(1); POOL_CASE(2); POOL_CASE(4); POOL_CASE(8);
#undef POOL_CASE
                if (lv_ok) --cnt;
                if (ev_ok) ++cnt;
            }
            const v4u me = row[i + 8];
            const float ic = 1.0f / (float)cnt;
            v4u o; o.x = pk2(sum[0] * ic - blo(me.x), sum[1] * ic - bhi(me.x)); o.y = pk2(sum[2] * ic - blo(me.y), sum[3] * ic - bhi(me.y));
            o.z = pk2(sum[4] * ic - blo(me.z), sum[5] * ic - bhi(me.z)); o.w = pk2(sum[6] * ic - blo(me.w), sum[7] * ic - bhi(me.w));
            *(v4u*)(MX + (size_t)t * PW + c0) = o;
        }
    }
#undef POOL_ACC
}

__device__ __forceinline__ void ph_finalize(Frame& F, int l) {
    const bf16* CQ = (const bf16*)(KWS + WS_CQ); const bf16* CKV = (const bf16*)(KWS + WS_CKV); const bf16* KP = (const bf16*)(KWS + WS_KPEP);
    const bf16* QR = (const bf16*)(KWS + WS_QRAW); const bf16* KVR = (const bf16*)(KWS + WS_KVRAW);
    bf16* Q = (bf16*)(KWS + WS_Q); bf16* K = (bf16*)(KWS + WS_K); bf16* V = (bf16*)(KWS + WS_VV);
    const int* pos = (const int*)KIN(1);
    const float* ghq = (const float*)KIN(8) + l * QKH; const float* ghk = (const float*)KIN(9) + l * QKH;
    const int lane = pg8::fresh_lane(), h = lane >> 3, sub = lane & 7;
    const float inv0 = __builtin_amdgcn_exp2f(-(float)(2 * sub) * 0.8304820237218406f), inv1 = __builtin_amdgcn_exp2f(-(float)(2 * sub + 1) * 0.8304820237218406f);
    float gqn[8], gkn[8];
#pragma unroll
    for (int j = 0; j < 8; ++j) { gqn[j] = ghq[8 * sub + j]; gkn[j] = ghk[8 * sub + j]; }
    const float gq10 = ghq[64 + 2 * sub], gq11 = ghq[65 + 2 * sub], gq20 = ghq[80 + 2 * sub], gq21 = ghq[81 + 2 * sub];
    const float gk10 = ghk[64 + 2 * sub], gk11 = ghk[65 + 2 * sub], gk20 = ghk[80 + 2 * sub], gk21 = ghk[81 + 2 * sub];
    for (int t = F.gw; t < MTOK; t += F.NGW) {
        float sq = 0.f, sk = 0.f;
        if (lane < 48) { const v4u w = *(const v4u*)(CQ + (size_t)t * QL + lane * 8);
            sq = (blo(w.x) * blo(w.x) + bhi(w.x) * bhi(w.x)) + (blo(w.y) * blo(w.y) + bhi(w.y) * bhi(w.y)) + (blo(w.z) * blo(w.z) + bhi(w.z) * bhi(w.z)) + (blo(w.w) * blo(w.w) + bhi(w.w) * bhi(w.w)); }
        if (lane < 32) { const v4u w = *(const v4u*)(CKV + (size_t)t * KVL + lane * 8);
            sk = (blo(w.x) * blo(w.x) + bhi(w.x) * bhi(w.x)) + (blo(w.y) * blo(w.y) + bhi(w.y) * bhi(w.y)) + (blo(w.z) * blo(w.z) + bhi(w.z) * bhi(w.z)) + (blo(w.w) * blo(w.w) + bhi(w.w) * bhi(w.w)); }
        const float rq = 1.0f / sqrtf(wave_sum(sq) * (1.f / QL) + RMS_EPS), rkv = 1.0f / sqrtf(wave_sum(sk) * (1.f / KVL) + RMS_EPS);
        const float p = (float)pos[t];
        float c0, s0, c1, s1;
        { const float a0 = p * inv0, a1 = p * inv1;
          const float n0 = rintf(a0 * 0.15915494309189535f), n1 = rintf(a1 * 0.15915494309189535f);
          float r0 = fmaf(-n0, 6.28318548202514648f, a0); r0 = fmaf(-n0, -1.7484556e-7f, r0);
          float r1 = fmaf(-n1, 6.28318548202514648f, a1); r1 = fmaf(-n1, -1.7484556e-7f, r1);
          r0 *= 0.15915494309189535f; r1 *= 0.15915494309189535f;
          s0 = __builtin_amdgcn_sinf(r0); c0 = __builtin_amdgcn_cosf(r0); s1 = __builtin_amdgcn_sinf(r1); c1 = __builtin_amdgcn_cosf(r1); }
        { const bf16* qp = QR + (size_t)t * 768 + h * QKH;
          const v4u w = *(const v4u*)(qp + 8 * sub); const unsigned wa = *(const unsigned*)(qp + 64 + 2 * sub), wb = *(const unsigned*)(qp + 80 + 2 * sub);
          float x[8] = {blo(w.x), bhi(w.x), blo(w.y), bhi(w.y), blo(w.z), bhi(w.z), blo(w.w), bhi(w.w)};
          float ss = 0.f;
#pragma unroll
          for (int j = 0; j < 8; ++j) { x[j] *= rq; ss += x[j] * x[j]; }
          const float x10 = blo(wa) * rq, x11 = bhi(wa) * rq, x20 = blo(wb) * rq, x21 = bhi(wb) * rq;
          const float y10 = x10 * c0 - x20 * s0, y20 = x10 * s0 + x20 * c0, y11 = x11 * c1 - x21 * s1, y21 = x11 * s1 + x21 * c1;
          ss += (y10 * y10 + y20 * y20) + (y11 * y11 + y21 * y21);
          ss += __shfl_xor(ss, 1); ss += __shfl_xor(ss, 2); ss += __shfl_xor(ss, 4);
          const float rn = 1.0f / sqrtf(ss * (1.f / QKH) + RMS_EPS);
          bf16* qo = Q + (size_t)t * 768 + h * QKH;
          v4u o; o.x = pk2(x[0] * rn * gqn[0], x[1] * rn * gqn[1]); o.y = pk2(x[2] * rn * gqn[2], x[3] * rn * gqn[3]); o.z = pk2(x[4] * rn * gqn[4], x[5] * rn * gqn[5]); o.w = pk2(x[6] * rn * gqn[6], x[7] * rn * gqn[7]);
          *(v4u*)(qo + 8 * sub) = o;
          *(unsigned*)(qo + 64 + 2 * sub) = pk2(y10 * rn * gq10, y11 * rn * gq11);
          *(unsigned*)(qo + 80 + 2 * sub) = pk2(y20 * rn * gq20, y21 * rn * gq21); }
        { const bf16* kp = KVR + (size_t)t * 1024 + h * 128;
          const v4u w = *(const v4u*)(kp + 8 * sub); const v4u wv = *(const v4u*)(kp + 64 + 8 * sub);
          const unsigned wa = *(const unsigned*)(KP + (size_t)t * KPEPW + 2 * sub), wb = *(const unsigned*)(KP + (size_t)t * KPEPW + 16 + 2 * sub);
          float x[8] = {blo(w.x), bhi(w.x), blo(w.y), bhi(w.y), blo(w.z), bhi(w.z), blo(w.w), bhi(w.w)};
          float ss = 0.f;
#pragma unroll
          for (int j = 0; j < 8; ++j) { x[j] *= rkv; ss += x[j] * x[j]; }
          const float x10 = blo(wa), x11 = bhi(wa), x20 = blo(wb), x21 = bhi(wb);
          const float y10 = x10 * c0 - x20 * s0, y20 = x10 * s0 + x20 * c0, y11 = x11 * c1 - x21 * s1, y21 = x11 * s1 + x21 * c1;
          ss += (y10 * y10 + y20 * y20) + (y11 * y11 + y21 * y21);
          ss += __shfl_xor(ss, 1); ss += __shfl_xor(ss, 2); ss += __shfl_xor(ss, 4);
          const float rn = 1.0f / sqrtf(ss * (1.f / QKH) + RMS_EPS);
          bf16* ko = K + (size_t)t * 768 + h * QKH;
          v4u o; o.x = pk2(x[0] * rn * gkn[0], x[1] * rn * gkn[1]); o.y = pk2(x[2] * rn * gkn[2], x[3] * rn * gkn[3]); o.z = pk2(x[4] * rn * gkn[4], x[5] * rn * gkn[5]); o.w = pk2(x[6] * rn * gkn[6], x[7] * rn * gkn[7]);
          *(v4u*)(ko + 8 * sub) = o;
          *(unsigned*)(ko + 64 + 2 * sub) = pk2(y10 * rn * gk10, y11 * rn * gk11);
          *(unsigned*)(ko + 80 + 2 * sub) = pk2(y20 * rn * gk20, y21 * rn * gk21);
          v4u ov; ov.x = pk2(blo(wv.x) * rkv, bhi(wv.x) * rkv); ov.y = pk2(blo(wv.y) * rkv, bhi(wv.y) * rkv); ov.z = pk2(blo(wv.z) * rkv, bhi(wv.z) * rkv); ov.w = pk2(blo(wv.w) * rkv, bhi(wv.w) * rkv);
          *(v4u*)(V + (size_t)t * 512 + h * VHD + 8 * sub) = ov; }
    }
}

__device__ __forceinline__ void ph_attn(Frame& F, unsigned char* lds_generic) {
    const att::bf16* Q = (const att::bf16*)(KWS + WS_Q); const att::bf16* K = (const att::bf16*)(KWS + WS_K); const att::bf16* V = (const att::bf16*)(KWS + WS_VV);
    att::bf16* O = (att::bf16*)(KWS + WS_O);
    for (int u = F.vcu; u < NB * NH * (SEQ / 256); u += F.G) {
        const int bh = u >> 3, qb = u & 7, b = bh >> 3, h = bh & 7;
        __syncthreads();
        att::attn_dense_body(Q + ((size_t)(b * SEQ + qb * 256)) * 768 + h * QKH, K + (size_t)(b * SEQ) * 768 + h * QKH, V + (size_t)(b * SEQ) * 512 + h * VHD,
                             O + ((size_t)(b * SEQ + qb * 256)) * 512 + h * VHD, SEQ, (char*)lds_generic, F.wave);
    }
    __syncthreads();
}

__device__ __forceinline__ unsigned fkey(float f) { const unsigned b = __builtin_bit_cast(unsigned, f); return b ^ ((unsigned)((int)b >> 31) | 0x80000000u); }
__device__ __forceinline__ float funkey(unsigned u) { const unsigned b = u ^ (~(unsigned)((int)u >> 31) | 0x80000000u); return __builtin_bit_cast(float, b); }
__device__ __forceinline__ unsigned umax(unsigned a, unsigned b) { return a > b ? a : b; }
__device__ __forceinline__ unsigned umin(unsigned a, unsigned b) { return a < b ? a : b; }
#define INS16(T, x) do { unsigned _x = (x); _Pragma("unroll") for (int _i = 0; _i < 16; ++_i) { const unsigned _h = umax(T[_i], _x); _x = umin(T[_i], _x); T[_i] = _h; } } while (0)
__device__ __forceinline__ void sort16_desc(unsigned (&a)[16]) {
#pragma unroll
    for (int k = 2; k <= 16; k <<= 1)
#pragma unroll
        for (int j = k >> 1; j > 0; j >>= 1)
#pragma unroll
            for (int i = 0; i < 16; ++i) { const int l = i ^ j;
                if (l > i) { const unsigned hi = umax(a[i], a[l]), lo = umin(a[i], a[l]); if ((i & k) == 0) { a[i] = hi; a[l] = lo; } else { a[i] = lo; a[l] = hi; } } }
}
__device__ __forceinline__ void merge_top16(unsigned (&T)[16], const unsigned (&S)[16]) {
#pragma unroll
    for (int i = 0; i < 16; ++i) T[i] = umax(T[i], S[15 - i]);
#pragma unroll
    for (int j = 8; j > 0; j >>= 1)
#pragma unroll
        for (int i = 0; i < 16; ++i) { const int l = i ^ j; if (l > i) { const unsigned hi = umax(T[i], T[l]), lo = umin(T[i], T[l]); T[i] = hi; T[l] = lo; } }
}

__device__ __forceinline__ void ph_select(Frame& F, int l) {
    const bf16* QP = (const bf16*)(KWS + WS_QP); const bf16* KEYS = (const bf16*)(KWS + WS_W + (size_t)l * W_STRIDE + WO_KEYS);
    const float* SSQ = (const float*)(KWS + WS_SSQ); float* RR = (float*)(KWS + WS_RR); unsigned* EO = (unsigned*)(KWS + WS_E); float* GO = (float*)(KWS + WS_G);
    const int lane = pg8::fresh_lane(), r32 = lane & 31, hi = lane >> 5;
    LAS unsigned* TL = (LAS unsigned*)(F.lds + 65536) + (F.wave * 64 + lane);
    { const bf16* XG2 = (const bf16*)(KWS + WS_XB); unsigned char* XQ = KWS + WS_XQ; float* SX = (float*)(KWS + WS_SX); const float* g2p = (const float*)KIN(16) + (size_t)l * DM + 16 * lane;
      float g2v[16];
#pragma unroll
      for (int j = 0; j < 4; ++j) { const f32x4 gq = *(const f32x4*)(g2p + 4 * j); g2v[4 * j] = gq.x; g2v[4 * j + 1] = gq.y; g2v[4 * j + 2] = gq.z; g2v[4 * j + 3] = gq.w; }
      for (int t0 = F.gw; t0 < MTOK; t0 += 4 * F.NGW) {
          v4u ra[4], rb[4]; float m[4];
#pragma unroll
          for (int u = 0; u < 4; ++u) { const int t = (t0 + u * F.NGW < MTOK) ? t0 + u * F.NGW : t0; ra[u] = *(const v4u*)(XG2 + (size_t)t * DM + 16 * lane); rb[u] = *(const v4u*)(XG2 + (size_t)t * DM + 16 * lane + 8); }
          float xf[4][16];
#pragma unroll
          for (int u = 0; u < 4; ++u) { const v4u a = ra[u], b = rb[u];
              const float x_[16] = {blo(a.x), bhi(a.x), blo(a.y), bhi(a.y), blo(a.z), bhi(a.z), blo(a.w), bhi(a.w), blo(b.x), bhi(b.x), blo(b.y), bhi(b.y), blo(b.z), bhi(b.z), blo(b.w), bhi(b.w)};
              float mm = 0.f;
#pragma unroll
              for (int j = 0; j < 16; ++j) { xf[u][j] = x_[j] * g2v[j]; mm = fmaxf(mm, fabsf(xf[u][j])); }
              m[u] = mm; }
#pragma unroll
          for (int o = 1; o < 64; o <<= 1)
#pragma unroll
              for (int u = 0; u < 4; ++u) m[u] = fmaxf(m[u], __shfl_xor(m[u], o));
#pragma unroll
          for (int u = 0; u < 4; ++u) { const int t = t0 + u * F.NGW; if (t < MTOK) {
              const float inv = m[u] > 0.f ? 127.0f / m[u] : 0.f;
              v4u q;
#define Q4(j) (((unsigned)((int)rintf(xf[u][4 * (j)] * inv) & 255)) | ((unsigned)((int)rintf(xf[u][4 * (j) + 1] * inv) & 255) << 8) | ((unsigned)((int)rintf(xf[u][4 * (j) + 2] * inv) & 255) << 16) | ((unsigned)((int)rintf(xf[u][4 * (j) + 3] * inv) & 255) << 24))
              q.x = Q4(0); q.y = Q4(1); q.z = Q4(2); q.w = Q4(3);
#undef Q4
              *(v4u*)(XQ + (size_t)(lane >> 3) * ((size_t)MTOK * 128) + (size_t)t * 128 + 16 * (lane & 7)) = q;
              if (lane == 0) SX[t] = m[u] * (1.0f / 127.0f); } }
      } }
    const int h = F.vcu & 7, tbg = F.vcu >> 3, ntbg = F.G >> 3;
    { const int tid = F.wave * 64 + lane;
#pragma unroll
      for (int j = 0; j < 8; ++j) { const int idx = tid + 512 * j, p = idx >> 11, n = (idx >> 4) & 127, ch = idx & 15;
          const v4u v = *(const v4u*)(KEYS + ((size_t)(2 * h + p) * 128 + n) * 128 + ch * 8);
          *(LAS v4u*)(F.lds + p * 32768 + n * 256 + ((ch * 16) ^ ((n & 7) << 4))) = v; }
      __syncthreads(); }
    for (int tb = tbg * 8 + F.wave; tb < MTOK / 32; tb += ntbg * 8) {
        const int tok = tb * 32 + r32;
        float ssq = 0.f;
        { const f32x4* sp = (const f32x4*)(SSQ + (size_t)tok * 16);
#pragma unroll
          for (int j = 0; j < 4; ++j) { const f32x4 v = sp[j]; ssq += (v.x + v.y) + (v.z + v.w); } }
        const float rr = 1.0f / sqrtf(ssq * (1.f / DM) + RMS_EPS);
        if (h == 0 && hi == 0) RR[tok] = rr;
        unsigned C[16];
#pragma unroll
        for (int i = 0; i < 16; ++i) C[i] = 0u;
        {
        unsigned T[2][16];
        bf16x8 qfa[2][8];
#pragma unroll
        for (int p = 0; p < 2; ++p) { const bf16* qrow = QP + (size_t)tok * 2048 + (2 * h + p) * 128 + hi * 8;
#pragma unroll
            for (int s = 0; s < 8; ++s) qfa[p][s] = *(const bf16x8*)(qrow + s * 16); }
#pragma unroll
        for (int p = 0; p < 2; ++p) {
            const int hp = 2 * h + p;
            bf16x8 qf[8];
#pragma unroll
            for (int s = 0; s < 8; ++s) qf[s] = qfa[p][s];
#pragma unroll
            for (int i = 0; i < 16; ++i) T[p][i] = 0u;
#pragma unroll 1
            for (int blk = 0; blk < 4; ++blk) {
                f32x16 acc = f32x16{};
                const int n = blk * 32 + r32; const LAS unsigned char* krow = F.lds + p * 32768 + n * 256; const int sw = (n & 7) << 4;
#pragma unroll
                for (int s = 0; s < 8; ++s) { const bf16x8 a = *(const LAS bf16x8*)(krow + ((32 * s + 16 * hi) ^ sw)); acc = __builtin_amdgcn_mfma_f32_32x32x16_bf16(a, qf[s], acc, 0, 0, 0); }
                const int nb = 127 - (blk * 32 + 4 * hi);
                unsigned K[16];
#pragma unroll
                for (int r = 0; r < 16; ++r) K[r] = (fkey(acc[r]) & ~127u) | (unsigned)(nb - ((r & 3) + 8 * (r >> 2)));
                sort16_desc(K); merge_top16(T[p], K);
            }
            unsigned oth[16];
#pragma unroll
            for (int i = 0; i < 16; ++i) oth[i] = (unsigned)__shfl_xor((int)T[p][i], 32);
            merge_top16(T[p], oth);
#pragma unroll
            for (int i = 0; i < 16; ++i) TL[(p * 16 + i) * 512] = T[p][i];
        }
        float s0[16], s1[16];
#pragma unroll
        for (int i = 0; i < 16; ++i) { s0[i] = funkey((T[0][i] & ~127u) | 64u); s1[i] = funkey((T[1][i] & ~127u) | 64u); }
#define CAND(i, j) ((fkey(s0[i] + s1[j]) & ~255u) | (unsigned)((i) * 16 + (j)))
#pragma unroll
        for (int j = 0; j < 16; ++j) C[j] = CAND(0, j);
        { unsigned B[16];
#pragma unroll
          for (int j = 0; j < 8; ++j) B[j] = CAND(1, j);
#pragma unroll
          for (int j = 0; j < 5; ++j) B[8 + j] = CAND(2, j);
#pragma unroll
          for (int j = 0; j < 3; ++j) B[13 + j] = CAND(4, j);
          sort16_desc(B); merge_top16(C, B); }
        { unsigned B[16];
#pragma unroll
          for (int j = 0; j < 4; ++j) B[j] = CAND(3, j);
#pragma unroll
          for (int j = 0; j < 2; ++j) { B[4 + j] = CAND(5, j); B[6 + j] = CAND(6, j); B[8 + j] = CAND(7, j); }
#pragma unroll
          for (int i = 0; i < 6; ++i) B[10 + i] = CAND(8 + i, 0);
          sort16_desc(B); merge_top16(C, B); }
        INS16(C, CAND(14, 0)); INS16(C, CAND(15, 0));
#undef CAND
        }
        float sc[16]; unsigned ex[16];
#pragma unroll
        for (int k = 0; k < 16; ++k) {
            const unsigned code = C[k] & 255u;
            const unsigned a = TL[(code >> 4) * 512], b = TL[(16 + (code & 15u)) * 512];
            ex[k] = (127u - (a & 127u)) * 128u + (127u - (b & 127u));
            sc[k] = funkey((a & ~127u) | 64u) + funkey((b & ~127u) | 64u);
        }
        float smax = sc[0];
#pragma unroll
        for (int k = 1; k < 16; ++k) smax = fmaxf(smax, sc[k]);
        float den = 0.f;
#pragma unroll
        for (int k = 0; k < 16; ++k) { sc[k] = __builtin_amdgcn_exp2f((sc[k] - smax) * rr * 1.4426950408889634f); den += sc[k]; }
        const float iden = 1.0f / den;
        v4u* edst = (v4u*)(EO + (size_t)tok * 128 + h * 16 + hi * 8); f32x4* gdst = (f32x4*)(GO + (size_t)tok * 128 + h * 16 + hi * 8);
#pragma unroll
        for (int k = 0; k < 8; k += 4) {
            unsigned ea[4], eb[4]; float wa[4], wb2[4];
#pragma unroll
            for (int j = 0; j < 4; ++j) { ea[j] = ex[k + j]; eb[j] = ex[8 + k + j]; wa[j] = sc[k + j]; wb2[j] = sc[8 + k + j];
                asm volatile("" : "+v"(ea[j]), "+v"(eb[j]), "+v"(wa[j]), "+v"(wb2[j])); }
            edst[k >> 2] = (v4u){hi ? eb[0] : ea[0], hi ? eb[1] : ea[1], hi ? eb[2] : ea[2], hi ? eb[3] : ea[3]};
            gdst[k >> 2] = (f32x4){(hi ? wb2[0] : wa[0]) * iden, (hi ? wb2[1] : wa[1]) * iden, (hi ? wb2[2] : wa[2]) * iden, (hi ? wb2[3] : wa[3]) * iden};
        }
    }
}

__device__ __forceinline__ float gelu_tanh(float h) {
    const float z = 0.7978845608028654f * (h + 0.044715f * h * h * h);
    return h * __builtin_amdgcn_rcpf(1.0f + __builtin_amdgcn_exp2f(-2.0f * 1.4426950408889634f * z));
}
__device__ __forceinline__ float ub0(unsigned x) { return (float)(x & 0xffu); }
__device__ __forceinline__ float ub1(unsigned x) { return (float)((x >> 8) & 0xffu); }
__device__ __forceinline__ float ub2(unsigned x) { return (float)((x >> 16) & 0xffu); }
__device__ __forceinline__ float ub3(unsigned x) { return (float)(x >> 24); }
#define DPP_I(x, ctrl) __builtin_amdgcn_update_dpp(0, (x), (ctrl), 0xf, 0xf, false)
#define DPP_F(x, ctrl) __builtin_bit_cast(float, __builtin_amdgcn_update_dpp(0, __builtin_bit_cast(int, (x)), (ctrl), 0xf, 0xf, false))
__device__ __forceinline__ void ph_g1(Frame& F, int l) {
    const unsigned char* XQ = KWS + WS_XQ; const unsigned* E = (const unsigned*)(KWS + WS_E); const unsigned char* U = KWS + WS_U + (size_t)l * UV_STRIDE; short* HPI = (short*)(KWS + WS_HPI);
    const int lane = pg8::fresh_lane(), c = lane & 7, q8 = lane >> 3;
    const int G = F.G, bx = blockIdx.x, wave = F.wave;
    const int nit = (8 * (MTOK / 8) - bx + G - 1) / G;
#define G1_IT(i) (bx + (i) * G)
#define G1_TOK(i) ((G1_IT(i) >> 3) * 8 + wave)
#define G1_COFF(i) ((size_t)128 * (G1_IT(i) & 7) + 16 * c)
#define G1_LOADA(XQV, EV, i) do { const size_t t_ = (size_t)G1_TOK(i); XQV = *(const v4u*)(XQ + (size_t)(G1_IT(i) & 7) * ((size_t)MTOK * 128) + t_ * 128 + 16 * c); \
        _Pragma("unroll") for (int j_ = 0; j_ < 4; ++j_) EV[j_] = *(const v4u*)(E + t_ * 128 + q8 * 16 + 4 * j_); } while (0)
#define G1_LOADB(URV, EV, i) do { const size_t co_ = (size_t)(G1_IT(i) & 7) * (NEXP * 128) + 16 * c; _Pragma("unroll") for (int i_ = 0; i_ < 16; ++i_) URV[i_] = *(const v4u*)(U + (size_t)(EV[i_ >> 2][i_ & 3] & (NEXP - 1)) * 128 + co_); } while (0)
#define G1_COMP(URV, XQV, i) do { int p_[16]; \
        _Pragma("unroll") for (int i_ = 0; i_ < 16; ++i_) { \
            int d_ = __builtin_amdgcn_sdot4((int)URV[i_].x, (int)XQV.x, 0, false); d_ = __builtin_amdgcn_sdot4((int)URV[i_].y, (int)XQV.y, d_, false); \
            d_ = __builtin_amdgcn_sdot4((int)URV[i_].z, (int)XQV.z, d_, false); d_ = __builtin_amdgcn_sdot4((int)URV[i_].w, (int)XQV.w, d_, false); \
            d_ += DPP_I(d_, 0xB1); d_ += DPP_I(d_, 0x4E); d_ += DPP_I(d_, 0x141); p_[i_] = d_; } \
        if (c == 0) { v4u* dst_ = (v4u*)(HPI + ((size_t)(G1_IT(i) & 7) * MTOK + G1_TOK(i)) * 128 + q8 * 16);   \
            _Pragma("unroll") for (int j_ = 0; j_ < 2; ++j_) { unsigned w_[4]; \
                _Pragma("unroll") for (int k_ = 0; k_ < 4; ++k_) w_[k_] = ((unsigned)((p_[8 * j_ + 2 * k_] + 32) >> 6) & 0xffffu) | ((unsigned)((p_[8 * j_ + 2 * k_ + 1] + 32) >> 6) << 16); \
                dst_[j_] = (v4u){w_[0], w_[1], w_[2], w_[3]}; } } } while (0)
    v4u xqA, xqB, xqN = (v4u){0u, 0u, 0u, 0u}, eA[4], eB[4], urA[16], urB[16];
    if (nit > 0) G1_LOADA(xqA, eA, 0);
    if (nit > 1) G1_LOADA(xqB, eB, 1);
    if (nit > 0) G1_LOADB(urA, eA, 0);
    for (int i = 0; i < nit; i += 2) {
        if (i + 1 < nit) G1_LOADB(urB, eB, i + 1);
        if (i + 2 < nit) G1_LOADA(xqN, eA, i + 2);
        G1_COMP(urA, xqA, i);
        xqA = xqN;
        if (i + 1 < nit) {
            if (i + 2 < nit) G1_LOADB(urA, eA, i + 2);
            if (i + 3 < nit) G1_LOADA(xqN, eB, i + 3);
            G1_COMP(urB, xqB, i + 1);
            xqB = xqN;
        }
    }
#undef G1_LOADA
#undef G1_LOADB
#undef G1_COMP
}
__device__ __forceinline__ void ph_g1b(Frame& F, int l) {
    const short* HPI = (const short*)(KWS + WS_HPI); const unsigned* E = (const unsigned*)(KWS + WS_E); const float* G = (const float*)(KWS + WS_G);
    const float* RR = (const float*)(KWS + WS_RR); const float* SX = (const float*)(KWS + WS_SX);
    typedef float f32x2s __attribute__((ext_vector_type(2)));
    const f32x2s* SUV = (const f32x2s*)(KWS + WS_SU) + (size_t)l * NEXP;
    unsigned char* WQ = KWS + WS_WF; float* SW = (float*)(KWS + WS_WSUM);
    const int lane = pg8::fresh_lane();
    typedef int i32x2 __attribute__((ext_vector_type(2))); typedef float f32x2 __attribute__((ext_vector_type(2)));
    constexpr int NU = 4;
    for (int t0 = F.gw; t0 < MTOK; t0 += NU * F.NGW) {
        i32x2 isum[NU]; v2u e2[NU]; f32x2 g2[NU]; float hs[NU];
#pragma unroll
        for (int u = 0; u < NU; ++u) { const int t = (t0 + u * F.NGW < MTOK) ? t0 + u * F.NGW : t0;
            hs[u] = RR[t] * SX[t] * 64.0f;
            isum[u] = (i32x2){0, 0};
#pragma unroll
            for (int s = 0; s < 8; ++s) { const int w = *(const int*)(HPI + ((size_t)s * MTOK + t) * 128 + 2 * lane); isum[u].x += (int)(short)(w & 0xffff); isum[u].y += (w >> 16); }
            e2[u] = *(const v2u*)(E + (size_t)t * 128 + 2 * lane); g2[u] = *(const f32x2*)(G + (size_t)t * 128 + 2 * lane); }
        float w0[NU], w1[NU], m[NU];
#pragma unroll
        for (int u = 0; u < NU; ++u) { const unsigned e0 = e2[u].x & (NEXP - 1), e1 = e2[u].y & (NEXP - 1);
            const f32x2s sa = SUV[e0], sb = SUV[e1];
            w0[u] = g2[u].x * gelu_tanh((float)isum[u].x * hs[u] * sa.x) * sa.y; w1[u] = g2[u].y * gelu_tanh((float)isum[u].y * hs[u] * sb.x) * sb.y;
            m[u] = fmaxf(fabsf(w0[u]), fabsf(w1[u])); }
#pragma unroll
        for (int o = 1; o < 64; o <<= 1)
#pragma unroll
            for (int u = 0; u < NU; ++u) m[u] = fmaxf(m[u], __shfl_xor(m[u], o));
#pragma unroll
        for (int u = 0; u < NU; ++u) { const int t = t0 + u * F.NGW; if (t < MTOK) {
            const float inv = m[u] > 0.f ? 127.0f / m[u] : 0.f;
            const unsigned q = ((unsigned)((int)rintf(w0[u] * inv) & 255)) | ((unsigned)((int)rintf(w1[u] * inv) & 255) << 8);
            *(unsigned short*)(WQ + (size_t)t * 128 + 2 * lane) = (unsigned short)q;
            if (lane == 0) SW[t] = m[u] * (1.0f / 127.0f); } }
    }
}
__device__ __forceinline__ void ph_g2(Frame& F, int l, bf16* Xout) {
    const unsigned* E = (const unsigned*)(KWS + WS_E); const unsigned char* WQ = KWS + WS_WF; const float* SW = (const float*)(KWS + WS_WSUM);
    const unsigned char* V = KWS + WS_V + (size_t)l * UV_STRIDE;
    const bf16* X = (const bf16*)(KWS + WS_XB); float* SSQN = (float*)(KWS + WS_SSQN); float* OUTF = KOUT;
    const bool last = (l + 1 >= DEPTH);
    const int lane = pg8::fresh_lane(), c = lane & 7, q8 = lane >> 3;
    const bool b3 = (lane & 8) != 0;
    const int G = F.G, bx = blockIdx.x, wave = F.wave;
    const int nit = (8 * (MTOK / 8) - bx + G - 1) / G;
    typedef float f32x2 __attribute__((ext_vector_type(2)));
#define G2_LOADE(EV, i) do { const size_t t_ = (size_t)G1_TOK(i); _Pragma("unroll") for (int j_ = 0; j_ < 4; ++j_) EV[j_] = *(const v4u*)(E + t_ * 128 + q8 * 16 + 4 * j_); } while (0)
#define G2_LOADW(WV, SWV, i) do { WV = *(const v4u*)(WQ + (size_t)G1_TOK(i) * 128 + q8 * 16); SWV = SW[G1_TOK(i)]; } while (0)
#define G2_LOADB(VRV, XV, EV, i) do { const size_t co_ = (size_t)(G1_IT(i) & 7) * (NEXP * 128) + 16 * c; _Pragma("unroll") for (int i_ = 0; i_ < 16; ++i_) VRV[i_] = *(const v4u*)(V + (size_t)(EV[i_ >> 2][i_ & 3] & (NEXP - 1)) * 128 + co_); \
        XV = *(const unsigned*)(X + (size_t)G1_TOK(i) * DM + (size_t)128 * (G1_IT(i) & 7) + 16 * c + 2 * q8); } while (0)
#define G2_T4(R0, R1, R2, R3, WQW, A0, A1, A2, A3) do { \
        const unsigned t0_ = __builtin_amdgcn_perm((R1), (R0), 0x05010400u), t1_ = __builtin_amdgcn_perm((R1), (R0), 0x07030602u); \
        const unsigned t2_ = __builtin_amdgcn_perm((R3), (R2), 0x05010400u), t3_ = __builtin_amdgcn_perm((R3), (R2), 0x07030602u); \
        A0 = __builtin_amdgcn_sdot4((int)__builtin_amdgcn_perm(t2_, t0_, 0x05040100u), (int)(WQW), A0, false); \
        A1 = __builtin_amdgcn_sdot4((int)__builtin_amdgcn_perm(t2_, t0_, 0x07060302u), (int)(WQW), A1, false); \
        A2 = __builtin_amdgcn_sdot4((int)__builtin_amdgcn_perm(t3_, t1_, 0x05040100u), (int)(WQW), A2, false); \
        A3 = __builtin_amdgcn_sdot4((int)__builtin_amdgcn_perm(t3_, t1_, 0x07060302u), (int)(WQW), A3, false); } while (0)
#define G2_COMP(VRV, XV, WV, SWV, i) do { int acc_[16]; \
        _Pragma("unroll") for (int j_ = 0; j_ < 16; ++j_) acc_[j_] = 0; \
        _Pragma("unroll") for (int m_ = 0; m_ < 4; ++m_) { const unsigned wq_ = WV[m_]; \
            G2_T4(VRV[4 * m_].x, VRV[4 * m_ + 1].x, VRV[4 * m_ + 2].x, VRV[4 * m_ + 3].x, wq_, acc_[0], acc_[1], acc_[2], acc_[3]); \
            G2_T4(VRV[4 * m_].y, VRV[4 * m_ + 1].y, VRV[4 * m_ + 2].y, VRV[4 * m_ + 3].y, wq_, acc_[4], acc_[5], acc_[6], acc_[7]); \
            G2_T4(VRV[4 * m_].z, VRV[4 * m_ + 1].z, VRV[4 * m_ + 2].z, VRV[4 * m_ + 3].z, wq_, acc_[8], acc_[9], acc_[10], acc_[11]); \
            G2_T4(VRV[4 * m_].w, VRV[4 * m_ + 1].w, VRV[4 * m_ + 2].w, VRV[4 * m_ + 3].w, wq_, acc_[12], acc_[13], acc_[14], acc_[15]); } \
        int a8_[8], a4_[4], a2_[2]; \
        _Pragma("unroll") for (int j_ = 0; j_ < 8; ++j_) { auto r_ = __builtin_amdgcn_permlane32_swap((unsigned)acc_[j_], (unsigned)acc_[j_ + 8], false, false); \
            unsigned r0_ = r_[0], r1_ = r_[1]; asm volatile("" : "+v"(r0_), "+v"(r1_)); a8_[j_] = (int)r0_ + (int)r1_; } \
        _Pragma("unroll") for (int j_ = 0; j_ < 4; ++j_) { auto r_ = __builtin_amdgcn_permlane16_swap((unsigned)a8_[j_], (unsigned)a8_[j_ + 4], false, false); \
            unsigned r0_ = r_[0], r1_ = r_[1]; asm volatile("" : "+v"(r0_), "+v"(r1_)); a4_[j_] = (int)r0_ + (int)r1_; } \
        _Pragma("unroll") for (int j_ = 0; j_ < 2; ++j_) { const int keep_ = b3 ? a4_[j_ + 2] : a4_[j_], send_ = b3 ? a4_[j_] : a4_[j_ + 2]; a2_[j_] = keep_ + DPP_I(send_, 0x128); } \
        const int t_ = G1_TOK(i), s_ = G1_IT(i) & 7; const size_t col_ = (size_t)128 * s_ + 16 * c + 2 * q8; \
        const float sw_ = SWV; \
        f32x2 xo_; xo_.x = blo(XV) + (float)a2_[0] * sw_; xo_.y = bhi(XV) + (float)a2_[1] * sw_; \
        if (last) *(f32x2*)(OUTF + (size_t)t_ * DM + col_) = xo_; \
        else { *(unsigned*)(Xout + (size_t)t_ * DM + col_) = pk2(xo_.x, xo_.y); \
            const float ss_ = wave_sum(xo_.x * xo_.x + xo_.y * xo_.y); if (lane == 0) SSQN[(size_t)t_ * 8 + s_] = ss_; } } while (0)
    v4u eA[4], eB[4], vrA[16], vrB[16], wA, wB; unsigned xA, xB; float swA = 0.f, swB = 0.f;
    if (nit > 0) { G2_LOADE(eA, 0); G2_LOADW(wA, swA, 0); }
    if (nit > 1) { G2_LOADE(eB, 1); G2_LOADW(wB, swB, 1); }
    if (nit > 0) G2_LOADB(vrA, xA, eA, 0);
    for (int i = 0; i < nit; i += 2) {
        if (i + 1 < nit) G2_LOADB(vrB, xB, eB, i + 1);
        if (i + 2 < nit) G2_LOADE(eA, i + 2);
        G2_COMP(vrA, xA, wA, swA, i);
        if (i + 2 < nit) G2_LOADW(wA, swA, i + 2);
        if (i + 1 < nit) {
            if (i + 2 < nit) G2_LOADB(vrA, xA, eA, i + 2);
            if (i + 3 < nit) G2_LOADE(eB, i + 3);
            G2_COMP(vrB, xB, wB, swB, i + 1);
            if (i + 3 < nit) G2_LOADW(wB, swB, i + 3);
        }
    }
#undef G2_LOADE
#undef G2_LOADW
#undef G2_LOADB
#undef G2_COMP
#undef G2_T4
#undef G1_IT
#undef G1_TOK
#undef G1_COFF
}

constexpr int PH_PER_LAYER = 11, N_PHASES = 1 + DEPTH * PH_PER_LAYER;
__global__ void __launch_bounds__(NWAVES * 64, 2) fwd_kernel(Args A) {
    extern __shared__ __attribute__((aligned(16))) unsigned char lds[];
    Frame F;
    F.lds = (LAS unsigned char*)lds;
    F.wave = __builtin_amdgcn_readfirstlane((int)threadIdx.x >> 6);
    F.G = gridDim.x; { const int bx = blockIdx.x; F.vcu = (F.G % 8 == 0) ? (bx % 8) * (F.G / 8) + bx / 8 : bx; }
    F.gw = F.vcu * NWAVES + F.wave; F.NGW = F.G * NWAVES;
    cg::grid_group grid = cg::this_grid();
    for (int u = threadIdx.x; u < 64; u += NWAVES * 64) ((LAS unsigned*)(F.lds + 131072))[u + 64] = 0u;
    __syncthreads();
    XcdBarrier bar = xcd_barrier_post((unsigned*)(KWS + WS_CTL), (volatile LAS unsigned*)(F.lds + MISC_OFF) + 8);
    const int lo = karg_int(23 * 8), hi = karg_int(23 * 8 + 4);
#ifndef PH_MASK
#define PH_MASK 0xfff
#endif
#define KIND(k) ((k) == 0 ? 0 : 1 + ((k) - 1) % PH_PER_LAYER)
#define IN(k) (((PH_MASK >> KIND(k)) & 1) && lo <= (k) && (k) < hi)
#define SEAM(k) do { if (IN(k) && IN((k) + 1)) xcd_barrier(bar); } while (0)
#ifndef PROBE_KIND
#define PROBE_KIND (-1)
#endif
#define REPS(kind) for (int rep_ = ((kind) == PROBE_KIND ? 0 : 1); rep_ < 2; ++rep_)
#define REP_SYNC() do { if (rep_ == 0) xcd_barrier(bar); } while (0)
    if (lo < 0) grid.sync();
    if (IN(0)) { REPS(0) { ph_prologue(F); REP_SYNC(); } SEAM(0); }
    for (int l = 0; l < DEPTH; ++l) {
        const int p0 = 1 + l * PH_PER_LAYER;
        if (IN(p0 + 0)) { REPS(1) {
            unsigned char* ws = KWS; unsigned char* wb = ws + WS_W + (size_t)l * W_STRIDE;
            pg8::Gemm g{(const pg8::bf16_t*)(ws + WS_XB), (const pg8::bf16_t*)(wb + WO_WIN), MTOK, INWP, DM}; pg8::StaticOrder S; S.init(MTOK, INWP, F.G, (int)blockIdx.x);
            pg8::EpiIn E{(pg8::bf16_t*)(ws + WS_GATES), (const float*)KIN(14) + (size_t)l * 2048, (pg8::bf16_t*)(ws + WS_CQ), (pg8::bf16_t*)(ws + WS_CKV), (pg8::bf16_t*)(ws + WS_KPEP), (const float*)(ws + WS_SSQN)};
            pg8::gemm_phase<pg8::EpiIn, pg8::StaticOrder, true, true>(F.lds, g, S, E, F.wave);
            { const int nu = MTOK / 256 * (INWP / 256), nfull = nu % F.G;
              if (nfull == 0) convert_tables(l, F.gw, F.NGW);
              else if ((int)blockIdx.x >= nfull) convert_tables(l, ((int)blockIdx.x - nfull) * NWAVES + F.wave, (F.G - nfull) * NWAVES); }
            REP_SYNC(); }
            SEAM(p0 + 0);
        }
        if (IN(p0 + 1)) { REPS(2) {
            unsigned char* ws = KWS; unsigned char* wb = ws + WS_W + (size_t)l * W_STRIDE;
            { pg8::Gemm g{(const pg8::bf16_t*)(ws + WS_CQ), (const pg8::bf16_t*)(wb + WO_WUQ), MTOK, 768, QL}; pg8::StaticOrder S; S.init(MTOK, 768, F.G, (int)blockIdx.x);
              pg8::EpiBf16<0> E{(pg8::bf16_t*)(ws + WS_QRAW), 768, nullptr, 0, 0, 1.f};
              pg8::gemm_phase<pg8::EpiBf16<0>, pg8::StaticOrder, true, true>(F.lds, g, S, E, F.wave); }
            { pg8::Gemm g{(const pg8::bf16_t*)(ws + WS_CKV), (const pg8::bf16_t*)(wb + WO_WUKV), MTOK, 1024, KVL}; pg8::StaticOrder S; S.init(MTOK, 1024, F.G, (int)blockIdx.x);
              pg8::EpiBf16<0> E{(pg8::bf16_t*)(ws + WS_KVRAW), 1024, nullptr, 0, 0, 1.f};
              pg8::gemm_phase<pg8::EpiBf16<0>, pg8::StaticOrder, true, true>(F.lds, g, S, E, F.wave); }
            ph_pool(F);
            REP_SYNC(); }
            SEAM(p0 + 1);
        }
        if (IN(p0 + 2)) { REPS(3) { ph_finalize(F, l); REP_SYNC(); } SEAM(p0 + 2); }
        if (IN(p0 + 3)) { REPS(4) { ph_attn(F, lds); REP_SYNC(); } SEAM(p0 + 3); }
        if (IN(p0 + 4)) { REPS(5) {
            unsigned char* ws = KWS; unsigned char* wb = ws + WS_W + (size_t)l * W_STRIDE;
            { pg8::Gemm g{(const pg8::bf16_t*)(ws + WS_O), (const pg8::bf16_t*)(wb + WO_WO), MTOK, DM, 512}; pg8::StaticOrder S; S.init(MTOK, DM, F.G, (int)blockIdx.x);
              pg8::EpiBf16<0> E{(pg8::bf16_t*)(ws + WS_ABUF), DM, nullptr, 0, 0, 1.f};
              pg8::gemm_phase<pg8::EpiBf16<0>, pg8::StaticOrder, true, true>(F.lds, g, S, E, F.wave); }
            { pg8::Gemm g{(const pg8::bf16_t*)(ws + WS_MIXED), (const pg8::bf16_t*)(wb + WO_WC), MTOK, DM, 512}; pg8::StaticOrder S; S.init(MTOK, DM, F.G, (int)blockIdx.x);
              pg8::EpiMix E{(const pg8::bf16_t*)(ws + WS_ABUF), (const pg8::bf16_t*)(ws + WS_GATES), (pg8::bf16_t*)(ws + WS_MIX)};
              pg8::gemm_phase<pg8::EpiMix, pg8::StaticOrder, true, true>(F.lds, g, S, E, F.wave); }
            REP_SYNC(); }
            SEAM(p0 + 4);
        }
        if (IN(p0 + 5)) { REPS(6) {
            unsigned char* ws = KWS; unsigned char* wb = ws + WS_W + (size_t)l * W_STRIDE;
            pg8::Gemm g{(const pg8::bf16_t*)(ws + WS_MIX), (const pg8::bf16_t*)(wb + WO_WOUT), MTOK, DM, DM}; pg8::StaticOrder S; S.init(MTOK, DM, F.G, (int)blockIdx.x);
            pg8::EpiRes E{(const pg8::bf16_t*)(ws + WS_XB), rep_ == 0 ? (pg8::bf16_t*)(ws + WS_GATES) : (pg8::bf16_t*)(ws + WS_XB), (float*)(ws + WS_SSQ)};
            pg8::gemm_phase<pg8::EpiRes, pg8::StaticOrder, true, true>(F.lds, g, S, E, F.wave);
            REP_SYNC(); }
            SEAM(p0 + 5);
        }
        if (IN(p0 + 6)) { REPS(7) {
            unsigned char* ws = KWS; unsigned char* wb = ws + WS_W + (size_t)l * W_STRIDE;
            pg8::Gemm g{(const pg8::bf16_t*)(ws + WS_XB), (const pg8::bf16_t*)(wb + WO_WQ), MTOK, 2048, DM}; pg8::StaticOrder S; S.init(MTOK, 2048, F.G, (int)blockIdx.x);
            pg8::EpiBf16<0> E{(pg8::bf16_t*)(ws + WS_QP), 2048, nullptr, 0, 0, 1.f};
            pg8::gemm_phase<pg8::EpiBf16<0>, pg8::StaticOrder, true, true>(F.lds, g, S, E, F.wave);
            REP_SYNC(); }
            SEAM(p0 + 6);
        }
        if (IN(p0 + 7)) { REPS(8) { ph_select(F, l); REP_SYNC(); } SEAM(p0 + 7); }
        if (IN(p0 + 8)) { REPS(9) { ph_g1(F, l); REP_SYNC(); } SEAM(p0 + 8); }
        if (IN(p0 + 9)) { REPS(10) { ph_g1b(F, l); REP_SYNC(); } SEAM(p0 + 9); }
        if (IN(p0 + 10)) { REPS(11) { ph_g2(F, l, rep_ == 0 ? (bf16*)(KWS + WS_QP) : (bf16*)(KWS + WS_XB)); REP_SYNC(); } SEAM(p0 + 10); }
    }
#undef IN
#undef SEAM
}

extern "C" void kernel_launch(void* const* d_in, const int* in_sizes, int n_in, void* d_out, int out_size, void* d_ws, size_t ws_size, hipStream_t stream) {
    static int grid = 0;
    if (grid == 0) {
        if (n_in != 21 || in_sizes[0] != MTOK * DM || out_size != MTOK * DM || ws_size < WS_END) {
            fprintf(stderr, "kernel_launch: unexpected shapes: n_in %d in0 %d out %d ws %zu (need %zu)\n", n_in, n_in > 0 ? in_sizes[0] : -1, out_size, ws_size, (size_t)WS_END); grid = -1; return; }
        int dev = 0, cus = 0, per_cu = 0;
        if (hipGetDevice(&dev) != hipSuccess || hipDeviceGetAttribute(&cus, hipDeviceAttributeMultiprocessorCount, dev) != hipSuccess) { grid = -1; return; }
        if (hipFuncSetAttribute((const void*)fwd_kernel, hipFuncAttributeMaxDynamicSharedMemorySize, LDS_BYTES) != hipSuccess) { fprintf(stderr, "kernel_launch: hipFuncSetAttribute failed\n"); grid = -1; return; }
        if (hipOccupancyMaxActiveBlocksPerMultiprocessor(&per_cu, (const void*)fwd_kernel, NWAVES * 64, LDS_BYTES) != hipSuccess || per_cu < 1) { fprintf(stderr, "kernel_launch: occupancy query says %d blocks per CU\n", per_cu); grid = -1; return; }
        (void)hipGetLastError();
        grid = cus & ~7;
    }
    if (grid < 0) return;
    if (hipMemsetAsync((char*)d_ws + WS_CTL, 0, CTL_ZERO_BYTES, stream) != hipSuccess) { fprintf(stderr, "kernel_launch: hipMemsetAsync failed\n"); return; }
    Args a{};
    for (int i = 0; i < 21; ++i) a.in[i] = d_in[i];
    a.out = (float*)d_out; a.ws = (unsigned char*)d_ws;
#if MK_ONE_LAUNCH
    a.ph_lo = 0; a.ph_hi = N_PHASES;
    void* args[] = {&a};
    hipError_t e = hipLaunchCooperativeKernel((const void*)fwd_kernel, dim3(grid), dim3(NWAVES * 64), args, LDS_BYTES, stream);
    if (e != hipSuccess) fprintf(stderr, "kernel_launch: cooperative launch failed: %s (grid %d)\n", hipGetErrorString(e), grid);
#else
    for (int p = 0; p < N_PHASES; ++p) {
        a.ph_lo = p; a.ph_hi = p + 1;
        hipLaunchKernelGGL(fwd_kernel, dim3(grid), dim3(NWAVES * 64), LDS_BYTES, stream, a);
    }
    hipError_t e = hipPeekAtLastError();
    if (e != hipSuccess) fprintf(stderr, "kernel_launch: launch failed: %s\n", hipGetErrorName(e));
#endif
}
```

```cpp
#include <hip/hip_runtime.h>
#include <hip/hip_cooperative_groups.h>
#include <cstdio>
#include <cstdint>
namespace cg = cooperative_groups;
namespace pg8 {
#define PG8_LAS __attribute__((address_space(3)))
typedef unsigned short bf16_t;
typedef short bf16x8 __attribute__((ext_vector_type(8)));
typedef float f32x4 __attribute__((ext_vector_type(4)));
typedef unsigned u32x4 __attribute__((ext_vector_type(4)));
constexpr int BM = 256, BK = 64, HALF = 128, HTB = HALF * BK * 2  , STAGE_BYTES = 8 * HTB, NXCD = 8, WGM = 8;

__host__ __device__ __forceinline__ int lds_byte(int r, int c) { const int st = (r >> 4) * 2 + (c >> 5), rr = r & 15, cc = c & 31, ob = rr * 64 + cc * 2; return st * 1024 + (ob ^ (((ob >> 9) & 1) << 5)); }
__host__ __device__ __forceinline__ void stage_rc(int b, int& R, int& C) { const int st = b / 1024, sb = b % 1024, swz = sb ^ (((sb >> 9) & 1) << 5); R = (st >> 1) * 16 + swz / 64; C = (st & 1) * 32 + (swz % 64) / 2; }
__host__ __device__ __forceinline__ int perm32(int rho) { const int n = rho >> 4, i = rho & 15; return 8 * (i >> 2) + 4 * n + (i & 3); }

struct Unit { int pm, pn; };
struct Gemm { const bf16_t* A; const bf16_t* Bt; int M, N, K; };

struct StaticOrder {
    int nM, nN, nwg, G, c;
    __host__ __device__ void init(int M, int N, int G_, int c_) { nM = M / BM; nN = N / BM; nwg = nM * nN; G = G_; c = c_; }
    __host__ __device__ bool next(int i, Unit& u) const {
        const long L = (long)i * G + c; if (L >= nwg) return false;
        int wgid = (int)L; { const int q = nwg / NXCD, r = nwg % NXCD, xcd = wgid % NXCD, off = wgid / NXCD; wgid = (xcd < r ? xcd * (q + 1) : r * (q + 1) + (xcd - r) * q) + off; }
        const int nig = WGM * nN, gid = wgid / nig, fm = gid * WGM, gsz = (nM - fm) < WGM ? (nM - fm) : WGM;
        u.pm = fm + ((wgid % nig) % gsz); u.pn = (wgid % nig) / gsz; return true;
    }
    __device__ __forceinline__ void a_ready(const Unit&) const {}
    __device__ __forceinline__ void done(const Unit&) const {}
};

__device__ __forceinline__ unsigned cvt_pk_bf16(float lo, float hi) { unsigned r; asm volatile("v_cvt_pk_bf16_f32 %0, %1, %2" : "=v"(r) : "v"(lo), "v"(hi)); return r; }
typedef float f32x2 __attribute__((ext_vector_type(2)));
__device__ __forceinline__ f32x2 gelu_pk(f32x2 v) {
    const f32x2 av = __builtin_elementwise_abs(v), d = av * 0.2316418882f + 1.0f;
    f32x2 t; t.x = __builtin_amdgcn_rcpf(d.x); t.y = __builtin_amdgcn_rcpf(d.y);
    f32x2 q = t * 0.5307027145f + (-0.7265760135f); q = q * t + 0.7107068705f; q = q * t + (-0.142248368f); q = q * t + 0.127414796f; q = q * t;
    const f32x2 s = (v * v) * (-0.72134752044f);
    f32x2 e; e.x = __builtin_amdgcn_exp2f(s.x); e.y = __builtin_amdgcn_exp2f(s.y);
    const f32x2 m = v * (q * e), r = v - m;
    f32x2 o; o.x = v.x < 0.f ? m.x : r.x; o.y = v.y < 0.f ? m.y : r.y; return o;
}

template <int ACT  > struct EpiBf16 {
    static constexpr bool PERM = true, AFTER_DRAIN = false; static_assert(ACT == 0 || ACT == 1, "EpiBf16: ACT is 0 (none) or 1 (gelu_pk)");
    bf16_t* O; int ldc; const float* bias; int split_cols; size_t split_stride; float scale0;
    __device__ __forceinline__ void operator()(const f32x4 (&acc)[2][2][4][2], const Unit& u, int wr, int wc, int fr, int fq) const {
        const int row0 = u.pm * BM + wr * 64 + fr; int colt = u.pn * BM; bf16_t* base = O;
        float sc = 1.f; if (split_cols) { const int t = colt / split_cols; base += (size_t)t * split_stride; colt -= t * split_cols; if (t == 0) sc = scale0; }
        const int col0 = colt + wc * 32 + 8 * fq, bcol0 = u.pn * BM + wc * 32 + 8 * fq;
        f32x4 bv[2][2];
#pragma unroll
        for (int bj = 0; bj < 2; ++bj)
#pragma unroll
            for (int n = 0; n < 2; ++n) bv[bj][n] = bias ? *(const f32x4*)(bias + bcol0 + bj * HALF + 4 * n) : (f32x4){0.f, 0.f, 0.f, 0.f};
#pragma unroll
        for (int ai = 0; ai < 2; ++ai)
#pragma unroll
            for (int m = 0; m < 4; ++m) { bf16_t* rowp = base + (size_t)(row0 + ai * HALF + m * 16) * ldc + col0;
#pragma unroll
                for (int bj = 0; bj < 2; ++bj) { f32x4 v0 = acc[ai][bj][m][0] + bv[bj][0], v1 = acc[ai][bj][m][1] + bv[bj][1];
                    if (ACT == 1) { f32x2 a = gelu_pk((f32x2){v0[0], v0[1]}), b = gelu_pk((f32x2){v0[2], v0[3]}), c = gelu_pk((f32x2){v1[0], v1[1]}), d = gelu_pk((f32x2){v1[2], v1[3]});
                        v0 = (f32x4){a.x, a.y, b.x, b.y}; v1 = (f32x4){c.x, c.y, d.x, d.y}; }
                    v0 = v0 * sc; v1 = v1 * sc; u32x4 w; w.x = cvt_pk_bf16(v0[0], v0[1]); w.y = cvt_pk_bf16(v0[2], v0[3]); w.z = cvt_pk_bf16(v1[0], v1[1]); w.w = cvt_pk_bf16(v1[2], v1[3]);
                    *(u32x4*)(rowp + bj * HALF) = w; } }
    }
};
__device__ __forceinline__ int fresh_lane() { int l; asm volatile("v_mbcnt_lo_u32_b32 %0, -1, 0\n\tv_mbcnt_hi_u32_b32 %0, -1, %0" : "=v"(l)); return l; }
__device__ __forceinline__ float bflo(unsigned w) { return __builtin_bit_cast(float, w << 16); }
__device__ __forceinline__ float bfhi(unsigned w) { return __builtin_bit_cast(float, w & 0xffff0000u); }
__device__ __forceinline__ float sigmoid_f(float x) { return __builtin_amdgcn_rcpf(1.0f + __builtin_amdgcn_exp2f(-1.4426950408889634f * x)); }

struct EpiIn {
    static constexpr bool PERM = true, AFTER_DRAIN = false;
    bf16_t* gates; const float* gbias; bf16_t* cq; bf16_t* ckv; bf16_t* kpep; const float* ssqn; float* ssqc; const int* pos;
    __device__ __forceinline__ void operator()(const f32x4 (&acc)[2][2][4][2], const Unit& u, int wr, int wc, int fr, int fq) const {
        const int row0 = u.pm * BM + wr * 64 + fr;
        float rs[2][4];
#pragma unroll
        for (int ai = 0; ai < 2; ++ai)
#pragma unroll
            for (int m = 0; m < 4; ++m) { const f32x4* sp = (const f32x4*)(ssqn + (size_t)(row0 + ai * HALF + m * 16) * 8); const f32x4 a = sp[0], b = sp[1];
                rs[ai][m] = 1.0f / sqrtf(((a[0] + a[1]) + (a[2] + a[3]) + (b[0] + b[1]) + (b[2] + b[3])) * (1.0f / 1024.0f) + 1e-6f); }
#pragma unroll
        for (int bj = 0; bj < 2; ++bj) {
            const int colw = u.pn * BM + bj * HALF + wc * 32;
            bf16_t* dst; int ld; bool gate = false;
            if (colw < 2048) { dst = gates + colw; ld = 2048; gate = true; }
            else { const int pc = colw - 2048;
                if (pc < 384) { dst = cq + pc; ld = 384; }
                else if (pc < 640) { dst = ckv + (pc - 384); ld = 256; }
                else if (pc < 1184) { dst = kpep + (pc - 640); ld = 544; }
                else continue; }
            dst += 8 * fq;
            f32x4 b0 = (f32x4){0.f, 0.f, 0.f, 0.f}, b1 = b0;
            if (gate) { b0 = *(const f32x4*)(gbias + colw + 8 * fq); b1 = *(const f32x4*)(gbias + colw + 8 * fq + 4); }
#pragma unroll
            for (int ai = 0; ai < 2; ++ai)
#pragma unroll
                for (int m = 0; m < 4; ++m) {
                    f32x4 v0 = acc[ai][bj][m][0] * rs[ai][m] + b0, v1 = acc[ai][bj][m][1] * rs[ai][m] + b1;
                    if (gate) {
#pragma unroll
                        for (int j = 0; j < 4; ++j) { v0[j] = sigmoid_f(v0[j]); v1[j] = sigmoid_f(v1[j]); }
                    }
                    if (gate) {
                        typedef unsigned u32x2g __attribute__((ext_vector_type(2)));
                        u32x2g w;
                        w.x = (unsigned)(v0[0] * 255.0f + 0.5f) | ((unsigned)(v0[1] * 255.0f + 0.5f) << 8) | ((unsigned)(v0[2] * 255.0f + 0.5f) << 16) | ((unsigned)(v0[3] * 255.0f + 0.5f) << 24);
                        w.y = (unsigned)(v1[0] * 255.0f + 0.5f) | ((unsigned)(v1[1] * 255.0f + 0.5f) << 8) | ((unsigned)(v1[2] * 255.0f + 0.5f) << 16) | ((unsigned)(v1[3] * 255.0f + 0.5f) << 24);
                        *(u32x2g*)((unsigned char*)gates + (size_t)(row0 + ai * HALF + m * 16) * 2048 + colw + 8 * fq) = w;
                    } else {
                    const int pc = colw - 2048;
                    if (pc <= 640) {
                        float s = (v0[0] * v0[0] + v0[1] * v0[1]) + (v0[2] * v0[2] + v0[3] * v0[3]) + (v1[0] * v1[0] + v1[1] * v1[1]) + (v1[2] * v1[2] + v1[3] * v1[3]);
                        s += __int_as_float(__builtin_amdgcn_ds_swizzle(__float_as_int(s), 0x401F));
                    { unsigned r0_ = __float_as_uint(s), r1_ = r0_;
#if __has_builtin(__builtin_amdgcn_permlane32_swap)
                      auto r_ = __builtin_amdgcn_permlane32_swap(r0_, r1_, false, false); r0_ = r_[0]; r1_ = r_[1];
#else
                      asm volatile("v_permlane32_swap_b32 %0, %1" : "+v"(r0_), "+v"(r1_));
#endif
                      asm volatile("" : "+v"(r0_), "+v"(r1_));
                      s = __uint_as_float(r0_) + __uint_as_float(r1_); }
                        if (fq == 0) ssqc[(size_t)(row0 + ai * HALF + m * 16) * 24 + (pc >> 5)] = s;
                    }
                    if (pc == 640) {
                        const float p = (float)pos[row0 + ai * HALF + m * 16];
                        float x[8] = {v0[0], v0[1], v0[2], v0[3], v1[0], v1[1], v1[2], v1[3]};
#pragma unroll
                        for (int e8 = 0; e8 < 8; ++e8) {
                            const float other = __shfl_xor(x[e8], 32);
                            const float ang = p * __builtin_amdgcn_exp2f(-(float)(8 * (fq & 1) + e8) * 0.8304820237218406f);
                            const float nn = rintf(ang * 0.15915494309189535f);
                            float r = fmaf(-nn, 6.28318548202514648f, ang); r = fmaf(-nn, -1.7484556e-7f, r); r *= 0.15915494309189535f;
                            const float sn = __builtin_amdgcn_sinf(r), cs = __builtin_amdgcn_cosf(r);
                            x[e8] = (fq < 2) ? x[e8] * cs - other * sn : other * sn + x[e8] * cs;
                        }
                        v0 = (f32x4){x[0], x[1], x[2], x[3]}; v1 = (f32x4){x[4], x[5], x[6], x[7]};
                    }
                    u32x4 w; w.x = cvt_pk_bf16(v0[0], v0[1]); w.y = cvt_pk_bf16(v0[2], v0[3]); w.z = cvt_pk_bf16(v1[0], v1[1]); w.w = cvt_pk_bf16(v1[2], v1[3]);
                    *(u32x4*)(dst + (size_t)(row0 + ai * HALF + m * 16) * ld) = w; }
                }
        }
    }
};

struct EpiKV {
    static constexpr bool PERM = true, AFTER_DRAIN = false;
    bf16_t* K; bf16_t* V; const bf16_t* kpep; const float* ssqc; const float* gk;
    __device__ __forceinline__ void operator()(const f32x4 (&acc)[2][2][4][2], const Unit& u, int wr, int wc, int fr, int fq) const {
        { const int ln = fresh_lane(); fr = ln & 15; fq = ln >> 4; }
        const int row0 = u.pm * BM + wr * 64 + fr, head = 2 * u.pn + (wc >> 1);
        const bool isk = (wc & 1) == 0;
#pragma unroll
        for (int ai = 0; ai < 2; ++ai)
#pragma unroll
            for (int m = 0; m < 4; ++m) {
                __builtin_amdgcn_sched_barrier(0);
                const size_t row = (size_t)(row0 + ai * HALF + m * 16);
                const f32x4* sp = (const f32x4*)(ssqc + row * 24);
                const f32x4 sa = sp[3], sb = sp[4];
                const float rkv = 16.0f * __builtin_amdgcn_rsqf(((sa[0] + sa[1]) + (sa[2] + sa[3]) + (sb[0] + sb[1]) + (sb[2] + sb[3])) + 256e-6f);
                const f32x4 a0 = acc[ai][0][m][0], a1 = acc[ai][0][m][1], b0 = acc[ai][1][m][0], b1 = acc[ai][1][m][1];
                if (isk) {
                    float s = (a0[0] * a0[0] + a0[1] * a0[1]) + (a0[2] * a0[2] + a0[3] * a0[3]) + (a1[0] * a1[0] + a1[1] * a1[1]) + (a1[2] * a1[2] + a1[3] * a1[3])
                            + (b0[0] * b0[0] + b0[1] * b0[1]) + (b0[2] * b0[2] + b0[3] * b0[3]) + (b1[0] * b1[0] + b1[1] * b1[1]) + (b1[2] * b1[2] + b1[3] * b1[3]);
                    s += __int_as_float(__builtin_amdgcn_ds_swizzle(__float_as_int(s), 0x401F));
                    { unsigned r0_ = __float_as_uint(s), r1_ = r0_;
#if __has_builtin(__builtin_amdgcn_permlane32_swap)
                      auto r_ = __builtin_amdgcn_permlane32_swap(r0_, r1_, false, false); r0_ = r_[0]; r1_ = r_[1];
#else
                      asm volatile("v_permlane32_swap_b32 %0, %1" : "+v"(r0_), "+v"(r1_));
#endif
                      asm volatile("" : "+v"(r0_), "+v"(r1_));
                      s = __uint_as_float(r0_) + __uint_as_float(r1_); }
                    const float sspe = ssqc[row * 24 + 20];
                    const float rn = 9.797958971f * __builtin_amdgcn_rsqf((rkv * rkv * s + sspe) + 96e-6f), sc = rkv * rn;
                    bf16_t* kp = K + (row * 8 + head) * 96 + 8 * fq;
                    { asm volatile("" ::: "memory"); const f32x4 ga = *(const f32x4*)(gk + 8 * fq), gb = *(const f32x4*)(gk + 8 * fq + 4);
                      u32x4 w; w.x = cvt_pk_bf16(a0[0] * sc * ga[0], a0[1] * sc * ga[1]); w.y = cvt_pk_bf16(a0[2] * sc * ga[2], a0[3] * sc * ga[3]);
                      w.z = cvt_pk_bf16(a1[0] * sc * gb[0], a1[1] * sc * gb[1]); w.w = cvt_pk_bf16(a1[2] * sc * gb[2], a1[3] * sc * gb[3]);
                      *(u32x4*)(kp) = w; }
                    { asm volatile("" ::: "memory"); const f32x4 ga = *(const f32x4*)(gk + 32 + 8 * fq), gb = *(const f32x4*)(gk + 32 + 8 * fq + 4);
                      u32x4 w; w.x = cvt_pk_bf16(b0[0] * sc * ga[0], b0[1] * sc * ga[1]); w.y = cvt_pk_bf16(b0[2] * sc * ga[2], b0[3] * sc * ga[3]);
                      w.z = cvt_pk_bf16(b1[0] * sc * gb[0], b1[1] * sc * gb[1]); w.w = cvt_pk_bf16(b1[2] * sc * gb[2], b1[3] * sc * gb[3]);
                      *(u32x4*)(kp + 32) = w; }
                    { asm volatile("" ::: "memory"); const f32x4 ga = *(const f32x4*)(gk + 64 + 8 * fq), gb = *(const f32x4*)(gk + 64 + 8 * fq + 4);
                      const u32x4 pe = *(const u32x4*)(kpep + row * 544 + 8 * fq);
                      u32x4 w; w.x = cvt_pk_bf16(bflo(pe.x) * rn * ga[0], bfhi(pe.x) * rn * ga[1]); w.y = cvt_pk_bf16(bflo(pe.y) * rn * ga[2], bfhi(pe.y) * rn * ga[3]);
                      w.z = cvt_pk_bf16(bflo(pe.z) * rn * gb[0], bfhi(pe.z) * rn * gb[1]); w.w = cvt_pk_bf16(bflo(pe.w) * rn * gb[2], bfhi(pe.w) * rn * gb[3]);
                      *(u32x4*)(kp + 64) = w; }
                } else {
                    bf16_t* vp = V + (row * 8 + head) * 64 + 8 * fq;
                    u32x4 w; w.x = cvt_pk_bf16(a0[0] * rkv, a0[1] * rkv); w.y = cvt_pk_bf16(a0[2] * rkv, a0[3] * rkv); w.z = cvt_pk_bf16(a1[0] * rkv, a1[1] * rkv); w.w = cvt_pk_bf16(a1[2] * rkv, a1[3] * rkv);
                    *(u32x4*)(vp) = w;
                    w.x = cvt_pk_bf16(b0[0] * rkv, b0[1] * rkv); w.y = cvt_pk_bf16(b0[2] * rkv, b0[3] * rkv); w.z = cvt_pk_bf16(b1[0] * rkv, b1[1] * rkv); w.w = cvt_pk_bf16(b1[2] * rkv, b1[3] * rkv);
                    *(u32x4*)(vp + 32) = w;
                }
            }
    }
};

struct EpiMix {
    static constexpr bool PERM = true, AFTER_DRAIN = false;
    const bf16_t* a; const bf16_t* gates; bf16_t* mix;
    __device__ __forceinline__ void operator()(const f32x4 (&acc)[2][2][4][2], const Unit& u, int wr, int wc, int fr, int fq) const {
        const int row0 = u.pm * BM + wr * 64 + fr, col0 = u.pn * BM + wc * 32 + 8 * fq;
#pragma unroll
        for (int ai = 0; ai < 2; ++ai)
#pragma unroll
            for (int m = 0; m < 4; ++m) {
                const size_t row = (size_t)(row0 + ai * HALF + m * 16);
#pragma unroll
                for (int bj = 0; bj < 2; ++bj) {
                    const int c = col0 + bj * HALF;
                    const u32x4 av = *(const u32x4*)(a + row * 1024 + c);
                    typedef unsigned u32x2g __attribute__((ext_vector_type(2)));
                    const u32x2g g0 = *(const u32x2g*)((const unsigned char*)gates + row * 2048 + c);
                    const u32x2g g1 = *(const u32x2g*)((const unsigned char*)gates + row * 2048 + 1024 + c);
                    const float k = 1.0f / 255.0f;
                    const f32x4 v0 = acc[ai][bj][m][0] * k, v1 = acc[ai][bj][m][1] * k;
#define GB(W, B) ((float)(((W) >> (8 * (B))) & 0xffu))
                    u32x4 w;
                    w.x = cvt_pk_bf16(GB(g0.x, 0) * k * bflo(av.x) + GB(g1.x, 0) * v0[0], GB(g0.x, 1) * k * bfhi(av.x) + GB(g1.x, 1) * v0[1]);
                    w.y = cvt_pk_bf16(GB(g0.x, 2) * k * bflo(av.y) + GB(g1.x, 2) * v0[2], GB(g0.x, 3) * k * bfhi(av.y) + GB(g1.x, 3) * v0[3]);
                    w.z = cvt_pk_bf16(GB(g0.y, 0) * k * bflo(av.z) + GB(g1.y, 0) * v1[0], GB(g0.y, 1) * k * bfhi(av.z) + GB(g1.y, 1) * v1[1]);
                    w.w = cvt_pk_bf16(GB(g0.y, 2) * k * bflo(av.w) + GB(g1.y, 2) * v1[2], GB(g0.y, 3) * k * bfhi(av.w) + GB(g1.y, 3) * v1[3]);
#undef GB
                    *(u32x4*)(mix + row * 1024 + c) = w;
                }
            }
    }
};

struct EpiRes {
    static constexpr bool PERM = false, AFTER_DRAIN = false;
    const bf16_t* xin; bf16_t* xout; float* ssq;
    __device__ __forceinline__ void operator()(const f32x4 (&acc)[2][2][4][2], const Unit& u, int wr, int wc, int fr, int fq) const {
        const int row0 = u.pm * BM + wr * 64 + fr, col0 = u.pn * BM + wc * 32 + 4 * fq;
        typedef unsigned u32x2 __attribute__((ext_vector_type(2)));
#pragma unroll
        for (int ai = 0; ai < 2; ++ai)
#pragma unroll
            for (int m = 0; m < 4; ++m) {
                const size_t row = (size_t)(row0 + ai * HALF + m * 16); float s = 0.f;
#pragma unroll
                for (int bj = 0; bj < 2; ++bj)
#pragma unroll
                    for (int n = 0; n < 2; ++n) {
                        const size_t off = row * 1024 + col0 + bj * HALF + n * 16;
                        const u32x2 xi = *(const u32x2*)(xin + off);
                        const f32x4 xo = (f32x4){bflo(xi.x), bfhi(xi.x), bflo(xi.y), bfhi(xi.y)} + acc[ai][bj][m][n];
                        s += (xo[0] * xo[0] + xo[1] * xo[1]) + (xo[2] * xo[2] + xo[3] * xo[3]);
                        u32x2 w; w.x = cvt_pk_bf16(xo[0], xo[1]); w.y = cvt_pk_bf16(xo[2], xo[3]);
                        *(u32x2*)(xout + off) = w;
                    }
                s += __int_as_float(__builtin_amdgcn_ds_swizzle(__float_as_int(s), 0x401F));
                    { unsigned r0_ = __float_as_uint(s), r1_ = r0_;
#if __has_builtin(__builtin_amdgcn_permlane32_swap)
                      auto r_ = __builtin_amdgcn_permlane32_swap(r0_, r1_, false, false); r0_ = r_[0]; r1_ = r_[1];
#else
                      asm volatile("v_permlane32_swap_b32 %0, %1" : "+v"(r0_), "+v"(r1_));
#endif
                      asm volatile("" : "+v"(r0_), "+v"(r1_));
                      s = __uint_as_float(r0_) + __uint_as_float(r1_); }
                if (fq == 0) ssq[row * 16 + u.pn * 4 + wc] = s;
            }
    }
};
template <class Epi, class Sched, bool ALIGN_EPI = false, bool SP2 = false>
__device__ __forceinline__ void gemm_phase(PG8_LAS unsigned char* lds, const Gemm g, const Sched& S, const Epi& E, const int wave_id) {
    const int wid = wave_id, lane = fresh_lane(), tid = (wid << 6) | lane, wr = wid >> 2, wc = wid & 3, fr = lane & 15, fq = lane >> 4;
    const int K = g.K, nt = K / BK;
    unsigned voffA[2], voffB[2];
#pragma unroll
    for (int i = 0; i < 2; ++i) { int R, C; stage_rc(tid * 16 + i * 8192, R, C); const int Rb = Epi::PERM ? ((R & ~31) + perm32(R & 31)) : R;
        voffA[i] = (unsigned)(R * K + C) * 2u; voffB[i] = (unsigned)(Rb * K + C) * 2u; }
    const size_t kstep = (size_t)(BK * 2);
    const size_t hstep = (size_t)HALF * K * 2;
    const size_t tstep = 2 * hstep;
    const unsigned ldsw = (unsigned)wid * 1024u;
    const int aoff = lds_byte(wr * 64 + fr, fq * 8), boff = lds_byte(wc * 32 + fr, fq * 8);
#define PG8_SA(b, h) (((b) * 2 + (h)) * HTB)
#define PG8_SB(b, h) ((4 + (b) * 2 + (h)) * HTB)
#define PG8_STAGE(bufoff, gbase, voff) do { _Pragma("unroll") for (int _i = 0; _i < 2; ++_i) \
        __builtin_amdgcn_global_load_lds((const unsigned*)((const char*)(gbase) + (voff)[_i]), (PG8_LAS unsigned*)(lds + (bufoff) + ldsw + _i * 8192), 16, 0, 0); } while (0)
#define PG8_LDA(dst, b, h) do { _Pragma("unroll") for (int m = 0; m < 4; ++m) _Pragma("unroll") for (int k = 0; k < 2; ++k) dst[m][k] = *(const PG8_LAS bf16x8*)(lds + PG8_SA(b, h) + aoff + m * 2048 + k * 1024); } while (0)
#define PG8_LDB(dst, b, h) do { _Pragma("unroll") for (int n = 0; n < 2; ++n) _Pragma("unroll") for (int k = 0; k < 2; ++k) dst[n][k] = *(const PG8_LAS bf16x8*)(lds + PG8_SB(b, h) + boff + n * 2048 + k * 1024); } while (0)
#define PG8_MMA(ai, bj, At, Bt) do { __builtin_amdgcn_s_setprio(1); _Pragma("unroll") for (int m = 0; m < 4; ++m) _Pragma("unroll") for (int n = 0; n < 2; ++n) _Pragma("unroll") for (int k = 0; k < 2; ++k) \
        acc[ai][bj][m][n] = __builtin_amdgcn_mfma_f32_16x16x32_bf16(Bt[n][k], At[m][k], acc[ai][bj][m][n], 0, 0, 0); __builtin_amdgcn_s_setprio(0); } while (0)
#define PG8_WAIT_V(n) asm volatile("s_waitcnt vmcnt(" #n ")" ::: "memory")
#define PG8_WAIT_L(n) asm volatile("s_waitcnt lgkmcnt(" #n ")" ::: "memory")
#define PG8_BAR __builtin_amdgcn_s_barrier()
#define PG8_SCHED __builtin_amdgcn_sched_barrier(0)
    Unit cur, nxt; int ui = 0;
    if (!S.next(0, cur)) return;
    f32x4 acc[2][2][4][2];
#pragma unroll
    for (int a = 0; a < 2; ++a)
#pragma unroll
        for (int b = 0; b < 2; ++b)
#pragma unroll
            for (int m = 0; m < 4; ++m)
#pragma unroll
                for (int n = 0; n < 2; ++n) acc[a][b][m][n] = (f32x4){0.f, 0.f, 0.f, 0.f};
    bf16x8 At[4][2], B0[2][2], B1[2][2];
    const char* cA = (const char*)g.A + (size_t)cur.pm * tstep; const char* cB = (const char*)g.Bt + (size_t)cur.pn * tstep;
    S.a_ready(cur);
    if constexpr (SP2) {
        PG8_STAGE(PG8_SB(0, 0), cB, voffB); PG8_STAGE(PG8_SB(0, 1), cB + hstep, voffB); PG8_STAGE(PG8_SA(0, 0), cA, voffA); PG8_STAGE(PG8_SA(0, 1), cA + hstep, voffA);
        if (wr == 1) PG8_BAR;
        PG8_WAIT_V(2); PG8_BAR;
        PG8_STAGE(PG8_SB(1, 0), cB + kstep, voffB); PG8_STAGE(PG8_SA(1, 0), cA + kstep, voffA); PG8_STAGE(PG8_SB(1, 1), cB + hstep + kstep, voffB);
        PG8_WAIT_V(6); PG8_BAR;
    } else {
        PG8_STAGE(PG8_SB(0, 0), cB, voffB); PG8_STAGE(PG8_SA(0, 0), cA, voffA); PG8_STAGE(PG8_SB(0, 1), cB + hstep, voffB); PG8_STAGE(PG8_SA(0, 1), cA + hstep, voffA);
        if (wr == 1) PG8_BAR;
        PG8_WAIT_V(4); PG8_BAR;
        PG8_STAGE(PG8_SB(1, 0), cB + kstep, voffB); PG8_STAGE(PG8_SA(1, 0), cA + kstep, voffA); PG8_STAGE(PG8_SB(1, 1), cB + hstep + kstep, voffB);
        PG8_WAIT_V(6); PG8_BAR;
    }
    for (;;) {
        const bool has_next = S.next(ui + 1, nxt);
        const char* nA = has_next ? (const char*)g.A + (size_t)nxt.pm * tstep : cA; const char* nB = has_next ? (const char*)g.Bt + (size_t)nxt.pn * tstep : cB;
        for (int t = 0; t < nt; t += 2) {
            const bool last = (t == nt - 2);
            const char* a1 = cA + (size_t)(t + 1) * kstep;
            const char* a2 = last ? nA : cA + (size_t)(t + 2) * kstep; const char* b2 = last ? nB : cB + (size_t)(t + 2) * kstep;
            const char* a3 = a2 + kstep; const char* b3 = b2 + kstep;
            if (last && has_next) S.a_ready(nxt);
            if constexpr (SP2) {
            PG8_LDB(B0, 0, 0); PG8_LDB(B1, 0, 1); PG8_SCHED; PG8_LDA(At, 0, 0); PG8_STAGE(PG8_SA(1, 1), a1 + hstep, voffA);
            PG8_WAIT_V(8); PG8_WAIT_L(0); PG8_BAR; PG8_MMA(0, 0, At, B0); PG8_MMA(0, 1, At, B1); PG8_BAR; PG8_SCHED;
            PG8_LDA(At, 0, 1); PG8_STAGE(PG8_SB(0, 0), b2, voffB); PG8_STAGE(PG8_SB(0, 1), b2 + hstep, voffB); PG8_STAGE(PG8_SA(0, 0), a2, voffA);
            PG8_WAIT_V(8); PG8_WAIT_L(0); PG8_BAR; PG8_MMA(1, 0, At, B0); PG8_MMA(1, 1, At, B1); PG8_BAR; PG8_SCHED;
            PG8_LDB(B0, 1, 0); PG8_LDB(B1, 1, 1); PG8_SCHED; PG8_LDA(At, 1, 0); PG8_STAGE(PG8_SA(0, 1), a2 + hstep, voffA);
            PG8_WAIT_V(8); PG8_WAIT_L(0); PG8_BAR; PG8_MMA(0, 0, At, B0); PG8_MMA(0, 1, At, B1); PG8_BAR; PG8_SCHED;
            PG8_LDA(At, 1, 1); PG8_STAGE(PG8_SB(1, 0), b3, voffB); PG8_STAGE(PG8_SB(1, 1), b3 + hstep, voffB); PG8_STAGE(PG8_SA(1, 0), a3, voffA);
            PG8_WAIT_V(8); PG8_WAIT_L(0); PG8_BAR; PG8_MMA(1, 0, At, B0); PG8_MMA(1, 1, At, B1); PG8_BAR; PG8_SCHED;
            } else {
            PG8_LDB(B0, 0, 0); PG8_SCHED; PG8_LDA(At, 0, 0); PG8_STAGE(PG8_SA(1, 1), a1 + hstep, voffA);
            PG8_WAIT_L(8); PG8_BAR; PG8_WAIT_L(0); PG8_MMA(0, 0, At, B0); PG8_BAR; PG8_SCHED;
            PG8_LDB(B1, 0, 1); PG8_STAGE(PG8_SB(0, 0), b2, voffB);
            PG8_BAR; PG8_WAIT_L(0); PG8_MMA(0, 1, At, B1); PG8_BAR;
            PG8_LDA(At, 0, 1); PG8_STAGE(PG8_SA(0, 0), a2, voffA);
            PG8_BAR; PG8_WAIT_L(0); PG8_MMA(1, 0, At, B0); PG8_BAR; PG8_SCHED;
            PG8_STAGE(PG8_SB(0, 1), b2 + hstep, voffB);
            PG8_WAIT_V(6); PG8_BAR; PG8_MMA(1, 1, At, B1); PG8_BAR;
            PG8_LDB(B0, 1, 0); PG8_SCHED; PG8_LDA(At, 1, 0); PG8_STAGE(PG8_SA(0, 1), a2 + hstep, voffA);
            PG8_WAIT_L(8); PG8_BAR; PG8_WAIT_L(0); PG8_MMA(0, 0, At, B0); PG8_BAR; PG8_SCHED;
            PG8_LDB(B1, 1, 1); PG8_STAGE(PG8_SB(1, 0), b3, voffB);
            PG8_BAR; PG8_WAIT_L(0); PG8_MMA(0, 1, At, B1); PG8_BAR;
            PG8_LDA(At, 1, 1); PG8_STAGE(PG8_SA(1, 0), a3, voffA);
            PG8_BAR; PG8_WAIT_L(0); PG8_MMA(1, 0, At, B0); PG8_BAR; PG8_SCHED;
            PG8_STAGE(PG8_SB(1, 1), b3 + hstep, voffB);
            PG8_WAIT_V(6); PG8_BAR; PG8_MMA(1, 1, At, B1); PG8_BAR;
            }
        }
        if constexpr (ALIGN_EPI) { if (wr == 0) PG8_BAR; }
        if constexpr (!Epi::AFTER_DRAIN) { E(acc, cur, wr, wc, fr, fq); S.done(cur); }
        if (!has_next) break;
#pragma unroll
        for (int a = 0; a < 2; ++a)
#pragma unroll
            for (int b = 0; b < 2; ++b)
#pragma unroll
                for (int m = 0; m < 4; ++m)
#pragma unroll
                    for (int n = 0; n < 2; ++n) acc[a][b][m][n] = (f32x4){0.f, 0.f, 0.f, 0.f};
        cur = nxt; cA = nA; cB = nB; ++ui;
        if constexpr (ALIGN_EPI) { if (wr == 1) PG8_BAR; }
    }
    PG8_WAIT_V(0);
    if constexpr (!ALIGN_EPI) { if (wr == 0) PG8_BAR; }
    PG8_BAR;
    if constexpr (Epi::AFTER_DRAIN) { E.fused(acc, cur, wr, wc, fr, fq, lds, wid, lane); S.done(cur); }
#undef PG8_SA
#undef PG8_SB
#undef PG8_STAGE
#undef PG8_LDA
#undef PG8_LDB
#undef PG8_MMA
#undef PG8_WAIT_V
#undef PG8_WAIT_L
#undef PG8_BAR
#undef PG8_SCHED
}
}
namespace att {
typedef unsigned short bf16;
using bf16x8 = __attribute__((ext_vector_type(8))) short;
using s16x4  = __attribute__((ext_vector_type(4))) short;
using f32x16 = __attribute__((ext_vector_type(16))) float;
using u32x4  = __attribute__((ext_vector_type(4))) unsigned;
constexpr int   DQ = 96, DV = 64, NW = 8, QBLK = 32, KVBLK = 64;
constexpr int   ND0 = DQ / 16;
constexpr int   NDV = DV / 32;
constexpr float SCALE = 0.10206207261596575f;
constexpr float THR = 8.f;
constexpr int   LDQ = 768, LDK = 768, LDV = 512, LDO = 512;
constexpr size_t SHM_V = KVBLK * 128 * 2, SHM_K = KVBLK * 128 * 2, SHM_ATTN = 2 * SHM_V + 2 * SHM_K + NW * 64 * 4;
#define KSWZ(row, colB) ((row) * 256 + ((colB) ^ (((row) & 7) << 4)))
#define SBAR() __builtin_amdgcn_sched_barrier(0)
__device__ __forceinline__ int crow(int r, int hi) { return (r & 3) + 8 * (r >> 2) + 4 * hi; }
__device__ __forceinline__ unsigned cvtpk(float lo, float hi) { unsigned r; asm volatile("v_cvt_pk_bf16_f32 %0, %1, %2" : "=v"(r) : "v"(lo), "v"(hi)); return r; }

__device__ __forceinline__ void partialSM(f32x16& p0, f32x16& p1, float& m_reg, float& mn, float& alpha) {
  constexpr float C = SCALE * 1.4426950408889634f;
  float pmax = p0[0];
#pragma unroll
  for (int r = 1; r < 16; ++r) pmax = fmaxf(pmax, p0[r]);
#pragma unroll
  for (int r = 0; r < 16; ++r) pmax = fmaxf(pmax, p1[r]);
  { auto rr = __builtin_amdgcn_permlane32_swap(__float_as_uint(pmax), __float_as_uint(pmax), false, false);
    pmax = fmaxf(__uint_as_float(rr[0]), __uint_as_float(rr[1])); }
  if (__builtin_expect(__all(pmax - m_reg <= THR / SCALE), 1)) { mn = m_reg; alpha = 1.f; }
  else { mn = fmaxf(m_reg, pmax); alpha = __builtin_amdgcn_exp2f((m_reg - mn) * C); m_reg = mn; }
  float mnC = -mn * C;
#pragma unroll
  for (int r = 0; r < 16; ++r) p0[r] = fmaf(p0[r], C, mnC);
#pragma unroll
  for (int r = 0; r < 16; ++r) p1[r] = fmaf(p1[r], C, mnC);
#pragma unroll
  for (int r = 0; r < 16; ++r) p0[r] = __builtin_amdgcn_exp2f(p0[r]);
}
__device__ __forceinline__ void finishSM(f32x16& p0, f32x16& p1, float alpha, float& l_reg, bf16x8& pa0, bf16x8& pa1, bf16x8& pa2, bf16x8& pa3) {
#pragma unroll
  for (int r = 0; r < 16; ++r) p1[r] = __builtin_amdgcn_exp2f(p1[r]);
  float ps = 0;
#pragma unroll
  for (int r = 0; r < 16; ++r) ps += p0[r];
#pragma unroll
  for (int r = 0; r < 16; ++r) ps += p1[r];
  { auto rr = __builtin_amdgcn_permlane32_swap(__float_as_uint(ps), __float_as_uint(ps), false, false);
    ps = __uint_as_float(rr[0]) + __uint_as_float(rr[1]); }
  l_reg = l_reg * alpha + ps;
#define PK4(P, BASE, OUT) do { unsigned a0 = cvtpk(P[BASE + 0], P[BASE + 1]), a1 = cvtpk(P[BASE + 2], P[BASE + 3]);   \
    unsigned b0 = cvtpk(P[BASE + 4], P[BASE + 5]), b1 = cvtpk(P[BASE + 6], P[BASE + 7]);                              \
    auto r0 = __builtin_amdgcn_permlane32_swap(a0, b0, false, false); auto r1 = __builtin_amdgcn_permlane32_swap(a1, b1, false, false); \
    u32x4 w = {r0[0], r1[0], r0[1], r1[1]}; OUT = *reinterpret_cast<bf16x8*>(&w); } while (0)
  PK4(p0, 0, pa0); PK4(p0, 8, pa1); PK4(p1, 0, pa2); PK4(p1, 8, pa3);
#undef PK4
}
__device__ __forceinline__ void qkt(f32x16& p0, f32x16& p1, const bf16* Ks, const bf16x8* qr, int r32, int hi) {
  p0 = f32x16{}; p1 = f32x16{};
#pragma unroll
  for (int d0 = 0; d0 < ND0; ++d0) { int cb = (d0 * 16 + hi * 8) * 2;
    bf16x8 b0 = *reinterpret_cast<const bf16x8*>((const char*)Ks + KSWZ(r32, cb));
    bf16x8 b1 = *reinterpret_cast<const bf16x8*>((const char*)Ks + KSWZ(32 + r32, cb));
    p0 = __builtin_amdgcn_mfma_f32_32x32x16_bf16(b0, qr[d0], p0, 0, 0, 0);
    p1 = __builtin_amdgcn_mfma_f32_32x32x16_bf16(b1, qr[d0], p1, 0, 0, 0); }
}
__device__ __forceinline__ int v_st(int k, int c) { const int kk = (k & ~0xC) | ((k & 4) << 1) | ((k & 8) >> 1); return ((kk >> 3) * 4 + (c >> 5)) * 512 + ((kk & 7) * 32 + (c & 31)) * 2; }
__device__ __forceinline__ int v_rd_base(int lane) { return ((lane & 3) << 3) | (((lane >> 2) & 3) << 6) | (((lane >> 4) & 1) << 5) | (((lane >> 5) & 1) << 8); }
constexpr int v_rd_off(int d0, int ks, int half) { return d0 * 512 + ks * 4096 + half * 2048; }
template <int OFF> __device__ __forceinline__ s16x4 tr_read(int vb) {
  s16x4 r; asm volatile("ds_read_b64_tr_b16 %0, %1 offset:%2" : "=&v"(r) : "v"(vb), "i"(OFF) : "memory"); return r;
}
template <int D0> __device__ __forceinline__ void pv_one(f32x16& od, int vb, bf16x8 pa0, bf16x8 pa1, bf16x8 pa2, bf16x8 pa3) {
  const s16x4 l0 = tr_read<v_rd_off(D0, 0, 0)>(vb), h0 = tr_read<v_rd_off(D0, 0, 1)>(vb), l1 = tr_read<v_rd_off(D0, 1, 0)>(vb), h1 = tr_read<v_rd_off(D0, 1, 1)>(vb);
  const s16x4 l2 = tr_read<v_rd_off(D0, 2, 0)>(vb), h2 = tr_read<v_rd_off(D0, 2, 1)>(vb), l3 = tr_read<v_rd_off(D0, 3, 0)>(vb), h3 = tr_read<v_rd_off(D0, 3, 1)>(vb);
  asm volatile("s_waitcnt lgkmcnt(0)" ::: "memory"); SBAR();
#define PK(L, H) (bf16x8){L[0], L[1], L[2], L[3], H[0], H[1], H[2], H[3]}
  od = __builtin_amdgcn_mfma_f32_32x32x16_bf16(pa0, PK(l0, h0), od, 0, 0, 0);
  od = __builtin_amdgcn_mfma_f32_32x32x16_bf16(pa1, PK(l1, h1), od, 0, 0, 0);
  od = __builtin_amdgcn_mfma_f32_32x32x16_bf16(pa2, PK(l2, h2), od, 0, 0, 0);
  od = __builtin_amdgcn_mfma_f32_32x32x16_bf16(pa3, PK(l3, h3), od, 0, 0, 0);
#undef PK
}
__device__ __forceinline__ void pv_d0(f32x16* o, int vb, bf16x8 pa0, bf16x8 pa1, bf16x8 pa2, bf16x8 pa3) {
  pv_one<0>(o[0], vb, pa0, pa1, pa2, pa3); pv_one<1>(o[1], vb, pa0, pa1, pa2, pa3);
}

__device__ __forceinline__ void attn_dense_body(const bf16* __restrict__ Qb, const bf16* __restrict__ Kh, const bf16* __restrict__ Vh,
                                                bf16* __restrict__ Ob, int seq, char* lds, const int wave_id) {
  const int wid = wave_id, lane = pg8::fresh_lane(), tid = (wid << 6) | lane, r32 = lane & 31, hi = lane >> 5;
  bf16* V_lds = (bf16*)lds; bf16* K_lds = (bf16*)(lds + 2 * SHM_V);
  float* ws = (float*)(lds + 2 * SHM_V + 2 * SHM_K) + wid * 64; float* li_l = ws; float* al_l = ws + 32;
  float m_reg = -1e30f, l_reg = 0; f32x16 o[NDV] = {}; bf16x8 qr[ND0];
  const bf16* Qw = Qb + (long)(wid * QBLK + r32) * LDQ + hi * 8;
#pragma unroll
  for (int d0 = 0; d0 < ND0; ++d0) qr[d0] = *reinterpret_cast<const bf16x8*>(Qw + d0 * 16);
  const int kr0 = tid / 12, kc0 = tid - kr0 * 12, kr1 = (512 + tid) / 12, kc1 = (512 + tid) - kr1 * 12, vr0 = tid >> 3, vc0 = tid & 7;
  const int kst0 = KSWZ(kr0, kc0 * 16), kst1 = KSWZ(kr1, kc1 * 16), vst0 = v_st(vr0, vc0 * 8);
  const bool k2 = wid < 4;
  const int vb0 = (int)(uintptr_t)V_lds + v_rd_base(lane);
  struct { bf16x8 vs0, ks0, ks1; } sr_[2];
#define SLOAD(i, k0) do { sr_[i].vs0 = *reinterpret_cast<const bf16x8*>(&Vh[(long)((k0) + vr0) * LDV + vc0 * 8]); \
    sr_[i].ks0 = *reinterpret_cast<const bf16x8*>(&Kh[(long)((k0) + kr0) * LDK + kc0 * 8]); \
    if (k2) sr_[i].ks1 = *reinterpret_cast<const bf16x8*>(&Kh[(long)((k0) + kr1) * LDK + kc1 * 8]); } while (0)
#define SWRITE(b, i) do { *(bf16x8*)((char*)V_lds + (b) * SHM_V + vst0) = sr_[i].vs0;          \
    *(bf16x8*)((char*)K_lds + (b) * SHM_K + kst0) = sr_[i].ks0;                       \
    if (k2) *(bf16x8*)((char*)K_lds + (b) * SHM_K + kst1) = sr_[i].ks1; } while (0)
#define SWAIT() do { if (k2) asm volatile("s_waitcnt vmcnt(3)" ::: "memory"); else asm volatile("s_waitcnt vmcnt(2)" ::: "memory"); } while (0)
#define RESC(a) do { if (__any((a) < 1.f)) { if (hi == 0) al_l[r32] = (a); asm volatile("s_waitcnt lgkmcnt(0)" ::: "memory"); \
    _Pragma("unroll") for (int d = 0; d < NDV; ++d) _Pragma("unroll") for (int r = 0; r < 16; ++r) o[d][r] *= al_l[crow(r, hi)]; } } while (0)
  f32x16 pA0, pA1, pB0, pB1; float mnA, mnB, alA, alB; bf16x8 pa0, pa1, pa2, pa3; const int NT = seq / KVBLK;
  constexpr int SE = 0, SO = 1;
  SLOAD(SE, 0); asm volatile("s_waitcnt vmcnt(0)" ::: "memory"); SWRITE(0, SE); __syncthreads();
  qkt(pA0, pA1, K_lds, qr, r32, hi); partialSM(pA0, pA1, m_reg, mnA, alA);
  SLOAD(SO, KVBLK); if (2 < NT) SLOAD(SE, 2 * KVBLK);
  SWAIT(); SWRITE(1, SO); __syncthreads();
  for (int j = 1; j + 1 < NT; j += 2) {
    SBAR(); qkt(pB0, pB1, (bf16*)((char*)K_lds + SHM_K), qr, r32, hi);
    finishSM(pA0, pA1, alA, l_reg, pa0, pa1, pa2, pa3); SBAR();
    SLOAD(SO, (j + 2) * KVBLK); SBAR();
    pv_d0(o, vb0, pa0, pa1, pa2, pa3); partialSM(pB0, pB1, m_reg, mnB, alB);
    __syncthreads(); SWAIT(); SWRITE(0, SE);
    RESC(alB); __syncthreads();
    SBAR(); qkt(pA0, pA1, K_lds, qr, r32, hi);
    finishSM(pB0, pB1, alB, l_reg, pa0, pa1, pa2, pa3); SBAR();
    if (j + 3 < NT) SLOAD(SE, (j + 3) * KVBLK); SBAR();
    pv_d0(o, vb0 + (int)SHM_V, pa0, pa1, pa2, pa3); partialSM(pA0, pA1, m_reg, mnA, alA);
    __syncthreads(); SWAIT(); SWRITE(1, SO);
    RESC(alA); __syncthreads();
  }
  SBAR(); qkt(pB0, pB1, (bf16*)((char*)K_lds + SHM_K), qr, r32, hi);
  finishSM(pA0, pA1, alA, l_reg, pa0, pa1, pa2, pa3); SBAR();
  pv_d0(o, vb0, pa0, pa1, pa2, pa3); partialSM(pB0, pB1, m_reg, mnB, alB);
  __syncthreads(); RESC(alB);
  finishSM(pB0, pB1, alB, l_reg, pa0, pa1, pa2, pa3); SBAR();
  pv_d0(o, vb0 + (int)SHM_V, pa0, pa1, pa2, pa3);
  if (hi == 0) li_l[r32] = l_reg; asm volatile("s_waitcnt lgkmcnt(0)" ::: "memory");
  float rli[16];
#pragma unroll
  for (int r = 0; r < 16; ++r) rli[r] = __builtin_amdgcn_rcpf(li_l[crow(r, hi)]);
  bf16* Ow = Ob + (long)(wid * QBLK) * LDO;
#pragma unroll
  for (int r = 0; r < 16; ++r) { int orow = crow(r, hi);
#pragma unroll
    for (int d0 = 0; d0 < NDV; ++d0) Ow[(long)orow * LDO + d0 * 32 + r32] = (bf16)(cvtpk(o[d0][r] * rli[r], 0.f) & 0xffffu); }
#undef SLOAD
#undef SWRITE
#undef SWAIT
#undef RESC
}
#undef KSWZ
#undef SBAR
}
constexpr int NWAVES = 8;
#ifndef MK_ONE_LAUNCH
#define MK_ONE_LAUNCH 1
#endif
constexpr int NB = 8, SEQ = 2048, DM = 1024, MTOK = NB * SEQ, DEPTH = 2;
constexpr int NH = 8, QL = 384, KVL = 256, NOPE = 64, ROPE = 32, QKH = 96, VHD = 64;
constexpr int PW = 512, INW = 3232, INWP = 3328, KPEPW = 544;
constexpr int NKEY = 128, NEXP = 16384, TOPK = 16;
constexpr float RMS_EPS = 1e-6f;
constexpr size_t MiB = 1u << 20;
constexpr size_t WS_CTL = 0;
constexpr size_t WS_W = 1 * MiB, W_STRIDE = 18 * MiB;
constexpr size_t WO_WIN = 0, WO_WUQ = 6656 * 1024, WO_WUKV = 7424 * 1024, WO_WO = 8 * MiB, WO_WC = 9 * MiB, WO_WOUT = 10 * MiB, WO_WQ = 12 * MiB, WO_KEYS = 16 * MiB;
constexpr size_t WS_U = 40 * MiB, WS_V = 72 * MiB, UV_STRIDE = 16 * MiB;
constexpr size_t WS_SU = 512 * 1024, WS_SV = 768 * 1024, SC_STRIDE = 64 * 1024;
constexpr size_t WS_XB = 168 * MiB;
constexpr size_t WS_GATES = 232 * MiB, WS_QP = 232 * MiB;
constexpr size_t WS_CQ = 296 * MiB, WS_CKV = 308 * MiB, WS_KPEP = 316 * MiB, WS_QRAW = 333 * MiB, WS_KVRAW = 357 * MiB;
constexpr size_t WS_ABUF = 296 * MiB, WS_MIX = 328 * MiB;
constexpr size_t WS_MIXED = 389 * MiB;
constexpr size_t WS_Q = 405 * MiB, WS_K = 429 * MiB, WS_VV = 453 * MiB;
constexpr size_t WS_E = 405 * MiB, WS_G = 413 * MiB, WS_XQ = 429 * MiB, WS_WF = 445 * MiB, WS_HPI = 232 * MiB;
constexpr size_t WS_O = 469 * MiB, WS_SSQ = 485 * MiB, WS_RR = 486 * MiB, WS_SX = WS_RR + 65536, WS_WSUM = WS_RR + 131072, WS_SSQN = WS_RR + 262144, WS_SSQC = 487 * MiB, WS_END = 489 * MiB;
static_assert(WO_WUQ >= (size_t)INWP * DM * 2 && WO_WUKV >= WO_WUQ + 768 * 384 * 2 && WO_WO >= WO_WUKV + 1024 * 256 * 2, "weight map");
static_assert(WS_KPEP + (size_t)MTOK * KPEPW * 2 <= WS_QRAW && WS_QRAW + (size_t)MTOK * 768 * 2 <= WS_KVRAW && WS_KVRAW + (size_t)MTOK * 1024 * 2 <= WS_MIXED, "ws map");

constexpr int LDS_BYTES = 147456;

#define GAS __attribute__((address_space(1)))
#define LAS __attribute__((address_space(3)))
typedef unsigned short bf16;
typedef unsigned v4u __attribute__((ext_vector_type(4)));
typedef unsigned v2u __attribute__((ext_vector_type(2)));
typedef float f32x4 __attribute__((ext_vector_type(4)));
typedef float f32x16 __attribute__((ext_vector_type(16)));
typedef short bf16x8 __attribute__((ext_vector_type(8)));
#define LDS_WAIT() asm volatile("s_waitcnt lgkmcnt(0)" ::: "memory")
__device__ __forceinline__ unsigned f2bf(float f) { unsigned u = __builtin_bit_cast(unsigned, f); return (u + 0x7fffu + ((u >> 16) & 1u)) >> 16; }
__device__ __forceinline__ unsigned pk2(float lo, float hi) { return f2bf(lo) | (f2bf(hi) << 16); }
__device__ __forceinline__ float blo(unsigned w) { return __builtin_bit_cast(float, w << 16); }
__device__ __forceinline__ float bhi(unsigned w) { return __builtin_bit_cast(float, w & 0xffff0000u); }
__device__ __forceinline__ float wave_sum(float v) {
#pragma unroll
    for (int o = 1; o < 64; o <<= 1) v += __shfl_xor(v, o);
    return v;
}

#define XB_TMO      128
#define XB_XCNT(j)  (256  + 64 * (j))
#define XB_XSUB(j)  (1280 + 64 * (j))
#define XB_XGEN(j)  (2304 + 64 * (j))
#define XB_TOP      3328
#define XB_TOPGEN   3392
#define XCD_BAR_WORDS 3456
#define XB_SPIN_CAP (1u << 18)

__device__ __forceinline__ unsigned xb_ld(unsigned* p)              { return __hip_atomic_load(p, __ATOMIC_RELAXED, __HIP_MEMORY_SCOPE_AGENT); }
__device__ __forceinline__ unsigned xb_add(unsigned* p, unsigned v) { return __hip_atomic_fetch_add(p, v, __ATOMIC_RELAXED, __HIP_MEMORY_SCOPE_AGENT); }
__device__ __forceinline__ unsigned xb_xcc_id() { return (unsigned)__builtin_amdgcn_s_getreg((3 << 11) | 20) & 0xFu; }
#define XB_SPIN(cond, bar) do { unsigned _sp = 0; while (cond) { __builtin_amdgcn_s_sleep(1); \
    if ((++_sp & 255u) == 0u) { if (xb_ld(&(bar)[XB_TMO])) break; if (_sp > XB_SPIN_CAP) { atomicAdd(&(bar)[XB_TMO], 1u); break; } } } } while (0)

struct XcdBarrier {
    unsigned* bar; unsigned x;
    volatile LAS unsigned* st;
};

__device__ __forceinline__ XcdBarrier xcd_barrier_post(unsigned* bar, volatile LAS unsigned* st) {
    XcdBarrier b; b.bar = bar; b.x = xb_xcc_id(); b.st = st;
    if (threadIdx.x == 0) (void)xb_add(&bar[XB_XCNT(b.x)], 1u);
    return b;
}
__device__ __forceinline__ void xcd_barrier_complete(unsigned* bar, unsigned x, unsigned& nloc, unsigned& nx) {
    const unsigned G = gridDim.x * gridDim.y * gridDim.z;
    unsigned sum, cnt, mine, sp = 0u;
    for (;;) {
        sum = 0u; cnt = 0u; mine = 0u;
#pragma unroll
        for (unsigned j = 0; j < 16; ++j) { const unsigned c = xb_ld(&bar[XB_XCNT(j)]); sum += c; cnt += (c > 0u) ? 1u : 0u; mine = (j == x) ? c : mine; }
        if (sum == G) break;
        __builtin_amdgcn_s_sleep(1);
        if ((++sp & 255u) == 0u) { if (xb_ld(&bar[XB_TMO])) break; if (sp > XB_SPIN_CAP) { atomicAdd(&bar[XB_TMO], 1u); break; } }
    }
    nloc = mine > 0u ? mine : 1u; nx = cnt > 0u ? cnt : 1u;
}

__device__ __forceinline__ void xcd_barrier(const XcdBarrier& b) {
    asm volatile("s_waitcnt vmcnt(0)" ::: "memory");
    __syncthreads();
    if (threadIdx.x == 0) {
        unsigned* bar = b.bar; unsigned bx_ = b.x;
        asm volatile("" : "+s"(bar), "+s"(bx_));
        __builtin_amdgcn_s_waitcnt(0);
        unsigned nloc = b.st[0], nx = b.st[1];
        if (nloc == 0u) { xcd_barrier_complete(bar, bx_, nloc, nx); b.st[0] = nloc; b.st[1] = nx; }
        const unsigned old = xb_add(&bar[XB_XSUB(bx_)], 1u);
        const unsigned gen = old / nloc;
        if (old + 1u == (gen + 1u) * nloc) {
            __builtin_amdgcn_fence(__ATOMIC_RELEASE, "agent");
            asm volatile("s_waitcnt vmcnt(0)" ::: "memory");
            const unsigned og = xb_add(&bar[XB_TOP], 1u);
            const unsigned tg = og / nx;
            if (og + 1u == (tg + 1u) * nx) xb_add(&bar[XB_TOPGEN], 1u);
            else XB_SPIN(xb_ld(&bar[XB_TOPGEN]) == tg, bar);
            __builtin_amdgcn_fence(__ATOMIC_ACQUIRE, "agent");
            xb_add(&bar[XB_XGEN(bx_)], 1u);
            asm volatile("s_waitcnt vmcnt(0)" ::: "memory");
        } else {
            XB_SPIN(xb_ld(&bar[XB_XGEN(bx_)]) == gen, bar);
            __builtin_amdgcn_fence(__ATOMIC_ACQUIRE, "agent");
            asm volatile("s_waitcnt vmcnt(0)" ::: "memory");
        }
    }
    __syncthreads();
}

constexpr int MISC_OFF = 131072 + 320;
constexpr size_t CTL_ZERO_BYTES = 65536;

struct Args { const void* in[21]; float* out; unsigned char* ws; int ph_lo, ph_hi; };
static_assert(sizeof(Args) == 23 * 8 + 8, "Args has no padding");


typedef const char __attribute__((address_space(4)))* kseg_t;
__device__ __forceinline__ const void* karg_ptr(int i) {
    kseg_t base = (kseg_t)__builtin_amdgcn_kernarg_segment_ptr();
    asm volatile("" : "+s"(base));
    return *(const void* const __attribute__((address_space(4)))*)(base + 8 * i);
}
__device__ __forceinline__ int karg_int(int byte_off) {
    kseg_t base = (kseg_t)__builtin_amdgcn_kernarg_segment_ptr();
    asm volatile("" : "+s"(base));
    return *(const int __attribute__((address_space(4)))*)(base + byte_off);
}
#define KIN(i) karg_ptr(i)
#define KOUT ((float*)karg_ptr(21))
#define KWS ((unsigned char*)karg_ptr(22))

struct Frame {
    LAS unsigned char* lds;
    int wave, vcu, G, gw, NGW, bx;
};
__device__ __forceinline__ Frame fresh_frame(const Frame& F) {
    Frame R = F;
    asm volatile("" : "+s"(R.wave), "+s"(R.vcu), "+s"(R.G), "+s"(R.gw), "+s"(R.NGW), "+s"(R.bx));
    return R;
}

__device__ __forceinline__ void transpose_item(const float* W, int ldw, int n_begin, int nblk, const float* gain, bf16* WT, int K, int row_off, LAS float* scr, int item, int lane, int permkv = 0) {
    const int kb = item / nblk, nb = item % nblk, k0 = 64 * kb, n0 = 32 * nb;
    const int nd0 = permkv ? 256 * (n0 >> 8) + 128 * ((n0 >> 5) & 1) + 32 * (2 * ((n0 >> 7) & 1) + ((n0 >> 6) & 1)) : n0;
    float tv[32];
#pragma unroll
    for (int i = 0; i < 32; ++i) tv[i] = W[(size_t)(k0 + 2 * i + (lane >> 5)) * ldw + n_begin + n0 + (lane & 31)];
    if (gain) {
#pragma unroll
        for (int i = 0; i < 32; ++i) tv[i] *= gain[k0 + 2 * i + (lane >> 5)]; }
#pragma unroll
    for (int i = 0; i < 32; ++i) scr[(2 * i + (lane >> 5)) * 33 + (lane & 31)] = tv[i];
    LDS_WAIT(); asm volatile("" ::: "memory");
    const int c = lane & 7;
#pragma unroll
    for (int j = 0; j < 4; ++j) { const int n = (lane >> 3) + 8 * j; const LAS float* s = scr + (8 * c) * 33 + n;
        v4u o; o.x = pk2(s[0 * 33], s[1 * 33]); o.y = pk2(s[2 * 33], s[3 * 33]); o.z = pk2(s[4 * 33], s[5 * 33]); o.w = pk2(s[6 * 33], s[7 * 33]);
        *(GAS v4u*)(WT + (size_t)(row_off + nd0 + n) * K + k0 + 8 * c) = o; }
    LDS_WAIT(); asm volatile("" ::: "memory");
}
__device__ __forceinline__ void rms_row_to_bf16(const float* xrow, const float* g, bf16* orow, int lane) {
    const f32x4* xr = (const f32x4*)xrow + lane; const f32x4* gr = (const f32x4*)g + lane;
    f32x4 v[4]; float s = 0.f;
#pragma unroll
    for (int j = 0; j < 4; ++j) { v[j] = xr[64 * j]; s += (v[j].x * v[j].x + v[j].y * v[j].y) + (v[j].z * v[j].z + v[j].w * v[j].w); }
    const float r = 1.0f / sqrtf(wave_sum(s) * (1.f / DM) + RMS_EPS);
    v2u* o8 = (v2u*)orow + lane;
#pragma unroll
    for (int j = 0; j < 4; ++j) { const f32x4 gv = gr[64 * j]; v2u w; w.x = pk2(v[j].x * r * gv.x, v[j].y * r * gv.y); w.y = pk2(v[j].z * r * gv.z, v[j].w * r * gv.w); o8[64 * j] = w; }
}
__device__ __forceinline__ void cvt8(const float* src, bf16* dst, size_t i8) {
    const f32x4 a = *(const f32x4*)(src + i8 * 8), b = *(const f32x4*)(src + i8 * 8 + 4);
    v4u o; o.x = pk2(a.x, a.y); o.y = pk2(a.z, a.w); o.z = pk2(b.x, b.y); o.w = pk2(b.z, b.w);
    *(v4u*)(dst + i8 * 8) = o;
}

__device__ __forceinline__ void convert_tables(int l, int cw, int ncw) {
    const int lane = pg8::fresh_lane();
    constexpr int NR = 8;
    for (int it0 = cw * NR; it0 < 2 * NEXP; it0 += ncw * NR) {
        f32x4 va[NR][4]; float m[NR];
#pragma unroll
        for (int r = 0; r < NR; ++r) { const int it = it0 + r, tab = it / NEXP, row = l * NEXP + it % NEXP;
            const f32x4* src = (const f32x4*)((const float*)(tab ? KIN(20) : KIN(19)) + (size_t)row * DM) + lane;
#pragma unroll
            for (int j = 0; j < 4; ++j) va[r][j] = __builtin_nontemporal_load(src + 64 * j); }
#pragma unroll
        for (int r = 0; r < NR; ++r) { float mm = 0.f;
#pragma unroll
            for (int j = 0; j < 4; ++j) mm = fmaxf(mm, fmaxf(fmaxf(fabsf(va[r][j].x), fabsf(va[r][j].y)), fmaxf(fabsf(va[r][j].z), fabsf(va[r][j].w))));
            m[r] = mm; }
#pragma unroll
        for (int o = 1; o < 64; o <<= 1)
#pragma unroll
            for (int r = 0; r < NR; ++r) m[r] = fmaxf(m[r], __shfl_xor(m[r], o));
#pragma unroll
        for (int r = 0; r < NR; ++r) { const int it = it0 + r, tab = it / NEXP, row = l * NEXP + it % NEXP;
            const float inv = m[r] > 0.f ? 127.0f / m[r] : 0.f;
#define Q8(x) ((unsigned)((int)rintf((x) * inv) & 255))
            unsigned char* dstb = KWS + (tab ? WS_V : WS_U) + (size_t)l * UV_STRIDE + (size_t)(it % NEXP) * 128 + ((4 * lane) & 127);
#pragma unroll
            for (int j = 0; j < 4; ++j) *(unsigned*)(dstb + (size_t)(2 * j + (lane >> 5)) * (NEXP * 128)) = Q8(va[r][j].x) | (Q8(va[r][j].y) << 8) | (Q8(va[r][j].z) << 16) | (Q8(va[r][j].w) << 24);
#undef Q8
            if (lane == 0) ((float*)(KWS + WS_SU))[2 * row + tab] = m[r] * (1.0f / 127.0f); }
    }
}

__device__ __forceinline__ void ph_prologue(Frame& F) {
    LAS float* scr = (LAS float*)(F.lds + F.wave * 16384);
    const int gw = F.gw, NGW = F.NGW, lane = pg8::fresh_lane();
    constexpr int I_G = 16 * 64, I_P = 16 * 37, I_UQ = 6 * 24, I_UKV = 4 * 32, I_O = 8 * 32, I_OUT = 16 * 32, I_WQ = 16 * 64;
    constexpr int I_L = I_G + I_P + I_UQ + I_UKV + I_O + I_OUT + I_WQ;
    for (int it = gw; it < DEPTH * I_L; it += NGW) {
        const int l = it / I_L; int r = it % I_L;
        unsigned char* wb = KWS + WS_W + (size_t)l * W_STRIDE;
        const float* w_in = (const float*)KIN(3) + (size_t)l * DM * INW;
        const float* g1 = (const float*)KIN(2) + (size_t)l * DM;
        if (r < I_G) { transpose_item(w_in, INW, 1184, 64, g1, (bf16*)(wb + WO_WIN), DM, 0, scr, r, lane); continue; } r -= I_G;
        if (r < I_P) { transpose_item(w_in, INW, 0, 37, g1, (bf16*)(wb + WO_WIN), DM, 2048, scr, r, lane); continue; } r -= I_P;
        if (r < I_UQ) { transpose_item((const float*)KIN(6) + (size_t)l * QL * 768, 768, 0, 24, (const float*)KIN(4) + l * QL, (bf16*)(wb + WO_WUQ), QL, 0, scr, r, lane); continue; } r -= I_UQ;
        if (r < I_UKV) { transpose_item((const float*)KIN(7) + (size_t)l * KVL * 1024, 1024, 0, 32, (const float*)KIN(5) + l * KVL, (bf16*)(wb + WO_WUKV), KVL, 0, scr, r, lane, 1); continue; } r -= I_UKV;
        if (r < I_O) { transpose_item((const float*)KIN(10) + (size_t)l * 512 * DM, DM, 0, 32, nullptr, (bf16*)(wb + WO_WO), 512, 0, scr, r, lane); continue; } r -= I_O;
        if (r < I_OUT) { transpose_item((const float*)KIN(15) + (size_t)l * DM * DM, DM, 0, 32, nullptr, (bf16*)(wb + WO_WOUT), DM, 0, scr, r, lane); continue; } r -= I_OUT;
        transpose_item((const float*)KIN(17) + (size_t)l * DM * 2048, 2048, 0, 64, (const float*)KIN(16) + (size_t)l * DM, (bf16*)(wb + WO_WQ), DM, 0, scr, r, lane);
    }
    for (int i = gw * 64 + lane; i < DEPTH * 96 * DM / 8; i += NGW * 64) {
        const int l = i / (96 * DM / 8), r = i % (96 * DM / 8);
        *(v4u*)((bf16*)(KWS + WS_W + (size_t)l * W_STRIDE + WO_WIN) + (size_t)INW * DM + (size_t)r * 8) = (v4u){0u, 0u, 0u, 0u};
    }
    for (int it = gw; it < DEPTH * 16 * 32; it += NGW) {
        const int l = it >> 9, cb = (it >> 5) & 15, db = it & 31, g = cb >> 2, r32 = lane & 31, hi = lane >> 5;
        const float* pw = (const float*)KIN(11) + (size_t)l * 4 * 128 * 128 + (size_t)(cb * 32 + r32) * 128 + 64 * hi;
        const float* ps = (const float*)KIN(12) + (size_t)l * 512 + g * 128 + 64 * hi;
        const float* wp = (const float*)KIN(13) + (size_t)l * 512 * DM + (size_t)(g * 128 + 64 * hi) * DM + db * 32 + r32;
        float av[64], bv[64];
#pragma unroll
        for (int j = 0; j < 16; ++j) { const f32x4 v = *(const f32x4*)(pw + 4 * j); av[4 * j] = v.x; av[4 * j + 1] = v.y; av[4 * j + 2] = v.z; av[4 * j + 3] = v.w; }
#pragma unroll
        for (int j = 0; j < 64; ++j) bv[j] = wp[(size_t)j * DM];
#pragma unroll
        for (int j = 0; j < 16; ++j) { const f32x4 s4 = *(const f32x4*)(ps + 4 * j); bv[4 * j] *= s4.x; bv[4 * j + 1] *= s4.y; bv[4 * j + 2] *= s4.z; bv[4 * j + 3] *= s4.w; }
        f32x16 acc = f32x16{};
#pragma unroll
        for (int s = 0; s < 64; ++s) acc = __builtin_amdgcn_mfma_f32_32x32x2f32(av[s], bv[s], acc, 0, 0, 0);
        bf16* dst = (bf16*)(KWS + WS_W + (size_t)l * W_STRIDE + WO_WC) + (size_t)(db * 32 + r32) * 512 + cb * 32 + 4 * hi;
#pragma unroll
        for (int q = 0; q < 4; ++q) { v2u o; o.x = pk2(acc[4 * q], acc[4 * q + 1]); o.y = pk2(acc[4 * q + 2], acc[4 * q + 3]); *(v2u*)(dst + 8 * q) = o; }
    }
    for (int i = gw * 64 + lane; i < DEPTH * 16 * 128 * 128 / 8; i += NGW * 64) {
        const int l = i / (16 * 128 * 128 / 8), r = i % (16 * 128 * 128 / 8);
        cvt8((const float*)KIN(18) + (size_t)l * 16 * 128 * 128, (bf16*)(KWS + WS_W + (size_t)l * W_STRIDE + WO_KEYS), (size_t)r);
    }
    for (int m0 = gw; m0 < MTOK; m0 += 2 * NGW) {
        f32x4 v[2][4]; float s[2];
#pragma unroll
        for (int u = 0; u < 2; ++u) { const int m = (m0 + u * NGW < MTOK) ? m0 + u * NGW : m0; const f32x4* xr = (const f32x4*)((const float*)KIN(0) + (size_t)m * DM) + lane;
#pragma unroll
            for (int j = 0; j < 4; ++j) v[u][j] = xr[64 * j]; }
#pragma unroll
        for (int u = 0; u < 2; ++u) { float ss = 0.f;
#pragma unroll
            for (int j = 0; j < 4; ++j) ss += (v[u][j].x * v[u][j].x + v[u][j].y * v[u][j].y) + (v[u][j].z * v[u][j].z + v[u][j].w * v[u][j].w);
            s[u] = ss; }
#pragma unroll
        for (int o = 1; o < 64; o <<= 1) { s[0] += __shfl_xor(s[0], o); s[1] += __shfl_xor(s[1], o); }
#pragma unroll
        for (int u = 0; u < 2; ++u) { const int m = m0 + u * NGW; if (m < MTOK) {
            v2u* o8 = (v2u*)((bf16*)(KWS + WS_XB) + (size_t)m * DM) + lane;
#pragma unroll
            for (int j = 0; j < 4; ++j) { v2u w; w.x = pk2(v[u][j].x, v[u][j].y); w.y = pk2(v[u][j].z, v[u][j].w); o8[64 * j] = w; }
            if (lane == 0) { f32x4* sp = (f32x4*)((float*)(KWS + WS_SSQN) + (size_t)m * 8); sp[0] = (f32x4){s[u], 0.f, 0.f, 0.f}; sp[1] = (f32x4){0.f, 0.f, 0.f, 0.f}; } } }
    }
}

__device__ __forceinline__ void ph_pool(Frame& F, int cw, int ncw) {
    const bf16* KP = (const bf16*)(KWS + WS_KPEP); bf16* MX = (bf16*)(KWS + WS_MIXED);
    const int lane = pg8::fresh_lane(), g = lane >> 4, half = 1 << g, c0 = lane * 8;
#define POOL_ACC(W, SGN) do { sum[0] += SGN blo(W.x); sum[1] += SGN bhi(W.x); sum[2] += SGN blo(W.y); sum[3] += SGN bhi(W.y); sum[4] += SGN blo(W.z); sum[5] += SGN bhi(W.z); sum[6] += SGN blo(W.w); sum[7] += SGN bhi(W.w); } while (0)
    for (int run = cw; run < MTOK / 8; run += ncw) {
        const int t0 = run * 8, s0 = t0 & (SEQ - 1);
        v4u row[23];
#pragma unroll
        for (int k = 0; k < 23; ++k) { const int d = k - 8; const bool ok = (d >= -half) && (d < 8 + half - 1 + 1) && (s0 + d >= 0) && (s0 + d < SEQ);
            row[k] = ok ? *(const v4u*)(KP + (size_t)(t0 + d) * KPEPW + 32 + c0) : (v4u){0u, 0u, 0u, 0u}; }
        float sum[8];
#pragma unroll
        for (int j = 0; j < 8; ++j) sum[j] = 0.f;
        int cnt = 0;
#pragma unroll
        for (int d = -8; d < 8; ++d) { const bool ok = (d >= -half) && (d < half) && (s0 + d >= 0) && (s0 + d < SEQ); if (ok) { POOL_ACC(row[d + 8], +); ++cnt; } }
#pragma unroll
        for (int i = 0; i < 8; ++i) {
            const int t = t0 + i, s = s0 + i;
            if (i > 0) {
                const bool lv_ok = (s - 1 - half >= 0), ev_ok = (s + half - 1 < SEQ);
#define POOL_CASE(H) do { if (half == (H)) { if ((i - 1 - (H) + 8) >= 0) { if (lv_ok) { POOL_ACC(row[(i - 1 - (H) + 8) >= 0 ? (i - 1 - (H) + 8) : 0], -); } } if (ev_ok) { POOL_ACC(row[i + (H) - 1 + 8], +); } } } while (0)
                POOL_CASE(1); POOL_CASE(2); POOL_CASE(4); POOL_CASE(8);
#undef POOL_CASE
                if (lv_ok) --cnt;
                if (ev_ok) ++cnt;
            }
            const v4u me = row[i + 8];
            const float ic = 1.0f / (float)cnt;
            v4u o; o.x = pk2(sum[0] * ic - blo(me.x), sum[1] * ic - bhi(me.x)); o.y = pk2(sum[2] * ic - blo(me.y), sum[3] * ic - bhi(me.y));
            o.z = pk2(sum[4] * ic - blo(me.z), sum[5] * ic - bhi(me.z)); o.w = pk2(sum[6] * ic - blo(me.w), sum[7] * ic - bhi(me.w));
            *(v4u*)(MX + (size_t)t * PW + c0) = o;
        }
    }
#undef POOL_ACC
}

__device__ __forceinline__ void ph_finalize(Frame& F, int l) {
    const bf16* QR = (const bf16*)(KWS + WS_QRAW); const float* SSQC = (const float*)(KWS + WS_SSQC);
    bf16* Q = (bf16*)(KWS + WS_Q);
    const int* pos = (const int*)KIN(1);
    const float* ghq = (const float*)KIN(8) + l * QKH;
    const int lane = pg8::fresh_lane(), h = lane >> 3, sub = lane & 7;
    const float inv0 = __builtin_amdgcn_exp2f(-(float)(2 * sub) * 0.8304820237218406f), inv1 = __builtin_amdgcn_exp2f(-(float)(2 * sub + 1) * 0.8304820237218406f);
    float gqn[8];
#pragma unroll
    for (int j = 0; j < 8; ++j) gqn[j] = ghq[8 * sub + j];
    const float gq10 = ghq[64 + 2 * sub], gq11 = ghq[65 + 2 * sub], gq20 = ghq[80 + 2 * sub], gq21 = ghq[81 + 2 * sub];
    for (int t = F.gw; t < MTOK; t += F.NGW) {
        const f32x4* sp = (const f32x4*)(SSQC + (size_t)t * 24); const f32x4 sa = sp[0], sb = sp[1], sc = sp[2];
        const float rq = 1.0f / sqrtf(((sa.x + sa.y) + (sa.z + sa.w) + (sb.x + sb.y) + (sb.z + sb.w) + (sc.x + sc.y) + (sc.z + sc.w)) * (1.f / QL) + RMS_EPS);
        const float p = (float)pos[t];
        float c0, s0, c1, s1;
        { const float a0 = p * inv0, a1 = p * inv1;
          const float n0 = rintf(a0 * 0.15915494309189535f), n1 = rintf(a1 * 0.15915494309189535f);
          float r0 = fmaf(-n0, 6.28318548202514648f, a0); r0 = fmaf(-n0, -1.7484556e-7f, r0);
          float r1 = fmaf(-n1, 6.28318548202514648f, a1); r1 = fmaf(-n1, -1.7484556e-7f, r1);
          r0 *= 0.15915494309189535f; r1 *= 0.15915494309189535f;
          s0 = __builtin_amdgcn_sinf(r0); c0 = __builtin_amdgcn_cosf(r0); s1 = __builtin_amdgcn_sinf(r1); c1 = __builtin_amdgcn_cosf(r1); }
        { const bf16* qp = QR + (size_t)t * 768 + h * QKH;
          const v4u w = *(const v4u*)(qp + 8 * sub); const unsigned wa = *(const unsigned*)(qp + 64 + 2 * sub), wb = *(const unsigned*)(qp + 80 + 2 * sub);
          float x[8] = {blo(w.x), bhi(w.x), blo(w.y), bhi(w.y), blo(w.z), bhi(w.z), blo(w.w), bhi(w.w)};
          float ss = 0.f;
#pragma unroll
          for (int j = 0; j < 8; ++j) { x[j] *= rq; ss += x[j] * x[j]; }
          const float x10 = blo(wa) * rq, x11 = bhi(wa) * rq, x20 = blo(wb) * rq, x21 = bhi(wb) * rq;
          const float y10 = x10 * c0 - x20 * s0, y20 = x10 * s0 + x20 * c0, y11 = x11 * c1 - x21 * s1, y21 = x11 * s1 + x21 * c1;
          ss += (y10 * y10 + y20 * y20) + (y11 * y11 + y21 * y21);
          ss += __shfl_xor(ss, 1); ss += __shfl_xor(ss, 2); ss += __shfl_xor(ss, 4);
          const float rn = 1.0f / sqrtf(ss * (1.f / QKH) + RMS_EPS);
          bf16* qo = Q + (size_t)t * 768 + h * QKH;
          v4u o; o.x = pk2(x[0] * rn * gqn[0], x[1] * rn * gqn[1]); o.y = pk2(x[2] * rn * gqn[2], x[3] * rn * gqn[3]); o.z = pk2(x[4] * rn * gqn[4], x[5] * rn * gqn[5]); o.w = pk2(x[6] * rn * gqn[6], x[7] * rn * gqn[7]);
          *(v4u*)(qo + 8 * sub) = o;
          *(unsigned*)(qo + 64 + 2 * sub) = pk2(y10 * rn * gq10, y11 * rn * gq11);
          *(unsigned*)(qo + 80 + 2 * sub) = pk2(y20 * rn * gq20, y21 * rn * gq21); }
    }
}

__device__ __forceinline__ void ph_attn(Frame& F, unsigned char* lds_generic) {
    const att::bf16* Q = (const att::bf16*)(KWS + WS_Q); const att::bf16* K = (const att::bf16*)(KWS + WS_K); const att::bf16* V = (const att::bf16*)(KWS + WS_VV);
    att::bf16* O = (att::bf16*)(KWS + WS_O);
    for (int u = F.vcu; u < NB * NH * (SEQ / 256); u += F.G) {
        const int bh = u >> 3, qb = u & 7, b = bh >> 3, h = bh & 7;
        __syncthreads();
        att::attn_dense_body(Q + ((size_t)(b * SEQ + qb * 256)) * 768 + h * QKH, K + (size_t)(b * SEQ) * 768 + h * QKH, V + (size_t)(b * SEQ) * 512 + h * VHD,
                             O + ((size_t)(b * SEQ + qb * 256)) * 512 + h * VHD, SEQ, (char*)lds_generic, F.wave);
    }
    __syncthreads();
}

__device__ __forceinline__ unsigned fkey(float f) { const unsigned b = __builtin_bit_cast(unsigned, f); return b ^ ((unsigned)((int)b >> 31) | 0x80000000u); }
__device__ __forceinline__ float funkey(unsigned u) { const unsigned b = u ^ (~(unsigned)((int)u >> 31) | 0x80000000u); return __builtin_bit_cast(float, b); }
__device__ __forceinline__ unsigned umax(unsigned a, unsigned b) { return a > b ? a : b; }
__device__ __forceinline__ unsigned umin(unsigned a, unsigned b) { return a < b ? a : b; }
#define INS16(T, x) do { unsigned _x = (x); _Pragma("unroll") for (int _i = 0; _i < 16; ++_i) { const unsigned _h = umax(T[_i], _x); _x = umin(T[_i], _x); T[_i] = _h; } } while (0)
__device__ __forceinline__ void sort16_desc(unsigned (&a)[16]) {
#pragma unroll
    for (int k = 2; k <= 16; k <<= 1)
#pragma unroll
        for (int j = k >> 1; j > 0; j >>= 1)
#pragma unroll
            for (int i = 0; i < 16; ++i) { const int l = i ^ j;
                if (l > i) { const unsigned hi = umax(a[i], a[l]), lo = umin(a[i], a[l]); if ((i & k) == 0) { a[i] = hi; a[l] = lo; } else { a[i] = lo; a[l] = hi; } } }
}
__device__ __forceinline__ void merge_top16(unsigned (&T)[16], const unsigned (&S)[16]) {
#pragma unroll
    for (int i = 0; i < 16; ++i) T[i] = umax(T[i], S[15 - i]);
#pragma unroll
    for (int j = 8; j > 0; j >>= 1)
#pragma unroll
        for (int i = 0; i < 16; ++i) { const int l = i ^ j; if (l > i) { const unsigned hi = umax(T[i], T[l]), lo = umin(T[i], T[l]); T[i] = hi; T[l] = lo; } }
}

__device__ __forceinline__ void ph_select(Frame& F, int l) {
    const bf16* QP = (const bf16*)(KWS + WS_QP); const bf16* KEYS = (const bf16*)(KWS + WS_W + (size_t)l * W_STRIDE + WO_KEYS);
    const float* SSQ = (const float*)(KWS + WS_SSQ); float* RR = (float*)(KWS + WS_RR); unsigned* EO = (unsigned*)(KWS + WS_E); float* GO = (float*)(KWS + WS_G);
    const int lane = pg8::fresh_lane(), r32 = lane & 31, hi = lane >> 5;
    LAS unsigned* TL = (LAS unsigned*)(F.lds + 65536) + (F.wave * 64 + lane);
    { const bf16* XG2 = (const bf16*)(KWS + WS_XB); unsigned char* XQ = KWS + WS_XQ; float* SX = (float*)(KWS + WS_SX); const float* g2p = (const float*)KIN(16) + (size_t)l * DM + 16 * lane;
      float g2v[16];
#pragma unroll
      for (int j = 0; j < 4; ++j) { const f32x4 gq = *(const f32x4*)(g2p + 4 * j); g2v[4 * j] = gq.x; g2v[4 * j + 1] = gq.y; g2v[4 * j + 2] = gq.z; g2v[4 * j + 3] = gq.w; }
      for (int t0 = F.gw; t0 < MTOK; t0 += 4 * F.NGW) {
          v4u ra[4], rb[4]; float m[4];
#pragma unroll
          for (int u = 0; u < 4; ++u) { const int t = (t0 + u * F.NGW < MTOK) ? t0 + u * F.NGW : t0; ra[u] = *(const v4u*)(XG2 + (size_t)t * DM + 16 * lane); rb[u] = *(const v4u*)(XG2 + (size_t)t * DM + 16 * lane + 8); }
          float xf[4][16];
#pragma unroll
          for (int u = 0; u < 4; ++u) { const v4u a = ra[u], b = rb[u];
              const float x_[16] = {blo(a.x), bhi(a.x), blo(a.y), bhi(a.y), blo(a.z), bhi(a.z), blo(a.w), bhi(a.w), blo(b.x), bhi(b.x), blo(b.y), bhi(b.y), blo(b.z), bhi(b.z), blo(b.w), bhi(b.w)};
              float mm = 0.f;
#pragma unroll
              for (int j = 0; j < 16; ++j) { xf[u][j] = x_[j] * g2v[j]; mm = fmaxf(mm, fabsf(xf[u][j])); }
              m[u] = mm; }
#pragma unroll
          for (int o = 1; o < 64; o <<= 1)
#pragma unroll
              for (int u = 0; u < 4; ++u) m[u] = fmaxf(m[u], __shfl_xor(m[u], o));
#pragma unroll
          for (int u = 0; u < 4; ++u) { const int t = t0 + u * F.NGW; if (t < MTOK) {
              const float inv = m[u] > 0.f ? 127.0f / m[u] : 0.f;
              v4u q;
#define Q4(j) (((unsigned)((int)rintf(xf[u][4 * (j)] * inv) & 255)) | ((unsigned)((int)rintf(xf[u][4 * (j) + 1] * inv) & 255) << 8) | ((unsigned)((int)rintf(xf[u][4 * (j) + 2] * inv) & 255) << 16) | ((unsigned)((int)rintf(xf[u][4 * (j) + 3] * inv) & 255) << 24))
              q.x = Q4(0); q.y = Q4(1); q.z = Q4(2); q.w = Q4(3);
#undef Q4
              *(v4u*)(XQ + (size_t)(lane >> 3) * ((size_t)MTOK * 128) + (size_t)t * 128 + 16 * (lane & 7)) = q;
              if (lane == 0) SX[t] = m[u] * (1.0f / 127.0f); } }
      } }
    const int h = F.vcu & 7, tbg = F.vcu >> 3, ntbg = F.G >> 3;
    { const int tid = F.wave * 64 + lane;
#pragma unroll
      for (int j = 0; j < 8; ++j) { const int idx = tid + 512 * j, p = idx >> 11, n = (idx >> 4) & 127, ch = idx & 15;
          const v4u v = *(const v4u*)(KEYS + ((size_t)(2 * h + p) * 128 + n) * 128 + ch * 8);
          *(LAS v4u*)(F.lds + p * 32768 + n * 256 + ((ch * 16) ^ ((n & 7) << 4))) = v; }
      __syncthreads(); }
    for (int tb = tbg * 8 + F.wave; tb < MTOK / 32; tb += ntbg * 8) {
        const int tok = tb * 32 + r32;
        float ssq = 0.f;
        { const f32x4* sp = (const f32x4*)(SSQ + (size_t)tok * 16);
#pragma unroll
          for (int j = 0; j < 4; ++j) { const f32x4 v = sp[j]; ssq += (v.x + v.y) + (v.z + v.w); } }
        const float rr = 1.0f / sqrtf(ssq * (1.f / DM) + RMS_EPS);
        if (h == 0 && hi == 0) RR[tok] = rr;
        unsigned C[16];
#pragma unroll
        for (int i = 0; i < 16; ++i) C[i] = 0u;
        {
        unsigned T[2][16];
        bf16x8 qfa[2][8];
#pragma unroll
        for (int p = 0; p < 2; ++p) { const bf16* qrow = QP + (size_t)tok * 2048 + (2 * h + p) * 128 + hi * 8;
#pragma unroll
            for (int s = 0; s < 8; ++s) qfa[p][s] = *(const bf16x8*)(qrow + s * 16); }
#pragma unroll
        for (int p = 0; p < 2; ++p) {
            const int hp = 2 * h + p;
            bf16x8 qf[8];
#pragma unroll
            for (int s = 0; s < 8; ++s) qf[s] = qfa[p][s];
#pragma unroll
            for (int i = 0; i < 16; ++i) T[p][i] = 0u;
#pragma unroll 1
            for (int blk = 0; blk < 4; ++blk) {
                f32x16 acc = f32x16{};
                const int n = blk * 32 + r32; const LAS unsigned char* krow = F.lds + p * 32768 + n * 256; const int sw = (n & 7) << 4;
#pragma unroll
                for (int s = 0; s < 8; ++s) { const bf16x8 a = *(const LAS bf16x8*)(krow + ((32 * s + 16 * hi) ^ sw)); acc = __builtin_amdgcn_mfma_f32_32x32x16_bf16(a, qf[s], acc, 0, 0, 0); }
                const int nb = 127 - (blk * 32 + 4 * hi);
                unsigned K[16];
#pragma unroll
                for (int r = 0; r < 16; ++r) K[r] = (fkey(acc[r]) & ~127u) | (unsigned)(nb - ((r & 3) + 8 * (r >> 2)));
                sort16_desc(K); merge_top16(T[p], K);
            }
            unsigned oth[16];
#pragma unroll
            for (int i = 0; i < 16; ++i) oth[i] = (unsigned)__shfl_xor((int)T[p][i], 32);
            merge_top16(T[p], oth);
#pragma unroll
            for (int i = 0; i < 16; ++i) TL[(p * 16 + i) * 512] = T[p][i];
        }
        float s0[16], s1[16];
#pragma unroll
        for (int i = 0; i < 16; ++i) { s0[i] = funkey((T[0][i] & ~127u) | 64u); s1[i] = funkey((T[1][i] & ~127u) | 64u); }
#define CAND(i, j) ((fkey(s0[i] + s1[j]) & ~255u) | (unsigned)((i) * 16 + (j)))
#pragma unroll
        for (int j = 0; j < 16; ++j) C[j] = CAND(0, j);
        { unsigned B[16];
#pragma unroll
          for (int j = 0; j < 8; ++j) B[j] = CAND(1, j);
#pragma unroll
          for (int j = 0; j < 5; ++j) B[8 + j] = CAND(2, j);
#pragma unroll
          for (int j = 0; j < 3; ++j) B[13 + j] = CAND(4, j);
          sort16_desc(B); merge_top16(C, B); }
        { unsigned B[16];
#pragma unroll
          for (int j = 0; j < 4; ++j) B[j] = CAND(3, j);
#pragma unroll
          for (int j = 0; j < 2; ++j) { B[4 + j] = CAND(5, j); B[6 + j] = CAND(6, j); B[8 + j] = CAND(7, j); }
#pragma unroll
          for (int i = 0; i < 6; ++i) B[10 + i] = CAND(8 + i, 0);
          sort16_desc(B); merge_top16(C, B); }
        INS16(C, CAND(14, 0)); INS16(C, CAND(15, 0));
#undef CAND
        }
        float sc[16]; unsigned ex[16];
#pragma unroll
        for (int k = 0; k < 16; ++k) {
            const unsigned code = C[k] & 255u;
            const unsigned a = TL[(code >> 4) * 512], b = TL[(16 + (code & 15u)) * 512];
            ex[k] = (127u - (a & 127u)) * 128u + (127u - (b & 127u));
            sc[k] = funkey((a & ~127u) | 64u) + funkey((b & ~127u) | 64u);
        }
        float smax = sc[0];
#pragma unroll
        for (int k = 1; k < 16; ++k) smax = fmaxf(smax, sc[k]);
        float den = 0.f;
#pragma unroll
        for (int k = 0; k < 16; ++k) { sc[k] = __builtin_amdgcn_exp2f((sc[k] - smax) * rr * 1.4426950408889634f); den += sc[k]; }
        const float iden = 1.0f / den;
        v4u* edst = (v4u*)(EO + (size_t)tok * 128 + h * 16 + hi * 8); f32x4* gdst = (f32x4*)(GO + (size_t)tok * 128 + h * 16 + hi * 8);
#pragma unroll
        for (int k = 0; k < 8; k += 4) {
            unsigned ea[4], eb[4]; float wa[4], wb2[4];
#pragma unroll
            for (int j = 0; j < 4; ++j) { ea[j] = ex[k + j]; eb[j] = ex[8 + k + j]; wa[j] = sc[k + j]; wb2[j] = sc[8 + k + j];
                asm volatile("" : "+v"(ea[j]), "+v"(eb[j]), "+v"(wa[j]), "+v"(wb2[j])); }
            edst[k >> 2] = (v4u){hi ? eb[0] : ea[0], hi ? eb[1] : ea[1], hi ? eb[2] : ea[2], hi ? eb[3] : ea[3]};
            gdst[k >> 2] = (f32x4){(hi ? wb2[0] : wa[0]) * iden, (hi ? wb2[1] : wa[1]) * iden, (hi ? wb2[2] : wa[2]) * iden, (hi ? wb2[3] : wa[3]) * iden};
        }
    }
}

__device__ __forceinline__ float gelu_tanh(float h) {
    const float z = 0.7978845608028654f * (h + 0.044715f * h * h * h);
    return h * __builtin_amdgcn_rcpf(1.0f + __builtin_amdgcn_exp2f(-2.0f * 1.4426950408889634f * z));
}
__device__ __forceinline__ float ub0(unsigned x) { return (float)(x & 0xffu); }
__device__ __forceinline__ float ub1(unsigned x) { return (float)((x >> 8) & 0xffu); }
__device__ __forceinline__ float ub2(unsigned x) { return (float)((x >> 16) & 0xffu); }
__device__ __forceinline__ float ub3(unsigned x) { return (float)(x >> 24); }
#define DPP_I(x, ctrl) __builtin_amdgcn_update_dpp(0, (x), (ctrl), 0xf, 0xf, false)
#define DPP_F(x, ctrl) __builtin_bit_cast(float, __builtin_amdgcn_update_dpp(0, __builtin_bit_cast(int, (x)), (ctrl), 0xf, 0xf, false))
__device__ __forceinline__ void ph_g1(Frame& F, int l) {
    const unsigned char* XQ = KWS + WS_XQ; const unsigned* E = (const unsigned*)(KWS + WS_E); const unsigned char* U = KWS + WS_U + (size_t)l * UV_STRIDE; short* HPI = (short*)(KWS + WS_HPI);
    const int lane = pg8::fresh_lane(), c = lane & 7, q8 = lane >> 3;
    const int G = F.G, bx = blockIdx.x, wave = F.wave;
    const int nit = (8 * (MTOK / 8) - bx + G - 1) / G;
#define G1_IT(i) (bx + (i) * G)
#define G1_TOK(i) ((G1_IT(i) >> 3) * 8 + wave)
#define G1_COFF(i) ((size_t)128 * (G1_IT(i) & 7) + 16 * c)
#define G1_LOADA(XQV, EV, i) do { const size_t t_ = (size_t)G1_TOK(i); XQV = *(const v4u*)(XQ + (size_t)(G1_IT(i) & 7) * ((size_t)MTOK * 128) + t_ * 128 + 16 * c); \
        _Pragma("unroll") for (int j_ = 0; j_ < 4; ++j_) EV[j_] = *(const v4u*)(E + t_ * 128 + q8 * 16 + 4 * j_); } while (0)
#define G1_LOADB(URV, EV, i) do { const size_t co_ = (size_t)(G1_IT(i) & 7) * (NEXP * 128) + 16 * c; _Pragma("unroll") for (int i_ = 0; i_ < 16; ++i_) URV[i_] = *(const v4u*)(U + (size_t)(EV[i_ >> 2][i_ & 3] & (NEXP - 1)) * 128 + co_); } while (0)
#define G1_COMP(URV, XQV, i) do { int p_[16]; \
        _Pragma("unroll") for (int i_ = 0; i_ < 16; ++i_) { \
            int d_ = __builtin_amdgcn_sdot4((int)URV[i_].x, (int)XQV.x, 0, false); d_ = __builtin_amdgcn_sdot4((int)URV[i_].y, (int)XQV.y, d_, false); \
            d_ = __builtin_amdgcn_sdot4((int)URV[i_].z, (int)XQV.z, d_, false); d_ = __builtin_amdgcn_sdot4((int)URV[i_].w, (int)XQV.w, d_, false); \
            d_ += DPP_I(d_, 0xB1); d_ += DPP_I(d_, 0x4E); d_ += DPP_I(d_, 0x141); p_[i_] = d_; } \
        if (c == 0) { v4u* dst_ = (v4u*)(HPI + ((size_t)(G1_IT(i) & 7) * MTOK + G1_TOK(i)) * 128 + q8 * 16);   \
            _Pragma("unroll") for (int j_ = 0; j_ < 2; ++j_) { unsigned w_[4]; \
                _Pragma("unroll") for (int k_ = 0; k_ < 4; ++k_) w_[k_] = ((unsigned)((p_[8 * j_ + 2 * k_] + 32) >> 6) & 0xffffu) | ((unsigned)((p_[8 * j_ + 2 * k_ + 1] + 32) >> 6) << 16); \
                dst_[j_] = (v4u){w_[0], w_[1], w_[2], w_[3]}; } } } while (0)
    v4u xqA, xqB, xqN = (v4u){0u, 0u, 0u, 0u}, eA[4], eB[4], urA[16], urB[16];
    if (nit > 0) G1_LOADA(xqA, eA, 0);
    if (nit > 1) G1_LOADA(xqB, eB, 1);
    if (nit > 0) G1_LOADB(urA, eA, 0);
    for (int i = 0; i < nit; i += 2) {
        if (i + 1 < nit) G1_LOADB(urB, eB, i + 1);
        if (i + 2 < nit) G1_LOADA(xqN, eA, i + 2);
        G1_COMP(urA, xqA, i);
        xqA = xqN;
        if (i + 1 < nit) {
            if (i + 2 < nit) G1_LOADB(urA, eA, i + 2);
            if (i + 3 < nit) G1_LOADA(xqN, eB, i + 3);
            G1_COMP(urB, xqB, i + 1);
            xqB = xqN;
        }
    }
#undef G1_LOADA
#undef G1_LOADB
#undef G1_COMP
}
__device__ __forceinline__ void ph_g1b(Frame& F, int l) {
    const short* HPI = (const short*)(KWS + WS_HPI); const unsigned* E = (const unsigned*)(KWS + WS_E); const float* G = (const float*)(KWS + WS_G);
    const float* RR = (const float*)(KWS + WS_RR); const float* SX = (const float*)(KWS + WS_SX);
    typedef float f32x2s __attribute__((ext_vector_type(2)));
    const f32x2s* SUV = (const f32x2s*)(KWS + WS_SU) + (size_t)l * NEXP;
    unsigned char* WQ = KWS + WS_WF; float* SW = (float*)(KWS + WS_WSUM);
    const int lane = pg8::fresh_lane();
    typedef int i32x2 __attribute__((ext_vector_type(2))); typedef float f32x2 __attribute__((ext_vector_type(2)));
    constexpr int NU = 4;
    for (int t0 = F.gw; t0 < MTOK; t0 += NU * F.NGW) {
        i32x2 isum[NU]; v2u e2[NU]; f32x2 g2[NU]; float hs[NU];
#pragma unroll
        for (int u = 0; u < NU; ++u) { const int t = (t0 + u * F.NGW < MTOK) ? t0 + u * F.NGW : t0;
            hs[u] = RR[t] * SX[t] * 64.0f;
            isum[u] = (i32x2){0, 0};
#pragma unroll
            for (int s = 0; s < 8; ++s) { const int w = *(const int*)(HPI + ((size_t)s * MTOK + t) * 128 + 2 * lane); isum[u].x += (int)(short)(w & 0xffff); isum[u].y += (w >> 16); }
            e2[u] = *(const v2u*)(E + (size_t)t * 128 + 2 * lane); g2[u] = *(const f32x2*)(G + (size_t)t * 128 + 2 * lane); }
        float w0[NU], w1[NU], m[NU];
#pragma unroll
        for (int u = 0; u < NU; ++u) { const unsigned e0 = e2[u].x & (NEXP - 1), e1 = e2[u].y & (NEXP - 1);
            const f32x2s sa = SUV[e0], sb = SUV[e1];
            w0[u] = g2[u].x * gelu_tanh((float)isum[u].x * hs[u] * sa.x) * sa.y; w1[u] = g2[u].y * gelu_tanh((float)isum[u].y * hs[u] * sb.x) * sb.y;
            m[u] = fmaxf(fabsf(w0[u]), fabsf(w1[u])); }
#pragma unroll
        for (int o = 1; o < 64; o <<= 1)
#pragma unroll
            for (int u = 0; u < NU; ++u) m[u] = fmaxf(m[u], __shfl_xor(m[u], o));
#pragma unroll
        for (int u = 0; u < NU; ++u) { const int t = t0 + u * F.NGW; if (t < MTOK) {
            const float inv = m[u] > 0.f ? 127.0f / m[u] : 0.f;
            const unsigned q = ((unsigned)((int)rintf(w0[u] * inv) & 255)) | ((unsigned)((int)rintf(w1[u] * inv) & 255) << 8);
            *(unsigned short*)(WQ + (size_t)t * 128 + 2 * lane) = (unsigned short)q;
            if (lane == 0) SW[t] = m[u] * (1.0f / 127.0f); } }
    }
}
__device__ __forceinline__ void ph_g2(Frame& F, int l, bf16* Xout) {
    const unsigned* E = (const unsigned*)(KWS + WS_E); const unsigned char* WQ = KWS + WS_WF; const float* SW = (const float*)(KWS + WS_WSUM);
    const unsigned char* V = KWS + WS_V + (size_t)l * UV_STRIDE;
    const bf16* X = (const bf16*)(KWS + WS_XB); float* SSQN = (float*)(KWS + WS_SSQN); float* OUTF = KOUT;
    const bool last = (l + 1 >= DEPTH);
    const int lane = pg8::fresh_lane(), c = lane & 7, q8 = lane >> 3;
    const bool b3 = (lane & 8) != 0;
    const int G = F.G, bx = blockIdx.x, wave = F.wave;
    const int nit = (8 * (MTOK / 8) - bx + G - 1) / G;
    typedef float f32x2 __attribute__((ext_vector_type(2)));
#define G2_LOADE(EV, i) do { const size_t t_ = (size_t)G1_TOK(i); _Pragma("unroll") for (int j_ = 0; j_ < 4; ++j_) EV[j_] = *(const v4u*)(E + t_ * 128 + q8 * 16 + 4 * j_); } while (0)
#define G2_LOADW(WV, SWV, i) do { WV = *(const v4u*)(WQ + (size_t)G1_TOK(i) * 128 + q8 * 16); SWV = SW[G1_TOK(i)]; } while (0)
#define G2_LOADB(VRV, XV, EV, i) do { const size_t co_ = (size_t)(G1_IT(i) & 7) * (NEXP * 128) + 16 * c; _Pragma("unroll") for (int i_ = 0; i_ < 16; ++i_) VRV[i_] = *(const v4u*)(V + (size_t)(EV[i_ >> 2][i_ & 3] & (NEXP - 1)) * 128 + co_); \
        XV = *(const unsigned*)(X + (size_t)G1_TOK(i) * DM + (size_t)128 * (G1_IT(i) & 7) + 16 * c + 2 * q8); } while (0)
#define G2_T4(R0, R1, R2, R3, WQW, A0, A1, A2, A3) do { \
        const unsigned t0_ = __builtin_amdgcn_perm((R1), (R0), 0x05010400u), t1_ = __builtin_amdgcn_perm((R1), (R0), 0x07030602u); \
        const unsigned t2_ = __builtin_amdgcn_perm((R3), (R2), 0x05010400u), t3_ = __builtin_amdgcn_perm((R3), (R2), 0x07030602u); \
        A0 = __builtin_amdgcn_sdot4((int)__builtin_amdgcn_perm(t2_, t0_, 0x05040100u), (int)(WQW), A0, false); \
        A1 = __builtin_amdgcn_sdot4((int)__builtin_amdgcn_perm(t2_, t0_, 0x07060302u), (int)(WQW), A1, false); \
        A2 = __builtin_amdgcn_sdot4((int)__builtin_amdgcn_perm(t3_, t1_, 0x05040100u), (int)(WQW), A2, false); \
        A3 = __builtin_amdgcn_sdot4((int)__builtin_amdgcn_perm(t3_, t1_, 0x07060302u), (int)(WQW), A3, false); } while (0)
#define G2_COMP(VRV, XV, WV, SWV, i) do { int acc_[16]; \
        _Pragma("unroll") for (int j_ = 0; j_ < 16; ++j_) acc_[j_] = 0; \
        _Pragma("unroll") for (int m_ = 0; m_ < 4; ++m_) { const unsigned wq_ = WV[m_]; \
            G2_T4(VRV[4 * m_].x, VRV[4 * m_ + 1].x, VRV[4 * m_ + 2].x, VRV[4 * m_ + 3].x, wq_, acc_[0], acc_[1], acc_[2], acc_[3]); \
            G2_T4(VRV[4 * m_].y, VRV[4 * m_ + 1].y, VRV[4 * m_ + 2].y, VRV[4 * m_ + 3].y, wq_, acc_[4], acc_[5], acc_[6], acc_[7]); \
            G2_T4(VRV[4 * m_].z, VRV[4 * m_ + 1].z, VRV[4 * m_ + 2].z, VRV[4 * m_ + 3].z, wq_, acc_[8], acc_[9], acc_[10], acc_[11]); \
            G2_T4(VRV[4 * m_].w, VRV[4 * m_ + 1].w, VRV[4 * m_ + 2].w, VRV[4 * m_ + 3].w, wq_, acc_[12], acc_[13], acc_[14], acc_[15]); } \
        int a8_[8], a4_[4], a2_[2]; \
        _Pragma("unroll") for (int j_ = 0; j_ < 8; ++j_) { auto r_ = __builtin_amdgcn_permlane32_swap((unsigned)acc_[j_], (unsigned)acc_[j_ + 8], false, false); \
            unsigned r0_ = r_[0], r1_ = r_[1]; asm volatile("" : "+v"(r0_), "+v"(r1_)); a8_[j_] = (int)r0_ + (int)r1_; } \
        _Pragma("unroll") for (int j_ = 0; j_ < 4; ++j_) { auto r_ = __builtin_amdgcn_permlane16_swap((unsigned)a8_[j_], (unsigned)a8_[j_ + 4], false, false); \
            unsigned r0_ = r_[0], r1_ = r_[1]; asm volatile("" : "+v"(r0_), "+v"(r1_)); a4_[j_] = (int)r0_ + (int)r1_; } \
        _Pragma("unroll") for (int j_ = 0; j_ < 2; ++j_) { const int keep_ = b3 ? a4_[j_ + 2] : a4_[j_], send_ = b3 ? a4_[j_] : a4_[j_ + 2]; a2_[j_] = keep_ + DPP_I(send_, 0x128); } \
        const int t_ = G1_TOK(i), s_ = G1_IT(i) & 7; const size_t col_ = (size_t)128 * s_ + 16 * c + 2 * q8; \
        const float sw_ = SWV; \
        f32x2 xo_; xo_.x = blo(XV) + (float)a2_[0] * sw_; xo_.y = bhi(XV) + (float)a2_[1] * sw_; \
        if (last) *(f32x2*)(OUTF + (size_t)t_ * DM + col_) = xo_; \
        else { *(unsigned*)(Xout + (size_t)t_ * DM + col_) = pk2(xo_.x, xo_.y); \
            const float ss_ = wave_sum(xo_.x * xo_.x + xo_.y * xo_.y); if (lane == 0) SSQN[(size_t)t_ * 8 + s_] = ss_; } } while (0)
    v4u eA[4], eB[4], vrA[16], vrB[16], wA, wB; unsigned xA, xB; float swA = 0.f, swB = 0.f;
    if (nit > 0) { G2_LOADE(eA, 0); G2_LOADW(wA, swA, 0); }
    if (nit > 1) { G2_LOADE(eB, 1); G2_LOADW(wB, swB, 1); }
    if (nit > 0) G2_LOADB(vrA, xA, eA, 0);
    for (int i = 0; i < nit; i += 2) {
        if (i + 1 < nit) G2_LOADB(vrB, xB, eB, i + 1);
        if (i + 2 < nit) G2_LOADE(eA, i + 2);
        G2_COMP(vrA, xA, wA, swA, i);
        if (i + 2 < nit) G2_LOADW(wA, swA, i + 2);
        if (i + 1 < nit) {
            if (i + 2 < nit) G2_LOADB(vrA, xA, eA, i + 2);
            if (i + 3 < nit) G2_LOADE(eB, i + 3);
            G2_COMP(vrB, xB, wB, swB, i + 1);
            if (i + 3 < nit) G2_LOADW(wB, swB, i + 3);
        }
    }
#undef G2_LOADE
#undef G2_LOADW
#undef G2_LOADB
#undef G2_COMP
#undef G2_T4
#undef G1_IT
#undef G1_TOK
#undef G1_COFF
}

constexpr int PH_PER_LAYER = 11, N_PHASES = 1 + DEPTH * PH_PER_LAYER;
__global__ void __launch_bounds__(NWAVES * 64, 2) fwd_kernel(Args A) {
    extern __shared__ __attribute__((aligned(16))) unsigned char lds[];
    Frame F;
    F.lds = (LAS unsigned char*)lds;
    F.wave = __builtin_amdgcn_readfirstlane((int)threadIdx.x >> 6);
    F.G = gridDim.x; { const int bx = blockIdx.x; F.vcu = (F.G % 8 == 0) ? (bx % 8) * (F.G / 8) + bx / 8 : bx; }
    F.gw = F.vcu * NWAVES + F.wave; F.NGW = F.G * NWAVES; F.bx = (int)blockIdx.x;
    cg::grid_group grid = cg::this_grid();
    for (int u = threadIdx.x; u < 64; u += NWAVES * 64) ((LAS unsigned*)(F.lds + 131072))[u + 64] = 0u;
    __syncthreads();
    XcdBarrier bar = xcd_barrier_post((unsigned*)(KWS + WS_CTL), (volatile LAS unsigned*)(F.lds + MISC_OFF) + 8);
    const int lo = karg_int(23 * 8), hi = karg_int(23 * 8 + 4);
#ifndef PH_MASK
#define PH_MASK 0xfff
#endif
#define KIND(k) ((k) == 0 ? 0 : 1 + ((k) - 1) % PH_PER_LAYER)
#define IN(k) (((PH_MASK >> KIND(k)) & 1) && lo <= (k) && (k) < hi)
#define SEAM(k) do { if (IN(k) && IN((k) + 1)) xcd_barrier(bar); } while (0)
#ifndef PROBE_KIND
#define PROBE_KIND (-1)
#endif
#define REPS(kind) for (int rep_ = ((kind) == PROBE_KIND ? 0 : 1); rep_ < 2; ++rep_)
#define REP_SYNC() do { if (rep_ == 0) xcd_barrier(bar); } while (0)
    if (lo < 0) grid.sync();
    if (IN(0)) { REPS(0) { ph_prologue(F); REP_SYNC(); } SEAM(0); }
    for (int l = 0; l < DEPTH; ++l) {
        const int p0 = 1 + l * PH_PER_LAYER;
        if (IN(p0 + 0)) { REPS(1) { Frame Fq = fresh_frame(F);
            unsigned char* ws = KWS; unsigned char* wb = ws + WS_W + (size_t)l * W_STRIDE;
            pg8::Gemm g{(const pg8::bf16_t*)(ws + WS_XB), (const pg8::bf16_t*)(wb + WO_WIN), MTOK, INWP, DM}; pg8::StaticOrder S; S.init(MTOK, INWP, Fq.G, Fq.bx);
            pg8::EpiIn E{(pg8::bf16_t*)(ws + WS_GATES), (const float*)KIN(14) + (size_t)l * 2048, (pg8::bf16_t*)(ws + WS_CQ), (pg8::bf16_t*)(ws + WS_CKV), (pg8::bf16_t*)(ws + WS_KPEP), (const float*)(ws + WS_SSQN), (float*)(ws + WS_SSQC), (const int*)KIN(1)};
            pg8::gemm_phase<pg8::EpiIn, pg8::StaticOrder, true, true>(Fq.lds, g, S, E, Fq.wave);
            { const int nu = MTOK / 256 * (INWP / 256), nfull = nu % Fq.G;
              if (nfull == 0) convert_tables(l, Fq.gw, Fq.NGW);
              else if (Fq.bx >= nfull) convert_tables(l, (Fq.bx - nfull) * NWAVES + Fq.wave, (Fq.G - nfull) * NWAVES); }
            REP_SYNC(); }
            SEAM(p0 + 0);
        }
        if (IN(p0 + 1)) { REPS(2) { Frame Fq = fresh_frame(F);
            unsigned char* ws = KWS; unsigned char* wb = ws + WS_W + (size_t)l * W_STRIDE;
            { const int nq = (MTOK / 256) * 3;
              if (nq >= Fq.G) ph_pool(Fq, Fq.gw, Fq.NGW);
              else if (Fq.bx >= nq) ph_pool(Fq, (Fq.bx - nq) * NWAVES + Fq.wave, (Fq.G - nq) * NWAVES); }
            { pg8::Gemm g{(const pg8::bf16_t*)(ws + WS_CQ), (const pg8::bf16_t*)(wb + WO_WUQ), MTOK, 768, QL}; pg8::StaticOrder S; S.init(MTOK, 768, Fq.G, Fq.bx);
              pg8::EpiBf16<0> E{(pg8::bf16_t*)(ws + WS_QRAW), 768, nullptr, 0, 0, 1.f};
              pg8::gemm_phase<pg8::EpiBf16<0>, pg8::StaticOrder, true, true>(Fq.lds, g, S, E, Fq.wave); }
            { int kvl = KVL; asm volatile("" : "+s"(kvl));
              pg8::Gemm g{(const pg8::bf16_t*)(ws + WS_CKV), (const pg8::bf16_t*)(wb + WO_WUKV), MTOK, 1024, kvl}; pg8::StaticOrder S; S.init(MTOK, 1024, Fq.G, Fq.bx);
              pg8::EpiKV E{(pg8::bf16_t*)(ws + WS_K), (pg8::bf16_t*)(ws + WS_VV), (const pg8::bf16_t*)(ws + WS_KPEP), (const float*)(ws + WS_SSQC), (const float*)KIN(9) + l * QKH};
              pg8::gemm_phase<pg8::EpiKV, pg8::StaticOrder, true, true>(Fq.lds, g, S, E, Fq.wave); }
            REP_SYNC(); }
            SEAM(p0 + 1);
        }
        if (IN(p0 + 2)) { REPS(3) { Frame Fq = fresh_frame(F); ph_finalize(Fq, l); REP_SYNC(); } SEAM(p0 + 2); }
        if (IN(p0 + 3)) { REPS(4) { Frame Fq = fresh_frame(F); ph_attn(Fq, lds); REP_SYNC(); } SEAM(p0 + 3); }
        if (IN(p0 + 4)) { REPS(5) { Frame Fq = fresh_frame(F);
            unsigned char* ws = KWS; unsigned char* wb = ws + WS_W + (size_t)l * W_STRIDE;
            { pg8::Gemm g{(const pg8::bf16_t*)(ws + WS_O), (const pg8::bf16_t*)(wb + WO_WO), MTOK, DM, 512}; pg8::StaticOrder S; S.init(MTOK, DM, Fq.G, Fq.bx);
              pg8::EpiBf16<0> E{(pg8::bf16_t*)(ws + WS_ABUF), DM, nullptr, 0, 0, 1.f};
              pg8::gemm_phase<pg8::EpiBf16<0>, pg8::StaticOrder, true, true>(Fq.lds, g, S, E, Fq.wave); }
            { pg8::Gemm g{(const pg8::bf16_t*)(ws + WS_MIXED), (const pg8::bf16_t*)(wb + WO_WC), MTOK, DM, 512}; pg8::StaticOrder S; S.init(MTOK, DM, Fq.G, Fq.bx);
              pg8::EpiMix E{(const pg8::bf16_t*)(ws + WS_ABUF), (const pg8::bf16_t*)(ws + WS_GATES), (pg8::bf16_t*)(ws + WS_MIX)};
              pg8::gemm_phase<pg8::EpiMix, pg8::StaticOrder, true, true>(Fq.lds, g, S, E, Fq.wave); }
            REP_SYNC(); }
            SEAM(p0 + 4);
        }
        if (IN(p0 + 5)) { REPS(6) { Frame Fq = fresh_frame(F);
            unsigned char* ws = KWS; unsigned char* wb = ws + WS_W + (size_t)l * W_STRIDE;
            pg8::Gemm g{(const pg8::bf16_t*)(ws + WS_MIX), (const pg8::bf16_t*)(wb + WO_WOUT), MTOK, DM, DM}; pg8::StaticOrder S; S.init(MTOK, DM, Fq.G, Fq.bx);
            pg8::EpiRes E{(const pg8::bf16_t*)(ws + WS_XB), rep_ == 0 ? (pg8::bf16_t*)(ws + WS_GATES) : (pg8::bf16_t*)(ws + WS_XB), (float*)(ws + WS_SSQ)};
            pg8::gemm_phase<pg8::EpiRes, pg8::StaticOrder, true, true>(Fq.lds, g, S, E, Fq.wave);
            REP_SYNC(); }
            SEAM(p0 + 5);
        }
        if (IN(p0 + 6)) { REPS(7) { Frame Fq = fresh_frame(F);
            unsigned char* ws = KWS; unsigned char* wb = ws + WS_W + (size_t)l * W_STRIDE;
            pg8::Gemm g{(const pg8::bf16_t*)(ws + WS_XB), (const pg8::bf16_t*)(wb + WO_WQ), MTOK, 2048, DM}; pg8::StaticOrder S; S.init(MTOK, 2048, Fq.G, Fq.bx);
            pg8::EpiBf16<0> E{(pg8::bf16_t*)(ws + WS_QP), 2048, nullptr, 0, 0, 1.f};
            pg8::gemm_phase<pg8::EpiBf16<0>, pg8::StaticOrder, true, true>(Fq.lds, g, S, E, Fq.wave);
            REP_SYNC(); }
            SEAM(p0 + 6);
        }
        if (IN(p0 + 7)) { REPS(8) { Frame Fq = fresh_frame(F); ph_select(Fq, l); REP_SYNC(); } SEAM(p0 + 7); }
        if (IN(p0 + 8)) { REPS(9) { Frame Fq = fresh_frame(F); ph_g1(Fq, l); REP_SYNC(); } SEAM(p0 + 8); }
        if (IN(p0 + 9)) { REPS(10) { Frame Fq = fresh_frame(F); ph_g1b(Fq, l); REP_SYNC(); } SEAM(p0 + 9); }
        if (IN(p0 + 10)) { REPS(11) { Frame Fq = fresh_frame(F); ph_g2(Fq, l, rep_ == 0 ? (bf16*)(KWS + WS_QP) : (bf16*)(KWS + WS_XB)); REP_SYNC(); } SEAM(p0 + 10); }
    }
#undef IN
#undef SEAM
}

extern "C" void kernel_launch(void* const* d_in, const int* in_sizes, int n_in, void* d_out, int out_size, void* d_ws, size_t ws_size, hipStream_t stream) {
    static int grid = 0;
    if (grid == 0) {
        if (n_in != 21 || in_sizes[0] != MTOK * DM || out_size != MTOK * DM || ws_size < WS_END) {
            fprintf(stderr, "kernel_launch: unexpected shapes: n_in %d in0 %d out %d ws %zu (need %zu)\n", n_in, n_in > 0 ? in_sizes[0] : -1, out_size, ws_size, (size_t)WS_END); grid = -1; return; }
        int dev = 0, cus = 0, per_cu = 0;
        if (hipGetDevice(&dev) != hipSuccess || hipDeviceGetAttribute(&cus, hipDeviceAttributeMultiprocessorCount, dev) != hipSuccess) { grid = -1; return; }
        if (hipFuncSetAttribute((const void*)fwd_kernel, hipFuncAttributeMaxDynamicSharedMemorySize, LDS_BYTES) != hipSuccess) { fprintf(stderr, "kernel_launch: hipFuncSetAttribute failed\n"); grid = -1; return; }
        if (hipOccupancyMaxActiveBlocksPerMultiprocessor(&per_cu, (const void*)fwd_kernel, NWAVES * 64, LDS_BYTES) != hipSuccess || per_cu < 1) { fprintf(stderr, "kernel_launch: occupancy query says %d blocks per CU\n", per_cu); grid = -1; return; }
        (void)hipGetLastError();
        grid = cus & ~7;
    }
    if (grid < 0) return;
    if (hipMemsetAsync((char*)d_ws + WS_CTL, 0, CTL_ZERO_BYTES, stream) != hipSuccess) { fprintf(stderr, "kernel_launch: hipMemsetAsync failed\n"); return; }
    Args a{};
    for (int i = 0; i < 21; ++i) a.in[i] = d_in[i];
    a.out = (float*)d_out; a.ws = (unsigned char*)d_ws;
#if MK_ONE_LAUNCH
    a.ph_lo = 0; a.ph_hi = N_PHASES;
    void* args[] = {&a};
    hipError_t e = hipLaunchCooperativeKernel((const void*)fwd_kernel, dim3(grid), dim3(NWAVES * 64), args, LDS_BYTES, stream);
    if (e != hipSuccess) fprintf(stderr, "kernel_launch: cooperative launch failed: %s (grid %d)\n", hipGetErrorString(e), grid);
#else
    for (int p = 0; p < N_PHASES; ++p) {
        a.ph_lo = p; a.ph_hi = p + 1;
        hipLaunchKernelGGL(fwd_kernel, dim3(grid), dim3(NWAVES * 64), LDS_BYTES, stream, a);
    }
    hipError_t e = hipPeekAtLastError();
    if (e != hipSuccess) fprintf(stderr, "kernel_launch: launch failed: %s\n", hipGetErrorName(e));
#endif
}
```

```cpp
#include <hip/hip_runtime.h>
#include <hip/hip_cooperative_groups.h>
#include <cstdio>
#include <cstdint>
namespace cg = cooperative_groups;
namespace pg8 {
#define PG8_LAS __attribute__((address_space(3)))
typedef unsigned short bf16_t;
typedef short bf16x8 __attribute__((ext_vector_type(8)));
typedef float f32x4 __attribute__((ext_vector_type(4)));
typedef unsigned u32x4 __attribute__((ext_vector_type(4)));
constexpr int BM = 256, BK = 64, HALF = 128, HTB = HALF * BK * 2  , STAGE_BYTES = 8 * HTB, NXCD = 8, WGM = 8;

__host__ __device__ __forceinline__ int lds_byte(int r, int c) { const int st = (r >> 4) * 2 + (c >> 5), rr = r & 15, cc = c & 31, ob = rr * 64 + cc * 2; return st * 1024 + (ob ^ (((ob >> 9) & 1) << 5)); }
__host__ __device__ __forceinline__ void stage_rc(int b, int& R, int& C) { const int st = b / 1024, sb = b % 1024, swz = sb ^ (((sb >> 9) & 1) << 5); R = (st >> 1) * 16 + swz / 64; C = (st & 1) * 32 + (swz % 64) / 2; }
__host__ __device__ __forceinline__ int perm32(int rho) { const int n = rho >> 4, i = rho & 15; return 8 * (i >> 2) + 4 * n + (i & 3); }

struct Unit { int pm, pn; };
struct Gemm { const bf16_t* A; const bf16_t* Bt; int M, N, K; };

struct StaticOrder {
    int nM, nN, nwg, G, c;
    __host__ __device__ void init(int M, int N, int G_, int c_) { nM = M / BM; nN = N / BM; nwg = nM * nN; G = G_; c = c_; }
    __host__ __device__ bool next(int i, Unit& u) const {
        const long L = (long)i * G + c; if (L >= nwg) return false;
        int wgid = (int)L; { const int q = nwg / NXCD, r = nwg % NXCD, xcd = wgid % NXCD, off = wgid / NXCD; wgid = (xcd < r ? xcd * (q + 1) : r * (q + 1) + (xcd - r) * q) + off; }
        const int nig = WGM * nN, gid = wgid / nig, fm = gid * WGM, gsz = (nM - fm) < WGM ? (nM - fm) : WGM;
        u.pm = fm + ((wgid % nig) % gsz); u.pn = (wgid % nig) / gsz; return true;
    }
    __device__ __forceinline__ void a_ready(const Unit&) const {}
    __device__ __forceinline__ void done(const Unit&) const {}
};

__device__ __forceinline__ unsigned cvt_pk_bf16(float lo, float hi) { unsigned r; asm volatile("v_cvt_pk_bf16_f32 %0, %1, %2" : "=v"(r) : "v"(lo), "v"(hi)); return r; }
typedef float f32x2 __attribute__((ext_vector_type(2)));
__device__ __forceinline__ f32x2 gelu_pk(f32x2 v) {
    const f32x2 av = __builtin_elementwise_abs(v), d = av * 0.2316418882f + 1.0f;
    f32x2 t; t.x = __builtin_amdgcn_rcpf(d.x); t.y = __builtin_amdgcn_rcpf(d.y);
    f32x2 q = t * 0.5307027145f + (-0.7265760135f); q = q * t + 0.7107068705f; q = q * t + (-0.142248368f); q = q * t + 0.127414796f; q = q * t;
    const f32x2 s = (v * v) * (-0.72134752044f);
    f32x2 e; e.x = __builtin_amdgcn_exp2f(s.x); e.y = __builtin_amdgcn_exp2f(s.y);
    const f32x2 m = v * (q * e), r = v - m;
    f32x2 o; o.x = v.x < 0.f ? m.x : r.x; o.y = v.y < 0.f ? m.y : r.y; return o;
}

template <int ACT  > struct EpiBf16 {
    static constexpr bool PERM = true, AFTER_DRAIN = false; static_assert(ACT == 0 || ACT == 1, "EpiBf16: ACT is 0 (none) or 1 (gelu_pk)");
    bf16_t* O; int ldc; const float* bias; int split_cols; size_t split_stride; float scale0;
    __device__ __forceinline__ void operator()(const f32x4 (&acc)[2][2][4][2], const Unit& u, int wr, int wc, int fr, int fq) const {
        const int row0 = u.pm * BM + wr * 64 + fr; int colt = u.pn * BM; bf16_t* base = O;
        float sc = 1.f; if (split_cols) { const int t = colt / split_cols; base += (size_t)t * split_stride; colt -= t * split_cols; if (t == 0) sc = scale0; }
        const int col0 = colt + wc * 32 + 8 * fq, bcol0 = u.pn * BM + wc * 32 + 8 * fq;
        f32x4 bv[2][2];
#pragma unroll
        for (int bj = 0; bj < 2; ++bj)
#pragma unroll
            for (int n = 0; n < 2; ++n) bv[bj][n] = bias ? *(const f32x4*)(bias + bcol0 + bj * HALF + 4 * n) : (f32x4){0.f, 0.f, 0.f, 0.f};
#pragma unroll
        for (int ai = 0; ai < 2; ++ai)
#pragma unroll
            for (int m = 0; m < 4; ++m) { bf16_t* rowp = base + (size_t)(row0 + ai * HALF + m * 16) * ldc + col0;
#pragma unroll
                for (int bj = 0; bj < 2; ++bj) { f32x4 v0 = acc[ai][bj][m][0] + bv[bj][0], v1 = acc[ai][bj][m][1] + bv[bj][1];
                    if (ACT == 1) { f32x2 a = gelu_pk((f32x2){v0[0], v0[1]}), b = gelu_pk((f32x2){v0[2], v0[3]}), c = gelu_pk((f32x2){v1[0], v1[1]}), d = gelu_pk((f32x2){v1[2], v1[3]});
                        v0 = (f32x4){a.x, a.y, b.x, b.y}; v1 = (f32x4){c.x, c.y, d.x, d.y}; }
                    v0 = v0 * sc; v1 = v1 * sc; u32x4 w; w.x = cvt_pk_bf16(v0[0], v0[1]); w.y = cvt_pk_bf16(v0[2], v0[3]); w.z = cvt_pk_bf16(v1[0], v1[1]); w.w = cvt_pk_bf16(v1[2], v1[3]);
                    *(u32x4*)(rowp + bj * HALF) = w; } }
    }
};
__device__ __forceinline__ int fresh_lane() { int l; asm volatile("v_mbcnt_lo_u32_b32 %0, -1, 0\n\tv_mbcnt_hi_u32_b32 %0, -1, %0" : "=v"(l)); return l; }
__device__ __forceinline__ float bflo(unsigned w) { return __builtin_bit_cast(float, w << 16); }
__device__ __forceinline__ float bfhi(unsigned w) { return __builtin_bit_cast(float, w & 0xffff0000u); }
__device__ __forceinline__ float sigmoid_f(float x) { return __builtin_amdgcn_rcpf(1.0f + __builtin_amdgcn_exp2f(-1.4426950408889634f * x)); }

struct EpiIn {
    static constexpr bool PERM = true, AFTER_DRAIN = false;
    bf16_t* gates; const float* gbias; bf16_t* cq; bf16_t* ckv; bf16_t* kpep; const float* ssqn; float* ssqc; const int* pos;
    __device__ __forceinline__ void operator()(const f32x4 (&acc)[2][2][4][2], const Unit& u, int wr, int wc, int fr, int fq) const {
        const int row0 = u.pm * BM + wr * 64 + fr;
        float rs[2][4];
#pragma unroll
        for (int ai = 0; ai < 2; ++ai)
#pragma unroll
            for (int m = 0; m < 4; ++m) { const f32x4* sp = (const f32x4*)(ssqn + (size_t)(row0 + ai * HALF + m * 16) * 8); const f32x4 a = sp[0], b = sp[1];
                rs[ai][m] = 1.0f / sqrtf(((a[0] + a[1]) + (a[2] + a[3]) + (b[0] + b[1]) + (b[2] + b[3])) * (1.0f / 1024.0f) + 1e-6f); }
#pragma unroll
        for (int bj = 0; bj < 2; ++bj) {
            const int colw = u.pn * BM + bj * HALF + wc * 32;
            bf16_t* dst; int ld; bool gate = false;
            if (colw < 2048) { dst = gates + colw; ld = 2048; gate = true; }
            else { const int pc = colw - 2048;
                if (pc < 384) { dst = cq + pc; ld = 384; }
                else if (pc < 640) { dst = ckv + (pc - 384); ld = 256; }
                else if (pc < 1184) { dst = kpep + (pc - 640); ld = 544; }
                else continue; }
            dst += 8 * fq;
            f32x4 b0 = (f32x4){0.f, 0.f, 0.f, 0.f}, b1 = b0;
            if (gate) { b0 = *(const f32x4*)(gbias + colw + 8 * fq); b1 = *(const f32x4*)(gbias + colw + 8 * fq + 4); }
#pragma unroll
            for (int ai = 0; ai < 2; ++ai)
#pragma unroll
                for (int m = 0; m < 4; ++m) {
                    f32x4 v0 = acc[ai][bj][m][0] * rs[ai][m] + b0, v1 = acc[ai][bj][m][1] * rs[ai][m] + b1;
                    if (gate) {
#pragma unroll
                        for (int j = 0; j < 4; ++j) { v0[j] = sigmoid_f(v0[j]); v1[j] = sigmoid_f(v1[j]); }
                    }
                    if (gate) {
                        typedef unsigned u32x2g __attribute__((ext_vector_type(2)));
                        u32x2g w;
                        w.x = (unsigned)(v0[0] * 255.0f + 0.5f) | ((unsigned)(v0[1] * 255.0f + 0.5f) << 8) | ((unsigned)(v0[2] * 255.0f + 0.5f) << 16) | ((unsigned)(v0[3] * 255.0f + 0.5f) << 24);
                        w.y = (unsigned)(v1[0] * 255.0f + 0.5f) | ((unsigned)(v1[1] * 255.0f + 0.5f) << 8) | ((unsigned)(v1[2] * 255.0f + 0.5f) << 16) | ((unsigned)(v1[3] * 255.0f + 0.5f) << 24);
                        *(u32x2g*)((unsigned char*)gates + (size_t)(row0 + ai * HALF + m * 16) * 2048 + colw + 8 * fq) = w;
                    } else {
                    const int pc = colw - 2048;
                    if (pc <= 640) {
                        float s = (v0[0] * v0[0] + v0[1] * v0[1]) + (v0[2] * v0[2] + v0[3] * v0[3]) + (v1[0] * v1[0] + v1[1] * v1[1]) + (v1[2] * v1[2] + v1[3] * v1[3]);
                        s += __int_as_float(__builtin_amdgcn_ds_swizzle(__float_as_int(s), 0x401F));
                    { unsigned r0_ = __float_as_uint(s), r1_ = r0_;
#if __has_builtin(__builtin_amdgcn_permlane32_swap)
                      auto r_ = __builtin_amdgcn_permlane32_swap(r0_, r1_, false, false); r0_ = r_[0]; r1_ = r_[1];
#else
                      asm volatile("v_permlane32_swap_b32 %0, %1" : "+v"(r0_), "+v"(r1_));
#endif
                      asm volatile("" : "+v"(r0_), "+v"(r1_));
                      s = __uint_as_float(r0_) + __uint_as_float(r1_); }
                        if (fq == 0) ssqc[(size_t)(row0 + ai * HALF + m * 16) * 24 + (pc >> 5)] = s;
                    }
                    if (pc == 640) {
                        const float p = (float)pos[row0 + ai * HALF + m * 16];
                        float x[8] = {v0[0], v0[1], v0[2], v0[3], v1[0], v1[1], v1[2], v1[3]};
#pragma unroll
                        for (int e8 = 0; e8 < 8; ++e8) {
                            const float other = __shfl_xor(x[e8], 32);
                            const float ang = p * __builtin_amdgcn_exp2f(-(float)(8 * (fq & 1) + e8) * 0.8304820237218406f);
                            const float nn = rintf(ang * 0.15915494309189535f);
                            float r = fmaf(-nn, 6.28318548202514648f, ang); r = fmaf(-nn, -1.7484556e-7f, r); r *= 0.15915494309189535f;
                            const float sn = __builtin_amdgcn_sinf(r), cs = __builtin_amdgcn_cosf(r);
                            x[e8] = (fq < 2) ? x[e8] * cs - other * sn : other * sn + x[e8] * cs;
                        }
                        v0 = (f32x4){x[0], x[1], x[2], x[3]}; v1 = (f32x4){x[4], x[5], x[6], x[7]};
                    }
                    u32x4 w; w.x = cvt_pk_bf16(v0[0], v0[1]); w.y = cvt_pk_bf16(v0[2], v0[3]); w.z = cvt_pk_bf16(v1[0], v1[1]); w.w = cvt_pk_bf16(v1[2], v1[3]);
                    *(u32x4*)(dst + (size_t)(row0 + ai * HALF + m * 16) * ld) = w; }
                }
        }
    }
};

struct EpiKV {
    static constexpr bool PERM = true, AFTER_DRAIN = false;
    bf16_t* K; bf16_t* V; const bf16_t* kpep; const float* ssqc; const float* gk;
    __device__ __forceinline__ void operator()(const f32x4 (&acc)[2][2][4][2], const Unit& u, int wr, int wc, int fr, int fq) const {
        { const int ln = fresh_lane(); fr = ln & 15; fq = ln >> 4; }
        const int row0 = u.pm * BM + wr * 64 + fr, head = 2 * u.pn + (wc >> 1);
        const bool isk = (wc & 1) == 0;
#pragma unroll
        for (int ai = 0; ai < 2; ++ai)
#pragma unroll
            for (int m = 0; m < 4; ++m) {
                __builtin_amdgcn_sched_barrier(0);
                const size_t row = (size_t)(row0 + ai * HALF + m * 16);
                const f32x4* sp = (const f32x4*)(ssqc + row * 24);
                const f32x4 sa = sp[3], sb = sp[4];
                const float rkv = 16.0f * __builtin_amdgcn_rsqf(((sa[0] + sa[1]) + (sa[2] + sa[3]) + (sb[0] + sb[1]) + (sb[2] + sb[3])) + 256e-6f);
                const f32x4 a0 = acc[ai][0][m][0], a1 = acc[ai][0][m][1], b0 = acc[ai][1][m][0], b1 = acc[ai][1][m][1];
                if (isk) {
                    float s = (a0[0] * a0[0] + a0[1] * a0[1]) + (a0[2] * a0[2] + a0[3] * a0[3]) + (a1[0] * a1[0] + a1[1] * a1[1]) + (a1[2] * a1[2] + a1[3] * a1[3])
                            + (b0[0] * b0[0] + b0[1] * b0[1]) + (b0[2] * b0[2] + b0[3] * b0[3]) + (b1[0] * b1[0] + b1[1] * b1[1]) + (b1[2] * b1[2] + b1[3] * b1[3]);
                    s += __int_as_float(__builtin_amdgcn_ds_swizzle(__float_as_int(s), 0x401F));
                    { unsigned r0_ = __float_as_uint(s), r1_ = r0_;
#if __has_builtin(__builtin_amdgcn_permlane32_swap)
                      auto r_ = __builtin_amdgcn_permlane32_swap(r0_, r1_, false, false); r0_ = r_[0]; r1_ = r_[1];
#else
                      asm volatile("v_permlane32_swap_b32 %0, %1" : "+v"(r0_), "+v"(r1_));
#endif
                      asm volatile("" : "+v"(r0_), "+v"(r1_));
                      s = __uint_as_float(r0_) + __uint_as_float(r1_); }
                    const float sspe = ssqc[row * 24 + 20];
                    const float rn = 9.797958971f * __builtin_amdgcn_rsqf((rkv * rkv * s + sspe) + 96e-6f), sc = rkv * rn;
                    bf16_t* kp = K + (row * 8 + head) * 96 + 8 * fq;
                    { asm volatile("" ::: "memory"); const f32x4 ga = *(const f32x4*)(gk + 8 * fq), gb = *(const f32x4*)(gk + 8 * fq + 4);
                      u32x4 w; w.x = cvt_pk_bf16(a0[0] * sc * ga[0], a0[1] * sc * ga[1]); w.y = cvt_pk_bf16(a0[2] * sc * ga[2], a0[3] * sc * ga[3]);
                      w.z = cvt_pk_bf16(a1[0] * sc * gb[0], a1[1] * sc * gb[1]); w.w = cvt_pk_bf16(a1[2] * sc * gb[2], a1[3] * sc * gb[3]);
                      *(u32x4*)(kp) = w; }
                    { asm volatile("" ::: "memory"); const f32x4 ga = *(const f32x4*)(gk + 32 + 8 * fq), gb = *(const f32x4*)(gk + 32 + 8 * fq + 4);
                      u32x4 w; w.x = cvt_pk_bf16(b0[0] * sc * ga[0], b0[1] * sc * ga[1]); w.y = cvt_pk_bf16(b0[2] * sc * ga[2], b0[3] * sc * ga[3]);
                      w.z = cvt_pk_bf16(b1[0] * sc * gb[0], b1[1] * sc * gb[1]); w.w = cvt_pk_bf16(b1[2] * sc * gb[2], b1[3] * sc * gb[3]);
                      *(u32x4*)(kp + 32) = w; }
                    { asm volatile("" ::: "memory"); const f32x4 ga = *(const f32x4*)(gk + 64 + 8 * fq), gb = *(const f32x4*)(gk + 64 + 8 * fq + 4);
                      const u32x4 pe = *(const u32x4*)(kpep + row * 544 + 8 * fq);
                      u32x4 w; w.x = cvt_pk_bf16(bflo(pe.x) * rn * ga[0], bfhi(pe.x) * rn * ga[1]); w.y = cvt_pk_bf16(bflo(pe.y) * rn * ga[2], bfhi(pe.y) * rn * ga[3]);
                      w.z = cvt_pk_bf16(bflo(pe.z) * rn * gb[0], bfhi(pe.z) * rn * gb[1]); w.w = cvt_pk_bf16(bflo(pe.w) * rn * gb[2], bfhi(pe.w) * rn * gb[3]);
                      *(u32x4*)(kp + 64) = w; }
                } else {
                    bf16_t* vp = V + (row * 8 + head) * 64 + 8 * fq;
                    u32x4 w; w.x = cvt_pk_bf16(a0[0] * rkv, a0[1] * rkv); w.y = cvt_pk_bf16(a0[2] * rkv, a0[3] * rkv); w.z = cvt_pk_bf16(a1[0] * rkv, a1[1] * rkv); w.w = cvt_pk_bf16(a1[2] * rkv, a1[3] * rkv);
                    *(u32x4*)(vp) = w;
                    w.x = cvt_pk_bf16(b0[0] * rkv, b0[1] * rkv); w.y = cvt_pk_bf16(b0[2] * rkv, b0[3] * rkv); w.z = cvt_pk_bf16(b1[0] * rkv, b1[1] * rkv); w.w = cvt_pk_bf16(b1[2] * rkv, b1[3] * rkv);
                    *(u32x4*)(vp + 32) = w;
                }
            }
    }
};

struct EpiMix {
    static constexpr bool PERM = true, AFTER_DRAIN = false;
    const bf16_t* a; const bf16_t* gates; bf16_t* mix;
    __device__ __forceinline__ void operator()(const f32x4 (&acc)[2][2][4][2], const Unit& u, int wr, int wc, int fr, int fq) const {
        const int row0 = u.pm * BM + wr * 64 + fr, col0 = u.pn * BM + wc * 32 + 8 * fq;
#pragma unroll
        for (int ai = 0; ai < 2; ++ai)
#pragma unroll
            for (int m = 0; m < 4; ++m) {
                const size_t row = (size_t)(row0 + ai * HALF + m * 16);
#pragma unroll
                for (int bj = 0; bj < 2; ++bj) {
                    const int c = col0 + bj * HALF;
                    const u32x4 av = *(const u32x4*)(a + row * 1024 + c);
                    typedef unsigned u32x2g __attribute__((ext_vector_type(2)));
                    const u32x2g g0 = *(const u32x2g*)((const unsigned char*)gates + row * 2048 + c);
                    const u32x2g g1 = *(const u32x2g*)((const unsigned char*)gates + row * 2048 + 1024 + c);
                    const float k = 1.0f / 255.0f;
                    const f32x4 v0 = acc[ai][bj][m][0] * k, v1 = acc[ai][bj][m][1] * k;
#define GB(W, B) ((float)(((W) >> (8 * (B))) & 0xffu))
                    u32x4 w;
                    w.x = cvt_pk_bf16(GB(g0.x, 0) * k * bflo(av.x) + GB(g1.x, 0) * v0[0], GB(g0.x, 1) * k * bfhi(av.x) + GB(g1.x, 1) * v0[1]);
                    w.y = cvt_pk_bf16(GB(g0.x, 2) * k * bflo(av.y) + GB(g1.x, 2) * v0[2], GB(g0.x, 3) * k * bfhi(av.y) + GB(g1.x, 3) * v0[3]);
                    w.z = cvt_pk_bf16(GB(g0.y, 0) * k * bflo(av.z) + GB(g1.y, 0) * v1[0], GB(g0.y, 1) * k * bfhi(av.z) + GB(g1.y, 1) * v1[1]);
                    w.w = cvt_pk_bf16(GB(g0.y, 2) * k * bflo(av.w) + GB(g1.y, 2) * v1[2], GB(g0.y, 3) * k * bfhi(av.w) + GB(g1.y, 3) * v1[3]);
#undef GB
                    *(u32x4*)(mix + row * 1024 + c) = w;
                }
            }
    }
};

struct EpiRes {
    static constexpr bool PERM = false, AFTER_DRAIN = false;
    const bf16_t* xin; bf16_t* xout; float* ssq;
    __device__ __forceinline__ void operator()(const f32x4 (&acc)[2][2][4][2], const Unit& u, int wr, int wc, int fr, int fq) const {
        const int row0 = u.pm * BM + wr * 64 + fr, col0 = u.pn * BM + wc * 32 + 4 * fq;
        typedef unsigned u32x2 __attribute__((ext_vector_type(2)));
#pragma unroll
        for (int ai = 0; ai < 2; ++ai)
#pragma unroll
            for (int m = 0; m < 4; ++m) {
                const size_t row = (size_t)(row0 + ai * HALF + m * 16); float s = 0.f;
#pragma unroll
                for (int bj = 0; bj < 2; ++bj)
#pragma unroll
                    for (int n = 0; n < 2; ++n) {
                        const size_t off = row * 1024 + col0 + bj * HALF + n * 16;
                        const u32x2 xi = *(const u32x2*)(xin + off);
                        const f32x4 xo = (f32x4){bflo(xi.x), bfhi(xi.x), bflo(xi.y), bfhi(xi.y)} + acc[ai][bj][m][n];
                        s += (xo[0] * xo[0] + xo[1] * xo[1]) + (xo[2] * xo[2] + xo[3] * xo[3]);
                        u32x2 w; w.x = cvt_pk_bf16(xo[0], xo[1]); w.y = cvt_pk_bf16(xo[2], xo[3]);
                        *(u32x2*)(xout + off) = w;
                    }
                s += __int_as_float(__builtin_amdgcn_ds_swizzle(__float_as_int(s), 0x401F));
                    { unsigned r0_ = __float_as_uint(s), r1_ = r0_;
#if __has_builtin(__builtin_amdgcn_permlane32_swap)
                      auto r_ = __builtin_amdgcn_permlane32_swap(r0_, r1_, false, false); r0_ = r_[0]; r1_ = r_[1];
#else
                      asm volatile("v_permlane32_swap_b32 %0, %1" : "+v"(r0_), "+v"(r1_));
#endif
                      asm volatile("" : "+v"(r0_), "+v"(r1_));
                      s = __uint_as_float(r0_) + __uint_as_float(r1_); }
                if (fq == 0) ssq[row * 16 + u.pn * 4 + wc] = s;
            }
    }
};
template <class Epi, class Sched, bool ALIGN_EPI = false, bool SP2 = false>
__device__ __forceinline__ void gemm_phase(PG8_LAS unsigned char* lds, const Gemm g, const Sched& S, const Epi& E, const int wave_id) {
    const int wid = wave_id, lane = fresh_lane(), tid = (wid << 6) | lane, wr = wid >> 2, wc = wid & 3, fr = lane & 15, fq = lane >> 4;
    const int K = g.K, nt = K / BK;
    unsigned voffA[2], voffB[2];
#pragma unroll
    for (int i = 0; i < 2; ++i) { int R, C; stage_rc(tid * 16 + i * 8192, R, C); const int Rb = Epi::PERM ? ((R & ~31) + perm32(R & 31)) : R;
        voffA[i] = (unsigned)(R * K + C) * 2u; voffB[i] = (unsigned)(Rb * K + C) * 2u; }
    const size_t kstep = (size_t)(BK * 2);
    const size_t hstep = (size_t)HALF * K * 2;
    const size_t tstep = 2 * hstep;
    const unsigned ldsw = (unsigned)wid * 1024u;
    const int aoff = lds_byte(wr * 64 + fr, fq * 8), boff = lds_byte(wc * 32 + fr, fq * 8);
#define PG8_SA(b, h) (((b) * 2 + (h)) * HTB)
#define PG8_SB(b, h) ((4 + (b) * 2 + (h)) * HTB)
#define PG8_STAGE(bufoff, gbase, voff) do { _Pragma("unroll") for (int _i = 0; _i < 2; ++_i) \
        __builtin_amdgcn_global_load_lds((const unsigned*)((const char*)(gbase) + (voff)[_i]), (PG8_LAS unsigned*)(lds + (bufoff) + ldsw + _i * 8192), 16, 0, 0); } while (0)
#define PG8_LDA(dst, b, h) do { _Pragma("unroll") for (int m = 0; m < 4; ++m) _Pragma("unroll") for (int k = 0; k < 2; ++k) dst[m][k] = *(const PG8_LAS bf16x8*)(lds + PG8_SA(b, h) + aoff + m * 2048 + k * 1024); } while (0)
#define PG8_LDB(dst, b, h) do { _Pragma("unroll") for (int n = 0; n < 2; ++n) _Pragma("unroll") for (int k = 0; k < 2; ++k) dst[n][k] = *(const PG8_LAS bf16x8*)(lds + PG8_SB(b, h) + boff + n * 2048 + k * 1024); } while (0)
#define PG8_MMA(ai, bj, At, Bt) do { __builtin_amdgcn_s_setprio(1); _Pragma("unroll") for (int m = 0; m < 4; ++m) _Pragma("unroll") for (int n = 0; n < 2; ++n) _Pragma("unroll") for (int k = 0; k < 2; ++k) \
        acc[ai][bj][m][n] = __builtin_amdgcn_mfma_f32_16x16x32_bf16(Bt[n][k], At[m][k], acc[ai][bj][m][n], 0, 0, 0); __builtin_amdgcn_s_setprio(0); } while (0)
#define PG8_WAIT_V(n) asm volatile("s_waitcnt vmcnt(" #n ")" ::: "memory")
#define PG8_WAIT_L(n) asm volatile("s_waitcnt lgkmcnt(" #n ")" ::: "memory")
#define PG8_BAR __builtin_amdgcn_s_barrier()
#define PG8_SCHED __builtin_amdgcn_sched_barrier(0)
    Unit cur, nxt; int ui = 0;
    if (!S.next(0, cur)) return;
    f32x4 acc[2][2][4][2];
#pragma unroll
    for (int a = 0; a < 2; ++a)
#pragma unroll
        for (int b = 0; b < 2; ++b)
#pragma unroll
            for (int m = 0; m < 4; ++m)
#pragma unroll
                for (int n = 0; n < 2; ++n) acc[a][b][m][n] = (f32x4){0.f, 0.f, 0.f, 0.f};
    bf16x8 At[4][2], B0[2][2], B1[2][2];
    const char* cA = (const char*)g.A + (size_t)cur.pm * tstep; const char* cB = (const char*)g.Bt + (size_t)cur.pn * tstep;
    S.a_ready(cur);
    if constexpr (SP2) {
        PG8_STAGE(PG8_SB(0, 0), cB, voffB); PG8_STAGE(PG8_SB(0, 1), cB + hstep, voffB); PG8_STAGE(PG8_SA(0, 0), cA, voffA); PG8_STAGE(PG8_SA(0, 1), cA + hstep, voffA);
        if (wr == 1) PG8_BAR;
        PG8_WAIT_V(2); PG8_BAR;
        PG8_STAGE(PG8_SB(1, 0), cB + kstep, voffB); PG8_STAGE(PG8_SA(1, 0), cA + kstep, voffA); PG8_STAGE(PG8_SB(1, 1), cB + hstep + kstep, voffB);
        PG8_WAIT_V(6); PG8_BAR;
    } else {
        PG8_STAGE(PG8_SB(0, 0), cB, voffB); PG8_STAGE(PG8_SA(0, 0), cA, voffA); PG8_STAGE(PG8_SB(0, 1), cB + hstep, voffB); PG8_STAGE(PG8_SA(0, 1), cA + hstep, voffA);
        if (wr == 1) PG8_BAR;
        PG8_WAIT_V(4); PG8_BAR;
        PG8_STAGE(PG8_SB(1, 0), cB + kstep, voffB); PG8_STAGE(PG8_SA(1, 0), cA + kstep, voffA); PG8_STAGE(PG8_SB(1, 1), cB + hstep + kstep, voffB);
        PG8_WAIT_V(6); PG8_BAR;
    }
    for (;;) {
        const bool has_next = S.next(ui + 1, nxt);
        const char* nA = has_next ? (const char*)g.A + (size_t)nxt.pm * tstep : cA; const char* nB = has_next ? (const char*)g.Bt + (size_t)nxt.pn * tstep : cB;
        for (int t = 0; t < nt; t += 2) {
            const bool last = (t == nt - 2);
            const char* a1 = cA + (size_t)(t + 1) * kstep;
            const char* a2 = last ? nA : cA + (size_t)(t + 2) * kstep; const char* b2 = last ? nB : cB + (size_t)(t + 2) * kstep;
            const char* a3 = a2 + kstep; const char* b3 = b2 + kstep;
            if (last && has_next) S.a_ready(nxt);
            if constexpr (SP2) {
            PG8_LDB(B0, 0, 0); PG8_LDB(B1, 0, 1); PG8_SCHED; PG8_LDA(At, 0, 0); PG8_STAGE(PG8_SA(1, 1), a1 + hstep, voffA);
            PG8_WAIT_V(8); PG8_WAIT_L(0); PG8_BAR; PG8_MMA(0, 0, At, B0); PG8_MMA(0, 1, At, B1); PG8_BAR; PG8_SCHED;
            PG8_LDA(At, 0, 1); PG8_STAGE(PG8_SB(0, 0), b2, voffB); PG8_STAGE(PG8_SB(0, 1), b2 + hstep, voffB); PG8_STAGE(PG8_SA(0, 0), a2, voffA);
            PG8_WAIT_V(8); PG8_WAIT_L(0); PG8_BAR; PG8_MMA(1, 0, At, B0); PG8_MMA(1, 1, At, B1); PG8_BAR; PG8_SCHED;
            PG8_LDB(B0, 1, 0); PG8_LDB(B1, 1, 1); PG8_SCHED; PG8_LDA(At, 1, 0); PG8_STAGE(PG8_SA(0, 1), a2 + hstep, voffA);
            PG8_WAIT_V(8); PG8_WAIT_L(0); PG8_BAR; PG8_MMA(0, 0, At, B0); PG8_MMA(0, 1, At, B1); PG8_BAR; PG8_SCHED;
            PG8_LDA(At, 1, 1); PG8_STAGE(PG8_SB(1, 0), b3, voffB); PG8_STAGE(PG8_SB(1, 1), b3 + hstep, voffB); PG8_STAGE(PG8_SA(1, 0), a3, voffA);
            PG8_WAIT_V(8); PG8_WAIT_L(0); PG8_BAR; PG8_MMA(1, 0, At, B0); PG8_MMA(1, 1, At, B1); PG8_BAR; PG8_SCHED;
            } else {
            PG8_LDB(B0, 0, 0); PG8_SCHED; PG8_LDA(At, 0, 0); PG8_STAGE(PG8_SA(1, 1), a1 + hstep, voffA);
            PG8_WAIT_L(8); PG8_BAR; PG8_WAIT_L(0); PG8_MMA(0, 0, At, B0); PG8_BAR; PG8_SCHED;
            PG8_LDB(B1, 0, 1); PG8_STAGE(PG8_SB(0, 0), b2, voffB);
            PG8_BAR; PG8_WAIT_L(0); PG8_MMA(0, 1, At, B1); PG8_BAR;
            PG8_LDA(At, 0, 1); PG8_STAGE(PG8_SA(0, 0), a2, voffA);
            PG8_BAR; PG8_WAIT_L(0); PG8_MMA(1, 0, At, B0); PG8_BAR; PG8_SCHED;
            PG8_STAGE(PG8_SB(0, 1), b2 + hstep, voffB);
            PG8_WAIT_V(6); PG8_BAR; PG8_MMA(1, 1, At, B1); PG8_BAR;
            PG8_LDB(B0, 1, 0); PG8_SCHED; PG8_LDA(At, 1, 0); PG8_STAGE(PG8_SA(0, 1), a2 + hstep, voffA);
            PG8_WAIT_L(8); PG8_BAR; PG8_WAIT_L(0); PG8_MMA(0, 0, At, B0); PG8_BAR; PG8_SCHED;
            PG8_LDB(B1, 1, 1); PG8_STAGE(PG8_SB(1, 0), b3, voffB);
            PG8_BAR; PG8_WAIT_L(0); PG8_MMA(0, 1, At, B1); PG8_BAR;
            PG8_LDA(At, 1, 1); PG8_STAGE(PG8_SA(1, 0), a3, voffA);
            PG8_BAR; PG8_WAIT_L(0); PG8_MMA(1, 0, At, B0); PG8_BAR; PG8_SCHED;
            PG8_STAGE(PG8_SB(1, 1), b3 + hstep, voffB);
            PG8_WAIT_V(6); PG8_BAR; PG8_MMA(1, 1, At, B1); PG8_BAR;
            }
        }
        if constexpr (ALIGN_EPI) { if (wr == 0) PG8_BAR; }
        if constexpr (!Epi::AFTER_DRAIN) { E(acc, cur, wr, wc, fr, fq); S.done(cur); }
        if (!has_next) break;
#pragma unroll
        for (int a = 0; a < 2; ++a)
#pragma unroll
            for (int b = 0; b < 2; ++b)
#pragma unroll
                for (int m = 0; m < 4; ++m)
#pragma unroll
                    for (int n = 0; n < 2; ++n) acc[a][b][m][n] = (f32x4){0.f, 0.f, 0.f, 0.f};
        cur = nxt; cA = nA; cB = nB; ++ui;
        if constexpr (ALIGN_EPI) { if (wr == 1) PG8_BAR; }
    }
    PG8_WAIT_V(0);
    if constexpr (!ALIGN_EPI) { if (wr == 0) PG8_BAR; }
    PG8_BAR;
    if constexpr (Epi::AFTER_DRAIN) { E.fused(acc, cur, wr, wc, fr, fq, lds, wid, lane); S.done(cur); }
#undef PG8_SA
#undef PG8_SB
#undef PG8_STAGE
#undef PG8_LDA
#undef PG8_LDB
#undef PG8_MMA
#undef PG8_WAIT_V
#undef PG8_WAIT_L
#undef PG8_BAR
#undef PG8_SCHED
}
}
namespace att {
typedef unsigned short bf16;
using bf16x8 = __attribute__((ext_vector_type(8))) short;
using s16x4  = __attribute__((ext_vector_type(4))) short;
using f32x16 = __attribute__((ext_vector_type(16))) float;
using u32x4  = __attribute__((ext_vector_type(4))) unsigned;
constexpr int   DQ = 96, DV = 64, NW = 8, QBLK = 32, KVBLK = 64;
constexpr int   ND0 = DQ / 16;
constexpr int   NDV = DV / 32;
constexpr float SCALE = 0.10206207261596575f;
constexpr float THR = 8.f;
constexpr int   LDQ = 768, LDK = 768, LDV = 512, LDO = 512;
constexpr size_t SHM_V = KVBLK * 128 * 2, SHM_K = KVBLK * 128 * 2, SHM_ATTN = 2 * SHM_V + 2 * SHM_K + NW * 64 * 4;
#define KSWZ(row, colB) ((row) * 256 + ((colB) ^ (((row) & 7) << 4)))
#define SBAR() __builtin_amdgcn_sched_barrier(0)
__device__ __forceinline__ int crow(int r, int hi) { return (r & 3) + 8 * (r >> 2) + 4 * hi; }
__device__ __forceinline__ unsigned cvtpk(float lo, float hi) { unsigned r; asm volatile("v_cvt_pk_bf16_f32 %0, %1, %2" : "=v"(r) : "v"(lo), "v"(hi)); return r; }

__device__ __forceinline__ void partialSM(f32x16& p0, f32x16& p1, float& m_reg, float& mn, float& alpha) {
  constexpr float C = SCALE * 1.4426950408889634f;
  float pmax = p0[0];
#pragma unroll
  for (int r = 1; r < 16; ++r) pmax = fmaxf(pmax, p0[r]);
#pragma unroll
  for (int r = 0; r < 16; ++r) pmax = fmaxf(pmax, p1[r]);
  { auto rr = __builtin_amdgcn_permlane32_swap(__float_as_uint(pmax), __float_as_uint(pmax), false, false);
    pmax = fmaxf(__uint_as_float(rr[0]), __uint_as_float(rr[1])); }
  if (__builtin_expect(__all(pmax - m_reg <= THR / SCALE), 1)) { mn = m_reg; alpha = 1.f; }
  else { mn = fmaxf(m_reg, pmax); alpha = __builtin_amdgcn_exp2f((m_reg - mn) * C); m_reg = mn; }
  float mnC = -mn * C;
#pragma unroll
  for (int r = 0; r < 16; ++r) p0[r] = fmaf(p0[r], C, mnC);
#pragma unroll
  for (int r = 0; r < 16; ++r) p1[r] = fmaf(p1[r], C, mnC);
#pragma unroll
  for (int r = 0; r < 16; ++r) p0[r] = __builtin_amdgcn_exp2f(p0[r]);
}
__device__ __forceinline__ void finishSM(f32x16& p0, f32x16& p1, float alpha, float& l_reg, bf16x8& pa0, bf16x8& pa1, bf16x8& pa2, bf16x8& pa3) {
#pragma unroll
  for (int r = 0; r < 16; ++r) p1[r] = __builtin_amdgcn_exp2f(p1[r]);
  float ps = 0;
#pragma unroll
  for (int r = 0; r < 16; ++r) ps += p0[r];
#pragma unroll
  for (int r = 0; r < 16; ++r) ps += p1[r];
  { auto rr = __builtin_amdgcn_permlane32_swap(__float_as_uint(ps), __float_as_uint(ps), false, false);
    ps = __uint_as_float(rr[0]) + __uint_as_float(rr[1]); }
  l_reg = l_reg * alpha + ps;
#define PK4(P, BASE, OUT) do { unsigned a0 = cvtpk(P[BASE + 0], P[BASE + 1]), a1 = cvtpk(P[BASE + 2], P[BASE + 3]);   \
    unsigned b0 = cvtpk(P[BASE + 4], P[BASE + 5]), b1 = cvtpk(P[BASE + 6], P[BASE + 7]);                              \
    auto r0 = __builtin_amdgcn_permlane32_swap(a0, b0, false, false); auto r1 = __builtin_amdgcn_permlane32_swap(a1, b1, false, false); \
    u32x4 w = {r0[0], r1[0], r0[1], r1[1]}; OUT = *reinterpret_cast<bf16x8*>(&w); } while (0)
  PK4(p0, 0, pa0); PK4(p0, 8, pa1); PK4(p1, 0, pa2); PK4(p1, 8, pa3);
#undef PK4
}
__device__ __forceinline__ void qkt(f32x16& p0, f32x16& p1, const bf16* Ks, const bf16x8* qr, int r32, int hi) {
  p0 = f32x16{}; p1 = f32x16{};
#pragma unroll
  for (int d0 = 0; d0 < ND0; ++d0) { int cb = (d0 * 16 + hi * 8) * 2;
    bf16x8 b0 = *reinterpret_cast<const bf16x8*>((const char*)Ks + KSWZ(r32, cb));
    bf16x8 b1 = *reinterpret_cast<const bf16x8*>((const char*)Ks + KSWZ(32 + r32, cb));
    p0 = __builtin_amdgcn_mfma_f32_32x32x16_bf16(b0, qr[d0], p0, 0, 0, 0);
    p1 = __builtin_amdgcn_mfma_f32_32x32x16_bf16(b1, qr[d0], p1, 0, 0, 0); }
}
__device__ __forceinline__ int v_st(int k, int c) { const int kk = (k & ~0xC) | ((k & 4) << 1) | ((k & 8) >> 1); return ((kk >> 3) * 4 + (c >> 5)) * 512 + ((kk & 7) * 32 + (c & 31)) * 2; }
__device__ __forceinline__ int v_rd_base(int lane) { return ((lane & 3) << 3) | (((lane >> 2) & 3) << 6) | (((lane >> 4) & 1) << 5) | (((lane >> 5) & 1) << 8); }
constexpr int v_rd_off(int d0, int ks, int half) { return d0 * 512 + ks * 4096 + half * 2048; }
template <int OFF> __device__ __forceinline__ s16x4 tr_read(int vb) {
  s16x4 r; asm volatile("ds_read_b64_tr_b16 %0, %1 offset:%2" : "=&v"(r) : "v"(vb), "i"(OFF) : "memory"); return r;
}
template <int D0> __device__ __forceinline__ void pv_one(f32x16& od, int vb, bf16x8 pa0, bf16x8 pa1, bf16x8 pa2, bf16x8 pa3) {
  const s16x4 l0 = tr_read<v_rd_off(D0, 0, 0)>(vb), h0 = tr_read<v_rd_off(D0, 0, 1)>(vb), l1 = tr_read<v_rd_off(D0, 1, 0)>(vb), h1 = tr_read<v_rd_off(D0, 1, 1)>(vb);
  const s16x4 l2 = tr_read<v_rd_off(D0, 2, 0)>(vb), h2 = tr_read<v_rd_off(D0, 2, 1)>(vb), l3 = tr_read<v_rd_off(D0, 3, 0)>(vb), h3 = tr_read<v_rd_off(D0, 3, 1)>(vb);
  asm volatile("s_waitcnt lgkmcnt(0)" ::: "memory"); SBAR();
#define PK(L, H) (bf16x8){L[0], L[1], L[2], L[3], H[0], H[1], H[2], H[3]}
  od = __builtin_amdgcn_mfma_f32_32x32x16_bf16(pa0, PK(l0, h0), od, 0, 0, 0);
  od = __builtin_amdgcn_mfma_f32_32x32x16_bf16(pa1, PK(l1, h1), od, 0, 0, 0);
  od = __builtin_amdgcn_mfma_f32_32x32x16_bf16(pa2, PK(l2, h2), od, 0, 0, 0);
  od = __builtin_amdgcn_mfma_f32_32x32x16_bf16(pa3, PK(l3, h3), od, 0, 0, 0);
#undef PK
}
__device__ __forceinline__ void pv_d0(f32x16* o, int vb, bf16x8 pa0, bf16x8 pa1, bf16x8 pa2, bf16x8 pa3) {
  pv_one<0>(o[0], vb, pa0, pa1, pa2, pa3); pv_one<1>(o[1], vb, pa0, pa1, pa2, pa3);
}

__device__ __forceinline__ void attn_dense_body(const bf16* __restrict__ Qb, const bf16* __restrict__ Kh, const bf16* __restrict__ Vh,
                                                bf16* __restrict__ Ob, int seq, char* lds, const int wave_id,
                                                const float* __restrict__ ssq, const int* __restrict__ posp, const float* __restrict__ gq) {
  const int wid = wave_id, lane = pg8::fresh_lane(), tid = (wid << 6) | lane, r32 = lane & 31, hi = lane >> 5;
  bf16* V_lds = (bf16*)lds; bf16* K_lds = (bf16*)(lds + 2 * SHM_V);
  float* ws = (float*)(lds + 2 * SHM_V + 2 * SHM_K) + wid * 64; float* li_l = ws; float* al_l = ws + 32;
  float m_reg = -1e30f, l_reg = 0; f32x16 o[NDV] = {}; bf16x8 qr[ND0];
  const bf16* Qw = Qb + (long)(wid * QBLK + r32) * LDQ + hi * 8;
#pragma unroll
  for (int d0 = 0; d0 < ND0; ++d0) qr[d0] = *reinterpret_cast<const bf16x8*>(Qw + d0 * 16);
  {
    const int rowi = wid * QBLK + r32;
    const pg8::f32x4* sp = (const pg8::f32x4*)(ssq + (long)rowi * 24); const pg8::f32x4 sa = sp[0], sb = sp[1], sc = sp[2];
    const float p = (float)posp[rowi];
    const float rq = __builtin_amdgcn_rsqf(((sa[0] + sa[1]) + (sa[2] + sa[3]) + (sb[0] + sb[1]) + (sb[2] + sb[3]) + (sc[0] + sc[1]) + (sc[2] + sc[3])) * (1.0f / 384.0f) + 1e-6f);
    float xs[ND0][8]; float ss = 0.f;
#pragma unroll
    for (int d0 = 0; d0 < 4; ++d0)
#pragma unroll
      for (int j = 0; j < 8; ++j) { const float x = __uint_as_float((unsigned)(unsigned short)qr[d0][j] << 16) * rq; xs[d0][j] = x; ss += x * x; }
#pragma unroll
    for (int j = 0; j < 8; ++j) {
      const float ang = p * __builtin_amdgcn_exp2f(-(float)(8 * hi + j) * 0.8304820237218406f);
      const float n = rintf(ang * 0.15915494309189535f);
      float r = fmaf(-n, 6.28318548202514648f, ang); r = fmaf(-n, -1.7484556e-7f, r); r *= 0.15915494309189535f;
      const float sn = __builtin_amdgcn_sinf(r), cs = __builtin_amdgcn_cosf(r);
      const float x1 = __uint_as_float((unsigned)(unsigned short)qr[4][j] << 16) * rq, x2 = __uint_as_float((unsigned)(unsigned short)qr[5][j] << 16) * rq;
      const float y1 = x1 * cs - x2 * sn, y2 = x1 * sn + x2 * cs;
      xs[4][j] = y1; xs[5][j] = y2; ss += y1 * y1 + y2 * y2; }
    { unsigned r0_ = __float_as_uint(ss), r1_ = r0_;
      auto r_ = __builtin_amdgcn_permlane32_swap(r0_, r1_, false, false); r0_ = r_[0]; r1_ = r_[1];
      asm volatile("" : "+v"(r0_), "+v"(r1_));
      ss = __uint_as_float(r0_) + __uint_as_float(r1_); }
    const float rn = __builtin_amdgcn_rsqf(ss * (1.0f / 96.0f) + 1e-6f);
#pragma unroll
    for (int d0 = 0; d0 < ND0; ++d0) {
      const pg8::f32x4 ga = *(const pg8::f32x4*)(gq + 16 * d0 + 8 * hi), gb = *(const pg8::f32x4*)(gq + 16 * d0 + 8 * hi + 4);
      u32x4 w; w.x = cvtpk(xs[d0][0] * rn * ga[0], xs[d0][1] * rn * ga[1]); w.y = cvtpk(xs[d0][2] * rn * ga[2], xs[d0][3] * rn * ga[3]);
      w.z = cvtpk(xs[d0][4] * rn * gb[0], xs[d0][5] * rn * gb[1]); w.w = cvtpk(xs[d0][6] * rn * gb[2], xs[d0][7] * rn * gb[3]);
      qr[d0] = *reinterpret_cast<bf16x8*>(&w); } }
  const int kr0 = tid / 12, kc0 = tid - kr0 * 12, kr1 = (512 + tid) / 12, kc1 = (512 + tid) - kr1 * 12, vr0 = tid >> 3, vc0 = tid & 7;
  const int kst0 = KSWZ(kr0, kc0 * 16), kst1 = KSWZ(kr1, kc1 * 16), vst0 = v_st(vr0, vc0 * 8);
  const bool k2 = wid < 4;
  const int vb0 = (int)(uintptr_t)V_lds + v_rd_base(lane);
  struct { bf16x8 vs0, ks0, ks1; } sr_[2];
#define SLOAD(i, k0) do { sr_[i].vs0 = *reinterpret_cast<const bf16x8*>(&Vh[(long)((k0) + vr0) * LDV + vc0 * 8]); \
    sr_[i].ks0 = *reinterpret_cast<const bf16x8*>(&Kh[(long)((k0) + kr0) * LDK + kc0 * 8]); \
    if (k2) sr_[i].ks1 = *reinterpret_cast<const bf16x8*>(&Kh[(long)((k0) + kr1) * LDK + kc1 * 8]); } while (0)
#define SWRITE(b, i) do { *(bf16x8*)((char*)V_lds + (b) * SHM_V + vst0) = sr_[i].vs0;          \
    *(bf16x8*)((char*)K_lds + (b) * SHM_K + kst0) = sr_[i].ks0;                       \
    if (k2) *(bf16x8*)((char*)K_lds + (b) * SHM_K + kst1) = sr_[i].ks1; } while (0)
#define SWAIT() do { if (k2) asm volatile("s_waitcnt vmcnt(3)" ::: "memory"); else asm volatile("s_waitcnt vmcnt(2)" ::: "memory"); } while (0)
#define RESC(a) do { if (__any((a) < 1.f)) { if (hi == 0) al_l[r32] = (a); asm volatile("s_waitcnt lgkmcnt(0)" ::: "memory"); \
    _Pragma("unroll") for (int d = 0; d < NDV; ++d) _Pragma("unroll") for (int r = 0; r < 16; ++r) o[d][r] *= al_l[crow(r, hi)]; } } while (0)
  f32x16 pA0, pA1, pB0, pB1; float mnA, mnB, alA, alB; bf16x8 pa0, pa1, pa2, pa3; const int NT = seq / KVBLK;
  constexpr int SE = 0, SO = 1;
  SLOAD(SE, 0); asm volatile("s_waitcnt vmcnt(0)" ::: "memory"); SWRITE(0, SE); __syncthreads();
  qkt(pA0, pA1, K_lds, qr, r32, hi); partialSM(pA0, pA1, m_reg, mnA, alA);
  SLOAD(SO, KVBLK); if (2 < NT) SLOAD(SE, 2 * KVBLK);
  SWAIT(); SWRITE(1, SO); __syncthreads();
  for (int j = 1; j + 1 < NT; j += 2) {
    SBAR(); qkt(pB0, pB1, (bf16*)((char*)K_lds + SHM_K), qr, r32, hi);
    finishSM(pA0, pA1, alA, l_reg, pa0, pa1, pa2, pa3); SBAR();
    SLOAD(SO, (j + 2) * KVBLK); SBAR();
    pv_d0(o, vb0, pa0, pa1, pa2, pa3); partialSM(pB0, pB1, m_reg, mnB, alB);
    __syncthreads(); SWAIT(); SWRITE(0, SE);
    RESC(alB); __syncthreads();
    SBAR(); qkt(pA0, pA1, K_lds, qr, r32, hi);
    finishSM(pB0, pB1, alB, l_reg, pa0, pa1, pa2, pa3); SBAR();
    if (j + 3 < NT) SLOAD(SE, (j + 3) * KVBLK); SBAR();
    pv_d0(o, vb0 + (int)SHM_V, pa0, pa1, pa2, pa3); partialSM(pA0, pA1, m_reg, mnA, alA);
    __syncthreads(); SWAIT(); SWRITE(1, SO);
    RESC(alA); __syncthreads();
  }
  SBAR(); qkt(pB0, pB1, (bf16*)((char*)K_lds + SHM_K), qr, r32, hi);
  finishSM(pA0, pA1, alA, l_reg, pa0, pa1, pa2, pa3); SBAR();
  pv_d0(o, vb0, pa0, pa1, pa2, pa3); partialSM(pB0, pB1, m_reg, mnB, alB);
  __syncthreads(); RESC(alB);
  finishSM(pB0, pB1, alB, l_reg, pa0, pa1, pa2, pa3); SBAR();
  pv_d0(o, vb0 + (int)SHM_V, pa0, pa1, pa2, pa3);
  if (hi == 0) li_l[r32] = l_reg; asm volatile("s_waitcnt lgkmcnt(0)" ::: "memory");
  float rli[16];
#pragma unroll
  for (int r = 0; r < 16; ++r) rli[r] = __builtin_amdgcn_rcpf(li_l[crow(r, hi)]);
  bf16* Ow = Ob + (long)(wid * QBLK) * LDO;
#pragma unroll
  for (int r = 0; r < 16; ++r) { int orow = crow(r, hi);
#pragma unroll
    for (int d0 = 0; d0 < NDV; ++d0) Ow[(long)orow * LDO + d0 * 32 + r32] = (bf16)(cvtpk(o[d0][r] * rli[r], 0.f) & 0xffffu); }
#undef SLOAD
#undef SWRITE
#undef SWAIT
#undef RESC
}
#undef KSWZ
#undef SBAR
}
constexpr int NWAVES = 8;
#ifndef MK_ONE_LAUNCH
#define MK_ONE_LAUNCH 1
#endif
constexpr int NB = 8, SEQ = 2048, DM = 1024, MTOK = NB * SEQ, DEPTH = 2;
constexpr int NH = 8, QL = 384, KVL = 256, NOPE = 64, ROPE = 32, QKH = 96, VHD = 64;
constexpr int PW = 512, INW = 3232, INWP = 3328, KPEPW = 544;
constexpr int NKEY = 128, NEXP = 16384, TOPK = 16;
constexpr float RMS_EPS = 1e-6f;
constexpr size_t MiB = 1u << 20;
constexpr size_t WS_CTL = 0;
constexpr size_t WS_W = 1 * MiB, W_STRIDE = 18 * MiB;
constexpr size_t WO_WIN = 0, WO_WUQ = 6656 * 1024, WO_WUKV = 7424 * 1024, WO_WO = 8 * MiB, WO_WC = 9 * MiB, WO_WOUT = 10 * MiB, WO_WQ = 12 * MiB, WO_KEYS = 16 * MiB;
constexpr size_t WS_U = 40 * MiB, WS_V = 72 * MiB, UV_STRIDE = 16 * MiB;
constexpr size_t WS_SU = 512 * 1024, WS_SV = 768 * 1024, SC_STRIDE = 64 * 1024;
constexpr size_t WS_XB = 168 * MiB;
constexpr size_t WS_GATES = 232 * MiB, WS_QP = 232 * MiB;
constexpr size_t WS_CQ = 296 * MiB, WS_CKV = 308 * MiB, WS_KPEP = 316 * MiB, WS_QRAW = 333 * MiB, WS_KVRAW = 357 * MiB;
constexpr size_t WS_ABUF = 296 * MiB, WS_MIX = 328 * MiB;
constexpr size_t WS_MIXED = 389 * MiB;
constexpr size_t WS_Q = 405 * MiB, WS_K = 429 * MiB, WS_VV = 453 * MiB;
constexpr size_t WS_E = 405 * MiB, WS_G = 413 * MiB, WS_XQ = 429 * MiB, WS_WF = 445 * MiB, WS_HPI = 232 * MiB;
constexpr size_t WS_O = 469 * MiB, WS_SSQ = 485 * MiB, WS_RR = 486 * MiB, WS_SX = WS_RR + 65536, WS_WSUM = WS_RR + 131072, WS_SSQN = WS_RR + 262144, WS_SSQC = 487 * MiB, WS_END = 489 * MiB;
static_assert(WO_WUQ >= (size_t)INWP * DM * 2 && WO_WUKV >= WO_WUQ + 768 * 384 * 2 && WO_WO >= WO_WUKV + 1024 * 256 * 2, "weight map");
static_assert(WS_KPEP + (size_t)MTOK * KPEPW * 2 <= WS_QRAW && WS_QRAW + (size_t)MTOK * 768 * 2 <= WS_KVRAW && WS_KVRAW + (size_t)MTOK * 1024 * 2 <= WS_MIXED, "ws map");

constexpr int LDS_BYTES = 147456;

#define GAS __attribute__((address_space(1)))
#define LAS __attribute__((address_space(3)))
typedef unsigned short bf16;
typedef unsigned v4u __attribute__((ext_vector_type(4)));
typedef unsigned v2u __attribute__((ext_vector_type(2)));
typedef float f32x4 __attribute__((ext_vector_type(4)));
typedef float f32x16 __attribute__((ext_vector_type(16)));
typedef short bf16x8 __attribute__((ext_vector_type(8)));
#define LDS_WAIT() asm volatile("s_waitcnt lgkmcnt(0)" ::: "memory")
__device__ __forceinline__ unsigned f2bf(float f) { unsigned u = __builtin_bit_cast(unsigned, f); return (u + 0x7fffu + ((u >> 16) & 1u)) >> 16; }
__device__ __forceinline__ unsigned pk2(float lo, float hi) { return f2bf(lo) | (f2bf(hi) << 16); }
__device__ __forceinline__ float blo(unsigned w) { return __builtin_bit_cast(float, w << 16); }
__device__ __forceinline__ float bhi(unsigned w) { return __builtin_bit_cast(float, w & 0xffff0000u); }
__device__ __forceinline__ float wave_sum(float v) {
#pragma unroll
    for (int o = 1; o < 64; o <<= 1) v += __shfl_xor(v, o);
    return v;
}

#define XB_TMO      128
#define XB_XCNT(j)  (256  + 64 * (j))
#define XB_XSUB(j)  (1280 + 64 * (j))
#define XB_XGEN(j)  (2304 + 64 * (j))
#define XB_TOP      3328
#define XB_TOPGEN   3392
#define XCD_BAR_WORDS 3456
#define XB_SPIN_CAP (1u << 18)

__device__ __forceinline__ unsigned xb_ld(unsigned* p)              { return __hip_atomic_load(p, __ATOMIC_RELAXED, __HIP_MEMORY_SCOPE_AGENT); }
__device__ __forceinline__ unsigned xb_add(unsigned* p, unsigned v) { return __hip_atomic_fetch_add(p, v, __ATOMIC_RELAXED, __HIP_MEMORY_SCOPE_AGENT); }
__device__ __forceinline__ unsigned xb_xcc_id() { return (unsigned)__builtin_amdgcn_s_getreg((3 << 11) | 20) & 0xFu; }
#define XB_SPIN(cond, bar) do { unsigned _sp = 0; while (cond) { __builtin_amdgcn_s_sleep(1); \
    if ((++_sp & 255u) == 0u) { if (xb_ld(&(bar)[XB_TMO])) break; if (_sp > XB_SPIN_CAP) { atomicAdd(&(bar)[XB_TMO], 1u); break; } } } } while (0)

struct XcdBarrier {
    unsigned* bar; unsigned x;
    volatile LAS unsigned* st;
};

__device__ __forceinline__ XcdBarrier xcd_barrier_post(unsigned* bar, volatile LAS unsigned* st) {
    XcdBarrier b; b.bar = bar; b.x = xb_xcc_id(); b.st = st;
    if (threadIdx.x == 0) (void)xb_add(&bar[XB_XCNT(b.x)], 1u);
    return b;
}
__device__ __forceinline__ void xcd_barrier_complete(unsigned* bar, unsigned x, unsigned& nloc, unsigned& nx) {
    const unsigned G = gridDim.x * gridDim.y * gridDim.z;
    unsigned sum, cnt, mine, sp = 0u;
    for (;;) {
        sum = 0u; cnt = 0u; mine = 0u;
#pragma unroll
        for (unsigned j = 0; j < 16; ++j) { const unsigned c = xb_ld(&bar[XB_XCNT(j)]); sum += c; cnt += (c > 0u) ? 1u : 0u; mine = (j == x) ? c : mine; }
        if (sum == G) break;
        __builtin_amdgcn_s_sleep(1);
        if ((++sp & 255u) == 0u) { if (xb_ld(&bar[XB_TMO])) break; if (sp > XB_SPIN_CAP) { atomicAdd(&bar[XB_TMO], 1u); break; } }
    }
    nloc = mine > 0u ? mine : 1u; nx = cnt > 0u ? cnt : 1u;
}

__device__ __forceinline__ void xcd_barrier(const XcdBarrier& b) {
    asm volatile("s_waitcnt vmcnt(0)" ::: "memory");
    __syncthreads();
    if (threadIdx.x == 0) {
        unsigned* bar = b.bar; unsigned bx_ = b.x;
        asm volatile("" : "+s"(bar), "+s"(bx_));
        __builtin_amdgcn_s_waitcnt(0);
        unsigned nloc = b.st[0], nx = b.st[1];
        if (nloc == 0u) { xcd_barrier_complete(bar, bx_, nloc, nx); b.st[0] = nloc; b.st[1] = nx; }
        const unsigned old = xb_add(&bar[XB_XSUB(bx_)], 1u);
        const unsigned gen = old / nloc;
        if (old + 1u == (gen + 1u) * nloc) {
            __builtin_amdgcn_fence(__ATOMIC_RELEASE, "agent");
            asm volatile("s_waitcnt vmcnt(0)" ::: "memory");
            const unsigned og = xb_add(&bar[XB_TOP], 1u);
            const unsigned tg = og / nx;
            if (og + 1u == (tg + 1u) * nx) xb_add(&bar[XB_TOPGEN], 1u);
            else XB_SPIN(xb_ld(&bar[XB_TOPGEN]) == tg, bar);
            __builtin_amdgcn_fence(__ATOMIC_ACQUIRE, "agent");
            xb_add(&bar[XB_XGEN(bx_)], 1u);
            asm volatile("s_waitcnt vmcnt(0)" ::: "memory");
        } else {
            XB_SPIN(xb_ld(&bar[XB_XGEN(bx_)]) == gen, bar);
            __builtin_amdgcn_fence(__ATOMIC_ACQUIRE, "agent");
            asm volatile("s_waitcnt vmcnt(0)" ::: "memory");
        }
    }
    __syncthreads();
}

constexpr int MISC_OFF = 131072 + 320;
constexpr size_t CTL_ZERO_BYTES = 65536;

struct Args { const void* in[21]; float* out; unsigned char* ws; int ph_lo, ph_hi; };
static_assert(sizeof(Args) == 23 * 8 + 8, "Args has no padding");


typedef const char __attribute__((address_space(4)))* kseg_t;
__device__ __forceinline__ const void* karg_ptr(int i) {
    kseg_t base = (kseg_t)__builtin_amdgcn_kernarg_segment_ptr();
    asm volatile("" : "+s"(base));
    return *(const void* const __attribute__((address_space(4)))*)(base + 8 * i);
}
__device__ __forceinline__ int karg_int(int byte_off) {
    kseg_t base = (kseg_t)__builtin_amdgcn_kernarg_segment_ptr();
    asm volatile("" : "+s"(base));
    return *(const int __attribute__((address_space(4)))*)(base + byte_off);
}
#define KIN(i) karg_ptr(i)
#define KOUT ((float*)karg_ptr(21))
#define KWS ((unsigned char*)karg_ptr(22))

struct Frame {
    LAS unsigned char* lds;
    int wave, vcu, G, gw, NGW, bx;
};
__device__ __forceinline__ Frame fresh_frame(const Frame& F) {
    Frame R = F;
    asm volatile("" : "+s"(R.wave), "+s"(R.vcu), "+s"(R.G), "+s"(R.gw), "+s"(R.NGW), "+s"(R.bx));
    return R;
}

__device__ __forceinline__ void transpose_item(const float* W, int ldw, int n_begin, int nblk, const float* gain, bf16* WT, int K, int row_off, LAS float* scr, int item, int lane, int permkv = 0) {
    const int kb = item / nblk, nb = item % nblk, k0 = 64 * kb, n0 = 32 * nb;
    const int nd0 = permkv ? 256 * (n0 >> 8) + 128 * ((n0 >> 5) & 1) + 32 * (2 * ((n0 >> 7) & 1) + ((n0 >> 6) & 1)) : n0;
    float tv[32];
#pragma unroll
    for (int i = 0; i < 32; ++i) tv[i] = W[(size_t)(k0 + 2 * i + (lane >> 5)) * ldw + n_begin + n0 + (lane & 31)];
    if (gain) {
#pragma unroll
        for (int i = 0; i < 32; ++i) tv[i] *= gain[k0 + 2 * i + (lane >> 5)]; }
#pragma unroll
    for (int i = 0; i < 32; ++i) scr[(2 * i + (lane >> 5)) * 33 + (lane & 31)] = tv[i];
    LDS_WAIT(); asm volatile("" ::: "memory");
    const int c = lane & 7;
#pragma unroll
    for (int j = 0; j < 4; ++j) { const int n = (lane >> 3) + 8 * j; const LAS float* s = scr + (8 * c) * 33 + n;
        v4u o; o.x = pk2(s[0 * 33], s[1 * 33]); o.y = pk2(s[2 * 33], s[3 * 33]); o.z = pk2(s[4 * 33], s[5 * 33]); o.w = pk2(s[6 * 33], s[7 * 33]);
        *(GAS v4u*)(WT + (size_t)(row_off + nd0 + n) * K + k0 + 8 * c) = o; }
    LDS_WAIT(); asm volatile("" ::: "memory");
}
__device__ __forceinline__ void rms_row_to_bf16(const float* xrow, const float* g, bf16* orow, int lane) {
    const f32x4* xr = (const f32x4*)xrow + lane; const f32x4* gr = (const f32x4*)g + lane;
    f32x4 v[4]; float s = 0.f;
#pragma unroll
    for (int j = 0; j < 4; ++j) { v[j] = xr[64 * j]; s += (v[j].x * v[j].x + v[j].y * v[j].y) + (v[j].z * v[j].z + v[j].w * v[j].w); }
    const float r = 1.0f / sqrtf(wave_sum(s) * (1.f / DM) + RMS_EPS);
    v2u* o8 = (v2u*)orow + lane;
#pragma unroll
    for (int j = 0; j < 4; ++j) { const f32x4 gv = gr[64 * j]; v2u w; w.x = pk2(v[j].x * r * gv.x, v[j].y * r * gv.y); w.y = pk2(v[j].z * r * gv.z, v[j].w * r * gv.w); o8[64 * j] = w; }
}
__device__ __forceinline__ void cvt8(const float* src, bf16* dst, size_t i8) {
    const f32x4 a = *(const f32x4*)(src + i8 * 8), b = *(const f32x4*)(src + i8 * 8 + 4);
    v4u o; o.x = pk2(a.x, a.y); o.y = pk2(a.z, a.w); o.z = pk2(b.x, b.y); o.w = pk2(b.z, b.w);
    *(v4u*)(dst + i8 * 8) = o;
}

__device__ __forceinline__ void convert_tables(int l, int cw, int ncw) {
    const int lane = pg8::fresh_lane();
    constexpr int NR = 8;
    for (int it0 = cw * NR; it0 < 2 * NEXP; it0 += ncw * NR) {
        f32x4 va[NR][4]; float m[NR];
#pragma unroll
        for (int r = 0; r < NR; ++r) { const int it = it0 + r, tab = it / NEXP, row = l * NEXP + it % NEXP;
            const f32x4* src = (const f32x4*)((const float*)(tab ? KIN(20) : KIN(19)) + (size_t)row * DM) + lane;
#pragma unroll
            for (int j = 0; j < 4; ++j) va[r][j] = __builtin_nontemporal_load(src + 64 * j); }
#pragma unroll
        for (int r = 0; r < NR; ++r) { float mm = 0.f;
#pragma unroll
            for (int j = 0; j < 4; ++j) mm = fmaxf(mm, fmaxf(fmaxf(fabsf(va[r][j].x), fabsf(va[r][j].y)), fmaxf(fabsf(va[r][j].z), fabsf(va[r][j].w))));
            m[r] = mm; }
#pragma unroll
        for (int o = 1; o < 64; o <<= 1)
#pragma unroll
            for (int r = 0; r < NR; ++r) m[r] = fmaxf(m[r], __shfl_xor(m[r], o));
#pragma unroll
        for (int r = 0; r < NR; ++r) { const int it = it0 + r, tab = it / NEXP, row = l * NEXP + it % NEXP;
            const float inv = m[r] > 0.f ? 127.0f / m[r] : 0.f;
#define Q8(x) ((unsigned)((int)rintf((x) * inv) & 255))
            unsigned char* dstb = KWS + (tab ? WS_V : WS_U) + (size_t)l * UV_STRIDE + (size_t)(it % NEXP) * 128 + ((4 * lane) & 127);
#pragma unroll
            for (int j = 0; j < 4; ++j) *(unsigned*)(dstb + (size_t)(2 * j + (lane >> 5)) * (NEXP * 128)) = Q8(va[r][j].x) | (Q8(va[r][j].y) << 8) | (Q8(va[r][j].z) << 16) | (Q8(va[r][j].w) << 24);
#undef Q8
            if (lane == 0) ((float*)(KWS + WS_SU))[2 * row + tab] = m[r] * (1.0f / 127.0f); }
    }
}

__device__ __forceinline__ void ph_prologue(Frame& F) {
    LAS float* scr = (LAS float*)(F.lds + F.wave * 16384);
    const int gw = F.gw, NGW = F.NGW, lane = pg8::fresh_lane();
    constexpr int I_G = 16 * 64, I_P = 16 * 37, I_UQ = 6 * 24, I_UKV = 4 * 32, I_O = 8 * 32, I_OUT = 16 * 32, I_WQ = 16 * 64;
    constexpr int I_L = I_G + I_P + I_UQ + I_UKV + I_O + I_OUT + I_WQ;
    for (int it = gw; it < DEPTH * I_L; it += NGW) {
        const int l = it / I_L; int r = it % I_L;
        unsigned char* wb = KWS + WS_W + (size_t)l * W_STRIDE;
        const float* w_in = (const float*)KIN(3) + (size_t)l * DM * INW;
        const float* g1 = (const float*)KIN(2) + (size_t)l * DM;
        if (r < I_G) { transpose_item(w_in, INW, 1184, 64, g1, (bf16*)(wb + WO_WIN), DM, 0, scr, r, lane); continue; } r -= I_G;
        if (r < I_P) { transpose_item(w_in, INW, 0, 37, g1, (bf16*)(wb + WO_WIN), DM, 2048, scr, r, lane); continue; } r -= I_P;
        if (r < I_UQ) { transpose_item((const float*)KIN(6) + (size_t)l * QL * 768, 768, 0, 24, (const float*)KIN(4) + l * QL, (bf16*)(wb + WO_WUQ), QL, 0, scr, r, lane); continue; } r -= I_UQ;
        if (r < I_UKV) { transpose_item((const float*)KIN(7) + (size_t)l * KVL * 1024, 1024, 0, 32, (const float*)KIN(5) + l * KVL, (bf16*)(wb + WO_WUKV), KVL, 0, scr, r, lane, 1); continue; } r -= I_UKV;
        if (r < I_O) { transpose_item((const float*)KIN(10) + (size_t)l * 512 * DM, DM, 0, 32, nullptr, (bf16*)(wb + WO_WO), 512, 0, scr, r, lane); continue; } r -= I_O;
        if (r < I_OUT) { transpose_item((const float*)KIN(15) + (size_t)l * DM * DM, DM, 0, 32, nullptr, (bf16*)(wb + WO_WOUT), DM, 0, scr, r, lane); continue; } r -= I_OUT;
        transpose_item((const float*)KIN(17) + (size_t)l * DM * 2048, 2048, 0, 64, (const float*)KIN(16) + (size_t)l * DM, (bf16*)(wb + WO_WQ), DM, 0, scr, r, lane);
    }
    for (int i = gw * 64 + lane; i < DEPTH * 96 * DM / 8; i += NGW * 64) {
        const int l = i / (96 * DM / 8), r = i % (96 * DM / 8);
        *(v4u*)((bf16*)(KWS + WS_W + (size_t)l * W_STRIDE + WO_WIN) + (size_t)INW * DM + (size_t)r * 8) = (v4u){0u, 0u, 0u, 0u};
    }
    for (int it = gw; it < DEPTH * 16 * 32; it += NGW) {
        const int l = it >> 9, cb = (it >> 5) & 15, db = it & 31, g = cb >> 2, r32 = lane & 31, hi = lane >> 5;
        const float* pw = (const float*)KIN(11) + (size_t)l * 4 * 128 * 128 + (size_t)(cb * 32 + r32) * 128 + 64 * hi;
        const float* ps = (const float*)KIN(12) + (size_t)l * 512 + g * 128 + 64 * hi;
        const float* wp = (const float*)KIN(13) + (size_t)l * 512 * DM + (size_t)(g * 128 + 64 * hi) * DM + db * 32 + r32;
        float av[64], bv[64];
#pragma unroll
        for (int j = 0; j < 16; ++j) { const f32x4 v = *(const f32x4*)(pw + 4 * j); av[4 * j] = v.x; av[4 * j + 1] = v.y; av[4 * j + 2] = v.z; av[4 * j + 3] = v.w; }
#pragma unroll
        for (int j = 0; j < 64; ++j) bv[j] = wp[(size_t)j * DM];
#pragma unroll
        for (int j = 0; j < 16; ++j) { const f32x4 s4 = *(const f32x4*)(ps + 4 * j); bv[4 * j] *= s4.x; bv[4 * j + 1] *= s4.y; bv[4 * j + 2] *= s4.z; bv[4 * j + 3] *= s4.w; }
        f32x16 acc = f32x16{};
#pragma unroll
        for (int s = 0; s < 64; ++s) acc = __builtin_amdgcn_mfma_f32_32x32x2f32(av[s], bv[s], acc, 0, 0, 0);
        bf16* dst = (bf16*)(KWS + WS_W + (size_t)l * W_STRIDE + WO_WC) + (size_t)(db * 32 + r32) * 512 + cb * 32 + 4 * hi;
#pragma unroll
        for (int q = 0; q < 4; ++q) { v2u o; o.x = pk2(acc[4 * q], acc[4 * q + 1]); o.y = pk2(acc[4 * q + 2], acc[4 * q + 3]); *(v2u*)(dst + 8 * q) = o; }
    }
    for (int i = gw * 64 + lane; i < DEPTH * 16 * 128 * 128 / 8; i += NGW * 64) {
        const int l = i / (16 * 128 * 128 / 8), r = i % (16 * 128 * 128 / 8);
        cvt8((const float*)KIN(18) + (size_t)l * 16 * 128 * 128, (bf16*)(KWS + WS_W + (size_t)l * W_STRIDE + WO_KEYS), (size_t)r);
    }
    for (int m0 = gw; m0 < MTOK; m0 += 2 * NGW) {
        f32x4 v[2][4]; float s[2];
#pragma unroll
        for (int u = 0; u < 2; ++u) { const int m = (m0 + u * NGW < MTOK) ? m0 + u * NGW : m0; const f32x4* xr = (const f32x4*)((const float*)KIN(0) + (size_t)m * DM) + lane;
#pragma unroll
            for (int j = 0; j < 4; ++j) v[u][j] = xr[64 * j]; }
#pragma unroll
        for (int u = 0; u < 2; ++u) { float ss = 0.f;
#pragma unroll
            for (int j = 0; j < 4; ++j) ss += (v[u][j].x * v[u][j].x + v[u][j].y * v[u][j].y) + (v[u][j].z * v[u][j].z + v[u][j].w * v[u][j].w);
            s[u] = ss; }
#pragma unroll
        for (int o = 1; o < 64; o <<= 1) { s[0] += __shfl_xor(s[0], o); s[1] += __shfl_xor(s[1], o); }
#pragma unroll
        for (int u = 0; u < 2; ++u) { const int m = m0 + u * NGW; if (m < MTOK) {
            v2u* o8 = (v2u*)((bf16*)(KWS + WS_XB) + (size_t)m * DM) + lane;
#pragma unroll
            for (int j = 0; j < 4; ++j) { v2u w; w.x = pk2(v[u][j].x, v[u][j].y); w.y = pk2(v[u][j].z, v[u][j].w); o8[64 * j] = w; }
            if (lane == 0) { f32x4* sp = (f32x4*)((float*)(KWS + WS_SSQN) + (size_t)m * 8); sp[0] = (f32x4){s[u], 0.f, 0.f, 0.f}; sp[1] = (f32x4){0.f, 0.f, 0.f, 0.f}; } } }
    }
}

__device__ __forceinline__ void ph_pool(Frame& F, int cw, int ncw) {
    const bf16* KP = (const bf16*)(KWS + WS_KPEP); bf16* MX = (bf16*)(KWS + WS_MIXED);
    const int lane = pg8::fresh_lane(), g = lane >> 4, half = 1 << g, c0 = lane * 8;
#define POOL_ACC(W, SGN) do { sum[0] += SGN blo(W.x); sum[1] += SGN bhi(W.x); sum[2] += SGN blo(W.y); sum[3] += SGN bhi(W.y); sum[4] += SGN blo(W.z); sum[5] += SGN bhi(W.z); sum[6] += SGN blo(W.w); sum[7] += SGN bhi(W.w); } while (0)
    for (int run = cw; run < MTOK / 8; run += ncw) {
        const int t0 = run * 8, s0 = t0 & (SEQ - 1);
        v4u row[23];
#pragma unroll
        for (int k = 0; k < 23; ++k) { const int d = k - 8; const bool ok = (d >= -half) && (d < 8 + half - 1 + 1) && (s0 + d >= 0) && (s0 + d < SEQ);
            row[k] = ok ? *(const v4u*)(KP + (size_t)(t0 + d) * KPEPW + 32 + c0) : (v4u){0u, 0u, 0u, 0u}; }
        float sum[8];
#pragma unroll
        for (int j = 0; j < 8; ++j) sum[j] = 0.f;
        int cnt = 0;
#pragma unroll
        for (int d = -8; d < 8; ++d) { const bool ok = (d >= -half) && (d < half) && (s0 + d >= 0) && (s0 + d < SEQ); if (ok) { POOL_ACC(row[d + 8], +); ++cnt; } }
#pragma unroll
        for (int i = 0; i < 8; ++i) {
            const int t = t0 + i, s = s0 + i;
            if (i > 0) {
                const bool lv_ok = (s - 1 - half >= 0), ev_ok = (s + half - 1 < SEQ);
#define POOL_CASE(H) do { if (half == (H)) { if ((i - 1 - (H) + 8) >= 0) { if (lv_ok) { POOL_ACC(row[(i - 1 - (H) + 8) >= 0 ? (i - 1 - (H) + 8) : 0], -); } } if (ev_ok) { POOL_ACC(row[i + (H) - 1 + 8], +); } } } while (0)
                POOL_CASE(1); POOL_CASE(2); POOL_CASE(4); POOL_CASE(8);
#undef POOL_CASE
                if (lv_ok) --cnt;
                if (ev_ok) ++cnt;
            }
            const v4u me = row[i + 8];
            const float ic = 1.0f / (float)cnt;
            v4u o; o.x = pk2(sum[0] * ic - blo(me.x), sum[1] * ic - bhi(me.x)); o.y = pk2(sum[2] * ic - blo(me.y), sum[3] * ic - bhi(me.y));
            o.z = pk2(sum[4] * ic - blo(me.z), sum[5] * ic - bhi(me.z)); o.w = pk2(sum[6] * ic - blo(me.w), sum[7] * ic - bhi(me.w));
            *(v4u*)(MX + (size_t)t * PW + c0) = o;
        }
    }
#undef POOL_ACC
}

__device__ __forceinline__ void ph_finalize(Frame& F, int l) {
    const bf16* QR = (const bf16*)(KWS + WS_QRAW); const float* SSQC = (const float*)(KWS + WS_SSQC);
    bf16* Q = (bf16*)(KWS + WS_Q);
    const int* pos = (const int*)KIN(1);
    const float* ghq = (const float*)KIN(8) + l * QKH;
    const int lane = pg8::fresh_lane(), h = lane >> 3, sub = lane & 7;
    const float inv0 = __builtin_amdgcn_exp2f(-(float)(2 * sub) * 0.8304820237218406f), inv1 = __builtin_amdgcn_exp2f(-(float)(2 * sub + 1) * 0.8304820237218406f);
    float gqn[8];
#pragma unroll
    for (int j = 0; j < 8; ++j) gqn[j] = ghq[8 * sub + j];
    const float gq10 = ghq[64 + 2 * sub], gq11 = ghq[65 + 2 * sub], gq20 = ghq[80 + 2 * sub], gq21 = ghq[81 + 2 * sub];
    for (int t = F.gw; t < MTOK; t += F.NGW) {
        const f32x4* sp = (const f32x4*)(SSQC + (size_t)t * 24); const f32x4 sa = sp[0], sb = sp[1], sc = sp[2];
        const float rq = 1.0f / sqrtf(((sa.x + sa.y) + (sa.z + sa.w) + (sb.x + sb.y) + (sb.z + sb.w) + (sc.x + sc.y) + (sc.z + sc.w)) * (1.f / QL) + RMS_EPS);
        const float p = (float)pos[t];
        float c0, s0, c1, s1;
        { const float a0 = p * inv0, a1 = p * inv1;
          const float n0 = rintf(a0 * 0.15915494309189535f), n1 = rintf(a1 * 0.15915494309189535f);
          float r0 = fmaf(-n0, 6.28318548202514648f, a0); r0 = fmaf(-n0, -1.7484556e-7f, r0);
          float r1 = fmaf(-n1, 6.28318548202514648f, a1); r1 = fmaf(-n1, -1.7484556e-7f, r1);
          r0 *= 0.15915494309189535f; r1 *= 0.15915494309189535f;
          s0 = __builtin_amdgcn_sinf(r0); c0 = __builtin_amdgcn_cosf(r0); s1 = __builtin_amdgcn_sinf(r1); c1 = __builtin_amdgcn_cosf(r1); }
        { const bf16* qp = QR + (size_t)t * 768 + h * QKH;
          const v4u w = *(const v4u*)(qp + 8 * sub); const unsigned wa = *(const unsigned*)(qp + 64 + 2 * sub), wb = *(const unsigned*)(qp + 80 + 2 * sub);
          float x[8] = {blo(w.x), bhi(w.x), blo(w.y), bhi(w.y), blo(w.z), bhi(w.z), blo(w.w), bhi(w.w)};
          float ss = 0.f;
#pragma unroll
          for (int j = 0; j < 8; ++j) { x[j] *= rq; ss += x[j] * x[j]; }
          const float x10 = blo(wa) * rq, x11 = bhi(wa) * rq, x20 = blo(wb) * rq, x21 = bhi(wb) * rq;
          const float y10 = x10 * c0 - x20 * s0, y20 = x10 * s0 + x20 * c0, y11 = x11 * c1 - x21 * s1, y21 = x11 * s1 + x21 * c1;
          ss += (y10 * y10 + y20 * y20) + (y11 * y11 + y21 * y21);
          ss += __shfl_xor(ss, 1); ss += __shfl_xor(ss, 2); ss += __shfl_xor(ss, 4);
          const float rn = 1.0f / sqrtf(ss * (1.f / QKH) + RMS_EPS);
          bf16* qo = Q + (size_t)t * 768 + h * QKH;
          v4u o; o.x = pk2(x[0] * rn * gqn[0], x[1] * rn * gqn[1]); o.y = pk2(x[2] * rn * gqn[2], x[3] * rn * gqn[3]); o.z = pk2(x[4] * rn * gqn[4], x[5] * rn * gqn[5]); o.w = pk2(x[6] * rn * gqn[6], x[7] * rn * gqn[7]);
          *(v4u*)(qo + 8 * sub) = o;
          *(unsigned*)(qo + 64 + 2 * sub) = pk2(y10 * rn * gq10, y11 * rn * gq11);
          *(unsigned*)(qo + 80 + 2 * sub) = pk2(y20 * rn * gq20, y21 * rn * gq21); }
    }
}

__device__ __forceinline__ void ph_attn(Frame& F, unsigned char* lds_generic, int l) {
    const att::bf16* Q = (const att::bf16*)(KWS + WS_QRAW); const att::bf16* K = (const att::bf16*)(KWS + WS_K); const att::bf16* V = (const att::bf16*)(KWS + WS_VV);
    att::bf16* O = (att::bf16*)(KWS + WS_O);
    for (int u = F.vcu; u < NB * NH * (SEQ / 256); u += F.G) {
        const int bh = u >> 3, qb = u & 7, b = bh >> 3, h = bh & 7;
        __syncthreads();
        att::attn_dense_body(Q + ((size_t)(b * SEQ + qb * 256)) * 768 + h * QKH, K + (size_t)(b * SEQ) * 768 + h * QKH, V + (size_t)(b * SEQ) * 512 + h * VHD,
                             O + ((size_t)(b * SEQ + qb * 256)) * 512 + h * VHD, SEQ, (char*)lds_generic, F.wave,
                             (const float*)(KWS + WS_SSQC) + (size_t)(b * SEQ + qb * 256) * 24, (const int*)KIN(1) + (b * SEQ + qb * 256), (const float*)KIN(8) + l * QKH);
    }
    __syncthreads();
}

__device__ __forceinline__ unsigned fkey(float f) { const unsigned b = __builtin_bit_cast(unsigned, f); return b ^ ((unsigned)((int)b >> 31) | 0x80000000u); }
__device__ __forceinline__ float funkey(unsigned u) { const unsigned b = u ^ (~(unsigned)((int)u >> 31) | 0x80000000u); return __builtin_bit_cast(float, b); }
__device__ __forceinline__ unsigned umax(unsigned a, unsigned b) { return a > b ? a : b; }
__device__ __forceinline__ unsigned umin(unsigned a, unsigned b) { return a < b ? a : b; }
#define INS16(T, x) do { unsigned _x = (x); _Pragma("unroll") for (int _i = 0; _i < 16; ++_i) { const unsigned _h = umax(T[_i], _x); _x = umin(T[_i], _x); T[_i] = _h; } } while (0)
__device__ __forceinline__ void sort16_desc(unsigned (&a)[16]) {
#pragma unroll
    for (int k = 2; k <= 16; k <<= 1)
#pragma unroll
        for (int j = k >> 1; j > 0; j >>= 1)
#pragma unroll
            for (int i = 0; i < 16; ++i) { const int l = i ^ j;
                if (l > i) { const unsigned hi = umax(a[i], a[l]), lo = umin(a[i], a[l]); if ((i & k) == 0) { a[i] = hi; a[l] = lo; } else { a[i] = lo; a[l] = hi; } } }
}
__device__ __forceinline__ void merge_top16(unsigned (&T)[16], const unsigned (&S)[16]) {
#pragma unroll
    for (int i = 0; i < 16; ++i) T[i] = umax(T[i], S[15 - i]);
#pragma unroll
    for (int j = 8; j > 0; j >>= 1)
#pragma unroll
        for (int i = 0; i < 16; ++i) { const int l = i ^ j; if (l > i) { const unsigned hi = umax(T[i], T[l]), lo = umin(T[i], T[l]); T[i] = hi; T[l] = lo; } }
}

__device__ __forceinline__ void ph_select(Frame& F, int l) {
    const bf16* QP = (const bf16*)(KWS + WS_QP); const bf16* KEYS = (const bf16*)(KWS + WS_W + (size_t)l * W_STRIDE + WO_KEYS);
    const float* SSQ = (const float*)(KWS + WS_SSQ); float* RR = (float*)(KWS + WS_RR); unsigned* EO = (unsigned*)(KWS + WS_E); float* GO = (float*)(KWS + WS_G);
    const int lane = pg8::fresh_lane(), r32 = lane & 31, hi = lane >> 5;
    LAS unsigned* TL = (LAS unsigned*)(F.lds + 65536) + (F.wave * 64 + lane);
    { const bf16* XG2 = (const bf16*)(KWS + WS_XB); unsigned char* XQ = KWS + WS_XQ; float* SX = (float*)(KWS + WS_SX); const float* g2p = (const float*)KIN(16) + (size_t)l * DM + 16 * lane;
      float g2v[16];
#pragma unroll
      for (int j = 0; j < 4; ++j) { const f32x4 gq = *(const f32x4*)(g2p + 4 * j); g2v[4 * j] = gq.x; g2v[4 * j + 1] = gq.y; g2v[4 * j + 2] = gq.z; g2v[4 * j + 3] = gq.w; }
      for (int t0 = F.gw; t0 < MTOK; t0 += 4 * F.NGW) {
          v4u ra[4], rb[4]; float m[4];
#pragma unroll
          for (int u = 0; u < 4; ++u) { const int t = (t0 + u * F.NGW < MTOK) ? t0 + u * F.NGW : t0; ra[u] = *(const v4u*)(XG2 + (size_t)t * DM + 16 * lane); rb[u] = *(const v4u*)(XG2 + (size_t)t * DM + 16 * lane + 8); }
          float xf[4][16];
#pragma unroll
          for (int u = 0; u < 4; ++u) { const v4u a = ra[u], b = rb[u];
              const float x_[16] = {blo(a.x), bhi(a.x), blo(a.y), bhi(a.y), blo(a.z), bhi(a.z), blo(a.w), bhi(a.w), blo(b.x), bhi(b.x), blo(b.y), bhi(b.y), blo(b.z), bhi(b.z), blo(b.w), bhi(b.w)};
              float mm = 0.f;
#pragma unroll
              for (int j = 0; j < 16; ++j) { xf[u][j] = x_[j] * g2v[j]; mm = fmaxf(mm, fabsf(xf[u][j])); }
              m[u] = mm; }
#pragma unroll
          for (int o = 1; o < 64; o <<= 1)
#pragma unroll
              for (int u = 0; u < 4; ++u) m[u] = fmaxf(m[u], __shfl_xor(m[u], o));
#pragma unroll
          for (int u = 0; u < 4; ++u) { const int t = t0 + u * F.NGW; if (t < MTOK) {
              const float inv = m[u] > 0.f ? 127.0f / m[u] : 0.f;
              v4u q;
#define Q4(j) (((unsigned)((int)rintf(xf[u][4 * (j)] * inv) & 255)) | ((unsigned)((int)rintf(xf[u][4 * (j) + 1] * inv) & 255) << 8) | ((unsigned)((int)rintf(xf[u][4 * (j) + 2] * inv) & 255) << 16) | ((unsigned)((int)rintf(xf[u][4 * (j) + 3] * inv) & 255) << 24))
              q.x = Q4(0); q.y = Q4(1); q.z = Q4(2); q.w = Q4(3);
#undef Q4
              *(v4u*)(XQ + (size_t)(lane >> 3) * ((size_t)MTOK * 128) + (size_t)t * 128 + 16 * (lane & 7)) = q;
              if (lane == 0) SX[t] = m[u] * (1.0f / 127.0f); } }
      } }
    const int h = F.vcu & 7, tbg = F.vcu >> 3, ntbg = F.G >> 3;
    { const int tid = F.wave * 64 + lane;
#pragma unroll
      for (int j = 0; j < 8; ++j) { const int idx = tid + 512 * j, p = idx >> 11, n = (idx >> 4) & 127, ch = idx & 15;
          const v4u v = *(const v4u*)(KEYS + ((size_t)(2 * h + p) * 128 + n) * 128 + ch * 8);
          *(LAS v4u*)(F.lds + p * 32768 + n * 256 + ((ch * 16) ^ ((n & 7) << 4))) = v; }
      __syncthreads(); }
    for (int tb = tbg * 8 + F.wave; tb < MTOK / 32; tb += ntbg * 8) {
        const int tok = tb * 32 + r32;
        float ssq = 0.f;
        { const f32x4* sp = (const f32x4*)(SSQ + (size_t)tok * 16);
#pragma unroll
          for (int j = 0; j < 4; ++j) { const f32x4 v = sp[j]; ssq += (v.x + v.y) + (v.z + v.w); } }
        const float rr = 1.0f / sqrtf(ssq * (1.f / DM) + RMS_EPS);
        if (h == 0 && hi == 0) RR[tok] = rr;
        unsigned C[16];
#pragma unroll
        for (int i = 0; i < 16; ++i) C[i] = 0u;
        {
        unsigned T[2][16];
        bf16x8 qfa[2][8];
#pragma unroll
        for (int p = 0; p < 2; ++p) { const bf16* qrow = QP + (size_t)tok * 2048 + (2 * h + p) * 128 + hi * 8;
#pragma unroll
            for (int s = 0; s < 8; ++s) qfa[p][s] = *(const bf16x8*)(qrow + s * 16); }
#pragma unroll
        for (int p = 0; p < 2; ++p) {
            const int hp = 2 * h + p;
            bf16x8 qf[8];
#pragma unroll
            for (int s = 0; s < 8; ++s) qf[s] = qfa[p][s];
#pragma unroll
            for (int i = 0; i < 16; ++i) T[p][i] = 0u;
#pragma unroll 1
            for (int blk = 0; blk < 4; ++blk) {
                f32x16 acc = f32x16{};
                const int n = blk * 32 + r32; const LAS unsigned char* krow = F.lds + p * 32768 + n * 256; const int sw = (n & 7) << 4;
#pragma unroll
                for (int s = 0; s < 8; ++s) { const bf16x8 a = *(const LAS bf16x8*)(krow + ((32 * s + 16 * hi) ^ sw)); acc = __builtin_amdgcn_mfma_f32_32x32x16_bf16(a, qf[s], acc, 0, 0, 0); }
                const int nb = 127 - (blk * 32 + 4 * hi);
                unsigned K[16];
#pragma unroll
                for (int r = 0; r < 16; ++r) K[r] = (fkey(acc[r]) & ~127u) | (unsigned)(nb - ((r & 3) + 8 * (r >> 2)));
                sort16_desc(K); merge_top16(T[p], K);
            }
            unsigned oth[16];
#pragma unroll
            for (int i = 0; i < 16; ++i) oth[i] = (unsigned)__shfl_xor((int)T[p][i], 32);
            merge_top16(T[p], oth);
#pragma unroll
            for (int i = 0; i < 16; ++i) TL[(p * 16 + i) * 512] = T[p][i];
        }
        float s0[16], s1[16];
#pragma unroll
        for (int i = 0; i < 16; ++i) { s0[i] = funkey((T[0][i] & ~127u) | 64u); s1[i] = funkey((T[1][i] & ~127u) | 64u); }
#define CAND(i, j) ((fkey(s0[i] + s1[j]) & ~255u) | (unsigned)((i) * 16 + (j)))
#pragma unroll
        for (int j = 0; j < 16; ++j) C[j] = CAND(0, j);
        { unsigned B[16];
#pragma unroll
          for (int j = 0; j < 8; ++j) B[j] = CAND(1, j);
#pragma unroll
          for (int j = 0; j < 5; ++j) B[8 + j] = CAND(2, j);
#pragma unroll
          for (int j = 0; j < 3; ++j) B[13 + j] = CAND(4, j);
          sort16_desc(B); merge_top16(C, B); }
        { unsigned B[16];
#pragma unroll
          for (int j = 0; j < 4; ++j) B[j] = CAND(3, j);
#pragma unroll
          for (int j = 0; j < 2; ++j) { B[4 + j] = CAND(5, j); B[6 + j] = CAND(6, j); B[8 + j] = CAND(7, j); }
#pragma unroll
          for (int i = 0; i < 6; ++i) B[10 + i] = CAND(8 + i, 0);
          sort16_desc(B); merge_top16(C, B); }
        INS16(C, CAND(14, 0)); INS16(C, CAND(15, 0));
#undef CAND
        }
        float sc[16]; unsigned ex[16];
#pragma unroll
        for (int k = 0; k < 16; ++k) {
            const unsigned code = C[k] & 255u;
            const unsigned a = TL[(code >> 4) * 512], b = TL[(16 + (code & 15u)) * 512];
            ex[k] = (127u - (a & 127u)) * 128u + (127u - (b & 127u));
            sc[k] = funkey((a & ~127u) | 64u) + funkey((b & ~127u) | 64u);
        }
        float smax = sc[0];
#pragma unroll
        for (int k = 1; k < 16; ++k) smax = fmaxf(smax, sc[k]);
        float den = 0.f;
#pragma unroll
        for (int k = 0; k < 16; ++k) { sc[k] = __builtin_amdgcn_exp2f((sc[k] - smax) * rr * 1.4426950408889634f); den += sc[k]; }
        const float iden = 1.0f / den;
        v4u* edst = (v4u*)(EO + (size_t)tok * 128 + h * 16 + hi * 8); f32x4* gdst = (f32x4*)(GO + (size_t)tok * 128 + h * 16 + hi * 8);
#pragma unroll
        for (int k = 0; k < 8; k += 4) {
            unsigned ea[4], eb[4]; float wa[4], wb2[4];
#pragma unroll
            for (int j = 0; j < 4; ++j) { ea[j] = ex[k + j]; eb[j] = ex[8 + k + j]; wa[j] = sc[k + j]; wb2[j] = sc[8 + k + j];
                asm volatile("" : "+v"(ea[j]), "+v"(eb[j]), "+v"(wa[j]), "+v"(wb2[j])); }
            edst[k >> 2] = (v4u){hi ? eb[0] : ea[0], hi ? eb[1] : ea[1], hi ? eb[2] : ea[2], hi ? eb[3] : ea[3]};
            gdst[k >> 2] = (f32x4){(hi ? wb2[0] : wa[0]) * iden, (hi ? wb2[1] : wa[1]) * iden, (hi ? wb2[2] : wa[2]) * iden, (hi ? wb2[3] : wa[3]) * iden};
        }
    }
}

__device__ __forceinline__ float gelu_tanh(float h) {
    const float z = 0.7978845608028654f * (h + 0.044715f * h * h * h);
    return h * __builtin_amdgcn_rcpf(1.0f + __builtin_amdgcn_exp2f(-2.0f * 1.4426950408889634f * z));
}
__device__ __forceinline__ float ub0(unsigned x) { return (float)(x & 0xffu); }
__device__ __forceinline__ float ub1(unsigned x) { return (float)((x >> 8) & 0xffu); }
__device__ __forceinline__ float ub2(unsigned x) { return (float)((x >> 16) & 0xffu); }
__device__ __forceinline__ float ub3(unsigned x) { return (float)(x >> 24); }
#define DPP_I(x, ctrl) __builtin_amdgcn_update_dpp(0, (x), (ctrl), 0xf, 0xf, false)
#define DPP_F(x, ctrl) __builtin_bit_cast(float, __builtin_amdgcn_update_dpp(0, __builtin_bit_cast(int, (x)), (ctrl), 0xf, 0xf, false))
__device__ __forceinline__ void ph_g1(Frame& F, int l) {
    const unsigned char* XQ = KWS + WS_XQ; const unsigned* E = (const unsigned*)(KWS + WS_E); const unsigned char* U = KWS + WS_U + (size_t)l * UV_STRIDE; short* HPI = (short*)(KWS + WS_HPI);
    const int lane = pg8::fresh_lane(), c = lane & 7, q8 = lane >> 3;
    const int G = F.G, bx = blockIdx.x, wave = F.wave;
    const int nit = (8 * (MTOK / 8) - bx + G - 1) / G;
#define G1_IT(i) (bx + (i) * G)
#define G1_TOK(i) ((G1_IT(i) >> 3) * 8 + wave)
#define G1_COFF(i) ((size_t)128 * (G1_IT(i) & 7) + 16 * c)
#define G1_LOADA(XQV, EV, i) do { const size_t t_ = (size_t)G1_TOK(i); XQV = *(const v4u*)(XQ + (size_t)(G1_IT(i) & 7) * ((size_t)MTOK * 128) + t_ * 128 + 16 * c); \
        _Pragma("unroll") for (int j_ = 0; j_ < 4; ++j_) EV[j_] = *(const v4u*)(E + t_ * 128 + q8 * 16 + 4 * j_); } while (0)
#define G1_LOADB(URV, EV, i) do { const size_t co_ = (size_t)(G1_IT(i) & 7) * (NEXP * 128) + 16 * c; _Pragma("unroll") for (int i_ = 0; i_ < 16; ++i_) URV[i_] = *(const v4u*)(U + (size_t)(EV[i_ >> 2][i_ & 3] & (NEXP - 1)) * 128 + co_); } while (0)
#define G1_COMP(URV, XQV, i) do { int p_[16]; \
        _Pragma("unroll") for (int i_ = 0; i_ < 16; ++i_) { \
            int d_ = __builtin_amdgcn_sdot4((int)URV[i_].x, (int)XQV.x, 0, false); d_ = __builtin_amdgcn_sdot4((int)URV[i_].y, (int)XQV.y, d_, false); \
            d_ = __builtin_amdgcn_sdot4((int)URV[i_].z, (int)XQV.z, d_, false); d_ = __builtin_amdgcn_sdot4((int)URV[i_].w, (int)XQV.w, d_, false); \
            d_ += DPP_I(d_, 0xB1); d_ += DPP_I(d_, 0x4E); d_ += DPP_I(d_, 0x141); p_[i_] = d_; } \
        if (c == 0) { v4u* dst_ = (v4u*)(HPI + ((size_t)(G1_IT(i) & 7) * MTOK + G1_TOK(i)) * 128 + q8 * 16);   \
            _Pragma("unroll") for (int j_ = 0; j_ < 2; ++j_) { unsigned w_[4]; \
                _Pragma("unroll") for (int k_ = 0; k_ < 4; ++k_) w_[k_] = ((unsigned)((p_[8 * j_ + 2 * k_] + 32) >> 6) & 0xffffu) | ((unsigned)((p_[8 * j_ + 2 * k_ + 1] + 32) >> 6) << 16); \
                dst_[j_] = (v4u){w_[0], w_[1], w_[2], w_[3]}; } } } while (0)
    v4u xqA, xqB, xqN = (v4u){0u, 0u, 0u, 0u}, eA[4], eB[4], urA[16], urB[16];
    if (nit > 0) G1_LOADA(xqA, eA, 0);
    if (nit > 1) G1_LOADA(xqB, eB, 1);
    if (nit > 0) G1_LOADB(urA, eA, 0);
    for (int i = 0; i < nit; i += 2) {
        if (i + 1 < nit) G1_LOADB(urB, eB, i + 1);
        if (i + 2 < nit) G1_LOADA(xqN, eA, i + 2);
        G1_COMP(urA, xqA, i);
        xqA = xqN;
        if (i + 1 < nit) {
            if (i + 2 < nit) G1_LOADB(urA, eA, i + 2);
            if (i + 3 < nit) G1_LOADA(xqN, eB, i + 3);
            G1_COMP(urB, xqB, i + 1);
            xqB = xqN;
        }
    }
#undef G1_LOADA
#undef G1_LOADB
#undef G1_COMP
}
__device__ __forceinline__ void ph_g1b(Frame& F, int l) {
    const short* HPI = (const short*)(KWS + WS_HPI); const unsigned* E = (const unsigned*)(KWS + WS_E); const float* G = (const float*)(KWS + WS_G);
    const float* RR = (const float*)(KWS + WS_RR); const float* SX = (const float*)(KWS + WS_SX);
    typedef float f32x2s __attribute__((ext_vector_type(2)));
    const f32x2s* SUV = (const f32x2s*)(KWS + WS_SU) + (size_t)l * NEXP;
    unsigned char* WQ = KWS + WS_WF; float* SW = (float*)(KWS + WS_WSUM);
    const int lane = pg8::fresh_lane();
    typedef int i32x2 __attribute__((ext_vector_type(2))); typedef float f32x2 __attribute__((ext_vector_type(2)));
    constexpr int NU = 4;
    for (int t0 = F.gw; t0 < MTOK; t0 += NU * F.NGW) {
        i32x2 isum[NU]; v2u e2[NU]; f32x2 g2[NU]; float hs[NU];
#pragma unroll
        for (int u = 0; u < NU; ++u) { const int t = (t0 + u * F.NGW < MTOK) ? t0 + u * F.NGW : t0;
            hs[u] = RR[t] * SX[t] * 64.0f;
            isum[u] = (i32x2){0, 0};
#pragma unroll
            for (int s = 0; s < 8; ++s) { const int w = *(const int*)(HPI + ((size_t)s * MTOK + t) * 128 + 2 * lane); isum[u].x += (int)(short)(w & 0xffff); isum[u].y += (w >> 16); }
            e2[u] = *(const v2u*)(E + (size_t)t * 128 + 2 * lane); g2[u] = *(const f32x2*)(G + (size_t)t * 128 + 2 * lane); }
        float w0[NU], w1[NU], m[NU];
#pragma unroll
        for (int u = 0; u < NU; ++u) { const unsigned e0 = e2[u].x & (NEXP - 1), e1 = e2[u].y & (NEXP - 1);
            const f32x2s sa = SUV[e0], sb = SUV[e1];
            w0[u] = g2[u].x * gelu_tanh((float)isum[u].x * hs[u] * sa.x) * sa.y; w1[u] = g2[u].y * gelu_tanh((float)isum[u].y * hs[u] * sb.x) * sb.y;
            m[u] = fmaxf(fabsf(w0[u]), fabsf(w1[u])); }
#pragma unroll
        for (int o = 1; o < 64; o <<= 1)
#pragma unroll
            for (int u = 0; u < NU; ++u) m[u] = fmaxf(m[u], __shfl_xor(m[u], o));
#pragma unroll
        for (int u = 0; u < NU; ++u) { const int t = t0 + u * F.NGW; if (t < MTOK) {
            const float inv = m[u] > 0.f ? 127.0f / m[u] : 0.f;
            const unsigned q = ((unsigned)((int)rintf(w0[u] * inv) & 255)) | ((unsigned)((int)rintf(w1[u] * inv) & 255) << 8);
            *(unsigned short*)(WQ + (size_t)t * 128 + 2 * lane) = (unsigned short)q;
            if (lane == 0) SW[t] = m[u] * (1.0f / 127.0f); } }
    }
}
__device__ __forceinline__ void ph_g2(Frame& F, int l, bf16* Xout) {
    const unsigned* E = (const unsigned*)(KWS + WS_E); const unsigned char* WQ = KWS + WS_WF; const float* SW = (const float*)(KWS + WS_WSUM);
    const unsigned char* V = KWS + WS_V + (size_t)l * UV_STRIDE;
    const bf16* X = (const bf16*)(KWS + WS_XB); float* SSQN = (float*)(KWS + WS_SSQN); float* OUTF = KOUT;
    const bool last = (l + 1 >= DEPTH);
    const int lane = pg8::fresh_lane(), c = lane & 7, q8 = lane >> 3;
    const bool b3 = (lane & 8) != 0;
    const int G = F.G, bx = blockIdx.x, wave = F.wave;
    const int nit = (8 * (MTOK / 8) - bx + G - 1) / G;
    typedef float f32x2 __attribute__((ext_vector_type(2)));
#define G2_LOADE(EV, i) do { const size_t t_ = (size_t)G1_TOK(i); _Pragma("unroll") for (int j_ = 0; j_ < 4; ++j_) EV[j_] = *(const v4u*)(E + t_ * 128 + q8 * 16 + 4 * j_); } while (0)
#define G2_LOADW(WV, SWV, i) do { WV = *(const v4u*)(WQ + (size_t)G1_TOK(i) * 128 + q8 * 16); SWV = SW[G1_TOK(i)]; } while (0)
#define G2_LOADB(VRV, XV, EV, i) do { const size_t co_ = (size_t)(G1_IT(i) & 7) * (NEXP * 128) + 16 * c; _Pragma("unroll") for (int i_ = 0; i_ < 16; ++i_) VRV[i_] = *(const v4u*)(V + (size_t)(EV[i_ >> 2][i_ & 3] & (NEXP - 1)) * 128 + co_); \
        XV = *(const unsigned*)(X + (size_t)G1_TOK(i) * DM + (size_t)128 * (G1_IT(i) & 7) + 16 * c + 2 * q8); } while (0)
#define G2_T4(R0, R1, R2, R3, WQW, A0, A1, A2, A3) do { \
        const unsigned t0_ = __builtin_amdgcn_perm((R1), (R0), 0x05010400u), t1_ = __builtin_amdgcn_perm((R1), (R0), 0x07030602u); \
        const unsigned t2_ = __builtin_amdgcn_perm((R3), (R2), 0x05010400u), t3_ = __builtin_amdgcn_perm((R3), (R2), 0x07030602u); \
        A0 = __builtin_amdgcn_sdot4((int)__builtin_amdgcn_perm(t2_, t0_, 0x05040100u), (int)(WQW), A0, false); \
        A1 = __builtin_amdgcn_sdot4((int)__builtin_amdgcn_perm(t2_, t0_, 0x07060302u), (int)(WQW), A1, false); \
        A2 = __builtin_amdgcn_sdot4((int)__builtin_amdgcn_perm(t3_, t1_, 0x05040100u), (int)(WQW), A2, false); \
        A3 = __builtin_amdgcn_sdot4((int)__builtin_amdgcn_perm(t3_, t1_, 0x07060302u), (int)(WQW), A3, false); } while (0)
#define G2_COMP(VRV, XV, WV, SWV, i) do { int acc_[16]; \
        _Pragma("unroll") for (int j_ = 0; j_ < 16; ++j_) acc_[j_] = 0; \
        _Pragma("unroll") for (int m_ = 0; m_ < 4; ++m_) { const unsigned wq_ = WV[m_]; \
            G2_T4(VRV[4 * m_].x, VRV[4 * m_ + 1].x, VRV[4 * m_ + 2].x, VRV[4 * m_ + 3].x, wq_, acc_[0], acc_[1], acc_[2], acc_[3]); \
            G2_T4(VRV[4 * m_].y, VRV[4 * m_ + 1].y, VRV[4 * m_ + 2].y, VRV[4 * m_ + 3].y, wq_, acc_[4], acc_[5], acc_[6], acc_[7]); \
            G2_T4(VRV[4 * m_].z, VRV[4 * m_ + 1].z, VRV[4 * m_ + 2].z, VRV[4 * m_ + 3].z, wq_, acc_[8], acc_[9], acc_[10], acc_[11]); \
            G2_T4(VRV[4 * m_].w, VRV[4 * m_ + 1].w, VRV[4 * m_ + 2].w, VRV[4 * m_ + 3].w, wq_, acc_[12], acc_[13], acc_[14], acc_[15]); } \
        int a8_[8], a4_[4], a2_[2]; \
        _Pragma("unroll") for (int j_ = 0; j_ < 8; ++j_) { auto r_ = __builtin_amdgcn_permlane32_swap((unsigned)acc_[j_], (unsigned)acc_[j_ + 8], false, false); \
            unsigned r0_ = r_[0], r1_ = r_[1]; asm volatile("" : "+v"(r0_), "+v"(r1_)); a8_[j_] = (int)r0_ + (int)r1_; } \
        _Pragma("unroll") for (int j_ = 0; j_ < 4; ++j_) { auto r_ = __builtin_amdgcn_permlane16_swap((unsigned)a8_[j_], (unsigned)a8_[j_ + 4], false, false); \
            unsigned r0_ = r_[0], r1_ = r_[1]; asm volatile("" : "+v"(r0_), "+v"(r1_)); a4_[j_] = (int)r0_ + (int)r1_; } \
        _Pragma("unroll") for (int j_ = 0; j_ < 2; ++j_) { const int keep_ = b3 ? a4_[j_ + 2] : a4_[j_], send_ = b3 ? a4_[j_] : a4_[j_ + 2]; a2_[j_] = keep_ + DPP_I(send_, 0x128); } \
        const int t_ = G1_TOK(i), s_ = G1_IT(i) & 7; const size_t col_ = (size_t)128 * s_ + 16 * c + 2 * q8; \
        const float sw_ = SWV; \
        f32x2 xo_; xo_.x = blo(XV) + (float)a2_[0] * sw_; xo_.y = bhi(XV) + (float)a2_[1] * sw_; \
        if (last) *(f32x2*)(OUTF + (size_t)t_ * DM + col_) = xo_; \
        else { *(unsigned*)(Xout + (size_t)t_ * DM + col_) = pk2(xo_.x, xo_.y); \
            const float ss_ = wave_sum(xo_.x * xo_.x + xo_.y * xo_.y); if (lane == 0) SSQN[(size_t)t_ * 8 + s_] = ss_; } } while (0)
    v4u eA[4], eB[4], vrA[16], vrB[16], wA, wB; unsigned xA, xB; float swA = 0.f, swB = 0.f;
    if (nit > 0) { G2_LOADE(eA, 0); G2_LOADW(wA, swA, 0); }
    if (nit > 1) { G2_LOADE(eB, 1); G2_LOADW(wB, swB, 1); }
    if (nit > 0) G2_LOADB(vrA, xA, eA, 0);
    for (int i = 0; i < nit; i += 2) {
        if (i + 1 < nit) G2_LOADB(vrB, xB, eB, i + 1);
        if (i + 2 < nit) G2_LOADE(eA, i + 2);
        G2_COMP(vrA, xA, wA, swA, i);
        if (i + 2 < nit) G2_LOADW(wA, swA, i + 2);
        if (i + 1 < nit) {
            if (i + 2 < nit) G2_LOADB(vrA, xA, eA, i + 2);
            if (i + 3 < nit) G2_LOADE(eB, i + 3);
            G2_COMP(vrB, xB, wB, swB, i + 1);
            if (i + 3 < nit) G2_LOADW(wB, swB, i + 3);
        }
    }
#undef G2_LOADE
#undef G2_LOADW
#undef G2_LOADB
#undef G2_COMP
#undef G2_T4
#undef G1_IT
#undef G1_TOK
#undef G1_COFF
}

constexpr int PH_PER_LAYER = 11, N_PHASES = 1 + DEPTH * PH_PER_LAYER;
__global__ void __launch_bounds__(NWAVES * 64, 2) fwd_kernel(Args A) {
    extern __shared__ __attribute__((aligned(16))) unsigned char lds[];
    Frame F;
    F.lds = (LAS unsigned char*)lds;
    F.wave = __builtin_amdgcn_readfirstlane((int)threadIdx.x >> 6);
    F.G = gridDim.x; { const int bx = blockIdx.x; F.vcu = (F.G % 8 == 0) ? (bx % 8) * (F.G / 8) + bx / 8 : bx; }
    F.gw = F.vcu * NWAVES + F.wave; F.NGW = F.G * NWAVES; F.bx = (int)blockIdx.x;
    cg::grid_group grid = cg::this_grid();
    for (int u = threadIdx.x; u < 64; u += NWAVES * 64) ((LAS unsigned*)(F.lds + 131072))[u + 64] = 0u;
    __syncthreads();
    XcdBarrier bar = xcd_barrier_post((unsigned*)(KWS + WS_CTL), (volatile LAS unsigned*)(F.lds + MISC_OFF) + 8);
    const int lo = karg_int(23 * 8), hi = karg_int(23 * 8 + 4);
#ifndef PH_MASK
#define PH_MASK 0xfff
#endif
#define KIND(k) ((k) == 0 ? 0 : 1 + ((k) - 1) % PH_PER_LAYER)
#define IN(k) (((PH_MASK >> KIND(k)) & 1) && lo <= (k) && (k) < hi)
#define SEAM(k) do { if (IN(k) && IN((k) + 1)) xcd_barrier(bar); } while (0)
#ifndef PROBE_KIND
#define PROBE_KIND (-1)
#endif
#define REPS(kind) for (int rep_ = ((kind) == PROBE_KIND ? 0 : 1); rep_ < 2; ++rep_)
#define REP_SYNC() do { if (rep_ == 0) xcd_barrier(bar); } while (0)
    if (lo < 0) grid.sync();
    if (IN(0)) { REPS(0) { ph_prologue(F); REP_SYNC(); } SEAM(0); }
    for (int l = 0; l < DEPTH; ++l) {
        const int p0 = 1 + l * PH_PER_LAYER;
        if (IN(p0 + 0)) { REPS(1) { Frame Fq = fresh_frame(F);
            unsigned char* ws = KWS; unsigned char* wb = ws + WS_W + (size_t)l * W_STRIDE;
            pg8::Gemm g{(const pg8::bf16_t*)(ws + WS_XB), (const pg8::bf16_t*)(wb + WO_WIN), MTOK, INWP, DM}; pg8::StaticOrder S; S.init(MTOK, INWP, Fq.G, Fq.bx);
            pg8::EpiIn E{(pg8::bf16_t*)(ws + WS_GATES), (const float*)KIN(14) + (size_t)l * 2048, (pg8::bf16_t*)(ws + WS_CQ), (pg8::bf16_t*)(ws + WS_CKV), (pg8::bf16_t*)(ws + WS_KPEP), (const float*)(ws + WS_SSQN), (float*)(ws + WS_SSQC), (const int*)KIN(1)};
            pg8::gemm_phase<pg8::EpiIn, pg8::StaticOrder, true, true>(Fq.lds, g, S, E, Fq.wave);
            { const int nu = MTOK / 256 * (INWP / 256), nfull = nu % Fq.G;
              if (nfull == 0) convert_tables(l, Fq.gw, Fq.NGW);
              else if (Fq.bx >= nfull) convert_tables(l, (Fq.bx - nfull) * NWAVES + Fq.wave, (Fq.G - nfull) * NWAVES); }
            REP_SYNC(); }
            SEAM(p0 + 0);
        }
        if (IN(p0 + 1)) { REPS(2) { Frame Fq = fresh_frame(F);
            unsigned char* ws = KWS; unsigned char* wb = ws + WS_W + (size_t)l * W_STRIDE;
            { const int nq = (MTOK / 256) * 3;
              if (nq >= Fq.G) ph_pool(Fq, Fq.gw, Fq.NGW);
              else if (Fq.bx >= nq) ph_pool(Fq, (Fq.bx - nq) * NWAVES + Fq.wave, (Fq.G - nq) * NWAVES); }
            { pg8::Gemm g{(const pg8::bf16_t*)(ws + WS_CQ), (const pg8::bf16_t*)(wb + WO_WUQ), MTOK, 768, QL}; pg8::StaticOrder S; S.init(MTOK, 768, Fq.G, Fq.bx);
              pg8::EpiBf16<0> E{(pg8::bf16_t*)(ws + WS_QRAW), 768, nullptr, 0, 0, 1.f};
              pg8::gemm_phase<pg8::EpiBf16<0>, pg8::StaticOrder, true, true>(Fq.lds, g, S, E, Fq.wave); }
            { int kvl = KVL; asm volatile("" : "+s"(kvl));
              pg8::Gemm g{(const pg8::bf16_t*)(ws + WS_CKV), (const pg8::bf16_t*)(wb + WO_WUKV), MTOK, 1024, kvl}; pg8::StaticOrder S; S.init(MTOK, 1024, Fq.G, Fq.bx);
              pg8::EpiKV E{(pg8::bf16_t*)(ws + WS_K), (pg8::bf16_t*)(ws + WS_VV), (const pg8::bf16_t*)(ws + WS_KPEP), (const float*)(ws + WS_SSQC), (const float*)KIN(9) + l * QKH};
              pg8::gemm_phase<pg8::EpiKV, pg8::StaticOrder, true, true>(Fq.lds, g, S, E, Fq.wave); }
            REP_SYNC(); }
            SEAM(p0 + 1);
        }
        if (IN(p0 + 3)) { REPS(4) { Frame Fq = fresh_frame(F); ph_attn(Fq, lds, l); REP_SYNC(); } SEAM(p0 + 3); }
        if (IN(p0 + 4)) { REPS(5) { Frame Fq = fresh_frame(F);
            unsigned char* ws = KWS; unsigned char* wb = ws + WS_W + (size_t)l * W_STRIDE;
            { pg8::Gemm g{(const pg8::bf16_t*)(ws + WS_O), (const pg8::bf16_t*)(wb + WO_WO), MTOK, DM, 512}; pg8::StaticOrder S; S.init(MTOK, DM, Fq.G, Fq.bx);
              pg8::EpiBf16<0> E{(pg8::bf16_t*)(ws + WS_ABUF), DM, nullptr, 0, 0, 1.f};
              pg8::gemm_phase<pg8::EpiBf16<0>, pg8::StaticOrder, true, true>(Fq.lds, g, S, E, Fq.wave); }
            { pg8::Gemm g{(const pg8::bf16_t*)(ws + WS_MIXED), (const pg8::bf16_t*)(wb + WO_WC), MTOK, DM, 512}; pg8::StaticOrder S; S.init(MTOK, DM, Fq.G, Fq.bx);
              pg8::EpiMix E{(const pg8::bf16_t*)(ws + WS_ABUF), (const pg8::bf16_t*)(ws + WS_GATES), (pg8::bf16_t*)(ws + WS_MIX)};
              pg8::gemm_phase<pg8::EpiMix, pg8::StaticOrder, true, true>(Fq.lds, g, S, E, Fq.wave); }
            REP_SYNC(); }
            SEAM(p0 + 4);
        }
        if (IN(p0 + 5)) { REPS(6) { Frame Fq = fresh_frame(F);
            unsigned char* ws = KWS; unsigned char* wb = ws + WS_W + (size_t)l * W_STRIDE;
            pg8::Gemm g{(const pg8::bf16_t*)(ws + WS_MIX), (const pg8::bf16_t*)(wb + WO_WOUT), MTOK, DM, DM}; pg8::StaticOrder S; S.init(MTOK, DM, Fq.G, Fq.bx);
            pg8::EpiRes E{(const pg8::bf16_t*)(ws + WS_XB), rep_ == 0 ? (pg8::bf16_t*)(ws + WS_GATES) : (pg8::bf16_t*)(ws + WS_XB), (float*)(ws + WS_SSQ)};
            pg8::gemm_phase<pg8::EpiRes, pg8::StaticOrder, true, true>(Fq.lds, g, S, E, Fq.wave);
            REP_SYNC(); }
            SEAM(p0 + 5);
        }
        if (IN(p0 + 6)) { REPS(7) { Frame Fq = fresh_frame(F);
            unsigned char* ws = KWS; unsigned char* wb = ws + WS_W + (size_t)l * W_STRIDE;
            pg8::Gemm g{(const pg8::bf16_t*)(ws + WS_XB), (const pg8::bf16_t*)(wb + WO_WQ), MTOK, 2048, DM}; pg8::StaticOrder S; S.init(MTOK, 2048, Fq.G, Fq.bx);
            pg8::EpiBf16<0> E{(pg8::bf16_t*)(ws + WS_QP), 2048, nullptr, 0, 0, 1.f};
            pg8::gemm_phase<pg8::EpiBf16<0>, pg8::StaticOrder, true, true>(Fq.lds, g, S, E, Fq.wave);
            REP_SYNC(); }
            SEAM(p0 + 6);
        }
        if (IN(p0 + 7)) { REPS(8) { Frame Fq = fresh_frame(F); ph_select(Fq, l); REP_SYNC(); } SEAM(p0 + 7); }
        if (IN(p0 + 8)) { REPS(9) { Frame Fq = fresh_frame(F); ph_g1(Fq, l); REP_SYNC(); } SEAM(p0 + 8); }
        if (IN(p0 + 9)) { REPS(10) { Frame Fq = fresh_frame(F); ph_g1b(Fq, l); REP_SYNC(); } SEAM(p0 + 9); }
        if (IN(p0 + 10)) { REPS(11) { Frame Fq = fresh_frame(F); ph_g2(Fq, l, rep_ == 0 ? (bf16*)(KWS + WS_QP) : (bf16*)(KWS + WS_XB)); REP_SYNC(); } SEAM(p0 + 10); }
    }
#undef IN
#undef SEAM
}

extern "C" void kernel_launch(void* const* d_in, const int* in_sizes, int n_in, void* d_out, int out_size, void* d_ws, size_t ws_size, hipStream_t stream) {
    static int grid = 0;
    if (grid == 0) {
        if (n_in != 21 || in_sizes[0] != MTOK * DM || out_size != MTOK * DM || ws_size < WS_END) {
            fprintf(stderr, "kernel_launch: unexpected shapes: n_in %d in0 %d out %d ws %zu (need %zu)\n", n_in, n_in > 0 ? in_sizes[0] : -1, out_size, ws_size, (size_t)WS_END); grid = -1; return; }
        int dev = 0, cus = 0, per_cu = 0;
        if (hipGetDevice(&dev) != hipSuccess || hipDeviceGetAttribute(&cus, hipDeviceAttributeMultiprocessorCount, dev) != hipSuccess) { grid = -1; return; }
        if (hipFuncSetAttribute((const void*)fwd_kernel, hipFuncAttributeMaxDynamicSharedMemorySize, LDS_BYTES) != hipSuccess) { fprintf(stderr, "kernel_launch: hipFuncSetAttribute failed\n"); grid = -1; return; }
        if (hipOccupancyMaxActiveBlocksPerMultiprocessor(&per_cu, (const void*)fwd_kernel, NWAVES * 64, LDS_BYTES) != hipSuccess || per_cu < 1) { fprintf(stderr, "kernel_launch: occupancy query says %d blocks per CU\n", per_cu); grid = -1; return; }
        (void)hipGetLastError();
        grid = cus & ~7;
    }
    if (grid < 0) return;
    if (hipMemsetAsync((char*)d_ws + WS_CTL, 0, CTL_ZERO_BYTES, stream) != hipSuccess) { fprintf(stderr, "kernel_launch: hipMemsetAsync failed\n"); return; }
    Args a{};
    for (int i = 0; i < 21; ++i) a.in[i] = d_in[i];
    a.out = (float*)d_out; a.ws = (unsigned char*)d_ws;
#if MK_ONE_LAUNCH
    a.ph_lo = 0; a.ph_hi = N_PHASES;
    void* args[] = {&a};
    hipError_t e = hipLaunchCooperativeKernel((const void*)fwd_kernel, dim3(grid), dim3(NWAVES * 64), args, LDS_BYTES, stream);
    if (e != hipSuccess) fprintf(stderr, "kernel_launch: cooperative launch failed: %s (grid %d)\n", hipGetErrorString(e), grid);
#else
    for (int p = 0; p < N_PHASES; ++p) {
        a.ph_lo = p; a.ph_hi = p + 1;
        hipLaunchKernelGGL(fwd_kernel, dim3(grid), dim3(NWAVES * 64), LDS_BYTES, stream, a);
    }
    hipError_t e = hipPeekAtLastError();
    if (e != hipSuccess) fprintf(stderr, "kernel_launch: launch failed: %s\n", hipGetErrorName(e));
#endif
}
```

```cpp
#include <hip/hip_runtime.h>
#include <hip/hip_cooperative_groups.h>
#include <cstdio>
#include <cstdint>
namespace cg = cooperative_groups;
namespace pg8 {
#define PG8_LAS __attribute__((address_space(3)))
typedef unsigned short bf16_t;
typedef short bf16x8 __attribute__((ext_vector_type(8)));
typedef float f32x4 __attribute__((ext_vector_type(4)));
typedef unsigned u32x4 __attribute__((ext_vector_type(4)));
constexpr int BM = 256, BK = 64, HALF = 128, HTB = HALF * BK * 2  , STAGE_BYTES = 8 * HTB, NXCD = 8, WGM = 8;

__host__ __device__ __forceinline__ int lds_byte(int r, int c) { const int st = (r >> 4) * 2 + (c >> 5), rr = r & 15, cc = c & 31, ob = rr * 64 + cc * 2; return st * 1024 + (ob ^ (((ob >> 9) & 1) << 5)); }
__host__ __device__ __forceinline__ void stage_rc(int b, int& R, int& C) { const int st = b / 1024, sb = b % 1024, swz = sb ^ (((sb >> 9) & 1) << 5); R = (st >> 1) * 16 + swz / 64; C = (st & 1) * 32 + (swz % 64) / 2; }
__host__ __device__ __forceinline__ int perm32(int rho) { const int n = rho >> 4, i = rho & 15; return 8 * (i >> 2) + 4 * n + (i & 3); }

struct Unit { int pm, pn; };
struct Gemm { const bf16_t* A; const bf16_t* Bt; int M, N, K; };

struct StaticOrder {
    int nM, nN, nwg, G, c;
    __host__ __device__ void init(int M, int N, int G_, int c_) { nM = M / BM; nN = N / BM; nwg = nM * nN; G = G_; c = c_; }
    __host__ __device__ bool next(int i, Unit& u) const {
        const long L = (long)i * G + c; if (L >= nwg) return false;
        int wgid = (int)L; { const int q = nwg / NXCD, r = nwg % NXCD, xcd = wgid % NXCD, off = wgid / NXCD; wgid = (xcd < r ? xcd * (q + 1) : r * (q + 1) + (xcd - r) * q) + off; }
        const int nig = WGM * nN, gid = wgid / nig, fm = gid * WGM, gsz = (nM - fm) < WGM ? (nM - fm) : WGM;
        u.pm = fm + ((wgid % nig) % gsz); u.pn = (wgid % nig) / gsz; return true;
    }
    __device__ __forceinline__ void a_ready(const Unit&) const {}
    __device__ __forceinline__ void done(const Unit&) const {}
};

__device__ __forceinline__ unsigned cvt_pk_bf16(float lo, float hi) { unsigned r; asm volatile("v_cvt_pk_bf16_f32 %0, %1, %2" : "=v"(r) : "v"(lo), "v"(hi)); return r; }
typedef float f32x2 __attribute__((ext_vector_type(2)));
__device__ __forceinline__ f32x2 gelu_pk(f32x2 v) {
    const f32x2 av = __builtin_elementwise_abs(v), d = av * 0.2316418882f + 1.0f;
    f32x2 t; t.x = __builtin_amdgcn_rcpf(d.x); t.y = __builtin_amdgcn_rcpf(d.y);
    f32x2 q = t * 0.5307027145f + (-0.7265760135f); q = q * t + 0.7107068705f; q = q * t + (-0.142248368f); q = q * t + 0.127414796f; q = q * t;
    const f32x2 s = (v * v) * (-0.72134752044f);
    f32x2 e; e.x = __builtin_amdgcn_exp2f(s.x); e.y = __builtin_amdgcn_exp2f(s.y);
    const f32x2 m = v * (q * e), r = v - m;
    f32x2 o; o.x = v.x < 0.f ? m.x : r.x; o.y = v.y < 0.f ? m.y : r.y; return o;
}

template <int ACT  > struct EpiBf16 {
    static constexpr bool PERM = true, AFTER_DRAIN = false; static_assert(ACT == 0 || ACT == 1, "EpiBf16: ACT is 0 (none) or 1 (gelu_pk)");
    bf16_t* O; int ldc; const float* bias; int split_cols; size_t split_stride; float scale0;
    __device__ __forceinline__ void operator()(const f32x4 (&acc)[2][2][4][2], const Unit& u, int wr, int wc, int fr, int fq) const {
        const int row0 = u.pm * BM + wr * 64 + fr; int colt = u.pn * BM; bf16_t* base = O;
        float sc = 1.f; if (split_cols) { const int t = colt / split_cols; base += (size_t)t * split_stride; colt -= t * split_cols; if (t == 0) sc = scale0; }
        const int col0 = colt + wc * 32 + 8 * fq, bcol0 = u.pn * BM + wc * 32 + 8 * fq;
        f32x4 bv[2][2];
#pragma unroll
        for (int bj = 0; bj < 2; ++bj)
#pragma unroll
            for (int n = 0; n < 2; ++n) bv[bj][n] = bias ? *(const f32x4*)(bias + bcol0 + bj * HALF + 4 * n) : (f32x4){0.f, 0.f, 0.f, 0.f};
#pragma unroll
        for (int ai = 0; ai < 2; ++ai)
#pragma unroll
            for (int m = 0; m < 4; ++m) { bf16_t* rowp = base + (size_t)(row0 + ai * HALF + m * 16) * ldc + col0;
#pragma unroll
                for (int bj = 0; bj < 2; ++bj) { f32x4 v0 = acc[ai][bj][m][0] + bv[bj][0], v1 = acc[ai][bj][m][1] + bv[bj][1];
                    if (ACT == 1) { f32x2 a = gelu_pk((f32x2){v0[0], v0[1]}), b = gelu_pk((f32x2){v0[2], v0[3]}), c = gelu_pk((f32x2){v1[0], v1[1]}), d = gelu_pk((f32x2){v1[2], v1[3]});
                        v0 = (f32x4){a.x, a.y, b.x, b.y}; v1 = (f32x4){c.x, c.y, d.x, d.y}; }
                    v0 = v0 * sc; v1 = v1 * sc; u32x4 w; w.x = cvt_pk_bf16(v0[0], v0[1]); w.y = cvt_pk_bf16(v0[2], v0[3]); w.z = cvt_pk_bf16(v1[0], v1[1]); w.w = cvt_pk_bf16(v1[2], v1[3]);
                    *(u32x4*)(rowp + bj * HALF) = w; } }
    }
};
__device__ __forceinline__ int fresh_lane() { int l; asm volatile("v_mbcnt_lo_u32_b32 %0, -1, 0\n\tv_mbcnt_hi_u32_b32 %0, -1, %0" : "=v"(l)); return l; }
__device__ __forceinline__ float bflo(unsigned w) { return __builtin_bit_cast(float, w << 16); }
__device__ __forceinline__ float bfhi(unsigned w) { return __builtin_bit_cast(float, w & 0xffff0000u); }
__device__ __forceinline__ float sigmoid_f(float x) { return __builtin_amdgcn_rcpf(1.0f + __builtin_amdgcn_exp2f(-1.4426950408889634f * x)); }

struct EpiIn {
    static constexpr bool PERM = true, AFTER_DRAIN = false;
    bf16_t* gates; const float* gbias; bf16_t* cq; bf16_t* ckv; bf16_t* kpep; const float* ssqn; float* ssqc; const int* pos;
    __device__ __forceinline__ void operator()(const f32x4 (&acc)[2][2][4][2], const Unit& u, int wr, int wc, int fr, int fq) const {
        const int row0 = u.pm * BM + wr * 64 + fr;
        float rs[2][4];
#pragma unroll
        for (int ai = 0; ai < 2; ++ai)
#pragma unroll
            for (int m = 0; m < 4; ++m) { const f32x4* sp = (const f32x4*)(ssqn + (size_t)(row0 + ai * HALF + m * 16) * 8); const f32x4 a = sp[0], b = sp[1];
                rs[ai][m] = 1.0f / sqrtf(((a[0] + a[1]) + (a[2] + a[3]) + (b[0] + b[1]) + (b[2] + b[3])) * (1.0f / 1024.0f) + 1e-6f); }
#pragma unroll
        for (int bj = 0; bj < 2; ++bj) {
            const int colw = u.pn * BM + bj * HALF + wc * 32;
            bf16_t* dst; int ld; bool gate = false;
            if (colw < 2048) { dst = gates + colw; ld = 2048; gate = true; }
            else { const int pc = colw - 2048;
                if (pc < 384) { dst = cq + pc; ld = 384; }
                else if (pc < 640) { dst = ckv + (pc - 384); ld = 256; }
                else if (pc < 1184) { dst = kpep + (pc - 640); ld = 544; }
                else continue; }
            dst += 8 * fq;
            f32x4 b0 = (f32x4){0.f, 0.f, 0.f, 0.f}, b1 = b0;
            if (gate) { b0 = *(const f32x4*)(gbias + colw + 8 * fq); b1 = *(const f32x4*)(gbias + colw + 8 * fq + 4); }
#pragma unroll
            for (int ai = 0; ai < 2; ++ai)
#pragma unroll
                for (int m = 0; m < 4; ++m) {
                    f32x4 v0 = acc[ai][bj][m][0] * rs[ai][m] + b0, v1 = acc[ai][bj][m][1] * rs[ai][m] + b1;
                    if (gate) {
#pragma unroll
                        for (int j = 0; j < 4; ++j) { v0[j] = sigmoid_f(v0[j]); v1[j] = sigmoid_f(v1[j]); }
                    }
                    if (gate) {
                        typedef unsigned u32x2g __attribute__((ext_vector_type(2)));
                        u32x2g w;
                        w.x = (unsigned)(v0[0] * 255.0f + 0.5f) | ((unsigned)(v0[1] * 255.0f + 0.5f) << 8) | ((unsigned)(v0[2] * 255.0f + 0.5f) << 16) | ((unsigned)(v0[3] * 255.0f + 0.5f) << 24);
                        w.y = (unsigned)(v1[0] * 255.0f + 0.5f) | ((unsigned)(v1[1] * 255.0f + 0.5f) << 8) | ((unsigned)(v1[2] * 255.0f + 0.5f) << 16) | ((unsigned)(v1[3] * 255.0f + 0.5f) << 24);
                        *(u32x2g*)((unsigned char*)gates + (size_t)(row0 + ai * HALF + m * 16) * 2048 + colw + 8 * fq) = w;
                    } else {
                    const int pc = colw - 2048;
                    if (pc <= 640) {
                        float s = (v0[0] * v0[0] + v0[1] * v0[1]) + (v0[2] * v0[2] + v0[3] * v0[3]) + (v1[0] * v1[0] + v1[1] * v1[1]) + (v1[2] * v1[2] + v1[3] * v1[3]);
                        s += __int_as_float(__builtin_amdgcn_ds_swizzle(__float_as_int(s), 0x401F));
                    { unsigned r0_ = __float_as_uint(s), r1_ = r0_;
#if __has_builtin(__builtin_amdgcn_permlane32_swap)
                      auto r_ = __builtin_amdgcn_permlane32_swap(r0_, r1_, false, false); r0_ = r_[0]; r1_ = r_[1];
#else
                      asm volatile("v_permlane32_swap_b32 %0, %1" : "+v"(r0_), "+v"(r1_));
#endif
                      asm volatile("" : "+v"(r0_), "+v"(r1_));
                      s = __uint_as_float(r0_) + __uint_as_float(r1_); }
                        if (fq == 0) ssqc[(size_t)(row0 + ai * HALF + m * 16) * 24 + (pc >> 5)] = s;
                    }
                    if (pc == 640) {
                        const float p = (float)pos[row0 + ai * HALF + m * 16];
                        float x[8] = {v0[0], v0[1], v0[2], v0[3], v1[0], v1[1], v1[2], v1[3]};
#pragma unroll
                        for (int e8 = 0; e8 < 8; ++e8) {
                            const float other = __shfl_xor(x[e8], 32);
                            const float ang = p * __builtin_amdgcn_exp2f(-(float)(8 * (fq & 1) + e8) * 0.8304820237218406f);
                            const float nn = rintf(ang * 0.15915494309189535f);
                            float r = fmaf(-nn, 6.28318548202514648f, ang); r = fmaf(-nn, -1.7484556e-7f, r); r *= 0.15915494309189535f;
                            const float sn = __builtin_amdgcn_sinf(r), cs = __builtin_amdgcn_cosf(r);
                            x[e8] = (fq < 2) ? x[e8] * cs - other * sn : other * sn + x[e8] * cs;
                        }
                        v0 = (f32x4){x[0], x[1], x[2], x[3]}; v1 = (f32x4){x[4], x[5], x[6], x[7]};
                    }
                    u32x4 w; w.x = cvt_pk_bf16(v0[0], v0[1]); w.y = cvt_pk_bf16(v0[2], v0[3]); w.z = cvt_pk_bf16(v1[0], v1[1]); w.w = cvt_pk_bf16(v1[2], v1[3]);
                    *(u32x4*)(dst + (size_t)(row0 + ai * HALF + m * 16) * ld) = w; }
                }
        }
    }
};

struct EpiKV {
    static constexpr bool PERM = true, AFTER_DRAIN = false;
    bf16_t* K; bf16_t* V; const bf16_t* kpep; const float* ssqc; const float* gk;
    __device__ __forceinline__ void operator()(const f32x4 (&acc)[2][2][4][2], const Unit& u, int wr, int wc, int fr, int fq) const {
        { const int ln = fresh_lane(); fr = ln & 15; fq = ln >> 4; }
        const int row0 = u.pm * BM + wr * 64 + fr, head = 2 * u.pn + (wc >> 1);
        const bool isk = (wc & 1) == 0;
#pragma unroll
        for (int ai = 0; ai < 2; ++ai)
#pragma unroll
            for (int m = 0; m < 4; ++m) {
                __builtin_amdgcn_sched_barrier(0);
                const size_t row = (size_t)(row0 + ai * HALF + m * 16);
                const f32x4* sp = (const f32x4*)(ssqc + row * 24);
                const f32x4 sa = sp[3], sb = sp[4];
                const float rkv = 16.0f * __builtin_amdgcn_rsqf(((sa[0] + sa[1]) + (sa[2] + sa[3]) + (sb[0] + sb[1]) + (sb[2] + sb[3])) + 256e-6f);
                const f32x4 a0 = acc[ai][0][m][0], a1 = acc[ai][0][m][1], b0 = acc[ai][1][m][0], b1 = acc[ai][1][m][1];
                if (isk) {
                    float s = (a0[0] * a0[0] + a0[1] * a0[1]) + (a0[2] * a0[2] + a0[3] * a0[3]) + (a1[0] * a1[0] + a1[1] * a1[1]) + (a1[2] * a1[2] + a1[3] * a1[3])
                            + (b0[0] * b0[0] + b0[1] * b0[1]) + (b0[2] * b0[2] + b0[3] * b0[3]) + (b1[0] * b1[0] + b1[1] * b1[1]) + (b1[2] * b1[2] + b1[3] * b1[3]);
                    s += __int_as_float(__builtin_amdgcn_ds_swizzle(__float_as_int(s), 0x401F));
                    { unsigned r0_ = __float_as_uint(s), r1_ = r0_;
#if __has_builtin(__builtin_amdgcn_permlane32_swap)
                      auto r_ = __builtin_amdgcn_permlane32_swap(r0_, r1_, false, false); r0_ = r_[0]; r1_ = r_[1];
#else
                      asm volatile("v_permlane32_swap_b32 %0, %1" : "+v"(r0_), "+v"(r1_));
#endif
                      asm volatile("" : "+v"(r0_), "+v"(r1_));
                      s = __uint_as_float(r0_) + __uint_as_float(r1_); }
                    const float sspe = ssqc[row * 24 + 20];
                    const float rn = 9.797958971f * __builtin_amdgcn_rsqf((rkv * rkv * s + sspe) + 96e-6f), sc = rkv * rn;
                    bf16_t* kp = K + (row * 8 + head) * 96 + 8 * fq;
                    { asm volatile("" ::: "memory"); const f32x4 ga = *(const f32x4*)(gk + 8 * fq), gb = *(const f32x4*)(gk + 8 * fq + 4);
                      u32x4 w; w.x = cvt_pk_bf16(a0[0] * sc * ga[0], a0[1] * sc * ga[1]); w.y = cvt_pk_bf16(a0[2] * sc * ga[2], a0[3] * sc * ga[3]);
                      w.z = cvt_pk_bf16(a1[0] * sc * gb[0], a1[1] * sc * gb[1]); w.w = cvt_pk_bf16(a1[2] * sc * gb[2], a1[3] * sc * gb[3]);
                      *(u32x4*)(kp) = w; }
                    { asm volatile("" ::: "memory"); const f32x4 ga = *(const f32x4*)(gk + 32 + 8 * fq), gb = *(const f32x4*)(gk + 32 + 8 * fq + 4);
                      u32x4 w; w.x = cvt_pk_bf16(b0[0] * sc * ga[0], b0[1] * sc * ga[1]); w.y = cvt_pk_bf16(b0[2] * sc * ga[2], b0[3] * sc * ga[3]);
                      w.z = cvt_pk_bf16(b1[0] * sc * gb[0], b1[1] * sc * gb[1]); w.w = cvt_pk_bf16(b1[2] * sc * gb[2], b1[3] * sc * gb[3]);
                      *(u32x4*)(kp + 32) = w; }
                    { asm volatile("" ::: "memory"); const f32x4 ga = *(const f32x4*)(gk + 64 + 8 * fq), gb = *(const f32x4*)(gk + 64 + 8 * fq + 4);
                      const u32x4 pe = *(const u32x4*)(kpep + row * 544 + 8 * fq);
                      u32x4 w; w.x = cvt_pk_bf16(bflo(pe.x) * rn * ga[0], bfhi(pe.x) * rn * ga[1]); w.y = cvt_pk_bf16(bflo(pe.y) * rn * ga[2], bfhi(pe.y) * rn * ga[3]);
                      w.z = cvt_pk_bf16(bflo(pe.z) * rn * gb[0], bfhi(pe.z) * rn * gb[1]); w.w = cvt_pk_bf16(bflo(pe.w) * rn * gb[2], bfhi(pe.w) * rn * gb[3]);
                      *(u32x4*)(kp + 64) = w; }
                } else {
                    bf16_t* vp = V + (row * 8 + head) * 64 + 8 * fq;
                    u32x4 w; w.x = cvt_pk_bf16(a0[0] * rkv, a0[1] * rkv); w.y = cvt_pk_bf16(a0[2] * rkv, a0[3] * rkv); w.z = cvt_pk_bf16(a1[0] * rkv, a1[1] * rkv); w.w = cvt_pk_bf16(a1[2] * rkv, a1[3] * rkv);
                    *(u32x4*)(vp) = w;
                    w.x = cvt_pk_bf16(b0[0] * rkv, b0[1] * rkv); w.y = cvt_pk_bf16(b0[2] * rkv, b0[3] * rkv); w.z = cvt_pk_bf16(b1[0] * rkv, b1[1] * rkv); w.w = cvt_pk_bf16(b1[2] * rkv, b1[3] * rkv);
                    *(u32x4*)(vp + 32) = w;
                }
            }
    }
};

struct EpiMix {
    static constexpr bool PERM = true, AFTER_DRAIN = false;
    const bf16_t* a; const bf16_t* gates; bf16_t* mix;
    __device__ __forceinline__ void operator()(const f32x4 (&acc)[2][2][4][2], const Unit& u, int wr, int wc, int fr, int fq) const {
        const int row0 = u.pm * BM + wr * 64 + fr, col0 = u.pn * BM + wc * 32 + 8 * fq;
#pragma unroll
        for (int ai = 0; ai < 2; ++ai)
#pragma unroll
            for (int m = 0; m < 4; ++m) {
                const size_t row = (size_t)(row0 + ai * HALF + m * 16);
#pragma unroll
                for (int bj = 0; bj < 2; ++bj) {
                    const int c = col0 + bj * HALF;
                    const u32x4 av = *(const u32x4*)(a + row * 1024 + c);
                    typedef unsigned u32x2g __attribute__((ext_vector_type(2)));
                    const u32x2g g0 = *(const u32x2g*)((const unsigned char*)gates + row * 2048 + c);
                    const u32x2g g1 = *(const u32x2g*)((const unsigned char*)gates + row * 2048 + 1024 + c);
                    const float k = 1.0f / 255.0f;
                    const f32x4 v0 = acc[ai][bj][m][0] * k, v1 = acc[ai][bj][m][1] * k;
#define GB(W, B) ((float)(((W) >> (8 * (B))) & 0xffu))
                    u32x4 w;
                    w.x = cvt_pk_bf16(GB(g0.x, 0) * k * bflo(av.x) + GB(g1.x, 0) * v0[0], GB(g0.x, 1) * k * bfhi(av.x) + GB(g1.x, 1) * v0[1]);
                    w.y = cvt_pk_bf16(GB(g0.x, 2) * k * bflo(av.y) + GB(g1.x, 2) * v0[2], GB(g0.x, 3) * k * bfhi(av.y) + GB(g1.x, 3) * v0[3]);
                    w.z = cvt_pk_bf16(GB(g0.y, 0) * k * bflo(av.z) + GB(g1.y, 0) * v1[0], GB(g0.y, 1) * k * bfhi(av.z) + GB(g1.y, 1) * v1[1]);
                    w.w = cvt_pk_bf16(GB(g0.y, 2) * k * bflo(av.w) + GB(g1.y, 2) * v1[2], GB(g0.y, 3) * k * bfhi(av.w) + GB(g1.y, 3) * v1[3]);
#undef GB
                    *(u32x4*)(mix + row * 1024 + c) = w;
                }
            }
    }
};

struct EpiRes {
    static constexpr bool PERM = false, AFTER_DRAIN = false;
    const bf16_t* xin; bf16_t* xout; float* ssq;
    __device__ __forceinline__ void operator()(const f32x4 (&acc)[2][2][4][2], const Unit& u, int wr, int wc, int fr, int fq) const {
        const int row0 = u.pm * BM + wr * 64 + fr, col0 = u.pn * BM + wc * 32 + 4 * fq;
        typedef unsigned u32x2 __attribute__((ext_vector_type(2)));
#pragma unroll
        for (int ai = 0; ai < 2; ++ai)
#pragma unroll
            for (int m = 0; m < 4; ++m) {
                const size_t row = (size_t)(row0 + ai * HALF + m * 16); float s = 0.f;
#pragma unroll
                for (int bj = 0; bj < 2; ++bj)
#pragma unroll
                    for (int n = 0; n < 2; ++n) {
                        const size_t off = row * 1024 + col0 + bj * HALF + n * 16;
                        const u32x2 xi = *(const u32x2*)(xin + off);
                        const f32x4 xo = (f32x4){bflo(xi.x), bfhi(xi.x), bflo(xi.y), bfhi(xi.y)} + acc[ai][bj][m][n];
                        s += (xo[0] * xo[0] + xo[1] * xo[1]) + (xo[2] * xo[2] + xo[3] * xo[3]);
                        u32x2 w; w.x = cvt_pk_bf16(xo[0], xo[1]); w.y = cvt_pk_bf16(xo[2], xo[3]);
                        *(u32x2*)(xout + off) = w;
                    }
                s += __int_as_float(__builtin_amdgcn_ds_swizzle(__float_as_int(s), 0x401F));
                    { unsigned r0_ = __float_as_uint(s), r1_ = r0_;
#if __has_builtin(__builtin_amdgcn_permlane32_swap)
                      auto r_ = __builtin_amdgcn_permlane32_swap(r0_, r1_, false, false); r0_ = r_[0]; r1_ = r_[1];
#else
                      asm volatile("v_permlane32_swap_b32 %0, %1" : "+v"(r0_), "+v"(r1_));
#endif
                      asm volatile("" : "+v"(r0_), "+v"(r1_));
                      s = __uint_as_float(r0_) + __uint_as_float(r1_); }
                if (fq == 0) ssq[row * 16 + u.pn * 4 + wc] = s;
            }
    }
};
template <class Epi, class Sched, bool ALIGN_EPI = false, bool SP2 = false>
__device__ __forceinline__ void gemm_phase(PG8_LAS unsigned char* lds, const Gemm g, const Sched& S, const Epi& E, const int wave_id) {
    const int wid = wave_id, lane = fresh_lane(), tid = (wid << 6) | lane, wr = wid >> 2, wc = wid & 3, fr = lane & 15, fq = lane >> 4;
    const int K = g.K, nt = K / BK;
    unsigned voffA[2], voffB[2];
#pragma unroll
    for (int i = 0; i < 2; ++i) { int R, C; stage_rc(tid * 16 + i * 8192, R, C); const int Rb = Epi::PERM ? ((R & ~31) + perm32(R & 31)) : R;
        voffA[i] = (unsigned)(R * K + C) * 2u; voffB[i] = (unsigned)(Rb * K + C) * 2u; }
    const size_t kstep = (size_t)(BK * 2);
    const size_t hstep = (size_t)HALF * K * 2;
    const size_t tstep = 2 * hstep;
    const unsigned ldsw = (unsigned)wid * 1024u;
    const int aoff = lds_byte(wr * 64 + fr, fq * 8), boff = lds_byte(wc * 32 + fr, fq * 8);
#define PG8_SA(b, h) (((b) * 2 + (h)) * HTB)
#define PG8_SB(b, h) ((4 + (b) * 2 + (h)) * HTB)
#define PG8_STAGE(bufoff, gbase, voff) do { _Pragma("unroll") for (int _i = 0; _i < 2; ++_i) \
        __builtin_amdgcn_global_load_lds((const unsigned*)((const char*)(gbase) + (voff)[_i]), (PG8_LAS unsigned*)(lds + (bufoff) + ldsw + _i * 8192), 16, 0, 0); } while (0)
#define PG8_LDA(dst, b, h) do { _Pragma("unroll") for (int m = 0; m < 4; ++m) _Pragma("unroll") for (int k = 0; k < 2; ++k) dst[m][k] = *(const PG8_LAS bf16x8*)(lds + PG8_SA(b, h) + aoff + m * 2048 + k * 1024); } while (0)
#define PG8_LDB(dst, b, h) do { _Pragma("unroll") for (int n = 0; n < 2; ++n) _Pragma("unroll") for (int k = 0; k < 2; ++k) dst[n][k] = *(const PG8_LAS bf16x8*)(lds + PG8_SB(b, h) + boff + n * 2048 + k * 1024); } while (0)
#define PG8_MMA(ai, bj, At, Bt) do { __builtin_amdgcn_s_setprio(1); _Pragma("unroll") for (int m = 0; m < 4; ++m) _Pragma("unroll") for (int n = 0; n < 2; ++n) _Pragma("unroll") for (int k = 0; k < 2; ++k) \
        acc[ai][bj][m][n] = __builtin_amdgcn_mfma_f32_16x16x32_bf16(Bt[n][k], At[m][k], acc[ai][bj][m][n], 0, 0, 0); __builtin_amdgcn_s_setprio(0); } while (0)
#define PG8_WAIT_V(n) asm volatile("s_waitcnt vmcnt(" #n ")" ::: "memory")
#define PG8_WAIT_L(n) asm volatile("s_waitcnt lgkmcnt(" #n ")" ::: "memory")
#define PG8_BAR __builtin_amdgcn_s_barrier()
#define PG8_SCHED __builtin_amdgcn_sched_barrier(0)
    Unit cur, nxt; int ui = 0;
    if (!S.next(0, cur)) return;
    f32x4 acc[2][2][4][2];
#pragma unroll
    for (int a = 0; a < 2; ++a)
#pragma unroll
        for (int b = 0; b < 2; ++b)
#pragma unroll
            for (int m = 0; m < 4; ++m)
#pragma unroll
                for (int n = 0; n < 2; ++n) acc[a][b][m][n] = (f32x4){0.f, 0.f, 0.f, 0.f};
    bf16x8 At[4][2], B0[2][2], B1[2][2];
    const char* cA = (const char*)g.A + (size_t)cur.pm * tstep; const char* cB = (const char*)g.Bt + (size_t)cur.pn * tstep;
    S.a_ready(cur);
    if constexpr (SP2) {
        PG8_STAGE(PG8_SB(0, 0), cB, voffB); PG8_STAGE(PG8_SB(0, 1), cB + hstep, voffB); PG8_STAGE(PG8_SA(0, 0), cA, voffA); PG8_STAGE(PG8_SA(0, 1), cA + hstep, voffA);
        if (wr == 1) PG8_BAR;
        PG8_WAIT_V(2); PG8_BAR;
        PG8_STAGE(PG8_SB(1, 0), cB + kstep, voffB); PG8_STAGE(PG8_SA(1, 0), cA + kstep, voffA); PG8_STAGE(PG8_SB(1, 1), cB + hstep + kstep, voffB);
        PG8_WAIT_V(6); PG8_BAR;
    } else {
        PG8_STAGE(PG8_SB(0, 0), cB, voffB); PG8_STAGE(PG8_SA(0, 0), cA, voffA); PG8_STAGE(PG8_SB(0, 1), cB + hstep, voffB); PG8_STAGE(PG8_SA(0, 1), cA + hstep, voffA);
        if (wr == 1) PG8_BAR;
        PG8_WAIT_V(4); PG8_BAR;
        PG8_STAGE(PG8_SB(1, 0), cB + kstep, voffB); PG8_STAGE(PG8_SA(1, 0), cA + kstep, voffA); PG8_STAGE(PG8_SB(1, 1), cB + hstep + kstep, voffB);
        PG8_WAIT_V(6); PG8_BAR;
    }
    for (;;) {
        const bool has_next = S.next(ui + 1, nxt);
        const char* nA = has_next ? (const char*)g.A + (size_t)nxt.pm * tstep : cA; const char* nB = has_next ? (const char*)g.Bt + (size_t)nxt.pn * tstep : cB;
        for (int t = 0; t < nt; t += 2) {
            const bool last = (t == nt - 2);
            const char* a1 = cA + (size_t)(t + 1) * kstep;
            const char* a2 = last ? nA : cA + (size_t)(t + 2) * kstep; const char* b2 = last ? nB : cB + (size_t)(t + 2) * kstep;
            const char* a3 = a2 + kstep; const char* b3 = b2 + kstep;
            if (last && has_next) S.a_ready(nxt);
            if constexpr (SP2) {
            PG8_LDB(B0, 0, 0); PG8_LDB(B1, 0, 1); PG8_SCHED; PG8_LDA(At, 0, 0); PG8_STAGE(PG8_SA(1, 1), a1 + hstep, voffA);
            PG8_WAIT_V(8); PG8_WAIT_L(0); PG8_BAR; PG8_MMA(0, 0, At, B0); PG8_MMA(0, 1, At, B1); PG8_BAR; PG8_SCHED;
            PG8_LDA(At, 0, 1); PG8_STAGE(PG8_SB(0, 0), b2, voffB); PG8_STAGE(PG8_SB(0, 1), b2 + hstep, voffB); PG8_STAGE(PG8_SA(0, 0), a2, voffA);
            PG8_WAIT_V(8); PG8_WAIT_L(0); PG8_BAR; PG8_MMA(1, 0, At, B0); PG8_MMA(1, 1, At, B1); PG8_BAR; PG8_SCHED;
            PG8_LDB(B0, 1, 0); PG8_LDB(B1, 1, 1); PG8_SCHED; PG8_LDA(At, 1, 0); PG8_STAGE(PG8_SA(0, 1), a2 + hstep, voffA);
            PG8_WAIT_V(8); PG8_WAIT_L(0); PG8_BAR; PG8_MMA(0, 0, At, B0); PG8_MMA(0, 1, At, B1); PG8_BAR; PG8_SCHED;
            PG8_LDA(At, 1, 1); PG8_STAGE(PG8_SB(1, 0), b3, voffB); PG8_STAGE(PG8_SB(1, 1), b3 + hstep, voffB); PG8_STAGE(PG8_SA(1, 0), a3, voffA);
            PG8_WAIT_V(8); PG8_WAIT_L(0); PG8_BAR; PG8_MMA(1, 0, At, B0); PG8_MMA(1, 1, At, B1); PG8_BAR; PG8_SCHED;
            } else {
            PG8_LDB(B0, 0, 0); PG8_SCHED; PG8_LDA(At, 0, 0); PG8_STAGE(PG8_SA(1, 1), a1 + hstep, voffA);
            PG8_WAIT_L(8); PG8_BAR; PG8_WAIT_L(0); PG8_MMA(0, 0, At, B0); PG8_BAR; PG8_SCHED;
            PG8_LDB(B1, 0, 1); PG8_STAGE(PG8_SB(0, 0), b2, voffB);
            PG8_BAR; PG8_WAIT_L(0); PG8_MMA(0, 1, At, B1); PG8_BAR;
            PG8_LDA(At, 0, 1); PG8_STAGE(PG8_SA(0, 0), a2, voffA);
            PG8_BAR; PG8_WAIT_L(0); PG8_MMA(1, 0, At, B0); PG8_BAR; PG8_SCHED;
            PG8_STAGE(PG8_SB(0, 1), b2 + hstep, voffB);
            PG8_WAIT_V(6); PG8_BAR; PG8_MMA(1, 1, At, B1); PG8_BAR;
            PG8_LDB(B0, 1, 0); PG8_SCHED; PG8_LDA(At, 1, 0); PG8_STAGE(PG8_SA(0, 1), a2 + hstep, voffA);
            PG8_WAIT_L(8); PG8_BAR; PG8_WAIT_L(0); PG8_MMA(0, 0, At, B0); PG8_BAR; PG8_SCHED;
            PG8_LDB(B1, 1, 1); PG8_STAGE(PG8_SB(1, 0), b3, voffB);
            PG8_BAR; PG8_WAIT_L(0); PG8_MMA(0, 1, At, B1); PG8_BAR;
            PG8_LDA(At, 1, 1); PG8_STAGE(PG8_SA(1, 0), a3, voffA);
            PG8_BAR; PG8_WAIT_L(0); PG8_MMA(1, 0, At, B0); PG8_BAR; PG8_SCHED;
            PG8_STAGE(PG8_SB(1, 1), b3 + hstep, voffB);
            PG8_WAIT_V(6); PG8_BAR; PG8_MMA(1, 1, At, B1); PG8_BAR;
            }
        }
        if constexpr (ALIGN_EPI) { if (wr == 0) PG8_BAR; }
        if constexpr (!Epi::AFTER_DRAIN) { E(acc, cur, wr, wc, fr, fq); S.done(cur); }
        if (!has_next) break;
#pragma unroll
        for (int a = 0; a < 2; ++a)
#pragma unroll
            for (int b = 0; b < 2; ++b)
#pragma unroll
                for (int m = 0; m < 4; ++m)
#pragma unroll
                    for (int n = 0; n < 2; ++n) acc[a][b][m][n] = (f32x4){0.f, 0.f, 0.f, 0.f};
        cur = nxt; cA = nA; cB = nB; ++ui;
        if constexpr (ALIGN_EPI) { if (wr == 1) PG8_BAR; }
    }
    PG8_WAIT_V(0);
    if constexpr (!ALIGN_EPI) { if (wr == 0) PG8_BAR; }
    PG8_BAR;
    if constexpr (Epi::AFTER_DRAIN) { E.fused(acc, cur, wr, wc, fr, fq, lds, wid, lane); S.done(cur); }
#undef PG8_SA
#undef PG8_SB
#undef PG8_STAGE
#undef PG8_LDA
#undef PG8_LDB
#undef PG8_MMA
#undef PG8_WAIT_V
#undef PG8_WAIT_L
#undef PG8_BAR
#undef PG8_SCHED
}
}
namespace att {
typedef unsigned short bf16;
using bf16x8 = __attribute__((ext_vector_type(8))) short;
using s16x4  = __attribute__((ext_vector_type(4))) short;
using f32x16 = __attribute__((ext_vector_type(16))) float;
using u32x4  = __attribute__((ext_vector_type(4))) unsigned;
constexpr int   DQ = 96, DV = 64, NW = 8, QBLK = 32, KVBLK = 64;
constexpr int   ND0 = DQ / 16;
constexpr int   NDV = DV / 32;
constexpr float SCALE = 0.10206207261596575f;
constexpr float THR = 8.f;
constexpr int   LDQ = 768, LDK = 768, LDV = 512, LDO = 512;
constexpr size_t SHM_V = KVBLK * 128 * 2, SHM_K = KVBLK * 128 * 2, SHM_ATTN = 2 * SHM_V + 2 * SHM_K + NW * 64 * 4;
#define KSWZ(row, colB) ((row) * 256 + ((colB) ^ (((row) & 7) << 4)))
#define SBAR() __builtin_amdgcn_sched_barrier(0)
__device__ __forceinline__ int crow(int r, int hi) { return (r & 3) + 8 * (r >> 2) + 4 * hi; }
__device__ __forceinline__ unsigned cvtpk(float lo, float hi) { unsigned r; asm volatile("v_cvt_pk_bf16_f32 %0, %1, %2" : "=v"(r) : "v"(lo), "v"(hi)); return r; }

__device__ __forceinline__ void partialSM(f32x16& p0, f32x16& p1, float& m_reg, float& mn, float& alpha) {
  constexpr float C = SCALE * 1.4426950408889634f;
  float pmax = p0[0];
#pragma unroll
  for (int r = 1; r < 16; ++r) pmax = fmaxf(pmax, p0[r]);
#pragma unroll
  for (int r = 0; r < 16; ++r) pmax = fmaxf(pmax, p1[r]);
  { auto rr = __builtin_amdgcn_permlane32_swap(__float_as_uint(pmax), __float_as_uint(pmax), false, false);
    pmax = fmaxf(__uint_as_float(rr[0]), __uint_as_float(rr[1])); }
  if (__builtin_expect(__all(pmax - m_reg <= THR / SCALE), 1)) { mn = m_reg; alpha = 1.f; }
  else { mn = fmaxf(m_reg, pmax); alpha = __builtin_amdgcn_exp2f((m_reg - mn) * C); m_reg = mn; }
  float mnC = -mn * C;
#pragma unroll
  for (int r = 0; r < 16; ++r) p0[r] = fmaf(p0[r], C, mnC);
#pragma unroll
  for (int r = 0; r < 16; ++r) p1[r] = fmaf(p1[r], C, mnC);
#pragma unroll
  for (int r = 0; r < 16; ++r) p0[r] = __builtin_amdgcn_exp2f(p0[r]);
}
__device__ __forceinline__ void finishSM(f32x16& p0, f32x16& p1, float alpha, float& l_reg, bf16x8& pa0, bf16x8& pa1, bf16x8& pa2, bf16x8& pa3) {
#pragma unroll
  for (int r = 0; r < 16; ++r) p1[r] = __builtin_amdgcn_exp2f(p1[r]);
  float ps = 0;
#pragma unroll
  for (int r = 0; r < 16; ++r) ps += p0[r];
#pragma unroll
  for (int r = 0; r < 16; ++r) ps += p1[r];
  { auto rr = __builtin_amdgcn_permlane32_swap(__float_as_uint(ps), __float_as_uint(ps), false, false);
    ps = __uint_as_float(rr[0]) + __uint_as_float(rr[1]); }
  l_reg = l_reg * alpha + ps;
#define PK4(P, BASE, OUT) do { unsigned a0 = cvtpk(P[BASE + 0], P[BASE + 1]), a1 = cvtpk(P[BASE + 2], P[BASE + 3]);   \
    unsigned b0 = cvtpk(P[BASE + 4], P[BASE + 5]), b1 = cvtpk(P[BASE + 6], P[BASE + 7]);                              \
    auto r0 = __builtin_amdgcn_permlane32_swap(a0, b0, false, false); auto r1 = __builtin_amdgcn_permlane32_swap(a1, b1, false, false); \
    u32x4 w = {r0[0], r1[0], r0[1], r1[1]}; OUT = *reinterpret_cast<bf16x8*>(&w); } while (0)
  PK4(p0, 0, pa0); PK4(p0, 8, pa1); PK4(p1, 0, pa2); PK4(p1, 8, pa3);
#undef PK4
}
__device__ __forceinline__ void qkt(f32x16& p0, f32x16& p1, const bf16* Ks, const bf16x8* qr, int r32, int hi) {
  p0 = f32x16{}; p1 = f32x16{};
#pragma unroll
  for (int d0 = 0; d0 < ND0; ++d0) { int cb = (d0 * 16 + hi * 8) * 2;
    bf16x8 b0 = *reinterpret_cast<const bf16x8*>((const char*)Ks + KSWZ(r32, cb));
    bf16x8 b1 = *reinterpret_cast<const bf16x8*>((const char*)Ks + KSWZ(32 + r32, cb));
    p0 = __builtin_amdgcn_mfma_f32_32x32x16_bf16(b0, qr[d0], p0, 0, 0, 0);
    p1 = __builtin_amdgcn_mfma_f32_32x32x16_bf16(b1, qr[d0], p1, 0, 0, 0); }
}
__device__ __forceinline__ int v_st(int k, int c) { const int kk = (k & ~0xC) | ((k & 4) << 1) | ((k & 8) >> 1); return ((kk >> 3) * 4 + (c >> 5)) * 512 + ((kk & 7) * 32 + (c & 31)) * 2; }
__device__ __forceinline__ int v_rd_base(int lane) { return ((lane & 3) << 3) | (((lane >> 2) & 3) << 6) | (((lane >> 4) & 1) << 5) | (((lane >> 5) & 1) << 8); }
constexpr int v_rd_off(int d0, int ks, int half) { return d0 * 512 + ks * 4096 + half * 2048; }
template <int OFF> __device__ __forceinline__ s16x4 tr_read(int vb) {
  s16x4 r; asm volatile("ds_read_b64_tr_b16 %0, %1 offset:%2" : "=&v"(r) : "v"(vb), "i"(OFF) : "memory"); return r;
}
template <int D0> __device__ __forceinline__ void pv_one(f32x16& od, int vb, bf16x8 pa0, bf16x8 pa1, bf16x8 pa2, bf16x8 pa3) {
  const s16x4 l0 = tr_read<v_rd_off(D0, 0, 0)>(vb), h0 = tr_read<v_rd_off(D0, 0, 1)>(vb), l1 = tr_read<v_rd_off(D0, 1, 0)>(vb), h1 = tr_read<v_rd_off(D0, 1, 1)>(vb);
  const s16x4 l2 = tr_read<v_rd_off(D0, 2, 0)>(vb), h2 = tr_read<v_rd_off(D0, 2, 1)>(vb), l3 = tr_read<v_rd_off(D0, 3, 0)>(vb), h3 = tr_read<v_rd_off(D0, 3, 1)>(vb);
  asm volatile("s_waitcnt lgkmcnt(0)" ::: "memory"); SBAR();
#define PK(L, H) (bf16x8){L[0], L[1], L[2], L[3], H[0], H[1], H[2], H[3]}
  od = __builtin_amdgcn_mfma_f32_32x32x16_bf16(pa0, PK(l0, h0), od, 0, 0, 0);
  od = __builtin_amdgcn_mfma_f32_32x32x16_bf16(pa1, PK(l1, h1), od, 0, 0, 0);
  od = __builtin_amdgcn_mfma_f32_32x32x16_bf16(pa2, PK(l2, h2), od, 0, 0, 0);
  od = __builtin_amdgcn_mfma_f32_32x32x16_bf16(pa3, PK(l3, h3), od, 0, 0, 0);
#undef PK
}
__device__ __forceinline__ void pv_d0(f32x16* o, int vb, bf16x8 pa0, bf16x8 pa1, bf16x8 pa2, bf16x8 pa3) {
  pv_one<0>(o[0], vb, pa0, pa1, pa2, pa3); pv_one<1>(o[1], vb, pa0, pa1, pa2, pa3);
}

__device__ __forceinline__ void attn_dense_body(const bf16* __restrict__ Qb, const bf16* __restrict__ Kh, const bf16* __restrict__ Vh,
                                                bf16* __restrict__ Ob, int seq, char* lds, const int wave_id,
                                                const float* __restrict__ ssq, const int* __restrict__ posp, const float* __restrict__ gq) {
  const int wid = wave_id, lane = pg8::fresh_lane(), tid = (wid << 6) | lane, r32 = lane & 31, hi = lane >> 5;
  bf16* V_lds = (bf16*)lds; bf16* K_lds = (bf16*)(lds + 2 * SHM_V);
  float* ws = (float*)(lds + 2 * SHM_V + 2 * SHM_K) + wid * 64; float* li_l = ws; float* al_l = ws + 32;
  float m_reg = -1e30f, l_reg = 0; f32x16 o[NDV] = {}; bf16x8 qr[ND0];
  const bf16* Qw = Qb + (long)(wid * QBLK + r32) * LDQ + hi * 8;
#pragma unroll
  for (int d0 = 0; d0 < ND0; ++d0) qr[d0] = *reinterpret_cast<const bf16x8*>(Qw + d0 * 16);
  {
    const int rowi = wid * QBLK + r32;
    const pg8::f32x4* sp = (const pg8::f32x4*)(ssq + (long)rowi * 24); const pg8::f32x4 sa = sp[0], sb = sp[1], sc = sp[2];
    const float p = (float)posp[rowi];
    const float rq = __builtin_amdgcn_rsqf(((sa[0] + sa[1]) + (sa[2] + sa[3]) + (sb[0] + sb[1]) + (sb[2] + sb[3]) + (sc[0] + sc[1]) + (sc[2] + sc[3])) * (1.0f / 384.0f) + 1e-6f);
    float xs[ND0][8]; float ss = 0.f;
#pragma unroll
    for (int d0 = 0; d0 < 4; ++d0)
#pragma unroll
      for (int j = 0; j < 8; ++j) { const float x = __uint_as_float((unsigned)(unsigned short)qr[d0][j] << 16) * rq; xs[d0][j] = x; ss += x * x; }
#pragma unroll
    for (int j = 0; j < 8; ++j) {
      const float ang = p * __builtin_amdgcn_exp2f(-(float)(8 * hi + j) * 0.8304820237218406f);
      const float n = rintf(ang * 0.15915494309189535f);
      float r = fmaf(-n, 6.28318548202514648f, ang); r = fmaf(-n, -1.7484556e-7f, r); r *= 0.15915494309189535f;
      const float sn = __builtin_amdgcn_sinf(r), cs = __builtin_amdgcn_cosf(r);
      const float x1 = __uint_as_float((unsigned)(unsigned short)qr[4][j] << 16) * rq, x2 = __uint_as_float((unsigned)(unsigned short)qr[5][j] << 16) * rq;
      const float y1 = x1 * cs - x2 * sn, y2 = x1 * sn + x2 * cs;
      xs[4][j] = y1; xs[5][j] = y2; ss += y1 * y1 + y2 * y2; }
    { unsigned r0_ = __float_as_uint(ss), r1_ = r0_;
      auto r_ = __builtin_amdgcn_permlane32_swap(r0_, r1_, false, false); r0_ = r_[0]; r1_ = r_[1];
      asm volatile("" : "+v"(r0_), "+v"(r1_));
      ss = __uint_as_float(r0_) + __uint_as_float(r1_); }
    const float rn = __builtin_amdgcn_rsqf(ss * (1.0f / 96.0f) + 1e-6f);
#pragma unroll
    for (int d0 = 0; d0 < ND0; ++d0) {
      const pg8::f32x4 ga = *(const pg8::f32x4*)(gq + 16 * d0 + 8 * hi), gb = *(const pg8::f32x4*)(gq + 16 * d0 + 8 * hi + 4);
      u32x4 w; w.x = cvtpk(xs[d0][0] * rn * ga[0], xs[d0][1] * rn * ga[1]); w.y = cvtpk(xs[d0][2] * rn * ga[2], xs[d0][3] * rn * ga[3]);
      w.z = cvtpk(xs[d0][4] * rn * gb[0], xs[d0][5] * rn * gb[1]); w.w = cvtpk(xs[d0][6] * rn * gb[2], xs[d0][7] * rn * gb[3]);
      qr[d0] = *reinterpret_cast<bf16x8*>(&w); } }
  const int kr0 = tid / 12, kc0 = tid - kr0 * 12, kr1 = (512 + tid) / 12, kc1 = (512 + tid) - kr1 * 12, vr0 = tid >> 3, vc0 = tid & 7;
  const int kst0 = KSWZ(kr0, kc0 * 16), kst1 = KSWZ(kr1, kc1 * 16), vst0 = v_st(vr0, vc0 * 8);
  const bool k2 = wid < 4;
  const int vb0 = (int)(uintptr_t)V_lds + v_rd_base(lane);
  struct { bf16x8 vs0, ks0, ks1; } sr_[2];
#define SLOAD(i, k0) do { sr_[i].vs0 = *reinterpret_cast<const bf16x8*>(&Vh[(long)((k0) + vr0) * LDV + vc0 * 8]); \
    sr_[i].ks0 = *reinterpret_cast<const bf16x8*>(&Kh[(long)((k0) + kr0) * LDK + kc0 * 8]); \
    if (k2) sr_[i].ks1 = *reinterpret_cast<const bf16x8*>(&Kh[(long)((k0) + kr1) * LDK + kc1 * 8]); } while (0)
#define SWRITE(b, i) do { *(bf16x8*)((char*)V_lds + (b) * SHM_V + vst0) = sr_[i].vs0;          \
    *(bf16x8*)((char*)K_lds + (b) * SHM_K + kst0) = sr_[i].ks0;                       \
    if (k2) *(bf16x8*)((char*)K_lds + (b) * SHM_K + kst1) = sr_[i].ks1; } while (0)
#define SWAIT() do { if (k2) asm volatile("s_waitcnt vmcnt(3)" ::: "memory"); else asm volatile("s_waitcnt vmcnt(2)" ::: "memory"); } while (0)
#define RESC(a) do { if (__any((a) < 1.f)) { if (hi == 0) al_l[r32] = (a); asm volatile("s_waitcnt lgkmcnt(0)" ::: "memory"); \
    _Pragma("unroll") for (int d = 0; d < NDV; ++d) _Pragma("unroll") for (int r = 0; r < 16; ++r) o[d][r] *= al_l[crow(r, hi)]; } } while (0)
  f32x16 pA0, pA1, pB0, pB1; float mnA, mnB, alA, alB; bf16x8 pa0, pa1, pa2, pa3; const int NT = seq / KVBLK;
  constexpr int SE = 0, SO = 1;
  SLOAD(SE, 0); asm volatile("s_waitcnt vmcnt(0)" ::: "memory"); SWRITE(0, SE); __syncthreads();
  qkt(pA0, pA1, K_lds, qr, r32, hi); partialSM(pA0, pA1, m_reg, mnA, alA);
  SLOAD(SO, KVBLK); if (2 < NT) SLOAD(SE, 2 * KVBLK);
  SWAIT(); SWRITE(1, SO); __syncthreads();
  for (int j = 1; j + 1 < NT; j += 2) {
    SBAR(); qkt(pB0, pB1, (bf16*)((char*)K_lds + SHM_K), qr, r32, hi);
    finishSM(pA0, pA1, alA, l_reg, pa0, pa1, pa2, pa3); SBAR();
    SLOAD(SO, (j + 2) * KVBLK); SBAR();
    pv_d0(o, vb0, pa0, pa1, pa2, pa3); partialSM(pB0, pB1, m_reg, mnB, alB);
    __syncthreads(); SWAIT(); SWRITE(0, SE);
    RESC(alB); __syncthreads();
    SBAR(); qkt(pA0, pA1, K_lds, qr, r32, hi);
    finishSM(pB0, pB1, alB, l_reg, pa0, pa1, pa2, pa3); SBAR();
    if (j + 3 < NT) SLOAD(SE, (j + 3) * KVBLK); SBAR();
    pv_d0(o, vb0 + (int)SHM_V, pa0, pa1, pa2, pa3); partialSM(pA0, pA1, m_reg, mnA, alA);
    __syncthreads(); SWAIT(); SWRITE(1, SO);
    RESC(alA); __syncthreads();
  }
  SBAR(); qkt(pB0, pB1, (bf16*)((char*)K_lds + SHM_K), qr, r32, hi);
  finishSM(pA0, pA1, alA, l_reg, pa0, pa1, pa2, pa3); SBAR();
  pv_d0(o, vb0, pa0, pa1, pa2, pa3); partialSM(pB0, pB1, m_reg, mnB, alB);
  __syncthreads(); RESC(alB);
  finishSM(pB0, pB1, alB, l_reg, pa0, pa1, pa2, pa3); SBAR();
  pv_d0(o, vb0 + (int)SHM_V, pa0, pa1, pa2, pa3);
  if (hi == 0) li_l[r32] = l_reg; asm volatile("s_waitcnt lgkmcnt(0)" ::: "memory");
  float rli[16];
#pragma unroll
  for (int r = 0; r < 16; ++r) rli[r] = __builtin_amdgcn_rcpf(li_l[crow(r, hi)]);
  bf16* Ow = Ob + (long)(wid * QBLK) * LDO;
#pragma unroll
  for (int r = 0; r < 16; ++r) { int orow = crow(r, hi);
#pragma unroll
    for (int d0 = 0; d0 < NDV; ++d0) Ow[(long)orow * LDO + d0 * 32 + r32] = (bf16)(cvtpk(o[d0][r] * rli[r], 0.f) & 0xffffu); }
#undef SLOAD
#undef SWRITE
#undef SWAIT
#undef RESC
}
#undef KSWZ
#undef SBAR
}
constexpr int NWAVES = 8;
#ifndef MK_ONE_LAUNCH
#define MK_ONE_LAUNCH 1
#endif
constexpr int NB = 8, SEQ = 2048, DM = 1024, MTOK = NB * SEQ, DEPTH = 2;
constexpr int NH = 8, QL = 384, KVL = 256, NOPE = 64, ROPE = 32, QKH = 96, VHD = 64;
constexpr int PW = 512, INW = 3232, INWP = 3328, KPEPW = 544;
constexpr int NKEY = 128, NEXP = 16384, TOPK = 16;
constexpr float RMS_EPS = 1e-6f;
constexpr size_t MiB = 1u << 20;
constexpr size_t WS_CTL = 0;
constexpr size_t WS_W = 1 * MiB, W_STRIDE = 18 * MiB;
constexpr size_t WO_WIN = 0, WO_WUQ = 6656 * 1024, WO_WUKV = 7424 * 1024, WO_WO = 8 * MiB, WO_WC = 9 * MiB, WO_WOUT = 10 * MiB, WO_WQ = 12 * MiB, WO_KEYS = 16 * MiB;
constexpr size_t WS_U = 40 * MiB, WS_V = 72 * MiB, UV_STRIDE = 16 * MiB;
constexpr size_t WS_SU = 512 * 1024, WS_SV = 768 * 1024, SC_STRIDE = 64 * 1024;
constexpr size_t WS_XB = 168 * MiB;
constexpr size_t WS_GATES = 232 * MiB, WS_QP = 232 * MiB;
constexpr size_t WS_CQ = 296 * MiB, WS_CKV = 308 * MiB, WS_KPEP = 316 * MiB, WS_QRAW = 333 * MiB, WS_KVRAW = 357 * MiB;
constexpr size_t WS_ABUF = 296 * MiB, WS_MIX = 328 * MiB;
constexpr size_t WS_MIXED = 389 * MiB;
constexpr size_t WS_Q = 405 * MiB, WS_K = 429 * MiB, WS_VV = 453 * MiB;
constexpr size_t WS_E = 405 * MiB, WS_G = 413 * MiB, WS_XQ = 429 * MiB, WS_WF = 445 * MiB, WS_HPI = 232 * MiB;
constexpr size_t WS_O = 469 * MiB, WS_SSQ = 485 * MiB, WS_RR = 486 * MiB, WS_SX = WS_RR + 65536, WS_WSUM = WS_RR + 131072, WS_SSQN = WS_RR + 262144, WS_SSQC = 487 * MiB, WS_END = 489 * MiB;
static_assert(WO_WUQ >= (size_t)INWP * DM * 2 && WO_WUKV >= WO_WUQ + 768 * 384 * 2 && WO_WO >= WO_WUKV + 1024 * 256 * 2, "weight map");
static_assert(WS_KPEP + (size_t)MTOK * KPEPW * 2 <= WS_QRAW && WS_QRAW + (size_t)MTOK * 768 * 2 <= WS_KVRAW && WS_KVRAW + (size_t)MTOK * 1024 * 2 <= WS_MIXED, "ws map");

constexpr int LDS_BYTES = 147456;

#define GAS __attribute__((address_space(1)))
#define LAS __attribute__((address_space(3)))
typedef unsigned short bf16;
typedef unsigned v4u __attribute__((ext_vector_type(4)));
typedef unsigned v2u __attribute__((ext_vector_type(2)));
typedef float f32x4 __attribute__((ext_vector_type(4)));
typedef float f32x16 __attribute__((ext_vector_type(16)));
typedef short bf16x8 __attribute__((ext_vector_type(8)));
#define LDS_WAIT() asm volatile("s_waitcnt lgkmcnt(0)" ::: "memory")
__device__ __forceinline__ unsigned f2bf(float f) { unsigned u = __builtin_bit_cast(unsigned, f); return (u + 0x7fffu + ((u >> 16) & 1u)) >> 16; }
__device__ __forceinline__ unsigned pk2(float lo, float hi) { return f2bf(lo) | (f2bf(hi) << 16); }
__device__ __forceinline__ float blo(unsigned w) { return __builtin_bit_cast(float, w << 16); }
__device__ __forceinline__ float bhi(unsigned w) { return __builtin_bit_cast(float, w & 0xffff0000u); }
__device__ __forceinline__ float wave_sum(float v) {
#pragma unroll
    for (int o = 1; o < 64; o <<= 1) v += __shfl_xor(v, o);
    return v;
}

#define XB_TMO      128
#define XB_XCNT(j)  (256  + 64 * (j))
#define XB_XSUB(j)  (1280 + 64 * (j))
#define XB_XGEN(j)  (2304 + 64 * (j))
#define XB_TOP      3328
#define XB_TOPGEN   3392
#define XCD_BAR_WORDS 3456
#define XB_SPIN_CAP (1u << 18)

__device__ __forceinline__ unsigned xb_ld(unsigned* p)              { return __hip_atomic_load(p, __ATOMIC_RELAXED, __HIP_MEMORY_SCOPE_AGENT); }
__device__ __forceinline__ unsigned xb_add(unsigned* p, unsigned v) { return __hip_atomic_fetch_add(p, v, __ATOMIC_RELAXED, __HIP_MEMORY_SCOPE_AGENT); }
__device__ __forceinline__ unsigned xb_xcc_id() { return (unsigned)__builtin_amdgcn_s_getreg((3 << 11) | 20) & 0xFu; }
#define XB_SPIN(cond, bar) do { unsigned _sp = 0; while (cond) { __builtin_amdgcn_s_sleep(1); \
    if ((++_sp & 255u) == 0u) { if (xb_ld(&(bar)[XB_TMO])) break; if (_sp > XB_SPIN_CAP) { atomicAdd(&(bar)[XB_TMO], 1u); break; } } } } while (0)

struct XcdBarrier {
    unsigned* bar; unsigned x;
    volatile LAS unsigned* st;
};

__device__ __forceinline__ XcdBarrier xcd_barrier_post(unsigned* bar, volatile LAS unsigned* st) {
    XcdBarrier b; b.bar = bar; b.x = xb_xcc_id(); b.st = st;
    if (threadIdx.x == 0) (void)xb_add(&bar[XB_XCNT(b.x)], 1u);
    return b;
}
__device__ __forceinline__ void xcd_barrier_complete(unsigned* bar, unsigned x, unsigned& nloc, unsigned& nx) {
    const unsigned G = gridDim.x * gridDim.y * gridDim.z;
    unsigned sum, cnt, mine, sp = 0u;
    for (;;) {
        sum = 0u; cnt = 0u; mine = 0u;
#pragma unroll
        for (unsigned j = 0; j < 16; ++j) { const unsigned c = xb_ld(&bar[XB_XCNT(j)]); sum += c; cnt += (c > 0u) ? 1u : 0u; mine = (j == x) ? c : mine; }
        if (sum == G) break;
        __builtin_amdgcn_s_sleep(1);
        if ((++sp & 255u) == 0u) { if (xb_ld(&bar[XB_TMO])) break; if (sp > XB_SPIN_CAP) { atomicAdd(&bar[XB_TMO], 1u); break; } }
    }
    nloc = mine > 0u ? mine : 1u; nx = cnt > 0u ? cnt : 1u;
}

__device__ __forceinline__ void xcd_barrier(const XcdBarrier& b) {
    asm volatile("s_waitcnt vmcnt(0)" ::: "memory");
    __syncthreads();
    if (threadIdx.x == 0) {
        unsigned* bar = b.bar; unsigned bx_ = b.x;
        asm volatile("" : "+s"(bar), "+s"(bx_));
        __builtin_amdgcn_s_waitcnt(0);
        unsigned nloc = b.st[0], nx = b.st[1];
        if (nloc == 0u) { xcd_barrier_complete(bar, bx_, nloc, nx); b.st[0] = nloc; b.st[1] = nx; }
        const unsigned old = xb_add(&bar[XB_XSUB(bx_)], 1u);
        const unsigned gen = old / nloc;
        if (old + 1u == (gen + 1u) * nloc) {
            __builtin_amdgcn_fence(__ATOMIC_RELEASE, "agent");
            asm volatile("s_waitcnt vmcnt(0)" ::: "memory");
            const unsigned og = xb_add(&bar[XB_TOP], 1u);
            const unsigned tg = og / nx;
            if (og + 1u == (tg + 1u) * nx) xb_add(&bar[XB_TOPGEN], 1u);
            else XB_SPIN(xb_ld(&bar[XB_TOPGEN]) == tg, bar);
            __builtin_amdgcn_fence(__ATOMIC_ACQUIRE, "agent");
            xb_add(&bar[XB_XGEN(bx_)], 1u);
            asm volatile("s_waitcnt vmcnt(0)" ::: "memory");
        } else {
            XB_SPIN(xb_ld(&bar[XB_XGEN(bx_)]) == gen, bar);
            __builtin_amdgcn_fence(__ATOMIC_ACQUIRE, "agent");
            asm volatile("s_waitcnt vmcnt(0)" ::: "memory");
        }
    }
    __syncthreads();
}

constexpr int MISC_OFF = 131072 + 320;
constexpr size_t CTL_ZERO_BYTES = 65536;

struct Args { const void* in[21]; float* out; unsigned char* ws; int ph_lo, ph_hi; };
static_assert(sizeof(Args) == 23 * 8 + 8, "Args has no padding");


typedef const char __attribute__((address_space(4)))* kseg_t;
__device__ __forceinline__ const void* karg_ptr(int i) {
    kseg_t base = (kseg_t)__builtin_amdgcn_kernarg_segment_ptr();
    asm volatile("" : "+s"(base));
    return *(const void* const __attribute__((address_space(4)))*)(base + 8 * i);
}
__device__ __forceinline__ int karg_int(int byte_off) {
    kseg_t base = (kseg_t)__builtin_amdgcn_kernarg_segment_ptr();
    asm volatile("" : "+s"(base));
    return *(const int __attribute__((address_space(4)))*)(base + byte_off);
}
#define KIN(i) karg_ptr(i)
#define KOUT ((float*)karg_ptr(21))
#define KWS ((unsigned char*)karg_ptr(22))

struct Frame {
    LAS unsigned char* lds;
    int wave, vcu, G, gw, NGW, bx;
};
__device__ __forceinline__ Frame fresh_frame(const Frame& F) {
    Frame R = F;
    asm volatile("" : "+s"(R.wave), "+s"(R.vcu), "+s"(R.G), "+s"(R.gw), "+s"(R.NGW), "+s"(R.bx));
    return R;
}

__device__ __forceinline__ void transpose_item(const float* W, int ldw, int n_begin, int nblk, const float* gain, bf16* WT, int K, int row_off, LAS float* scr, int item, int lane, int permkv = 0) {
    const int kb = item / nblk, nb = item % nblk, k0 = 64 * kb, n0 = 32 * nb;
    const int nd0 = permkv ? 256 * (n0 >> 8) + 128 * ((n0 >> 5) & 1) + 32 * (2 * ((n0 >> 7) & 1) + ((n0 >> 6) & 1)) : n0;
    float tv[32];
#pragma unroll
    for (int i = 0; i < 32; ++i) tv[i] = W[(size_t)(k0 + 2 * i + (lane >> 5)) * ldw + n_begin + n0 + (lane & 31)];
    if (gain) {
#pragma unroll
        for (int i = 0; i < 32; ++i) tv[i] *= gain[k0 + 2 * i + (lane >> 5)]; }
#pragma unroll
    for (int i = 0; i < 32; ++i) scr[(2 * i + (lane >> 5)) * 33 + (lane & 31)] = tv[i];
    LDS_WAIT(); asm volatile("" ::: "memory");
    const int c = lane & 7;
#pragma unroll
    for (int j = 0; j < 4; ++j) { const int n = (lane >> 3) + 8 * j; const LAS float* s = scr + (8 * c) * 33 + n;
        v4u o; o.x = pk2(s[0 * 33], s[1 * 33]); o.y = pk2(s[2 * 33], s[3 * 33]); o.z = pk2(s[4 * 33], s[5 * 33]); o.w = pk2(s[6 * 33], s[7 * 33]);
        *(GAS v4u*)(WT + (size_t)(row_off + nd0 + n) * K + k0 + 8 * c) = o; }
    LDS_WAIT(); asm volatile("" ::: "memory");
}
__device__ __forceinline__ void rms_row_to_bf16(const float* xrow, const float* g, bf16* orow, int lane) {
    const f32x4* xr = (const f32x4*)xrow + lane; const f32x4* gr = (const f32x4*)g + lane;
    f32x4 v[4]; float s = 0.f;
#pragma unroll
    for (int j = 0; j < 4; ++j) { v[j] = xr[64 * j]; s += (v[j].x * v[j].x + v[j].y * v[j].y) + (v[j].z * v[j].z + v[j].w * v[j].w); }
    const float r = 1.0f / sqrtf(wave_sum(s) * (1.f / DM) + RMS_EPS);
    v2u* o8 = (v2u*)orow + lane;
#pragma unroll
    for (int j = 0; j < 4; ++j) { const f32x4 gv = gr[64 * j]; v2u w; w.x = pk2(v[j].x * r * gv.x, v[j].y * r * gv.y); w.y = pk2(v[j].z * r * gv.z, v[j].w * r * gv.w); o8[64 * j] = w; }
}
__device__ __forceinline__ void cvt8(const float* src, bf16* dst, size_t i8) {
    const f32x4 a = *(const f32x4*)(src + i8 * 8), b = *(const f32x4*)(src + i8 * 8 + 4);
    v4u o; o.x = pk2(a.x, a.y); o.y = pk2(a.z, a.w); o.z = pk2(b.x, b.y); o.w = pk2(b.z, b.w);
    *(v4u*)(dst + i8 * 8) = o;
}

__device__ __forceinline__ void convert_tables(int l, int cw, int ncw) {
    const int lane = pg8::fresh_lane();
    constexpr int NR = 8;
    for (int it0 = cw * NR; it0 < 2 * NEXP; it0 += ncw * NR) {
        f32x4 va[NR][4]; float m[NR];
#pragma unroll
        for (int r = 0; r < NR; ++r) { const int it = it0 + r, tab = it / NEXP, row = l * NEXP + it % NEXP;
            const f32x4* src = (const f32x4*)((const float*)(tab ? KIN(20) : KIN(19)) + (size_t)row * DM) + lane;
#pragma unroll
            for (int j = 0; j < 4; ++j) va[r][j] = __builtin_nontemporal_load(src + 64 * j); }
#pragma unroll
        for (int r = 0; r < NR; ++r) { float mm = 0.f;
#pragma unroll
            for (int j = 0; j < 4; ++j) mm = fmaxf(mm, fmaxf(fmaxf(fabsf(va[r][j].x), fabsf(va[r][j].y)), fmaxf(fabsf(va[r][j].z), fabsf(va[r][j].w))));
            m[r] = mm; }
#pragma unroll
        for (int o = 1; o < 64; o <<= 1)
#pragma unroll
            for (int r = 0; r < NR; ++r) m[r] = fmaxf(m[r], __shfl_xor(m[r], o));
        if (it0 < NEXP) {
#pragma unroll
            for (int r = 0; r < NR; ++r) { const int it = it0 + r, row = l * NEXP + it;
                const float inv = m[r] > 0.f ? 6.0f / m[r] : 0.f;
#define Q4(x) ({ const float v_ = (x) * inv, a_ = fabsf(v_); \
                 const int c_ = (int)rintf(2.0f * fminf(a_, 2.0f)) + (int)rintf(fminf(fmaxf(a_ - 2.0f, 0.0f), 2.0f)) + (a_ > 5.0f ? 1 : 0); (unsigned)(c_ | (v_ < 0.0f ? 8 : 0)); })
                unsigned char* dstb = KWS + WS_U + (size_t)l * UV_STRIDE + (size_t)it * 128 + 2 * lane;
#pragma unroll
                for (int j = 0; j < 4; ++j) *(unsigned short*)(dstb + (size_t)j * (NEXP * 128)) = (unsigned short)(Q4(va[r][j].x) | (Q4(va[r][j].y) << 4) | (Q4(va[r][j].z) << 8) | (Q4(va[r][j].w) << 12));
#undef Q4
                if (lane == 0) ((float*)(KWS + WS_SU))[2 * row] = m[r] * (1.0f / 6.0f); }
            continue;
        }
#pragma unroll
        for (int r = 0; r < NR; ++r) { const int it = it0 + r, tab = it / NEXP, row = l * NEXP + it % NEXP;
            const float inv = m[r] > 0.f ? 127.0f / m[r] : 0.f;
#define Q8(x) ((unsigned)((int)rintf((x) * inv) & 255))
            unsigned char* dstb = KWS + (tab ? WS_V : WS_U) + (size_t)l * UV_STRIDE + (size_t)(it % NEXP) * 128 + ((4 * lane) & 127);
#pragma unroll
            for (int j = 0; j < 4; ++j) *(unsigned*)(dstb + (size_t)(2 * j + (lane >> 5)) * (NEXP * 128)) = Q8(va[r][j].x) | (Q8(va[r][j].y) << 8) | (Q8(va[r][j].z) << 16) | (Q8(va[r][j].w) << 24);
#undef Q8
            if (lane == 0) ((float*)(KWS + WS_SU))[2 * row + tab] = m[r] * (1.0f / 127.0f); }
    }
}

__device__ __forceinline__ void ph_prologue(Frame& F) {
    LAS float* scr = (LAS float*)(F.lds + F.wave * 16384);
    const int gw = F.gw, NGW = F.NGW, lane = pg8::fresh_lane();
    constexpr int I_G = 16 * 64, I_P = 16 * 37, I_UQ = 6 * 24, I_UKV = 4 * 32, I_O = 8 * 32, I_OUT = 16 * 32, I_WQ = 16 * 64;
    constexpr int I_L = I_G + I_P + I_UQ + I_UKV + I_O + I_OUT + I_WQ;
    for (int it = gw; it < DEPTH * I_L; it += NGW) {
        const int l = it / I_L; int r = it % I_L;
        unsigned char* wb = KWS + WS_W + (size_t)l * W_STRIDE;
        const float* w_in = (const float*)KIN(3) + (size_t)l * DM * INW;
        const float* g1 = (const float*)KIN(2) + (size_t)l * DM;
        if (r < I_G) { transpose_item(w_in, INW, 1184, 64, g1, (bf16*)(wb + WO_WIN), DM, 0, scr, r, lane); continue; } r -= I_G;
        if (r < I_P) { transpose_item(w_in, INW, 0, 37, g1, (bf16*)(wb + WO_WIN), DM, 2048, scr, r, lane); continue; } r -= I_P;
        if (r < I_UQ) { transpose_item((const float*)KIN(6) + (size_t)l * QL * 768, 768, 0, 24, (const float*)KIN(4) + l * QL, (bf16*)(wb + WO_WUQ), QL, 0, scr, r, lane); continue; } r -= I_UQ;
        if (r < I_UKV) { transpose_item((const float*)KIN(7) + (size_t)l * KVL * 1024, 1024, 0, 32, (const float*)KIN(5) + l * KVL, (bf16*)(wb + WO_WUKV), KVL, 0, scr, r, lane, 1); continue; } r -= I_UKV;
        if (r < I_O) { transpose_item((const float*)KIN(10) + (size_t)l * 512 * DM, DM, 0, 32, nullptr, (bf16*)(wb + WO_WO), 512, 0, scr, r, lane); continue; } r -= I_O;
        if (r < I_OUT) { transpose_item((const float*)KIN(15) + (size_t)l * DM * DM, DM, 0, 32, nullptr, (bf16*)(wb + WO_WOUT), DM, 0, scr, r, lane); continue; } r -= I_OUT;
        transpose_item((const float*)KIN(17) + (size_t)l * DM * 2048, 2048, 0, 64, (const float*)KIN(16) + (size_t)l * DM, (bf16*)(wb + WO_WQ), DM, 0, scr, r, lane);
    }
    for (int i = gw * 64 + lane; i < DEPTH * 96 * DM / 8; i += NGW * 64) {
        const int l = i / (96 * DM / 8), r = i % (96 * DM / 8);
        *(v4u*)((bf16*)(KWS + WS_W + (size_t)l * W_STRIDE + WO_WIN) + (size_t)INW * DM + (size_t)r * 8) = (v4u){0u, 0u, 0u, 0u};
    }
    for (int it = gw; it < DEPTH * 16 * 32; it += NGW) {
        const int l = it >> 9, cb = (it >> 5) & 15, db = it & 31, g = cb >> 2, r32 = lane & 31, hi = lane >> 5;
        const float* pw = (const float*)KIN(11) + (size_t)l * 4 * 128 * 128 + (size_t)(cb * 32 + r32) * 128 + 64 * hi;
        const float* ps = (const float*)KIN(12) + (size_t)l * 512 + g * 128 + 64 * hi;
        const float* wp = (const float*)KIN(13) + (size_t)l * 512 * DM + (size_t)(g * 128 + 64 * hi) * DM + db * 32 + r32;
        float av[64], bv[64];
#pragma unroll
        for (int j = 0; j < 16; ++j) { const f32x4 v = *(const f32x4*)(pw + 4 * j); av[4 * j] = v.x; av[4 * j + 1] = v.y; av[4 * j + 2] = v.z; av[4 * j + 3] = v.w; }
#pragma unroll
        for (int j = 0; j < 64; ++j) bv[j] = wp[(size_t)j * DM];
#pragma unroll
        for (int j = 0; j < 16; ++j) { const f32x4 s4 = *(const f32x4*)(ps + 4 * j); bv[4 * j] *= s4.x; bv[4 * j + 1] *= s4.y; bv[4 * j + 2] *= s4.z; bv[4 * j + 3] *= s4.w; }
        f32x16 acc = f32x16{};
#pragma unroll
        for (int s = 0; s < 64; ++s) acc = __builtin_amdgcn_mfma_f32_32x32x2f32(av[s], bv[s], acc, 0, 0, 0);
        bf16* dst = (bf16*)(KWS + WS_W + (size_t)l * W_STRIDE + WO_WC) + (size_t)(db * 32 + r32) * 512 + cb * 32 + 4 * hi;
#pragma unroll
        for (int q = 0; q < 4; ++q) { v2u o; o.x = pk2(acc[4 * q], acc[4 * q + 1]); o.y = pk2(acc[4 * q + 2], acc[4 * q + 3]); *(v2u*)(dst + 8 * q) = o; }
    }
    for (int i = gw * 64 + lane; i < DEPTH * 16 * 128 * 128 / 8; i += NGW * 64) {
        const int l = i / (16 * 128 * 128 / 8), r = i % (16 * 128 * 128 / 8);
        cvt8((const float*)KIN(18) + (size_t)l * 16 * 128 * 128, (bf16*)(KWS + WS_W + (size_t)l * W_STRIDE + WO_KEYS), (size_t)r);
    }
    for (int m0 = gw; m0 < MTOK; m0 += 2 * NGW) {
        f32x4 v[2][4]; float s[2];
#pragma unroll
        for (int u = 0; u < 2; ++u) { const int m = (m0 + u * NGW < MTOK) ? m0 + u * NGW : m0; const f32x4* xr = (const f32x4*)((const float*)KIN(0) + (size_t)m * DM) + lane;
#pragma unroll
            for (int j = 0; j < 4; ++j) v[u][j] = xr[64 * j]; }
#pragma unroll
        for (int u = 0; u < 2; ++u) { float ss = 0.f;
#pragma unroll
            for (int j = 0; j < 4; ++j) ss += (v[u][j].x * v[u][j].x + v[u][j].y * v[u][j].y) + (v[u][j].z * v[u][j].z + v[u][j].w * v[u][j].w);
            s[u] = ss; }
#pragma unroll
        for (int o = 1; o < 64; o <<= 1) { s[0] += __shfl_xor(s[0], o); s[1] += __shfl_xor(s[1], o); }
#pragma unroll
        for (int u = 0; u < 2; ++u) { const int m = m0 + u * NGW; if (m < MTOK) {
            v2u* o8 = (v2u*)((bf16*)(KWS + WS_XB) + (size_t)m * DM) + lane;
#pragma unroll
            for (int j = 0; j < 4; ++j) { v2u w; w.x = pk2(v[u][j].x, v[u][j].y); w.y = pk2(v[u][j].z, v[u][j].w); o8[64 * j] = w; }
            if (lane == 0) { f32x4* sp = (f32x4*)((float*)(KWS + WS_SSQN) + (size_t)m * 8); sp[0] = (f32x4){s[u], 0.f, 0.f, 0.f}; sp[1] = (f32x4){0.f, 0.f, 0.f, 0.f}; } } }
    }
}

__device__ __forceinline__ void ph_pool(Frame& F, int cw, int ncw) {
    const bf16* KP = (const bf16*)(KWS + WS_KPEP); bf16* MX = (bf16*)(KWS + WS_MIXED);
    const int lane = pg8::fresh_lane(), g = lane >> 4, half = 1 << g, c0 = lane * 8;
#define POOL_ACC(W, SGN) do { sum[0] += SGN blo(W.x); sum[1] += SGN bhi(W.x); sum[2] += SGN blo(W.y); sum[3] += SGN bhi(W.y); sum[4] += SGN blo(W.z); sum[5] += SGN bhi(W.z); sum[6] += SGN blo(W.w); sum[7] += SGN bhi(W.w); } while (0)
    for (int run = cw; run < MTOK / 8; run += ncw) {
        const int t0 = run * 8, s0 = t0 & (SEQ - 1);
        v4u row[23];
#pragma unroll
        for (int k = 0; k < 23; ++k) { const int d = k - 8; const bool ok = (d >= -half) && (d < 8 + half - 1 + 1) && (s0 + d >= 0) && (s0 + d < SEQ);
            row[k] = ok ? *(const v4u*)(KP + (size_t)(t0 + d) * KPEPW + 32 + c0) : (v4u){0u, 0u, 0u, 0u}; }
        float sum[8];
#pragma unroll
        for (int j = 0; j < 8; ++j) sum[j] = 0.f;
        int cnt = 0;
#pragma unroll
        for (int d = -8; d < 8; ++d) { const bool ok = (d >= -half) && (d < half) && (s0 + d >= 0) && (s0 + d < SEQ); if (ok) { POOL_ACC(row[d + 8], +); ++cnt; } }
#pragma unroll
        for (int i = 0; i < 8; ++i) {
            const int t = t0 + i, s = s0 + i;
            if (i > 0) {
                const bool lv_ok = (s - 1 - half >= 0), ev_ok = (s + half - 1 < SEQ);
#define POOL_CASE(H) do { if (half == (H)) { if ((i - 1 - (H) + 8) >= 0) { if (lv_ok) { POOL_ACC(row[(i - 1 - (H) + 8) >= 0 ? (i - 1 - (H) + 8) : 0], -); } } if (ev_ok) { POOL_ACC(row[i + (H) - 1 + 8], +); } } } while (0)
                POOL_CASE(1); POOL_CASE(2); POOL_CASE(4); POOL_CASE(8);
#undef POOL_CASE
                if (lv_ok) --cnt;
                if (ev_ok) ++cnt;
            }
            const v4u me = row[i + 8];
            const float ic = 1.0f / (float)cnt;
            v4u o; o.x = pk2(sum[0] * ic - blo(me.x), sum[1] * ic - bhi(me.x)); o.y = pk2(sum[2] * ic - blo(me.y), sum[3] * ic - bhi(me.y));
            o.z = pk2(sum[4] * ic - blo(me.z), sum[5] * ic - bhi(me.z)); o.w = pk2(sum[6] * ic - blo(me.w), sum[7] * ic - bhi(me.w));
            *(v4u*)(MX + (size_t)t * PW + c0) = o;
        }
    }
#undef POOL_ACC
}

__device__ __forceinline__ void ph_finalize(Frame& F, int l) {
    const bf16* QR = (const bf16*)(KWS + WS_QRAW); const float* SSQC = (const float*)(KWS + WS_SSQC);
    bf16* Q = (bf16*)(KWS + WS_Q);
    const int* pos = (const int*)KIN(1);
    const float* ghq = (const float*)KIN(8) + l * QKH;
    const int lane = pg8::fresh_lane(), h = lane >> 3, sub = lane & 7;
    const float inv0 = __builtin_amdgcn_exp2f(-(float)(2 * sub) * 0.8304820237218406f), inv1 = __builtin_amdgcn_exp2f(-(float)(2 * sub + 1) * 0.8304820237218406f);
    float gqn[8];
#pragma unroll
    for (int j = 0; j < 8; ++j) gqn[j] = ghq[8 * sub + j];
    const float gq10 = ghq[64 + 2 * sub], gq11 = ghq[65 + 2 * sub], gq20 = ghq[80 + 2 * sub], gq21 = ghq[81 + 2 * sub];
    for (int t = F.gw; t < MTOK; t += F.NGW) {
        const f32x4* sp = (const f32x4*)(SSQC + (size_t)t * 24); const f32x4 sa = sp[0], sb = sp[1], sc = sp[2];
        const float rq = 1.0f / sqrtf(((sa.x + sa.y) + (sa.z + sa.w) + (sb.x + sb.y) + (sb.z + sb.w) + (sc.x + sc.y) + (sc.z + sc.w)) * (1.f / QL) + RMS_EPS);
        const float p = (float)pos[t];
        float c0, s0, c1, s1;
        { const float a0 = p * inv0, a1 = p * inv1;
          const float n0 = rintf(a0 * 0.15915494309189535f), n1 = rintf(a1 * 0.15915494309189535f);
          float r0 = fmaf(-n0, 6.28318548202514648f, a0); r0 = fmaf(-n0, -1.7484556e-7f, r0);
          float r1 = fmaf(-n1, 6.28318548202514648f, a1); r1 = fmaf(-n1, -1.7484556e-7f, r1);
          r0 *= 0.15915494309189535f; r1 *= 0.15915494309189535f;
          s0 = __builtin_amdgcn_sinf(r0); c0 = __builtin_amdgcn_cosf(r0); s1 = __builtin_amdgcn_sinf(r1); c1 = __builtin_amdgcn_cosf(r1); }
        { const bf16* qp = QR + (size_t)t * 768 + h * QKH;
          const v4u w = *(const v4u*)(qp + 8 * sub); const unsigned wa = *(const unsigned*)(qp + 64 + 2 * sub), wb = *(const unsigned*)(qp + 80 + 2 * sub);
          float x[8] = {blo(w.x), bhi(w.x), blo(w.y), bhi(w.y), blo(w.z), bhi(w.z), blo(w.w), bhi(w.w)};
          float ss = 0.f;
#pragma unroll
          for (int j = 0; j < 8; ++j) { x[j] *= rq; ss += x[j] * x[j]; }
          const float x10 = blo(wa) * rq, x11 = bhi(wa) * rq, x20 = blo(wb) * rq, x21 = bhi(wb) * rq;
          const float y10 = x10 * c0 - x20 * s0, y20 = x10 * s0 + x20 * c0, y11 = x11 * c1 - x21 * s1, y21 = x11 * s1 + x21 * c1;
          ss += (y10 * y10 + y20 * y20) + (y11 * y11 + y21 * y21);
          ss += __shfl_xor(ss, 1); ss += __shfl_xor(ss, 2); ss += __shfl_xor(ss, 4);
          const float rn = 1.0f / sqrtf(ss * (1.f / QKH) + RMS_EPS);
          bf16* qo = Q + (size_t)t * 768 + h * QKH;
          v4u o; o.x = pk2(x[0] * rn * gqn[0], x[1] * rn * gqn[1]); o.y = pk2(x[2] * rn * gqn[2], x[3] * rn * gqn[3]); o.z = pk2(x[4] * rn * gqn[4], x[5] * rn * gqn[5]); o.w = pk2(x[6] * rn * gqn[6], x[7] * rn * gqn[7]);
          *(v4u*)(qo + 8 * sub) = o;
          *(unsigned*)(qo + 64 + 2 * sub) = pk2(y10 * rn * gq10, y11 * rn * gq11);
          *(unsigned*)(qo + 80 + 2 * sub) = pk2(y20 * rn * gq20, y21 * rn * gq21); }
    }
}

__device__ __forceinline__ void ph_attn(Frame& F, unsigned char* lds_generic, int l) {
    const att::bf16* Q = (const att::bf16*)(KWS + WS_QRAW); const att::bf16* K = (const att::bf16*)(KWS + WS_K); const att::bf16* V = (const att::bf16*)(KWS + WS_VV);
    att::bf16* O = (att::bf16*)(KWS + WS_O);
    for (int u = F.vcu; u < NB * NH * (SEQ / 256); u += F.G) {
        const int bh = u >> 3, qb = u & 7, b = bh >> 3, h = bh & 7;
        __syncthreads();
        att::attn_dense_body(Q + ((size_t)(b * SEQ + qb * 256)) * 768 + h * QKH, K + (size_t)(b * SEQ) * 768 + h * QKH, V + (size_t)(b * SEQ) * 512 + h * VHD,
                             O + ((size_t)(b * SEQ + qb * 256)) * 512 + h * VHD, SEQ, (char*)lds_generic, F.wave,
                             (const float*)(KWS + WS_SSQC) + (size_t)(b * SEQ + qb * 256) * 24, (const int*)KIN(1) + (b * SEQ + qb * 256), (const float*)KIN(8) + l * QKH);
    }
    __syncthreads();
}

__device__ __forceinline__ unsigned fkey(float f) { const unsigned b = __builtin_bit_cast(unsigned, f); return b ^ ((unsigned)((int)b >> 31) | 0x80000000u); }
__device__ __forceinline__ float funkey(unsigned u) { const unsigned b = u ^ (~(unsigned)((int)u >> 31) | 0x80000000u); return __builtin_bit_cast(float, b); }
__device__ __forceinline__ unsigned umax(unsigned a, unsigned b) { return a > b ? a : b; }
__device__ __forceinline__ unsigned umin(unsigned a, unsigned b) { return a < b ? a : b; }
#define INS16(T, x) do { unsigned _x = (x); _Pragma("unroll") for (int _i = 0; _i < 16; ++_i) { const unsigned _h = umax(T[_i], _x); _x = umin(T[_i], _x); T[_i] = _h; } } while (0)
__device__ __forceinline__ void sort16_desc(unsigned (&a)[16]) {
#pragma unroll
    for (int k = 2; k <= 16; k <<= 1)
#pragma unroll
        for (int j = k >> 1; j > 0; j >>= 1)
#pragma unroll
            for (int i = 0; i < 16; ++i) { const int l = i ^ j;
                if (l > i) { const unsigned hi = umax(a[i], a[l]), lo = umin(a[i], a[l]); if ((i & k) == 0) { a[i] = hi; a[l] = lo; } else { a[i] = lo; a[l] = hi; } } }
}
__device__ __forceinline__ void merge_top16(unsigned (&T)[16], const unsigned (&S)[16]) {
#pragma unroll
    for (int i = 0; i < 16; ++i) T[i] = umax(T[i], S[15 - i]);
#pragma unroll
    for (int j = 8; j > 0; j >>= 1)
#pragma unroll
        for (int i = 0; i < 16; ++i) { const int l = i ^ j; if (l > i) { const unsigned hi = umax(T[i], T[l]), lo = umin(T[i], T[l]); T[i] = hi; T[l] = lo; } }
}

__device__ __forceinline__ void ph_select(Frame& F, int l) {
    const bf16* QP = (const bf16*)(KWS + WS_QP); const bf16* KEYS = (const bf16*)(KWS + WS_W + (size_t)l * W_STRIDE + WO_KEYS);
    const float* SSQ = (const float*)(KWS + WS_SSQ); float* RR = (float*)(KWS + WS_RR); unsigned* EO = (unsigned*)(KWS + WS_E); float* GO = (float*)(KWS + WS_G);
    const int lane = pg8::fresh_lane(), r32 = lane & 31, hi = lane >> 5;
    LAS unsigned* TL = (LAS unsigned*)(F.lds + 65536) + (F.wave * 64 + lane);
    { const bf16* XG2 = (const bf16*)(KWS + WS_XB); unsigned char* XQ = KWS + WS_XQ; float* SX = (float*)(KWS + WS_SX); const float* g2p = (const float*)KIN(16) + (size_t)l * DM + 16 * lane;
      float g2v[16];
#pragma unroll
      for (int j = 0; j < 4; ++j) { const f32x4 gq = *(const f32x4*)(g2p + 4 * j); g2v[4 * j] = gq.x; g2v[4 * j + 1] = gq.y; g2v[4 * j + 2] = gq.z; g2v[4 * j + 3] = gq.w; }
      for (int t0 = F.gw; t0 < MTOK; t0 += 4 * F.NGW) {
          v4u ra[4], rb[4]; float m[4];
#pragma unroll
          for (int u = 0; u < 4; ++u) { const int t = (t0 + u * F.NGW < MTOK) ? t0 + u * F.NGW : t0; ra[u] = *(const v4u*)(XG2 + (size_t)t * DM + 16 * lane); rb[u] = *(const v4u*)(XG2 + (size_t)t * DM + 16 * lane + 8); }
          float xf[4][16];
#pragma unroll
          for (int u = 0; u < 4; ++u) { const v4u a = ra[u], b = rb[u];
              const float x_[16] = {blo(a.x), bhi(a.x), blo(a.y), bhi(a.y), blo(a.z), bhi(a.z), blo(a.w), bhi(a.w), blo(b.x), bhi(b.x), blo(b.y), bhi(b.y), blo(b.z), bhi(b.z), blo(b.w), bhi(b.w)};
              float mm = 0.f;
#pragma unroll
              for (int j = 0; j < 16; ++j) { xf[u][j] = x_[j] * g2v[j]; mm = fmaxf(mm, fabsf(xf[u][j])); }
              m[u] = mm; }
#pragma unroll
          for (int o = 1; o < 64; o <<= 1)
#pragma unroll
              for (int u = 0; u < 4; ++u) m[u] = fmaxf(m[u], __shfl_xor(m[u], o));
#pragma unroll
          for (int u = 0; u < 4; ++u) { const int t = t0 + u * F.NGW; if (t < MTOK) {
              const float inv = m[u] > 0.f ? 6.0f / m[u] : 0.f;
              unsigned c1[16], c2[16];
#pragma unroll
              for (int j = 0; j < 16; ++j) { const float v = xf[u][j] * inv, a = fabsf(v);
                  const float lo = rintf(2.0f * fminf(a, 2.0f)), hi2 = rintf(fminf(fmaxf(a - 2.0f, 0.0f), 2.0f)), top = a > 5.0f ? 1.0f : 0.0f;
                  c1[j] = (unsigned)(int)(lo + hi2 + top) | (v < 0.0f ? 8u : 0u);
                  const float qa = 0.5f * lo + hi2 + 2.0f * top, r = (a - qa) * 6.0f, ra = fabsf(r);
                  const float lo2 = rintf(2.0f * fminf(ra, 2.0f)), hi22 = rintf(fminf(fmaxf(ra - 2.0f, 0.0f), 2.0f)), top2 = ra > 5.0f ? 1.0f : 0.0f;
                  c2[j] = (unsigned)(int)(lo2 + hi22 + top2) | (((r < 0.0f) != (v < 0.0f)) ? 8u : 0u); }
              v2u q1, q2;
              q1.x = c1[0] | (c1[1] << 4) | (c1[2] << 8) | (c1[3] << 12) | (c1[4] << 16) | (c1[5] << 20) | (c1[6] << 24) | (c1[7] << 28);
              q1.y = c1[8] | (c1[9] << 4) | (c1[10] << 8) | (c1[11] << 12) | (c1[12] << 16) | (c1[13] << 20) | (c1[14] << 24) | (c1[15] << 28);
              q2.x = c2[0] | (c2[1] << 4) | (c2[2] << 8) | (c2[3] << 12) | (c2[4] << 16) | (c2[5] << 20) | (c2[6] << 24) | (c2[7] << 28);
              q2.y = c2[8] | (c2[9] << 4) | (c2[10] << 8) | (c2[11] << 12) | (c2[12] << 16) | (c2[13] << 20) | (c2[14] << 24) | (c2[15] << 28);
              unsigned char* xo = XQ + (size_t)(lane >> 4) * ((size_t)MTOK * 256) + (size_t)t * 256 + 8 * (lane & 15);
              *(v2u*)(xo) = q1; *(v2u*)(xo + 128) = q2;
              if (lane == 0) SX[t] = m[u] * (1.0f / 6.0f); } }
      } }
    const int h = F.vcu & 7, tbg = F.vcu >> 3, ntbg = F.G >> 3;
    { const int tid = F.wave * 64 + lane;
#pragma unroll
      for (int j = 0; j < 8; ++j) { const int idx = tid + 512 * j, p = idx >> 11, n = (idx >> 4) & 127, ch = idx & 15;
          const v4u v = *(const v4u*)(KEYS + ((size_t)(2 * h + p) * 128 + n) * 128 + ch * 8);
          *(LAS v4u*)(F.lds + p * 32768 + n * 256 + ((ch * 16) ^ ((n & 7) << 4))) = v; }
      __syncthreads(); }
    for (int tb = tbg * 8 + F.wave; tb < MTOK / 32; tb += ntbg * 8) {
        const int tok = tb * 32 + r32;
        float ssq = 0.f;
        { const f32x4* sp = (const f32x4*)(SSQ + (size_t)tok * 16);
#pragma unroll
          for (int j = 0; j < 4; ++j) { const f32x4 v = sp[j]; ssq += (v.x + v.y) + (v.z + v.w); } }
        const float rr = 1.0f / sqrtf(ssq * (1.f / DM) + RMS_EPS);
        if (h == 0 && hi == 0) RR[tok] = rr;
        unsigned C[16];
#pragma unroll
        for (int i = 0; i < 16; ++i) C[i] = 0u;
        {
        unsigned T[2][16];
        bf16x8 qfa[2][8];
#pragma unroll
        for (int p = 0; p < 2; ++p) { const bf16* qrow = QP + (size_t)tok * 2048 + (2 * h + p) * 128 + hi * 8;
#pragma unroll
            for (int s = 0; s < 8; ++s) qfa[p][s] = *(const bf16x8*)(qrow + s * 16); }
#pragma unroll
        for (int p = 0; p < 2; ++p) {
            const int hp = 2 * h + p;
            bf16x8 qf[8];
#pragma unroll
            for (int s = 0; s < 8; ++s) qf[s] = qfa[p][s];
#pragma unroll
            for (int i = 0; i < 16; ++i) T[p][i] = 0u;
#pragma unroll 1
            for (int blk = 0; blk < 4; ++blk) {
                f32x16 acc = f32x16{};
                const int n = blk * 32 + r32; const LAS unsigned char* krow = F.lds + p * 32768 + n * 256; const int sw = (n & 7) << 4;
#pragma unroll
                for (int s = 0; s < 8; ++s) { const bf16x8 a = *(const LAS bf16x8*)(krow + ((32 * s + 16 * hi) ^ sw)); acc = __builtin_amdgcn_mfma_f32_32x32x16_bf16(a, qf[s], acc, 0, 0, 0); }
                const int nb = 127 - (blk * 32 + 4 * hi);
                unsigned K[16];
#pragma unroll
                for (int r = 0; r < 16; ++r) K[r] = (fkey(acc[r]) & ~127u) | (unsigned)(nb - ((r & 3) + 8 * (r >> 2)));
                sort16_desc(K); merge_top16(T[p], K);
            }
            unsigned oth[16];
#pragma unroll
            for (int i = 0; i < 16; ++i) oth[i] = (unsigned)__shfl_xor((int)T[p][i], 32);
            merge_top16(T[p], oth);
#pragma unroll
            for (int i = 0; i < 16; ++i) TL[(p * 16 + i) * 512] = T[p][i];
        }
        float s0[16], s1[16];
#pragma unroll
        for (int i = 0; i < 16; ++i) { s0[i] = funkey((T[0][i] & ~127u) | 64u); s1[i] = funkey((T[1][i] & ~127u) | 64u); }
#define CAND(i, j) ((fkey(s0[i] + s1[j]) & ~255u) | (unsigned)((i) * 16 + (j)))
#pragma unroll
        for (int j = 0; j < 16; ++j) C[j] = CAND(0, j);
        { unsigned B[16];
#pragma unroll
          for (int j = 0; j < 8; ++j) B[j] = CAND(1, j);
#pragma unroll
          for (int j = 0; j < 5; ++j) B[8 + j] = CAND(2, j);
#pragma unroll
          for (int j = 0; j < 3; ++j) B[13 + j] = CAND(4, j);
          sort16_desc(B); merge_top16(C, B); }
        { unsigned B[16];
#pragma unroll
          for (int j = 0; j < 4; ++j) B[j] = CAND(3, j);
#pragma unroll
          for (int j = 0; j < 2; ++j) { B[4 + j] = CAND(5, j); B[6 + j] = CAND(6, j); B[8 + j] = CAND(7, j); }
#pragma unroll
          for (int i = 0; i < 6; ++i) B[10 + i] = CAND(8 + i, 0);
          sort16_desc(B); merge_top16(C, B); }
        INS16(C, CAND(14, 0)); INS16(C, CAND(15, 0));
#undef CAND
        }
        float sc[16]; unsigned ex[16];
#pragma unroll
        for (int k = 0; k < 16; ++k) {
            const unsigned code = C[k] & 255u;
            const unsigned a = TL[(code >> 4) * 512], b = TL[(16 + (code & 15u)) * 512];
            ex[k] = (127u - (a & 127u)) * 128u + (127u - (b & 127u));
            sc[k] = funkey((a & ~127u) | 64u) + funkey((b & ~127u) | 64u);
        }
        float smax = sc[0];
#pragma unroll
        for (int k = 1; k < 16; ++k) smax = fmaxf(smax, sc[k]);
        float den = 0.f;
#pragma unroll
        for (int k = 0; k < 16; ++k) { sc[k] = __builtin_amdgcn_exp2f((sc[k] - smax) * rr * 1.4426950408889634f); den += sc[k]; }
        const float iden = 1.0f / den;
        v4u* edst = (v4u*)(EO + (size_t)tok * 128 + h * 16 + hi * 8); f32x4* gdst = (f32x4*)(GO + (size_t)tok * 128 + h * 16 + hi * 8);
#pragma unroll
        for (int k = 0; k < 8; k += 4) {
            unsigned ea[4], eb[4]; float wa[4], wb2[4];
#pragma unroll
            for (int j = 0; j < 4; ++j) { ea[j] = ex[k + j]; eb[j] = ex[8 + k + j]; wa[j] = sc[k + j]; wb2[j] = sc[8 + k + j];
                asm volatile("" : "+v"(ea[j]), "+v"(eb[j]), "+v"(wa[j]), "+v"(wb2[j])); }
            edst[k >> 2] = (v4u){hi ? eb[0] : ea[0], hi ? eb[1] : ea[1], hi ? eb[2] : ea[2], hi ? eb[3] : ea[3]};
            gdst[k >> 2] = (f32x4){(hi ? wb2[0] : wa[0]) * iden, (hi ? wb2[1] : wa[1]) * iden, (hi ? wb2[2] : wa[2]) * iden, (hi ? wb2[3] : wa[3]) * iden};
        }
    }
}

__device__ __forceinline__ float gelu_tanh(float h) {
    const float z = 0.7978845608028654f * (h + 0.044715f * h * h * h);
    return h * __builtin_amdgcn_rcpf(1.0f + __builtin_amdgcn_exp2f(-2.0f * 1.4426950408889634f * z));
}
__device__ __forceinline__ float ub0(unsigned x) { return (float)(x & 0xffu); }
__device__ __forceinline__ float ub1(unsigned x) { return (float)((x >> 8) & 0xffu); }
__device__ __forceinline__ float ub2(unsigned x) { return (float)((x >> 16) & 0xffu); }
__device__ __forceinline__ float ub3(unsigned x) { return (float)(x >> 24); }
#define DPP_I(x, ctrl) __builtin_amdgcn_update_dpp(0, (x), (ctrl), 0xf, 0xf, false)
#define DPP_F(x, ctrl) __builtin_bit_cast(float, __builtin_amdgcn_update_dpp(0, __builtin_bit_cast(int, (x)), (ctrl), 0xf, 0xf, false))
#define G1_IT(i) (bx + (i) * G)
#define G1_TOK(i) ((G1_IT(i) >> 3) * 8 + wave)
__device__ __forceinline__ void ph_g1(Frame& F, int l) {
    const unsigned char* XQ = KWS + WS_XQ; const unsigned* E = (const unsigned*)(KWS + WS_E); const unsigned char* U = KWS + WS_U + (size_t)l * UV_STRIDE; float* HPF = (float*)(KWS + WS_HPI);
    const int lane = pg8::fresh_lane(), n = lane & 15, q = lane >> 4, m = n & 7, hh = n >> 3, k8 = hh * 4 + q, r8 = lane >> 3, c = lane & 7;
    const int G = F.G, bx = F.bx, wave = F.wave;
    const int nit = (4 * (MTOK / 8) - bx + G - 1) / G;
    LAS unsigned char* ldw = F.lds + wave * 16384 + lane * 16; const LAS unsigned char* ldr = F.lds + wave * 16384 + m * 128 + hh * 64 + q * 16;
    typedef int i32x8 __attribute__((ext_vector_type(8))); typedef float f32x2 __attribute__((ext_vector_type(2)));
#define F1_IT(i) (bx + (i) * G)
#define F1_TOK(i) ((F1_IT(i) >> 2) * 8 + wave)
#define F1_LOADE(EV, i) do { const unsigned* ep_ = E + (size_t)F1_TOK(i) * 128 + 16 * r8; _Pragma("unroll") for (int j_ = 0; j_ < 4; ++j_) EV[j_] = *(const v4u*)(ep_ + 4 * j_); } while (0)
#define F1_LOADB(URV, XV, EV, i) do { const size_t co_ = (size_t)(F1_IT(i) & 3) * (NEXP * 128) + 16 * c; \
        _Pragma("unroll") for (int g_ = 0; g_ < 16; ++g_) URV[g_] = *(const v4u*)(U + (size_t)(EV[g_ >> 2][g_ & 3] & (NEXP - 1)) * 128 + co_); \
        XV = *(const v4u*)(XQ + (size_t)(F1_IT(i) & 3) * ((size_t)MTOK * 256) + (size_t)F1_TOK(i) * 256 + 128 * (n & 1) + 64 * ((n >> 1) & 1) + 16 * q); } while (0)
#define F1_COMP(URV, XV, i) do { float h_[16]; \
        const i32x8 xa_ = {(int)XV.x, (int)XV.y, (int)XV.z, (int)XV.w, 0, 0, 0, 0}; \
        _Pragma("unroll") for (int g_ = 0; g_ < 16; ++g_) *(LAS v4u*)(ldw + g_ * 1024) = URV[g_]; \
        _Pragma("unroll") for (int g_ = 0; g_ < 16; ++g_) { const v4u ur_ = *(const LAS v4u*)(ldr + g_ * 1024); \
            const i32x8 ub_ = {(int)ur_.x, (int)ur_.y, (int)ur_.z, (int)ur_.w, 0, 0, 0, 0}; \
            const f32x4 d_ = __builtin_amdgcn_mfma_scale_f32_16x16x128_f8f6f4(xa_, ub_, (f32x4){0.f, 0.f, 0.f, 0.f}, 4, 4, 0, 0x7f7f7f7f, 0, 0x7f7f7f7f); \
            const float v_ = hh ? d_[2] + d_[3] * (1.0f / 6.0f) : d_[0] + d_[1] * (1.0f / 6.0f); \
            h_[g_] = v_ + DPP_F(v_, 0x128); } \
          \
        float s0_ = h_[0], s1_ = h_[1]; \
        _Pragma("unroll") for (int k_ = 1; k_ < 8; ++k_) { s0_ = k8 == k_ ? h_[2 * k_] : s0_; s1_ = k8 == k_ ? h_[2 * k_ + 1] : s1_; } \
        *(f32x2*)(HPF + ((size_t)(F1_IT(i) & 3) * MTOK + F1_TOK(i)) * 128 + 16 * m + 2 * k8) = (f32x2){s0_, s1_}; } while (0)
    v4u eA[4], eB[4], xA, xB, urA[16], urB[16];
#define F1_CL(i) ((i) < nit ? (i) : nit - 1)
    if (nit > 0) {
        F1_LOADE(eA, 0); F1_LOADE(eB, F1_CL(1)); F1_LOADB(urA, xA, eA, 0);
        for (int i = 0; i < nit; i += 2) {
            F1_LOADE(eA, F1_CL(i + 2));
            F1_LOADB(urB, xB, eB, F1_CL(i + 1));
            __builtin_amdgcn_sched_barrier(0);
            F1_COMP(urA, xA, i);
            __builtin_amdgcn_sched_barrier(0);
            F1_LOADE(eB, F1_CL(i + 3));
            F1_LOADB(urA, xA, eA, F1_CL(i + 2));
            __builtin_amdgcn_sched_barrier(0);
            F1_COMP(urB, xB, F1_CL(i + 1));
            __builtin_amdgcn_sched_barrier(0);
        }
    }
#undef F1_CL
#undef F1_IT
#undef F1_TOK
#undef F1_LOADE
#undef F1_LOADB
#undef F1_COMP
}
__device__ __forceinline__ void ph_g1b(Frame& F, int l) {
    const float* HPF = (const float*)(KWS + WS_HPI); const unsigned* E = (const unsigned*)(KWS + WS_E); const float* G = (const float*)(KWS + WS_G);
    const float* RR = (const float*)(KWS + WS_RR); const float* SX = (const float*)(KWS + WS_SX);
    typedef float f32x2s __attribute__((ext_vector_type(2)));
    const f32x2s* SUV = (const f32x2s*)(KWS + WS_SU) + (size_t)l * NEXP;
    unsigned char* WQ = KWS + WS_WF; float* SW = (float*)(KWS + WS_WSUM);
    const int lane = pg8::fresh_lane();
    typedef int i32x2 __attribute__((ext_vector_type(2))); typedef float f32x2 __attribute__((ext_vector_type(2)));
    constexpr int NU = 4;
    for (int t0 = F.gw; t0 < MTOK; t0 += NU * F.NGW) {
        f32x2 isum[NU]; v2u e2[NU]; f32x2 g2[NU]; float hs[NU];
#pragma unroll
        for (int u = 0; u < NU; ++u) { const int t = (t0 + u * F.NGW < MTOK) ? t0 + u * F.NGW : t0;
            hs[u] = RR[t] * SX[t];
            isum[u] = (f32x2){0.f, 0.f};
#pragma unroll
            for (int s = 0; s < 4; ++s) { const f32x2 w = *(const f32x2*)(HPF + ((size_t)s * MTOK + t) * 128 + 2 * lane); isum[u].x += w.x; isum[u].y += w.y; }
            e2[u] = *(const v2u*)(E + (size_t)t * 128 + 2 * lane); g2[u] = *(const f32x2*)(G + (size_t)t * 128 + 2 * lane); }
        float w0[NU], w1[NU], m[NU];
#pragma unroll
        for (int u = 0; u < NU; ++u) { const unsigned e0 = e2[u].x & (NEXP - 1), e1 = e2[u].y & (NEXP - 1);
            const f32x2s sa = SUV[e0], sb = SUV[e1];
            w0[u] = g2[u].x * gelu_tanh(isum[u].x * hs[u] * sa.x) * sa.y; w1[u] = g2[u].y * gelu_tanh(isum[u].y * hs[u] * sb.x) * sb.y;
            m[u] = fmaxf(fabsf(w0[u]), fabsf(w1[u])); }
#pragma unroll
        for (int o = 1; o < 64; o <<= 1)
#pragma unroll
            for (int u = 0; u < NU; ++u) m[u] = fmaxf(m[u], __shfl_xor(m[u], o));
#pragma unroll
        for (int u = 0; u < NU; ++u) { const int t = t0 + u * F.NGW; if (t < MTOK) {
            const float inv = m[u] > 0.f ? 127.0f / m[u] : 0.f;
            const unsigned q = ((unsigned)((int)rintf(w0[u] * inv) & 255)) | ((unsigned)((int)rintf(w1[u] * inv) & 255) << 8);
            *(unsigned short*)(WQ + (size_t)t * 128 + 2 * lane) = (unsigned short)q;
            if (lane == 0) SW[t] = m[u] * (1.0f / 127.0f); } }
    }
}
__device__ __forceinline__ void ph_g2(Frame& F, int l, bf16* Xout) {
    const unsigned* E = (const unsigned*)(KWS + WS_E); const unsigned char* WQ = KWS + WS_WF; const float* SW = (const float*)(KWS + WS_WSUM);
    const unsigned char* V = KWS + WS_V + (size_t)l * UV_STRIDE;
    const bf16* X = (const bf16*)(KWS + WS_XB); float* SSQN = (float*)(KWS + WS_SSQN); float* OUTF = KOUT;
    const bool last = (l + 1 >= DEPTH);
    const int lane = pg8::fresh_lane(), c = lane & 7, q8 = lane >> 3;
    const bool b3 = (lane & 8) != 0;
    const int G = F.G, bx = blockIdx.x, wave = F.wave;
    const int nit = (8 * (MTOK / 8) - bx + G - 1) / G;
    typedef float f32x2 __attribute__((ext_vector_type(2)));
#define G2_LOADE(EV, i) do { const size_t t_ = (size_t)G1_TOK(i); _Pragma("unroll") for (int j_ = 0; j_ < 4; ++j_) EV[j_] = *(const v4u*)(E + t_ * 128 + q8 * 16 + 4 * j_); } while (0)
#define G2_LOADW(WV, SWV, i) do { WV = *(const v4u*)(WQ + (size_t)G1_TOK(i) * 128 + q8 * 16); SWV = SW[G1_TOK(i)]; } while (0)
#define G2_LOADB(VRV, XV, EV, i) do { const size_t co_ = (size_t)(G1_IT(i) & 7) * (NEXP * 128) + 16 * c; _Pragma("unroll") for (int i_ = 0; i_ < 16; ++i_) VRV[i_] = *(const v4u*)(V + (size_t)(EV[i_ >> 2][i_ & 3] & (NEXP - 1)) * 128 + co_); \
        XV = *(const unsigned*)(X + (size_t)G1_TOK(i) * DM + (size_t)128 * (G1_IT(i) & 7) + 16 * c + 2 * q8); } while (0)
#define G2_T4(R0, R1, R2, R3, WQW, A0, A1, A2, A3) do { \
        const unsigned t0_ = __builtin_amdgcn_perm((R1), (R0), 0x05010400u), t1_ = __builtin_amdgcn_perm((R1), (R0), 0x07030602u); \
        const unsigned t2_ = __builtin_amdgcn_perm((R3), (R2), 0x05010400u), t3_ = __builtin_amdgcn_perm((R3), (R2), 0x07030602u); \
        A0 = __builtin_amdgcn_sdot4((int)__builtin_amdgcn_perm(t2_, t0_, 0x05040100u), (int)(WQW), A0, false); \
        A1 = __builtin_amdgcn_sdot4((int)__builtin_amdgcn_perm(t2_, t0_, 0x07060302u), (int)(WQW), A1, false); \
        A2 = __builtin_amdgcn_sdot4((int)__builtin_amdgcn_perm(t3_, t1_, 0x05040100u), (int)(WQW), A2, false); \
        A3 = __builtin_amdgcn_sdot4((int)__builtin_amdgcn_perm(t3_, t1_, 0x07060302u), (int)(WQW), A3, false); } while (0)
#define G2_COMP(VRV, XV, WV, SWV, i) do { int acc_[16]; \
        _Pragma("unroll") for (int j_ = 0; j_ < 16; ++j_) acc_[j_] = 0; \
        _Pragma("unroll") for (int m_ = 0; m_ < 4; ++m_) { const unsigned wq_ = WV[m_]; \
            G2_T4(VRV[4 * m_].x, VRV[4 * m_ + 1].x, VRV[4 * m_ + 2].x, VRV[4 * m_ + 3].x, wq_, acc_[0], acc_[1], acc_[2], acc_[3]); \
            G2_T4(VRV[4 * m_].y, VRV[4 * m_ + 1].y, VRV[4 * m_ + 2].y, VRV[4 * m_ + 3].y, wq_, acc_[4], acc_[5], acc_[6], acc_[7]); \
            G2_T4(VRV[4 * m_].z, VRV[4 * m_ + 1].z, VRV[4 * m_ + 2].z, VRV[4 * m_ + 3].z, wq_, acc_[8], acc_[9], acc_[10], acc_[11]); \
            G2_T4(VRV[4 * m_].w, VRV[4 * m_ + 1].w, VRV[4 * m_ + 2].w, VRV[4 * m_ + 3].w, wq_, acc_[12], acc_[13], acc_[14], acc_[15]); } \
        int a8_[8], a4_[4], a2_[2]; \
        _Pragma("unroll") for (int j_ = 0; j_ < 8; ++j_) { auto r_ = __builtin_amdgcn_permlane32_swap((unsigned)acc_[j_], (unsigned)acc_[j_ + 8], false, false); \
            unsigned r0_ = r_[0], r1_ = r_[1]; asm volatile("" : "+v"(r0_), "+v"(r1_)); a8_[j_] = (int)r0_ + (int)r1_; } \
        _Pragma("unroll") for (int j_ = 0; j_ < 4; ++j_) { auto r_ = __builtin_amdgcn_permlane16_swap((unsigned)a8_[j_], (unsigned)a8_[j_ + 4], false, false); \
            unsigned r0_ = r_[0], r1_ = r_[1]; asm volatile("" : "+v"(r0_), "+v"(r1_)); a4_[j_] = (int)r0_ + (int)r1_; } \
        _Pragma("unroll") for (int j_ = 0; j_ < 2; ++j_) { const int keep_ = b3 ? a4_[j_ + 2] : a4_[j_], send_ = b3 ? a4_[j_] : a4_[j_ + 2]; a2_[j_] = keep_ + DPP_I(send_, 0x128); } \
        const int t_ = G1_TOK(i), s_ = G1_IT(i) & 7; const size_t col_ = (size_t)128 * s_ + 16 * c + 2 * q8; \
        const float sw_ = SWV; \
        f32x2 xo_; xo_.x = blo(XV) + (float)a2_[0] * sw_; xo_.y = bhi(XV) + (float)a2_[1] * sw_; \
        if (last) *(f32x2*)(OUTF + (size_t)t_ * DM + col_) = xo_; \
        else { *(unsigned*)(Xout + (size_t)t_ * DM + col_) = pk2(xo_.x, xo_.y); \
            const float ss_ = wave_sum(xo_.x * xo_.x + xo_.y * xo_.y); if (lane == 0) SSQN[(size_t)t_ * 8 + s_] = ss_; } } while (0)
    v4u eA[4], eB[4], vrA[16], vrB[16], wA, wB; unsigned xA, xB; float swA = 0.f, swB = 0.f;
    if (nit > 0) { G2_LOADE(eA, 0); G2_LOADW(wA, swA, 0); }
    if (nit > 1) { G2_LOADE(eB, 1); G2_LOADW(wB, swB, 1); }
    if (nit > 0) G2_LOADB(vrA, xA, eA, 0);
    for (int i = 0; i < nit; i += 2) {
        if (i + 1 < nit) G2_LOADB(vrB, xB, eB, i + 1);
        if (i + 2 < nit) G2_LOADE(eA, i + 2);
        G2_COMP(vrA, xA, wA, swA, i);
        if (i + 2 < nit) G2_LOADW(wA, swA, i + 2);
        if (i + 1 < nit) {
            if (i + 2 < nit) G2_LOADB(vrA, xA, eA, i + 2);
            if (i + 3 < nit) G2_LOADE(eB, i + 3);
            G2_COMP(vrB, xB, wB, swB, i + 1);
            if (i + 3 < nit) G2_LOADW(wB, swB, i + 3);
        }
    }
#undef G2_LOADE
#undef G2_LOADW
#undef G2_LOADB
#undef G2_COMP
#undef G2_T4
#undef G1_IT
#undef G1_TOK
#undef G1_COFF
}

constexpr int PH_PER_LAYER = 11, N_PHASES = 1 + DEPTH * PH_PER_LAYER;
__global__ void __launch_bounds__(NWAVES * 64, 2) fwd_kernel(Args A) {
    extern __shared__ __attribute__((aligned(16))) unsigned char lds[];
    Frame F;
    F.lds = (LAS unsigned char*)lds;
    F.wave = __builtin_amdgcn_readfirstlane((int)threadIdx.x >> 6);
    F.G = gridDim.x; { const int bx = blockIdx.x; F.vcu = (F.G % 8 == 0) ? (bx % 8) * (F.G / 8) + bx / 8 : bx; }
    F.gw = F.vcu * NWAVES + F.wave; F.NGW = F.G * NWAVES; F.bx = (int)blockIdx.x;
    cg::grid_group grid = cg::this_grid();
    for (int u = threadIdx.x; u < 64; u += NWAVES * 64) ((LAS unsigned*)(F.lds + 131072))[u + 64] = 0u;
    __syncthreads();
    XcdBarrier bar = xcd_barrier_post((unsigned*)(KWS + WS_CTL), (volatile LAS unsigned*)(F.lds + MISC_OFF) + 8);
    const int lo = karg_int(23 * 8), hi = karg_int(23 * 8 + 4);
#ifndef PH_MASK
#define PH_MASK 0xfff
#endif
#define KIND(k) ((k) == 0 ? 0 : 1 + ((k) - 1) % PH_PER_LAYER)
#define IN(k) (((PH_MASK >> KIND(k)) & 1) && lo <= (k) && (k) < hi)
#define SEAM(k) do { if (IN(k) && IN((k) + 1)) xcd_barrier(bar); } while (0)
#ifndef PROBE_KIND
#define PROBE_KIND (-1)
#endif
#define REPS(kind) for (int rep_ = ((kind) == PROBE_KIND ? 0 : 1); rep_ < 2; ++rep_)
#define REP_SYNC() do { if (rep_ == 0) xcd_barrier(bar); } while (0)
    if (lo < 0) grid.sync();
    if (IN(0)) { REPS(0) { ph_prologue(F); REP_SYNC(); } SEAM(0); }
    for (int l = 0; l < DEPTH; ++l) {
        const int p0 = 1 + l * PH_PER_LAYER;
        if (IN(p0 + 0)) { REPS(1) { Frame Fq = fresh_frame(F);
            unsigned char* ws = KWS; unsigned char* wb = ws + WS_W + (size_t)l * W_STRIDE;
            pg8::Gemm g{(const pg8::bf16_t*)(ws + WS_XB), (const pg8::bf16_t*)(wb + WO_WIN), MTOK, INWP, DM}; pg8::StaticOrder S; S.init(MTOK, INWP, Fq.G, Fq.bx);
            pg8::EpiIn E{(pg8::bf16_t*)(ws + WS_GATES), (const float*)KIN(14) + (size_t)l * 2048, (pg8::bf16_t*)(ws + WS_CQ), (pg8::bf16_t*)(ws + WS_CKV), (pg8::bf16_t*)(ws + WS_KPEP), (const float*)(ws + WS_SSQN), (float*)(ws + WS_SSQC), (const int*)KIN(1)};
            pg8::gemm_phase<pg8::EpiIn, pg8::StaticOrder, true, true>(Fq.lds, g, S, E, Fq.wave);
            { const int nu = MTOK / 256 * (INWP / 256), nfull = nu % Fq.G;
              if (nfull == 0) convert_tables(l, Fq.gw, Fq.NGW);
              else if (Fq.bx >= nfull) convert_tables(l, (Fq.bx - nfull) * NWAVES + Fq.wave, (Fq.G - nfull) * NWAVES); }
            REP_SYNC(); }
            SEAM(p0 + 0);
        }
        if (IN(p0 + 1)) { REPS(2) { Frame Fq = fresh_frame(F);
            unsigned char* ws = KWS; unsigned char* wb = ws + WS_W + (size_t)l * W_STRIDE;
            { const int nq = (MTOK / 256) * 3;
              if (nq >= Fq.G) ph_pool(Fq, Fq.gw, Fq.NGW);
              else if (Fq.bx >= nq) ph_pool(Fq, (Fq.bx - nq) * NWAVES + Fq.wave, (Fq.G - nq) * NWAVES); }
            { pg8::Gemm g{(const pg8::bf16_t*)(ws + WS_CQ), (const pg8::bf16_t*)(wb + WO_WUQ), MTOK, 768, QL}; pg8::StaticOrder S; S.init(MTOK, 768, Fq.G, Fq.bx);
              pg8::EpiBf16<0> E{(pg8::bf16_t*)(ws + WS_QRAW), 768, nullptr, 0, 0, 1.f};
              pg8::gemm_phase<pg8::EpiBf16<0>, pg8::StaticOrder, true, true>(Fq.lds, g, S, E, Fq.wave); }
            { int kvl = KVL; asm volatile("" : "+s"(kvl));
              pg8::Gemm g{(const pg8::bf16_t*)(ws + WS_CKV), (const pg8::bf16_t*)(wb + WO_WUKV), MTOK, 1024, kvl}; pg8::StaticOrder S; S.init(MTOK, 1024, Fq.G, Fq.bx);
              pg8::EpiKV E{(pg8::bf16_t*)(ws + WS_K), (pg8::bf16_t*)(ws + WS_VV), (const pg8::bf16_t*)(ws + WS_KPEP), (const float*)(ws + WS_SSQC), (const float*)KIN(9) + l * QKH};
              pg8::gemm_phase<pg8::EpiKV, pg8::StaticOrder, true, true>(Fq.lds, g, S, E, Fq.wave); }
            REP_SYNC(); }
            SEAM(p0 + 1);
        }
        if (IN(p0 + 3)) { REPS(4) { Frame Fq = fresh_frame(F); ph_attn(Fq, lds, l); REP_SYNC(); } SEAM(p0 + 3); }
        if (IN(p0 + 4)) { REPS(5) { Frame Fq = fresh_frame(F);
            unsigned char* ws = KWS; unsigned char* wb = ws + WS_W + (size_t)l * W_STRIDE;
            { pg8::Gemm g{(const pg8::bf16_t*)(ws + WS_O), (const pg8::bf16_t*)(wb + WO_WO), MTOK, DM, 512}; pg8::StaticOrder S; S.init(MTOK, DM, Fq.G, Fq.bx);
              pg8::EpiBf16<0> E{(pg8::bf16_t*)(ws + WS_ABUF), DM, nullptr, 0, 0, 1.f};
              pg8::gemm_phase<pg8::EpiBf16<0>, pg8::StaticOrder, true, true>(Fq.lds, g, S, E, Fq.wave); }
            { pg8::Gemm g{(const pg8::bf16_t*)(ws + WS_MIXED), (const pg8::bf16_t*)(wb + WO_WC), MTOK, DM, 512}; pg8::StaticOrder S; S.init(MTOK, DM, Fq.G, Fq.bx);
              pg8::EpiMix E{(const pg8::bf16_t*)(ws + WS_ABUF), (const pg8::bf16_t*)(ws + WS_GATES), (pg8::bf16_t*)(ws + WS_MIX)};
              pg8::gemm_phase<pg8::EpiMix, pg8::StaticOrder, true, true>(Fq.lds, g, S, E, Fq.wave); }
            REP_SYNC(); }
            SEAM(p0 + 4);
        }
        if (IN(p0 + 5)) { REPS(6) { Frame Fq = fresh_frame(F);
            unsigned char* ws = KWS; unsigned char* wb = ws + WS_W + (size_t)l * W_STRIDE;
            pg8::Gemm g{(const pg8::bf16_t*)(ws + WS_MIX), (const pg8::bf16_t*)(wb + WO_WOUT), MTOK, DM, DM}; pg8::StaticOrder S; S.init(MTOK, DM, Fq.G, Fq.bx);
            pg8::EpiRes E{(const pg8::bf16_t*)(ws + WS_XB), rep_ == 0 ? (pg8::bf16_t*)(ws + WS_GATES) : (pg8::bf16_t*)(ws + WS_XB), (float*)(ws + WS_SSQ)};
            pg8::gemm_phase<pg8::EpiRes, pg8::StaticOrder, true, true>(Fq.lds, g, S, E, Fq.wave);
            REP_SYNC(); }
            SEAM(p0 + 5);
        }
        if (IN(p0 + 6)) { REPS(7) { Frame Fq = fresh_frame(F);
            unsigned char* ws = KWS; unsigned char* wb = ws + WS_W + (size_t)l * W_STRIDE;
            pg8::Gemm g{(const pg8::bf16_t*)(ws + WS_XB), (const pg8::bf16_t*)(wb + WO_WQ), MTOK, 2048, DM}; pg8::StaticOrder S; S.init(MTOK, 2048, Fq.G, Fq.bx);
            pg8::EpiBf16<0> E{(pg8::bf16_t*)(ws + WS_QP), 2048, nullptr, 0, 0, 1.f};
            pg8::gemm_phase<pg8::EpiBf16<0>, pg8::StaticOrder, true, true>(Fq.lds, g, S, E, Fq.wave);
            REP_SYNC(); }
            SEAM(p0 + 6);
        }
        if (IN(p0 + 7)) { REPS(8) { Frame Fq = fresh_frame(F); ph_select(Fq, l); REP_SYNC(); } SEAM(p0 + 7); }
        if (IN(p0 + 8)) { REPS(9) { Frame Fq = fresh_frame(F); ph_g1(Fq, l); REP_SYNC(); } SEAM(p0 + 8); }
        if (IN(p0 + 9)) { REPS(10) { Frame Fq = fresh_frame(F); ph_g1b(Fq, l); REP_SYNC(); } SEAM(p0 + 9); }
        if (IN(p0 + 10)) { REPS(11) { Frame Fq = fresh_frame(F); ph_g2(Fq, l, rep_ == 0 ? (bf16*)(KWS + WS_QP) : (bf16*)(KWS + WS_XB)); REP_SYNC(); } SEAM(p0 + 10); }
    }
#undef IN
#undef SEAM
}

extern "C" void kernel_launch(void* const* d_in, const int* in_sizes, int n_in, void* d_out, int out_size, void* d_ws, size_t ws_size, hipStream_t stream) {
    static int grid = 0;
    if (grid == 0) {
        if (n_in != 21 || in_sizes[0] != MTOK * DM || out_size != MTOK * DM || ws_size < WS_END) {
            fprintf(stderr, "kernel_launch: unexpected shapes: n_in %d in0 %d out %d ws %zu (need %zu)\n", n_in, n_in > 0 ? in_sizes[0] : -1, out_size, ws_size, (size_t)WS_END); grid = -1; return; }
        int dev = 0, cus = 0, per_cu = 0;
        if (hipGetDevice(&dev) != hipSuccess || hipDeviceGetAttribute(&cus, hipDeviceAttributeMultiprocessorCount, dev) != hipSuccess) { grid = -1; return; }
        if (hipFuncSetAttribute((const void*)fwd_kernel, hipFuncAttributeMaxDynamicSharedMemorySize, LDS_BYTES) != hipSuccess) { fprintf(stderr, "kernel_launch: hipFuncSetAttribute failed\n"); grid = -1; return; }
        if (hipOccupancyMaxActiveBlocksPerMultiprocessor(&per_cu, (const void*)fwd_kernel, NWAVES * 64, LDS_BYTES) != hipSuccess || per_cu < 1) { fprintf(stderr, "kernel_launch: occupancy query says %d blocks per CU\n", per_cu); grid = -1; return; }
        (void)hipGetLastError();
        grid = cus & ~7;
    }
    if (grid < 0) return;
    if (hipMemsetAsync((char*)d_ws + WS_CTL, 0, CTL_ZERO_BYTES, stream) != hipSuccess) { fprintf(stderr, "kernel_launch: hipMemsetAsync failed\n"); return; }
    Args a{};
    for (int i = 0; i < 21; ++i) a.in[i] = d_in[i];
    a.out = (float*)d_out; a.ws = (unsigned char*)d_ws;
#if MK_ONE_LAUNCH
    a.ph_lo = 0; a.ph_hi = N_PHASES;
    void* args[] = {&a};
    hipError_t e = hipLaunchCooperativeKernel((const void*)fwd_kernel, dim3(grid), dim3(NWAVES * 64), args, LDS_BYTES, stream);
    if (e != hipSuccess) fprintf(stderr, "kernel_launch: cooperative launch failed: %s (grid %d)\n", hipGetErrorString(e), grid);
#else
    for (int p = 0; p < N_PHASES; ++p) {
        a.ph_lo = p; a.ph_hi = p + 1;
        hipLaunchKernelGGL(fwd_kernel, dim3(grid), dim3(NWAVES * 64), LDS_BYTES, stream, a);
    }
    hipError_t e = hipPeekAtLastError();
    if (e != hipSuccess) fprintf(stderr, "kernel_launch: launch failed: %s\n", hipGetErrorName(e));
#endif
}
```

```cpp
#include <hip/hip_runtime.h>
#include <hip/hip_cooperative_groups.h>
#include <cstdio>
#include <cstdint>
namespace cg = cooperative_groups;
namespace pg8 {
#define PG8_LAS __attribute__((address_space(3)))
typedef unsigned short bf16_t;
typedef short bf16x8 __attribute__((ext_vector_type(8)));
typedef float f32x4 __attribute__((ext_vector_type(4)));
typedef unsigned u32x4 __attribute__((ext_vector_type(4)));
constexpr int BM = 256, BK = 64, HALF = 128, HTB = HALF * BK * 2  , STAGE_BYTES = 8 * HTB, NXCD = 8, WGM = 8;

__host__ __device__ __forceinline__ int lds_byte(int r, int c) { const int st = (r >> 4) * 2 + (c >> 5), rr = r & 15, cc = c & 31, ob = rr * 64 + cc * 2; return st * 1024 + (ob ^ (((ob >> 9) & 1) << 5)); }
__host__ __device__ __forceinline__ void stage_rc(int b, int& R, int& C) { const int st = b / 1024, sb = b % 1024, swz = sb ^ (((sb >> 9) & 1) << 5); R = (st >> 1) * 16 + swz / 64; C = (st & 1) * 32 + (swz % 64) / 2; }
__host__ __device__ __forceinline__ int perm32(int rho) { const int n = rho >> 4, i = rho & 15; return 8 * (i >> 2) + 4 * n + (i & 3); }

struct Unit { int pm, pn; };
struct Gemm { const bf16_t* A; const bf16_t* Bt; int M, N, K; };

struct StaticOrder {
    int nM, nN, nwg, G, c;
    __host__ __device__ void init(int M, int N, int G_, int c_) { nM = M / BM; nN = N / BM; nwg = nM * nN; G = G_; c = c_; }
    __host__ __device__ bool next(int i, Unit& u) const {
        const long L = (long)i * G + c; if (L >= nwg) return false;
        int wgid = (int)L; { const int q = nwg / NXCD, r = nwg % NXCD, xcd = wgid % NXCD, off = wgid / NXCD; wgid = (xcd < r ? xcd * (q + 1) : r * (q + 1) + (xcd - r) * q) + off; }
        const int nig = WGM * nN, gid = wgid / nig, fm = gid * WGM, gsz = (nM - fm) < WGM ? (nM - fm) : WGM;
        u.pm = fm + ((wgid % nig) % gsz); u.pn = (wgid % nig) / gsz; return true;
    }
    __device__ __forceinline__ void a_ready(const Unit&) const {}
    __device__ __forceinline__ void done(const Unit&) const {}
};

__device__ __forceinline__ unsigned cvt_pk_bf16(float lo, float hi) { unsigned r; asm volatile("v_cvt_pk_bf16_f32 %0, %1, %2" : "=v"(r) : "v"(lo), "v"(hi)); return r; }
typedef float f32x2 __attribute__((ext_vector_type(2)));
__device__ __forceinline__ f32x2 gelu_pk(f32x2 v) {
    const f32x2 av = __builtin_elementwise_abs(v), d = av * 0.2316418882f + 1.0f;
    f32x2 t; t.x = __builtin_amdgcn_rcpf(d.x); t.y = __builtin_amdgcn_rcpf(d.y);
    f32x2 q = t * 0.5307027145f + (-0.7265760135f); q = q * t + 0.7107068705f; q = q * t + (-0.142248368f); q = q * t + 0.127414796f; q = q * t;
    const f32x2 s = (v * v) * (-0.72134752044f);
    f32x2 e; e.x = __builtin_amdgcn_exp2f(s.x); e.y = __builtin_amdgcn_exp2f(s.y);
    const f32x2 m = v * (q * e), r = v - m;
    f32x2 o; o.x = v.x < 0.f ? m.x : r.x; o.y = v.y < 0.f ? m.y : r.y; return o;
}

template <int ACT  > struct EpiBf16 {
    static constexpr bool PERM = true, AFTER_DRAIN = false; static_assert(ACT == 0 || ACT == 1, "EpiBf16: ACT is 0 (none) or 1 (gelu_pk)");
    bf16_t* O; int ldc; const float* bias; int split_cols; size_t split_stride; float scale0;
    __device__ __forceinline__ void operator()(const f32x4 (&acc)[2][2][4][2], const Unit& u, int wr, int wc, int fr, int fq) const {
        const int row0 = u.pm * BM + wr * 64 + fr; int colt = u.pn * BM; bf16_t* base = O;
        float sc = 1.f; if (split_cols) { const int t = colt / split_cols; base += (size_t)t * split_stride; colt -= t * split_cols; if (t == 0) sc = scale0; }
        const int col0 = colt + wc * 32 + 8 * fq, bcol0 = u.pn * BM + wc * 32 + 8 * fq;
        f32x4 bv[2][2];
#pragma unroll
        for (int bj = 0; bj < 2; ++bj)
#pragma unroll
            for (int n = 0; n < 2; ++n) bv[bj][n] = bias ? *(const f32x4*)(bias + bcol0 + bj * HALF + 4 * n) : (f32x4){0.f, 0.f, 0.f, 0.f};
#pragma unroll
        for (int ai = 0; ai < 2; ++ai)
#pragma unroll
            for (int m = 0; m < 4; ++m) { bf16_t* rowp = base + (size_t)(row0 + ai * HALF + m * 16) * ldc + col0;
#pragma unroll
                for (int bj = 0; bj < 2; ++bj) { f32x4 v0 = acc[ai][bj][m][0] + bv[bj][0], v1 = acc[ai][bj][m][1] + bv[bj][1];
                    if (ACT == 1) { f32x2 a = gelu_pk((f32x2){v0[0], v0[1]}), b = gelu_pk((f32x2){v0[2], v0[3]}), c = gelu_pk((f32x2){v1[0], v1[1]}), d = gelu_pk((f32x2){v1[2], v1[3]});
                        v0 = (f32x4){a.x, a.y, b.x, b.y}; v1 = (f32x4){c.x, c.y, d.x, d.y}; }
                    v0 = v0 * sc; v1 = v1 * sc; u32x4 w; w.x = cvt_pk_bf16(v0[0], v0[1]); w.y = cvt_pk_bf16(v0[2], v0[3]); w.z = cvt_pk_bf16(v1[0], v1[1]); w.w = cvt_pk_bf16(v1[2], v1[3]);
                    *(u32x4*)(rowp + bj * HALF) = w; } }
    }
};
__device__ __forceinline__ int fresh_lane() { int l; asm volatile("v_mbcnt_lo_u32_b32 %0, -1, 0\n\tv_mbcnt_hi_u32_b32 %0, -1, %0" : "=v"(l)); return l; }
__device__ __forceinline__ float bflo(unsigned w) { return __builtin_bit_cast(float, w << 16); }
__device__ __forceinline__ float bfhi(unsigned w) { return __builtin_bit_cast(float, w & 0xffff0000u); }
__device__ __forceinline__ float sigmoid_f(float x) { return __builtin_amdgcn_rcpf(1.0f + __builtin_amdgcn_exp2f(-1.4426950408889634f * x)); }

struct EpiIn {
    static constexpr bool PERM = true, AFTER_DRAIN = false;
    bf16_t* gates; const float* gbias; bf16_t* cq; bf16_t* ckv; bf16_t* kpep; const float* ssqn; float* ssqc; const int* pos;
    __device__ __forceinline__ void operator()(const f32x4 (&acc)[2][2][4][2], const Unit& u, int wr, int wc, int fr, int fq) const {
        const int row0 = u.pm * BM + wr * 64 + fr;
        float rs[2][4];
#pragma unroll
        for (int ai = 0; ai < 2; ++ai)
#pragma unroll
            for (int m = 0; m < 4; ++m) { const f32x4* sp = (const f32x4*)(ssqn + (size_t)(row0 + ai * HALF + m * 16) * 8); const f32x4 a = sp[0], b = sp[1];
                rs[ai][m] = 1.0f / sqrtf(((a[0] + a[1]) + (a[2] + a[3]) + (b[0] + b[1]) + (b[2] + b[3])) * (1.0f / 1024.0f) + 1e-6f); }
#pragma unroll
        for (int bj = 0; bj < 2; ++bj) {
            const int colw = u.pn * BM + bj * HALF + wc * 32;
            bf16_t* dst; int ld; bool gate = false;
            if (colw < 2048) { dst = gates + colw; ld = 2048; gate = true; }
            else { const int pc = colw - 2048;
                if (pc < 384) { dst = cq + pc; ld = 384; }
                else if (pc < 640) { dst = ckv + (pc - 384); ld = 256; }
                else if (pc < 1184) { dst = kpep + (pc - 640); ld = 544; }
                else continue; }
            dst += 8 * fq;
            f32x4 b0 = (f32x4){0.f, 0.f, 0.f, 0.f}, b1 = b0;
            if (gate) { b0 = *(const f32x4*)(gbias + colw + 8 * fq); b1 = *(const f32x4*)(gbias + colw + 8 * fq + 4); }
#pragma unroll
            for (int ai = 0; ai < 2; ++ai)
#pragma unroll
                for (int m = 0; m < 4; ++m) {
                    f32x4 v0 = acc[ai][bj][m][0] * rs[ai][m] + b0, v1 = acc[ai][bj][m][1] * rs[ai][m] + b1;
                    if (gate) {
#pragma unroll
                        for (int j = 0; j < 4; ++j) { v0[j] = sigmoid_f(v0[j]); v1[j] = sigmoid_f(v1[j]); }
                    }
                    if (gate) {
                        typedef unsigned u32x2g __attribute__((ext_vector_type(2)));
                        u32x2g w;
                        w.x = (unsigned)(v0[0] * 255.0f + 0.5f) | ((unsigned)(v0[1] * 255.0f + 0.5f) << 8) | ((unsigned)(v0[2] * 255.0f + 0.5f) << 16) | ((unsigned)(v0[3] * 255.0f + 0.5f) << 24);
                        w.y = (unsigned)(v1[0] * 255.0f + 0.5f) | ((unsigned)(v1[1] * 255.0f + 0.5f) << 8) | ((unsigned)(v1[2] * 255.0f + 0.5f) << 16) | ((unsigned)(v1[3] * 255.0f + 0.5f) << 24);
                        *(u32x2g*)((unsigned char*)gates + (size_t)(row0 + ai * HALF + m * 16) * 2048 + colw + 8 * fq) = w;
                    } else {
                    const int pc = colw - 2048;
                    if (pc <= 640) {
                        float s = (v0[0] * v0[0] + v0[1] * v0[1]) + (v0[2] * v0[2] + v0[3] * v0[3]) + (v1[0] * v1[0] + v1[1] * v1[1]) + (v1[2] * v1[2] + v1[3] * v1[3]);
                        s += __int_as_float(__builtin_amdgcn_ds_swizzle(__float_as_int(s), 0x401F));
                    { unsigned r0_ = __float_as_uint(s), r1_ = r0_;
#if __has_builtin(__builtin_amdgcn_permlane32_swap)
                      auto r_ = __builtin_amdgcn_permlane32_swap(r0_, r1_, false, false); r0_ = r_[0]; r1_ = r_[1];
#else
                      asm volatile("v_permlane32_swap_b32 %0, %1" : "+v"(r0_), "+v"(r1_));
#endif
                      asm volatile("" : "+v"(r0_), "+v"(r1_));
                      s = __uint_as_float(r0_) + __uint_as_float(r1_); }
                        if (fq == 0) ssqc[(size_t)(row0 + ai * HALF + m * 16) * 24 + (pc >> 5)] = s;
                    }
                    if (pc == 640) {
                        const float p = (float)pos[row0 + ai * HALF + m * 16];
                        float x[8] = {v0[0], v0[1], v0[2], v0[3], v1[0], v1[1], v1[2], v1[3]};
#pragma unroll
                        for (int e8 = 0; e8 < 8; ++e8) {
                            const float other = __shfl_xor(x[e8], 32);
                            const float ang = p * __builtin_amdgcn_exp2f(-(float)(8 * (fq & 1) + e8) * 0.8304820237218406f);
                            const float nn = rintf(ang * 0.15915494309189535f);
                            float r = fmaf(-nn, 6.28318548202514648f, ang); r = fmaf(-nn, -1.7484556e-7f, r); r *= 0.15915494309189535f;
                            const float sn = __builtin_amdgcn_sinf(r), cs = __builtin_amdgcn_cosf(r);
                            x[e8] = (fq < 2) ? x[e8] * cs - other * sn : other * sn + x[e8] * cs;
                        }
                        v0 = (f32x4){x[0], x[1], x[2], x[3]}; v1 = (f32x4){x[4], x[5], x[6], x[7]};
                    }
                    u32x4 w; w.x = cvt_pk_bf16(v0[0], v0[1]); w.y = cvt_pk_bf16(v0[2], v0[3]); w.z = cvt_pk_bf16(v1[0], v1[1]); w.w = cvt_pk_bf16(v1[2], v1[3]);
                    *(u32x4*)(dst + (size_t)(row0 + ai * HALF + m * 16) * ld) = w; }
                }
        }
    }
};

struct EpiKV {
    static constexpr bool PERM = true, AFTER_DRAIN = false;
    bf16_t* K; bf16_t* V; const bf16_t* kpep; const float* ssqc; const float* gk;
    __device__ __forceinline__ void operator()(const f32x4 (&acc)[2][2][4][2], const Unit& u, int wr, int wc, int fr, int fq) const {
        { const int ln = fresh_lane(); fr = ln & 15; fq = ln >> 4; }
        const int row0 = u.pm * BM + wr * 64 + fr, head = 2 * u.pn + (wc >> 1);
        const bool isk = (wc & 1) == 0;
#pragma unroll
        for (int ai = 0; ai < 2; ++ai)
#pragma unroll
            for (int m = 0; m < 4; ++m) {
                __builtin_amdgcn_sched_barrier(0);
                const size_t row = (size_t)(row0 + ai * HALF + m * 16);
                const f32x4* sp = (const f32x4*)(ssqc + row * 24);
                const f32x4 sa = sp[3], sb = sp[4];
                const float rkv = 16.0f * __builtin_amdgcn_rsqf(((sa[0] + sa[1]) + (sa[2] + sa[3]) + (sb[0] + sb[1]) + (sb[2] + sb[3])) + 256e-6f);
                const f32x4 a0 = acc[ai][0][m][0], a1 = acc[ai][0][m][1], b0 = acc[ai][1][m][0], b1 = acc[ai][1][m][1];
                if (isk) {
                    float s = (a0[0] * a0[0] + a0[1] * a0[1]) + (a0[2] * a0[2] + a0[3] * a0[3]) + (a1[0] * a1[0] + a1[1] * a1[1]) + (a1[2] * a1[2] + a1[3] * a1[3])
                            + (b0[0] * b0[0] + b0[1] * b0[1]) + (b0[2] * b0[2] + b0[3] * b0[3]) + (b1[0] * b1[0] + b1[1] * b1[1]) + (b1[2] * b1[2] + b1[3] * b1[3]);
                    s += __int_as_float(__builtin_amdgcn_ds_swizzle(__float_as_int(s), 0x401F));
                    { unsigned r0_ = __float_as_uint(s), r1_ = r0_;
#if __has_builtin(__builtin_amdgcn_permlane32_swap)
                      auto r_ = __builtin_amdgcn_permlane32_swap(r0_, r1_, false, false); r0_ = r_[0]; r1_ = r_[1];
#else
                      asm volatile("v_permlane32_swap_b32 %0, %1" : "+v"(r0_), "+v"(r1_));
#endif
                      asm volatile("" : "+v"(r0_), "+v"(r1_));
                      s = __uint_as_float(r0_) + __uint_as_float(r1_); }
                    const float sspe = ssqc[row * 24 + 20];
                    const float rn = 9.797958971f * __builtin_amdgcn_rsqf((rkv * rkv * s + sspe) + 96e-6f), sc = rkv * rn;
                    bf16_t* kp = K + (row * 8 + head) * 96 + 8 * fq;
                    { asm volatile("" ::: "memory"); const f32x4 ga = *(const f32x4*)(gk + 8 * fq), gb = *(const f32x4*)(gk + 8 * fq + 4);
                      u32x4 w; w.x = cvt_pk_bf16(a0[0] * sc * ga[0], a0[1] * sc * ga[1]); w.y = cvt_pk_bf16(a0[2] * sc * ga[2], a0[3] * sc * ga[3]);
                      w.z = cvt_pk_bf16(a1[0] * sc * gb[0], a1[1] * sc * gb[1]); w.w = cvt_pk_bf16(a1[2] * sc * gb[2], a1[3] * sc * gb[3]);
                      *(u32x4*)(kp) = w; }
                    { asm volatile("" ::: "memory"); const f32x4 ga = *(const f32x4*)(gk + 32 + 8 * fq), gb = *(const f32x4*)(gk + 32 + 8 * fq + 4);
                      u32x4 w; w.x = cvt_pk_bf16(b0[0] * sc * ga[0], b0[1] * sc * ga[1]); w.y = cvt_pk_bf16(b0[2] * sc * ga[2], b0[3] * sc * ga[3]);
                      w.z = cvt_pk_bf16(b1[0] * sc * gb[0], b1[1] * sc * gb[1]); w.w = cvt_pk_bf16(b1[2] * sc * gb[2], b1[3] * sc * gb[3]);
                      *(u32x4*)(kp + 32) = w; }
                    { asm volatile("" ::: "memory"); const f32x4 ga = *(const f32x4*)(gk + 64 + 8 * fq), gb = *(const f32x4*)(gk + 64 + 8 * fq + 4);
                      const u32x4 pe = *(const u32x4*)(kpep + row * 544 + 8 * fq);
                      u32x4 w; w.x = cvt_pk_bf16(bflo(pe.x) * rn * ga[0], bfhi(pe.x) * rn * ga[1]); w.y = cvt_pk_bf16(bflo(pe.y) * rn * ga[2], bfhi(pe.y) * rn * ga[3]);
                      w.z = cvt_pk_bf16(bflo(pe.z) * rn * gb[0], bfhi(pe.z) * rn * gb[1]); w.w = cvt_pk_bf16(bflo(pe.w) * rn * gb[2], bfhi(pe.w) * rn * gb[3]);
                      *(u32x4*)(kp + 64) = w; }
                } else {
                    bf16_t* vp = V + (row * 8 + head) * 64 + 8 * fq;
                    u32x4 w; w.x = cvt_pk_bf16(a0[0] * rkv, a0[1] * rkv); w.y = cvt_pk_bf16(a0[2] * rkv, a0[3] * rkv); w.z = cvt_pk_bf16(a1[0] * rkv, a1[1] * rkv); w.w = cvt_pk_bf16(a1[2] * rkv, a1[3] * rkv);
                    *(u32x4*)(vp) = w;
                    w.x = cvt_pk_bf16(b0[0] * rkv, b0[1] * rkv); w.y = cvt_pk_bf16(b0[2] * rkv, b0[3] * rkv); w.z = cvt_pk_bf16(b1[0] * rkv, b1[1] * rkv); w.w = cvt_pk_bf16(b1[2] * rkv, b1[3] * rkv);
                    *(u32x4*)(vp + 32) = w;
                }
            }
    }
};

struct EpiMix {
    static constexpr bool PERM = true, AFTER_DRAIN = false;
    const bf16_t* a; const bf16_t* gates; bf16_t* mix;
    __device__ __forceinline__ void operator()(const f32x4 (&acc)[2][2][4][2], const Unit& u, int wr, int wc, int fr, int fq) const {
        const int row0 = u.pm * BM + wr * 64 + fr, col0 = u.pn * BM + wc * 32 + 8 * fq;
#pragma unroll
        for (int ai = 0; ai < 2; ++ai)
#pragma unroll
            for (int m = 0; m < 4; ++m) {
                const size_t row = (size_t)(row0 + ai * HALF + m * 16);
#pragma unroll
                for (int bj = 0; bj < 2; ++bj) {
                    const int c = col0 + bj * HALF;
                    const u32x4 av = *(const u32x4*)(a + row * 1024 + c);
                    typedef unsigned u32x2g __attribute__((ext_vector_type(2)));
                    const u32x2g g0 = *(const u32x2g*)((const unsigned char*)gates + row * 2048 + c);
                    const u32x2g g1 = *(const u32x2g*)((const unsigned char*)gates + row * 2048 + 1024 + c);
                    const float k = 1.0f / 255.0f;
                    const f32x4 v0 = acc[ai][bj][m][0] * k, v1 = acc[ai][bj][m][1] * k;
#define GB(W, B) ((float)(((W) >> (8 * (B))) & 0xffu))
                    u32x4 w;
                    w.x = cvt_pk_bf16(GB(g0.x, 0) * k * bflo(av.x) + GB(g1.x, 0) * v0[0], GB(g0.x, 1) * k * bfhi(av.x) + GB(g1.x, 1) * v0[1]);
                    w.y = cvt_pk_bf16(GB(g0.x, 2) * k * bflo(av.y) + GB(g1.x, 2) * v0[2], GB(g0.x, 3) * k * bfhi(av.y) + GB(g1.x, 3) * v0[3]);
                    w.z = cvt_pk_bf16(GB(g0.y, 0) * k * bflo(av.z) + GB(g1.y, 0) * v1[0], GB(g0.y, 1) * k * bfhi(av.z) + GB(g1.y, 1) * v1[1]);
                    w.w = cvt_pk_bf16(GB(g0.y, 2) * k * bflo(av.w) + GB(g1.y, 2) * v1[2], GB(g0.y, 3) * k * bfhi(av.w) + GB(g1.y, 3) * v1[3]);
#undef GB
                    *(u32x4*)(mix + row * 1024 + c) = w;
                }
            }
    }
};

struct EpiRes {
    static constexpr bool PERM = false, AFTER_DRAIN = false;
    const bf16_t* xin; bf16_t* xout; float* ssq;
    __device__ __forceinline__ void operator()(const f32x4 (&acc)[2][2][4][2], const Unit& u, int wr, int wc, int fr, int fq) const {
        const int row0 = u.pm * BM + wr * 64 + fr, col0 = u.pn * BM + wc * 32 + 4 * fq;
        typedef unsigned u32x2 __attribute__((ext_vector_type(2)));
#pragma unroll
        for (int ai = 0; ai < 2; ++ai)
#pragma unroll
            for (int m = 0; m < 4; ++m) {
                const size_t row = (size_t)(row0 + ai * HALF + m * 16); float s = 0.f;
#pragma unroll
                for (int bj = 0; bj < 2; ++bj)
#pragma unroll
                    for (int n = 0; n < 2; ++n) {
                        const size_t off = row * 1024 + col0 + bj * HALF + n * 16;
                        const u32x2 xi = *(const u32x2*)(xin + off);
                        const f32x4 xo = (f32x4){bflo(xi.x), bfhi(xi.x), bflo(xi.y), bfhi(xi.y)} + acc[ai][bj][m][n];
                        s += (xo[0] * xo[0] + xo[1] * xo[1]) + (xo[2] * xo[2] + xo[3] * xo[3]);
                        u32x2 w; w.x = cvt_pk_bf16(xo[0], xo[1]); w.y = cvt_pk_bf16(xo[2], xo[3]);
                        *(u32x2*)(xout + off) = w;
                    }
                s += __int_as_float(__builtin_amdgcn_ds_swizzle(__float_as_int(s), 0x401F));
                    { unsigned r0_ = __float_as_uint(s), r1_ = r0_;
#if __has_builtin(__builtin_amdgcn_permlane32_swap)
                      auto r_ = __builtin_amdgcn_permlane32_swap(r0_, r1_, false, false); r0_ = r_[0]; r1_ = r_[1];
#else
                      asm volatile("v_permlane32_swap_b32 %0, %1" : "+v"(r0_), "+v"(r1_));
#endif
                      asm volatile("" : "+v"(r0_), "+v"(r1_));
                      s = __uint_as_float(r0_) + __uint_as_float(r1_); }
                if (fq == 0) ssq[row * 16 + u.pn * 4 + wc] = s;
            }
    }
};
template <class Epi, class Sched, bool ALIGN_EPI = false, bool SP2 = false>
__device__ __forceinline__ void gemm_phase(PG8_LAS unsigned char* lds, const Gemm g, const Sched& S, const Epi& E, const int wave_id) {
    const int wid = wave_id, lane = fresh_lane(), tid = (wid << 6) | lane, wr = wid >> 2, wc = wid & 3, fr = lane & 15, fq = lane >> 4;
    const int K = g.K, nt = K / BK;
    unsigned voffA[2], voffB[2];
#pragma unroll
    for (int i = 0; i < 2; ++i) { int R, C; stage_rc(tid * 16 + i * 8192, R, C); const int Rb = Epi::PERM ? ((R & ~31) + perm32(R & 31)) : R;
        voffA[i] = (unsigned)(R * K + C) * 2u; voffB[i] = (unsigned)(Rb * K + C) * 2u; }
    const size_t kstep = (size_t)(BK * 2);
    const size_t hstep = (size_t)HALF * K * 2;
    const size_t tstep = 2 * hstep;
    const unsigned ldsw = (unsigned)wid * 1024u;
    const int aoff = lds_byte(wr * 64 + fr, fq * 8), boff = lds_byte(wc * 32 + fr, fq * 8);
#define PG8_SA(b, h) (((b) * 2 + (h)) * HTB)
#define PG8_SB(b, h) ((4 + (b) * 2 + (h)) * HTB)
#define PG8_STAGE(bufoff, gbase, voff) do { _Pragma("unroll") for (int _i = 0; _i < 2; ++_i) \
        __builtin_amdgcn_global_load_lds((const unsigned*)((const char*)(gbase) + (voff)[_i]), (PG8_LAS unsigned*)(lds + (bufoff) + ldsw + _i * 8192), 16, 0, 0); } while (0)
#define PG8_LDA(dst, b, h) do { _Pragma("unroll") for (int m = 0; m < 4; ++m) _Pragma("unroll") for (int k = 0; k < 2; ++k) dst[m][k] = *(const PG8_LAS bf16x8*)(lds + PG8_SA(b, h) + aoff + m * 2048 + k * 1024); } while (0)
#define PG8_LDB(dst, b, h) do { _Pragma("unroll") for (int n = 0; n < 2; ++n) _Pragma("unroll") for (int k = 0; k < 2; ++k) dst[n][k] = *(const PG8_LAS bf16x8*)(lds + PG8_SB(b, h) + boff + n * 2048 + k * 1024); } while (0)
#define PG8_MMA(ai, bj, At, Bt) do { __builtin_amdgcn_s_setprio(1); _Pragma("unroll") for (int m = 0; m < 4; ++m) _Pragma("unroll") for (int n = 0; n < 2; ++n) _Pragma("unroll") for (int k = 0; k < 2; ++k) \
        acc[ai][bj][m][n] = __builtin_amdgcn_mfma_f32_16x16x32_bf16(Bt[n][k], At[m][k], acc[ai][bj][m][n], 0, 0, 0); __builtin_amdgcn_s_setprio(0); } while (0)
#define PG8_WAIT_V(n) asm volatile("s_waitcnt vmcnt(" #n ")" ::: "memory")
#define PG8_WAIT_L(n) asm volatile("s_waitcnt lgkmcnt(" #n ")" ::: "memory")
#define PG8_BAR __builtin_amdgcn_s_barrier()
#define PG8_SCHED __builtin_amdgcn_sched_barrier(0)
    Unit cur, nxt; int ui = 0;
    if (!S.next(0, cur)) return;
    f32x4 acc[2][2][4][2];
#pragma unroll
    for (int a = 0; a < 2; ++a)
#pragma unroll
        for (int b = 0; b < 2; ++b)
#pragma unroll
            for (int m = 0; m < 4; ++m)
#pragma unroll
                for (int n = 0; n < 2; ++n) acc[a][b][m][n] = (f32x4){0.f, 0.f, 0.f, 0.f};
    bf16x8 At[4][2], B0[2][2], B1[2][2];
    const char* cA = (const char*)g.A + (size_t)cur.pm * tstep; const char* cB = (const char*)g.Bt + (size_t)cur.pn * tstep;
    S.a_ready(cur);
    if constexpr (SP2) {
        PG8_STAGE(PG8_SB(0, 0), cB, voffB); PG8_STAGE(PG8_SB(0, 1), cB + hstep, voffB); PG8_STAGE(PG8_SA(0, 0), cA, voffA); PG8_STAGE(PG8_SA(0, 1), cA + hstep, voffA);
        if (wr == 1) PG8_BAR;
        PG8_WAIT_V(2); PG8_BAR;
        PG8_STAGE(PG8_SB(1, 0), cB + kstep, voffB); PG8_STAGE(PG8_SA(1, 0), cA + kstep, voffA); PG8_STAGE(PG8_SB(1, 1), cB + hstep + kstep, voffB);
        PG8_WAIT_V(6); PG8_BAR;
    } else {
        PG8_STAGE(PG8_SB(0, 0), cB, voffB); PG8_STAGE(PG8_SA(0, 0), cA, voffA); PG8_STAGE(PG8_SB(0, 1), cB + hstep, voffB); PG8_STAGE(PG8_SA(0, 1), cA + hstep, voffA);
        if (wr == 1) PG8_BAR;
        PG8_WAIT_V(4); PG8_BAR;
        PG8_STAGE(PG8_SB(1, 0), cB + kstep, voffB); PG8_STAGE(PG8_SA(1, 0), cA + kstep, voffA); PG8_STAGE(PG8_SB(1, 1), cB + hstep + kstep, voffB);
        PG8_WAIT_V(6); PG8_BAR;
    }
    for (;;) {
        const bool has_next = S.next(ui + 1, nxt);
        const char* nA = has_next ? (const char*)g.A + (size_t)nxt.pm * tstep : cA; const char* nB = has_next ? (const char*)g.Bt + (size_t)nxt.pn * tstep : cB;
        for (int t = 0; t < nt; t += 2) {
            const bool last = (t == nt - 2);
            const char* a1 = cA + (size_t)(t + 1) * kstep;
            const char* a2 = last ? nA : cA + (size_t)(t + 2) * kstep; const char* b2 = last ? nB : cB + (size_t)(t + 2) * kstep;
            const char* a3 = a2 + kstep; const char* b3 = b2 + kstep;
            if (last && has_next) S.a_ready(nxt);
            if constexpr (SP2) {
            PG8_LDB(B0, 0, 0); PG8_LDB(B1, 0, 1); PG8_SCHED; PG8_LDA(At, 0, 0); PG8_STAGE(PG8_SA(1, 1), a1 + hstep, voffA);
            PG8_WAIT_V(8); PG8_WAIT_L(0); PG8_BAR; PG8_MMA(0, 0, At, B0); PG8_MMA(0, 1, At, B1); PG8_BAR; PG8_SCHED;
            PG8_LDA(At, 0, 1); PG8_STAGE(PG8_SB(0, 0), b2, voffB); PG8_STAGE(PG8_SB(0, 1), b2 + hstep, voffB); PG8_STAGE(PG8_SA(0, 0), a2, voffA);
            PG8_WAIT_V(8); PG8_WAIT_L(0); PG8_BAR; PG8_MMA(1, 0, At, B0); PG8_MMA(1, 1, At, B1); PG8_BAR; PG8_SCHED;
            PG8_LDB(B0, 1, 0); PG8_LDB(B1, 1, 1); PG8_SCHED; PG8_LDA(At, 1, 0); PG8_STAGE(PG8_SA(0, 1), a2 + hstep, voffA);
            PG8_WAIT_V(8); PG8_WAIT_L(0); PG8_BAR; PG8_MMA(0, 0, At, B0); PG8_MMA(0, 1, At, B1); PG8_BAR; PG8_SCHED;
            PG8_LDA(At, 1, 1); PG8_STAGE(PG8_SB(1, 0), b3, voffB); PG8_STAGE(PG8_SB(1, 1), b3 + hstep, voffB); PG8_STAGE(PG8_SA(1, 0), a3, voffA);
            PG8_WAIT_V(8); PG8_WAIT_L(0); PG8_BAR; PG8_MMA(1, 0, At, B0); PG8_MMA(1, 1, At, B1); PG8_BAR; PG8_SCHED;
            } else {
            PG8_LDB(B0, 0, 0); PG8_SCHED; PG8_LDA(At, 0, 0); PG8_STAGE(PG8_SA(1, 1), a1 + hstep, voffA);
            PG8_WAIT_L(8); PG8_BAR; PG8_WAIT_L(0); PG8_MMA(0, 0, At, B0); PG8_BAR; PG8_SCHED;
            PG8_LDB(B1, 0, 1); PG8_STAGE(PG8_SB(0, 0), b2, voffB);
            PG8_BAR; PG8_WAIT_L(0); PG8_MMA(0, 1, At, B1); PG8_BAR;
            PG8_LDA(At, 0, 1); PG8_STAGE(PG8_SA(0, 0), a2, voffA);
            PG8_BAR; PG8_WAIT_L(0); PG8_MMA(1, 0, At, B0); PG8_BAR; PG8_SCHED;
            PG8_STAGE(PG8_SB(0, 1), b2 + hstep, voffB);
            PG8_WAIT_V(6); PG8_BAR; PG8_MMA(1, 1, At, B1); PG8_BAR;
            PG8_LDB(B0, 1, 0); PG8_SCHED; PG8_LDA(At, 1, 0); PG8_STAGE(PG8_SA(0, 1), a2 + hstep, voffA);
            PG8_WAIT_L(8); PG8_BAR; PG8_WAIT_L(0); PG8_MMA(0, 0, At, B0); PG8_BAR; PG8_SCHED;
            PG8_LDB(B1, 1, 1); PG8_STAGE(PG8_SB(1, 0), b3, voffB);
            PG8_BAR; PG8_WAIT_L(0); PG8_MMA(0, 1, At, B1); PG8_BAR;
            PG8_LDA(At, 1, 1); PG8_STAGE(PG8_SA(1, 0), a3, voffA);
            PG8_BAR; PG8_WAIT_L(0); PG8_MMA(1, 0, At, B0); PG8_BAR; PG8_SCHED;
            PG8_STAGE(PG8_SB(1, 1), b3 + hstep, voffB);
            PG8_WAIT_V(6); PG8_BAR; PG8_MMA(1, 1, At, B1); PG8_BAR;
            }
        }
        if constexpr (ALIGN_EPI) { if (wr == 0) PG8_BAR; }
        if constexpr (!Epi::AFTER_DRAIN) { E(acc, cur, wr, wc, fr, fq); S.done(cur); }
        if (!has_next) break;
#pragma unroll
        for (int a = 0; a < 2; ++a)
#pragma unroll
            for (int b = 0; b < 2; ++b)
#pragma unroll
                for (int m = 0; m < 4; ++m)
#pragma unroll
                    for (int n = 0; n < 2; ++n) acc[a][b][m][n] = (f32x4){0.f, 0.f, 0.f, 0.f};
        cur = nxt; cA = nA; cB = nB; ++ui;
        if constexpr (ALIGN_EPI) { if (wr == 1) PG8_BAR; }
    }
    PG8_WAIT_V(0);
    if constexpr (!ALIGN_EPI) { if (wr == 0) PG8_BAR; }
    PG8_BAR;
    if constexpr (Epi::AFTER_DRAIN) { E.fused(acc, cur, wr, wc, fr, fq, lds, wid, lane); S.done(cur); }
#undef PG8_SA
#undef PG8_SB
#undef PG8_STAGE
#undef PG8_LDA
#undef PG8_LDB
#undef PG8_MMA
#undef PG8_WAIT_V
#undef PG8_WAIT_L
#undef PG8_BAR
#undef PG8_SCHED
}
}
namespace att {
typedef unsigned short bf16;
using bf16x8 = __attribute__((ext_vector_type(8))) short;
using s16x4  = __attribute__((ext_vector_type(4))) short;
using f32x16 = __attribute__((ext_vector_type(16))) float;
using u32x4  = __attribute__((ext_vector_type(4))) unsigned;
constexpr int   DQ = 96, DV = 64, NW = 8, QBLK = 32, KVBLK = 64;
constexpr int   ND0 = DQ / 16;
constexpr int   NDV = DV / 32;
constexpr float SCALE = 0.10206207261596575f;
constexpr float THR = 8.f;
constexpr int   LDQ = 768, LDK = 768, LDV = 512, LDO = 512;
constexpr size_t SHM_V = KVBLK * 128 * 2, SHM_K = KVBLK * 128 * 2, SHM_ATTN = 2 * SHM_V + 2 * SHM_K + NW * 64 * 4;
#define KSWZ(row, colB) ((row) * 256 + ((colB) ^ (((row) & 7) << 4)))
#define SBAR() __builtin_amdgcn_sched_barrier(0)
__device__ __forceinline__ int crow(int r, int hi) { return (r & 3) + 8 * (r >> 2) + 4 * hi; }
__device__ __forceinline__ unsigned cvtpk(float lo, float hi) { unsigned r; asm volatile("v_cvt_pk_bf16_f32 %0, %1, %2" : "=v"(r) : "v"(lo), "v"(hi)); return r; }

__device__ __forceinline__ void partialSM(f32x16& p0, f32x16& p1, float& m_reg, float& mn, float& alpha) {
  constexpr float C = SCALE * 1.4426950408889634f;
  float pmax = p0[0];
#pragma unroll
  for (int r = 1; r < 16; ++r) pmax = fmaxf(pmax, p0[r]);
#pragma unroll
  for (int r = 0; r < 16; ++r) pmax = fmaxf(pmax, p1[r]);
  { auto rr = __builtin_amdgcn_permlane32_swap(__float_as_uint(pmax), __float_as_uint(pmax), false, false);
    pmax = fmaxf(__uint_as_float(rr[0]), __uint_as_float(rr[1])); }
  if (__builtin_expect(__all(pmax - m_reg <= THR / SCALE), 1)) { mn = m_reg; alpha = 1.f; }
  else { mn = fmaxf(m_reg, pmax); alpha = __builtin_amdgcn_exp2f((m_reg - mn) * C); m_reg = mn; }
  float mnC = -mn * C;
#pragma unroll
  for (int r = 0; r < 16; ++r) p0[r] = fmaf(p0[r], C, mnC);
#pragma unroll
  for (int r = 0; r < 16; ++r) p1[r] = fmaf(p1[r], C, mnC);
#pragma unroll
  for (int r = 0; r < 16; ++r) p0[r] = __builtin_amdgcn_exp2f(p0[r]);
}
__device__ __forceinline__ void finishSM(f32x16& p0, f32x16& p1, float alpha, float& l_reg, bf16x8& pa0, bf16x8& pa1, bf16x8& pa2, bf16x8& pa3) {
#pragma unroll
  for (int r = 0; r < 16; ++r) p1[r] = __builtin_amdgcn_exp2f(p1[r]);
  float ps = 0;
#pragma unroll
  for (int r = 0; r < 16; ++r) ps += p0[r];
#pragma unroll
  for (int r = 0; r < 16; ++r) ps += p1[r];
  { auto rr = __builtin_amdgcn_permlane32_swap(__float_as_uint(ps), __float_as_uint(ps), false, false);
    ps = __uint_as_float(rr[0]) + __uint_as_float(rr[1]); }
  l_reg = l_reg * alpha + ps;
#define PK4(P, BASE, OUT) do { unsigned a0 = cvtpk(P[BASE + 0], P[BASE + 1]), a1 = cvtpk(P[BASE + 2], P[BASE + 3]);   \
    unsigned b0 = cvtpk(P[BASE + 4], P[BASE + 5]), b1 = cvtpk(P[BASE + 6], P[BASE + 7]);                              \
    auto r0 = __builtin_amdgcn_permlane32_swap(a0, b0, false, false); auto r1 = __builtin_amdgcn_permlane32_swap(a1, b1, false, false); \
    u32x4 w = {r0[0], r1[0], r0[1], r1[1]}; OUT = *reinterpret_cast<bf16x8*>(&w); } while (0)
  PK4(p0, 0, pa0); PK4(p0, 8, pa1); PK4(p1, 0, pa2); PK4(p1, 8, pa3);
#undef PK4
}
__device__ __forceinline__ void qkt(f32x16& p0, f32x16& p1, const bf16* Ks, const bf16x8* qr, int r32, int hi) {
  p0 = f32x16{}; p1 = f32x16{};
#pragma unroll
  for (int d0 = 0; d0 < ND0; ++d0) { int cb = (d0 * 16 + hi * 8) * 2;
    bf16x8 b0 = *reinterpret_cast<const bf16x8*>((const char*)Ks + KSWZ(r32, cb));
    bf16x8 b1 = *reinterpret_cast<const bf16x8*>((const char*)Ks + KSWZ(32 + r32, cb));
    p0 = __builtin_amdgcn_mfma_f32_32x32x16_bf16(b0, qr[d0], p0, 0, 0, 0);
    p1 = __builtin_amdgcn_mfma_f32_32x32x16_bf16(b1, qr[d0], p1, 0, 0, 0); }
}
__device__ __forceinline__ int v_st(int k, int c) { const int kk = (k & ~0xC) | ((k & 4) << 1) | ((k & 8) >> 1); return ((kk >> 3) * 4 + (c >> 5)) * 512 + ((kk & 7) * 32 + (c & 31)) * 2; }
__device__ __forceinline__ int v_rd_base(int lane) { return ((lane & 3) << 3) | (((lane >> 2) & 3) << 6) | (((lane >> 4) & 1) << 5) | (((lane >> 5) & 1) << 8); }
constexpr int v_rd_off(int d0, int ks, int half) { return d0 * 512 + ks * 4096 + half * 2048; }
template <int OFF> __device__ __forceinline__ s16x4 tr_read(int vb) {
  s16x4 r; asm volatile("ds_read_b64_tr_b16 %0, %1 offset:%2" : "=&v"(r) : "v"(vb), "i"(OFF) : "memory"); return r;
}
template <int D0> __device__ __forceinline__ void pv_one(f32x16& od, int vb, bf16x8 pa0, bf16x8 pa1, bf16x8 pa2, bf16x8 pa3) {
  const s16x4 l0 = tr_read<v_rd_off(D0, 0, 0)>(vb), h0 = tr_read<v_rd_off(D0, 0, 1)>(vb), l1 = tr_read<v_rd_off(D0, 1, 0)>(vb), h1 = tr_read<v_rd_off(D0, 1, 1)>(vb);
  const s16x4 l2 = tr_read<v_rd_off(D0, 2, 0)>(vb), h2 = tr_read<v_rd_off(D0, 2, 1)>(vb), l3 = tr_read<v_rd_off(D0, 3, 0)>(vb), h3 = tr_read<v_rd_off(D0, 3, 1)>(vb);
  asm volatile("s_waitcnt lgkmcnt(0)" ::: "memory"); SBAR();
#define PK(L, H) (bf16x8){L[0], L[1], L[2], L[3], H[0], H[1], H[2], H[3]}
  od = __builtin_amdgcn_mfma_f32_32x32x16_bf16(pa0, PK(l0, h0), od, 0, 0, 0);
  od = __builtin_amdgcn_mfma_f32_32x32x16_bf16(pa1, PK(l1, h1), od, 0, 0, 0);
  od = __builtin_amdgcn_mfma_f32_32x32x16_bf16(pa2, PK(l2, h2), od, 0, 0, 0);
  od = __builtin_amdgcn_mfma_f32_32x32x16_bf16(pa3, PK(l3, h3), od, 0, 0, 0);
#undef PK
}
__device__ __forceinline__ void pv_d0(f32x16* o, int vb, bf16x8 pa0, bf16x8 pa1, bf16x8 pa2, bf16x8 pa3) {
  pv_one<0>(o[0], vb, pa0, pa1, pa2, pa3); pv_one<1>(o[1], vb, pa0, pa1, pa2, pa3);
}

__device__ __forceinline__ void attn_dense_body(const bf16* __restrict__ Qb, const bf16* __restrict__ Kh, const bf16* __restrict__ Vh,
                                                bf16* __restrict__ Ob, int seq, char* lds, const int wave_id,
                                                const float* __restrict__ ssq, const int* __restrict__ posp, const float* __restrict__ gq) {
  const int wid = wave_id, lane = pg8::fresh_lane(), tid = (wid << 6) | lane, r32 = lane & 31, hi = lane >> 5;
  bf16* V_lds = (bf16*)lds; bf16* K_lds = (bf16*)(lds + 2 * SHM_V);
  float* ws = (float*)(lds + 2 * SHM_V + 2 * SHM_K) + wid * 64; float* li_l = ws; float* al_l = ws + 32;
  float m_reg = -1e30f, l_reg = 0; f32x16 o[NDV] = {}; bf16x8 qr[ND0];
  const bf16* Qw = Qb + (long)(wid * QBLK + r32) * LDQ + hi * 8;
#pragma unroll
  for (int d0 = 0; d0 < ND0; ++d0) qr[d0] = *reinterpret_cast<const bf16x8*>(Qw + d0 * 16);
  {
    const int rowi = wid * QBLK + r32;
    const pg8::f32x4* sp = (const pg8::f32x4*)(ssq + (long)rowi * 24); const pg8::f32x4 sa = sp[0], sb = sp[1], sc = sp[2];
    const float p = (float)posp[rowi];
    const float rq = __builtin_amdgcn_rsqf(((sa[0] + sa[1]) + (sa[2] + sa[3]) + (sb[0] + sb[1]) + (sb[2] + sb[3]) + (sc[0] + sc[1]) + (sc[2] + sc[3])) * (1.0f / 384.0f) + 1e-6f);
    float xs[ND0][8]; float ss = 0.f;
#pragma unroll
    for (int d0 = 0; d0 < 4; ++d0)
#pragma unroll
      for (int j = 0; j < 8; ++j) { const float x = __uint_as_float((unsigned)(unsigned short)qr[d0][j] << 16) * rq; xs[d0][j] = x; ss += x * x; }
#pragma unroll
    for (int j = 0; j < 8; ++j) {
      const float ang = p * __builtin_amdgcn_exp2f(-(float)(8 * hi + j) * 0.8304820237218406f);
      const float n = rintf(ang * 0.15915494309189535f);
      float r = fmaf(-n, 6.28318548202514648f, ang); r = fmaf(-n, -1.7484556e-7f, r); r *= 0.15915494309189535f;
      const float sn = __builtin_amdgcn_sinf(r), cs = __builtin_amdgcn_cosf(r);
      const float x1 = __uint_as_float((unsigned)(unsigned short)qr[4][j] << 16) * rq, x2 = __uint_as_float((unsigned)(unsigned short)qr[5][j] << 16) * rq;
      const float y1 = x1 * cs - x2 * sn, y2 = x1 * sn + x2 * cs;
      xs[4][j] = y1; xs[5][j] = y2; ss += y1 * y1 + y2 * y2; }
    { unsigned r0_ = __float_as_uint(ss), r1_ = r0_;
      auto r_ = __builtin_amdgcn_permlane32_swap(r0_, r1_, false, false); r0_ = r_[0]; r1_ = r_[1];
      asm volatile("" : "+v"(r0_), "+v"(r1_));
      ss = __uint_as_float(r0_) + __uint_as_float(r1_); }
    const float rn = __builtin_amdgcn_rsqf(ss * (1.0f / 96.0f) + 1e-6f);
#pragma unroll
    for (int d0 = 0; d0 < ND0; ++d0) {
      const pg8::f32x4 ga = *(const pg8::f32x4*)(gq + 16 * d0 + 8 * hi), gb = *(const pg8::f32x4*)(gq + 16 * d0 + 8 * hi + 4);
      u32x4 w; w.x = cvtpk(xs[d0][0] * rn * ga[0], xs[d0][1] * rn * ga[1]); w.y = cvtpk(xs[d0][2] * rn * ga[2], xs[d0][3] * rn * ga[3]);
      w.z = cvtpk(xs[d0][4] * rn * gb[0], xs[d0][5] * rn * gb[1]); w.w = cvtpk(xs[d0][6] * rn * gb[2], xs[d0][7] * rn * gb[3]);
      qr[d0] = *reinterpret_cast<bf16x8*>(&w); } }
  const int kr0 = tid / 12, kc0 = tid - kr0 * 12, kr1 = (512 + tid) / 12, kc1 = (512 + tid) - kr1 * 12, vr0 = tid >> 3, vc0 = tid & 7;
  const int kst0 = KSWZ(kr0, kc0 * 16), kst1 = KSWZ(kr1, kc1 * 16), vst0 = v_st(vr0, vc0 * 8);
  const bool k2 = wid < 4;
  const int vb0 = (int)(uintptr_t)V_lds + v_rd_base(lane);
  struct { bf16x8 vs0, ks0, ks1; } sr_[2];
#define SLOAD(i, k0) do { sr_[i].vs0 = *reinterpret_cast<const bf16x8*>(&Vh[(long)((k0) + vr0) * LDV + vc0 * 8]); \
    sr_[i].ks0 = *reinterpret_cast<const bf16x8*>(&Kh[(long)((k0) + kr0) * LDK + kc0 * 8]); \
    if (k2) sr_[i].ks1 = *reinterpret_cast<const bf16x8*>(&Kh[(long)((k0) + kr1) * LDK + kc1 * 8]); } while (0)
#define SWRITE(b, i) do { *(bf16x8*)((char*)V_lds + (b) * SHM_V + vst0) = sr_[i].vs0;          \
    *(bf16x8*)((char*)K_lds + (b) * SHM_K + kst0) = sr_[i].ks0;                       \
    if (k2) *(bf16x8*)((char*)K_lds + (b) * SHM_K + kst1) = sr_[i].ks1; } while (0)
#define SWAIT() do { if (k2) asm volatile("s_waitcnt vmcnt(3)" ::: "memory"); else asm volatile("s_waitcnt vmcnt(2)" ::: "memory"); } while (0)
#define RESC(a) do { if (__any((a) < 1.f)) { if (hi == 0) al_l[r32] = (a); asm volatile("s_waitcnt lgkmcnt(0)" ::: "memory"); \
    _Pragma("unroll") for (int d = 0; d < NDV; ++d) _Pragma("unroll") for (int r = 0; r < 16; ++r) o[d][r] *= al_l[crow(r, hi)]; } } while (0)
  f32x16 pA0, pA1, pB0, pB1; float mnA, mnB, alA, alB; bf16x8 pa0, pa1, pa2, pa3; const int NT = seq / KVBLK;
  constexpr int SE = 0, SO = 1;
  SLOAD(SE, 0); asm volatile("s_waitcnt vmcnt(0)" ::: "memory"); SWRITE(0, SE); __syncthreads();
  qkt(pA0, pA1, K_lds, qr, r32, hi); partialSM(pA0, pA1, m_reg, mnA, alA);
  SLOAD(SO, KVBLK); if (2 < NT) SLOAD(SE, 2 * KVBLK);
  SWAIT(); SWRITE(1, SO); __syncthreads();
  for (int j = 1; j + 1 < NT; j += 2) {
    SBAR(); qkt(pB0, pB1, (bf16*)((char*)K_lds + SHM_K), qr, r32, hi);
    finishSM(pA0, pA1, alA, l_reg, pa0, pa1, pa2, pa3); SBAR();
    SLOAD(SO, (j + 2) * KVBLK); SBAR();
    pv_d0(o, vb0, pa0, pa1, pa2, pa3); partialSM(pB0, pB1, m_reg, mnB, alB);
    __syncthreads(); SWAIT(); SWRITE(0, SE);
    RESC(alB); __syncthreads();
    SBAR(); qkt(pA0, pA1, K_lds, qr, r32, hi);
    finishSM(pB0, pB1, alB, l_reg, pa0, pa1, pa2, pa3); SBAR();
    if (j + 3 < NT) SLOAD(SE, (j + 3) * KVBLK); SBAR();
    pv_d0(o, vb0 + (int)SHM_V, pa0, pa1, pa2, pa3); partialSM(pA0, pA1, m_reg, mnA, alA);
    __syncthreads(); SWAIT(); SWRITE(1, SO);
    RESC(alA); __syncthreads();
  }
  SBAR(); qkt(pB0, pB1, (bf16*)((char*)K_lds + SHM_K), qr, r32, hi);
  finishSM(pA0, pA1, alA, l_reg, pa0, pa1, pa2, pa3); SBAR();
  pv_d0(o, vb0, pa0, pa1, pa2, pa3); partialSM(pB0, pB1, m_reg, mnB, alB);
  __syncthreads(); RESC(alB);
  finishSM(pB0, pB1, alB, l_reg, pa0, pa1, pa2, pa3); SBAR();
  pv_d0(o, vb0 + (int)SHM_V, pa0, pa1, pa2, pa3);
  if (hi == 0) li_l[r32] = l_reg; asm volatile("s_waitcnt lgkmcnt(0)" ::: "memory");
  float rli[16];
#pragma unroll
  for (int r = 0; r < 16; ++r) rli[r] = __builtin_amdgcn_rcpf(li_l[crow(r, hi)]);
  bf16* Ow = Ob + (long)(wid * QBLK) * LDO;
#pragma unroll
  for (int r = 0; r < 16; ++r) { int orow = crow(r, hi);
#pragma unroll
    for (int d0 = 0; d0 < NDV; ++d0) Ow[(long)orow * LDO + d0 * 32 + r32] = (bf16)(cvtpk(o[d0][r] * rli[r], 0.f) & 0xffffu); }
#undef SLOAD
#undef SWRITE
#undef SWAIT
#undef RESC
}
#undef KSWZ
#undef SBAR
}
constexpr int NWAVES = 8;
#ifndef MK_ONE_LAUNCH
#define MK_ONE_LAUNCH 1
#endif
constexpr int NB = 8, SEQ = 2048, DM = 1024, MTOK = NB * SEQ, DEPTH = 2;
constexpr int NH = 8, QL = 384, KVL = 256, NOPE = 64, ROPE = 32, QKH = 96, VHD = 64;
constexpr int PW = 512, INW = 3232, INWP = 3328, KPEPW = 544;
constexpr int NKEY = 128, NEXP = 16384, TOPK = 16;
constexpr float RMS_EPS = 1e-6f;
constexpr size_t MiB = 1u << 20;
constexpr size_t WS_CTL = 0;
constexpr size_t WS_W = 1 * MiB, W_STRIDE = 18 * MiB;
constexpr size_t WO_WIN = 0, WO_WUQ = 6656 * 1024, WO_WUKV = 7424 * 1024, WO_WO = 8 * MiB, WO_WC = 9 * MiB, WO_WOUT = 10 * MiB, WO_WQ = 12 * MiB, WO_KEYS = 16 * MiB;
constexpr size_t WS_U = 40 * MiB, WS_V = 72 * MiB, UV_STRIDE = 16 * MiB;
constexpr size_t WS_SU = 512 * 1024, WS_SV = 768 * 1024, SC_STRIDE = 64 * 1024;
constexpr size_t WS_XB = 168 * MiB;
constexpr size_t WS_GATES = 232 * MiB, WS_QP = 232 * MiB;
constexpr size_t WS_CQ = 296 * MiB, WS_CKV = 308 * MiB, WS_KPEP = 316 * MiB, WS_QRAW = 333 * MiB, WS_KVRAW = 357 * MiB;
constexpr size_t WS_ABUF = 296 * MiB, WS_MIX = 328 * MiB;
constexpr size_t WS_MIXED = 389 * MiB;
constexpr size_t WS_Q = 405 * MiB, WS_K = 429 * MiB, WS_VV = 453 * MiB;
constexpr size_t WS_E = 405 * MiB, WS_G = 413 * MiB, WS_XQ = 429 * MiB, WS_WF = 445 * MiB, WS_HPI = 232 * MiB;
constexpr size_t WS_O = 469 * MiB, WS_SSQ = 485 * MiB, WS_RR = 486 * MiB, WS_SX = WS_RR + 65536, WS_WSUM = WS_RR + 131072, WS_SSQN = WS_RR + 262144, WS_SSQC = 487 * MiB, WS_END = 489 * MiB;
static_assert(WO_WUQ >= (size_t)INWP * DM * 2 && WO_WUKV >= WO_WUQ + 768 * 384 * 2 && WO_WO >= WO_WUKV + 1024 * 256 * 2, "weight map");
static_assert(WS_KPEP + (size_t)MTOK * KPEPW * 2 <= WS_QRAW && WS_QRAW + (size_t)MTOK * 768 * 2 <= WS_KVRAW && WS_KVRAW + (size_t)MTOK * 1024 * 2 <= WS_MIXED, "ws map");

constexpr int LDS_BYTES = 147456;

#define GAS __attribute__((address_space(1)))
#define LAS __attribute__((address_space(3)))
typedef unsigned short bf16;
typedef unsigned v4u __attribute__((ext_vector_type(4)));
typedef unsigned v2u __attribute__((ext_vector_type(2)));
typedef float f32x4 __attribute__((ext_vector_type(4)));
typedef float f32x16 __attribute__((ext_vector_type(16)));
typedef short bf16x8 __attribute__((ext_vector_type(8)));
#define LDS_WAIT() asm volatile("s_waitcnt lgkmcnt(0)" ::: "memory")
__device__ __forceinline__ unsigned f2bf(float f) { unsigned u = __builtin_bit_cast(unsigned, f); return (u + 0x7fffu + ((u >> 16) & 1u)) >> 16; }
__device__ __forceinline__ unsigned pk2(float lo, float hi) { return f2bf(lo) | (f2bf(hi) << 16); }
__device__ __forceinline__ float blo(unsigned w) { return __builtin_bit_cast(float, w << 16); }
__device__ __forceinline__ float bhi(unsigned w) { return __builtin_bit_cast(float, w & 0xffff0000u); }
__device__ __forceinline__ float wave_sum(float v) {
#pragma unroll
    for (int o = 1; o < 64; o <<= 1) v += __shfl_xor(v, o);
    return v;
}

#define XB_TMO      128
#define XB_XCNT(j)  (256  + 64 * (j))
#define XB_XSUB(j)  (1280 + 64 * (j))
#define XB_XGEN(j)  (2304 + 64 * (j))
#define XB_TOP      3328
#define XB_TOPGEN   3392
#define XCD_BAR_WORDS 3456
#define XB_SPIN_CAP (1u << 18)

__device__ __forceinline__ unsigned xb_ld(unsigned* p)              { return __hip_atomic_load(p, __ATOMIC_RELAXED, __HIP_MEMORY_SCOPE_AGENT); }
__device__ __forceinline__ unsigned xb_add(unsigned* p, unsigned v) { return __hip_atomic_fetch_add(p, v, __ATOMIC_RELAXED, __HIP_MEMORY_SCOPE_AGENT); }
__device__ __forceinline__ unsigned xb_xcc_id() { return (unsigned)__builtin_amdgcn_s_getreg((3 << 11) | 20) & 0xFu; }
#define XB_SPIN(cond, bar) do { unsigned _sp = 0; while (cond) { __builtin_amdgcn_s_sleep(1); \
    if ((++_sp & 255u) == 0u) { if (xb_ld(&(bar)[XB_TMO])) break; if (_sp > XB_SPIN_CAP) { atomicAdd(&(bar)[XB_TMO], 1u); break; } } } } while (0)

struct XcdBarrier {
    unsigned* bar; unsigned x;
    volatile LAS unsigned* st;
};

__device__ __forceinline__ XcdBarrier xcd_barrier_post(unsigned* bar, volatile LAS unsigned* st) {
    XcdBarrier b; b.bar = bar; b.x = xb_xcc_id(); b.st = st;
    if (threadIdx.x == 0) (void)xb_add(&bar[XB_XCNT(b.x)], 1u);
    return b;
}
__device__ __forceinline__ void xcd_barrier_complete(unsigned* bar, unsigned x, unsigned& nloc, unsigned& nx) {
    const unsigned G = gridDim.x * gridDim.y * gridDim.z;
    unsigned sum, cnt, mine, sp = 0u;
    for (;;) {
        sum = 0u; cnt = 0u; mine = 0u;
#pragma unroll
        for (unsigned j = 0; j < 16; ++j) { const unsigned c = xb_ld(&bar[XB_XCNT(j)]); sum += c; cnt += (c > 0u) ? 1u : 0u; mine = (j == x) ? c : mine; }
        if (sum == G) break;
        __builtin_amdgcn_s_sleep(1);
        if ((++sp & 255u) == 0u) { if (xb_ld(&bar[XB_TMO])) break; if (sp > XB_SPIN_CAP) { atomicAdd(&bar[XB_TMO], 1u); break; } }
    }
    nloc = mine > 0u ? mine : 1u; nx = cnt > 0u ? cnt : 1u;
}

__device__ __forceinline__ void xcd_barrier(const XcdBarrier& b) {
    asm volatile("s_waitcnt vmcnt(0)" ::: "memory");
    __syncthreads();
    if (threadIdx.x == 0) {
        unsigned* bar = b.bar; unsigned bx_ = b.x;
        asm volatile("" : "+s"(bar), "+s"(bx_));
        __builtin_amdgcn_s_waitcnt(0);
        unsigned nloc = b.st[0], nx = b.st[1];
        if (nloc == 0u) { xcd_barrier_complete(bar, bx_, nloc, nx); b.st[0] = nloc; b.st[1] = nx; }
        const unsigned old = xb_add(&bar[XB_XSUB(bx_)], 1u);
        const unsigned gen = old / nloc;
        if (old + 1u == (gen + 1u) * nloc) {
            __builtin_amdgcn_fence(__ATOMIC_RELEASE, "agent");
            asm volatile("s_waitcnt vmcnt(0)" ::: "memory");
            const unsigned og = xb_add(&bar[XB_TOP], 1u);
            const unsigned tg = og / nx;
            if (og + 1u == (tg + 1u) * nx) xb_add(&bar[XB_TOPGEN], 1u);
            else XB_SPIN(xb_ld(&bar[XB_TOPGEN]) == tg, bar);
            __builtin_amdgcn_fence(__ATOMIC_ACQUIRE, "agent");
            xb_add(&bar[XB_XGEN(bx_)], 1u);
            asm volatile("s_waitcnt vmcnt(0)" ::: "memory");
        } else {
            XB_SPIN(xb_ld(&bar[XB_XGEN(bx_)]) == gen, bar);
            __builtin_amdgcn_fence(__ATOMIC_ACQUIRE, "agent");
            asm volatile("s_waitcnt vmcnt(0)" ::: "memory");
        }
    }
    __syncthreads();
}

constexpr int MISC_OFF = 131072 + 320;
constexpr size_t CTL_ZERO_BYTES = 65536;

struct Args { const void* in[21]; float* out; unsigned char* ws; int ph_lo, ph_hi; };
static_assert(sizeof(Args) == 23 * 8 + 8, "Args has no padding");


typedef const char __attribute__((address_space(4)))* kseg_t;
__device__ __forceinline__ const void* karg_ptr(int i) {
    kseg_t base = (kseg_t)__builtin_amdgcn_kernarg_segment_ptr();
    asm volatile("" : "+s"(base));
    return *(const void* const __attribute__((address_space(4)))*)(base + 8 * i);
}
__device__ __forceinline__ int karg_int(int byte_off) {
    kseg_t base = (kseg_t)__builtin_amdgcn_kernarg_segment_ptr();
    asm volatile("" : "+s"(base));
    return *(const int __attribute__((address_space(4)))*)(base + byte_off);
}
#define KIN(i) karg_ptr(i)
#define KOUT ((float*)karg_ptr(21))
#define KWS ((unsigned char*)karg_ptr(22))

struct Frame {
    LAS unsigned char* lds;
    int wave, vcu, G, gw, NGW, bx;
};
__device__ __forceinline__ Frame fresh_frame(const Frame& F) {
    Frame R = F;
    asm volatile("" : "+s"(R.wave), "+s"(R.vcu), "+s"(R.G), "+s"(R.gw), "+s"(R.NGW), "+s"(R.bx));
    return R;
}

__device__ __forceinline__ void transpose_item(const float* W, int ldw, int n_begin, int nblk, const float* gain, bf16* WT, int K, int row_off, LAS float* scr, int item, int lane, int permkv = 0) {
    const int kb = item / nblk, nb = item % nblk, k0 = 64 * kb, n0 = 32 * nb;
    const int nd0 = permkv ? 256 * (n0 >> 8) + 128 * ((n0 >> 5) & 1) + 32 * (2 * ((n0 >> 7) & 1) + ((n0 >> 6) & 1)) : n0;
    float tv[32];
#pragma unroll
    for (int i = 0; i < 32; ++i) tv[i] = W[(size_t)(k0 + 2 * i + (lane >> 5)) * ldw + n_begin + n0 + (lane & 31)];
    if (gain) {
#pragma unroll
        for (int i = 0; i < 32; ++i) tv[i] *= gain[k0 + 2 * i + (lane >> 5)]; }
#pragma unroll
    for (int i = 0; i < 32; ++i) scr[(2 * i + (lane >> 5)) * 33 + (lane & 31)] = tv[i];
    LDS_WAIT(); asm volatile("" ::: "memory");
    const int c = lane & 7;
#pragma unroll
    for (int j = 0; j < 4; ++j) { const int n = (lane >> 3) + 8 * j; const LAS float* s = scr + (8 * c) * 33 + n;
        v4u o; o.x = pk2(s[0 * 33], s[1 * 33]); o.y = pk2(s[2 * 33], s[3 * 33]); o.z = pk2(s[4 * 33], s[5 * 33]); o.w = pk2(s[6 * 33], s[7 * 33]);
        *(GAS v4u*)(WT + (size_t)(row_off + nd0 + n) * K + k0 + 8 * c) = o; }
    LDS_WAIT(); asm volatile("" ::: "memory");
}
__device__ __forceinline__ void rms_row_to_bf16(const float* xrow, const float* g, bf16* orow, int lane) {
    const f32x4* xr = (const f32x4*)xrow + lane; const f32x4* gr = (const f32x4*)g + lane;
    f32x4 v[4]; float s = 0.f;
#pragma unroll
    for (int j = 0; j < 4; ++j) { v[j] = xr[64 * j]; s += (v[j].x * v[j].x + v[j].y * v[j].y) + (v[j].z * v[j].z + v[j].w * v[j].w); }
    const float r = 1.0f / sqrtf(wave_sum(s) * (1.f / DM) + RMS_EPS);
    v2u* o8 = (v2u*)orow + lane;
#pragma unroll
    for (int j = 0; j < 4; ++j) { const f32x4 gv = gr[64 * j]; v2u w; w.x = pk2(v[j].x * r * gv.x, v[j].y * r * gv.y); w.y = pk2(v[j].z * r * gv.z, v[j].w * r * gv.w); o8[64 * j] = w; }
}
__device__ __forceinline__ void cvt8(const float* src, bf16* dst, size_t i8) {
    const f32x4 a = *(const f32x4*)(src + i8 * 8), b = *(const f32x4*)(src + i8 * 8 + 4);
    v4u o; o.x = pk2(a.x, a.y); o.y = pk2(a.z, a.w); o.z = pk2(b.x, b.y); o.w = pk2(b.z, b.w);
    *(v4u*)(dst + i8 * 8) = o;
}

__device__ __forceinline__ unsigned fp4_enc(float v, float& qa) {
    const float a = fabsf(v);
    const float lo = rintf(2.0f * fminf(a, 2.0f)), hi2 = rintf(fminf(fmaxf(a - 2.0f, 0.0f), 2.0f)), top = a > 5.0f ? 1.0f : 0.0f;
    qa = 0.5f * lo + hi2 + 2.0f * top;
    return (unsigned)(int)(lo + hi2 + top) | (v < 0.0f ? 8u : 0u);
}
__device__ __forceinline__ void convert_tables(int l, int cw, int ncw) {
    const int lane = pg8::fresh_lane();
    constexpr int NR = 8;
    for (int it0 = cw * NR; it0 < 2 * NEXP; it0 += ncw * NR) {
        f32x4 va[NR][4]; float m[NR];
#pragma unroll
        for (int r = 0; r < NR; ++r) { const int it = it0 + r, tab = it / NEXP, row = l * NEXP + it % NEXP;
            const f32x4* src = (const f32x4*)((const float*)(tab ? KIN(20) : KIN(19)) + (size_t)row * DM) + lane;
#pragma unroll
            for (int j = 0; j < 4; ++j) va[r][j] = __builtin_nontemporal_load(src + 64 * j); }
#pragma unroll
        for (int r = 0; r < NR; ++r) { float mm = 0.f;
#pragma unroll
            for (int j = 0; j < 4; ++j) mm = fmaxf(mm, fmaxf(fmaxf(fabsf(va[r][j].x), fabsf(va[r][j].y)), fmaxf(fabsf(va[r][j].z), fabsf(va[r][j].w))));
            m[r] = mm; }
#pragma unroll
        for (int o = 1; o < 64; o <<= 1)
#pragma unroll
            for (int r = 0; r < NR; ++r) m[r] = fmaxf(m[r], __shfl_xor(m[r], o));
#pragma unroll
        for (int r = 0; r < NR; ++r) { const int it = it0 + r, tab = it / NEXP, row = l * NEXP + it % NEXP;
            const float inv = m[r] > 0.f ? 6.0f / m[r] : 0.f; float qa_;
#define Q4(x) fp4_enc((x) * inv, qa_)
            unsigned char* dstb = KWS + (tab ? WS_V : WS_U) + (size_t)l * UV_STRIDE + (size_t)(it % NEXP) * 128 + 2 * lane;
#pragma unroll
            for (int j = 0; j < 4; ++j) *(unsigned short*)(dstb + (size_t)j * (NEXP * 128)) = (unsigned short)(Q4(va[r][j].x) | (Q4(va[r][j].y) << 4) | (Q4(va[r][j].z) << 8) | (Q4(va[r][j].w) << 12));
#undef Q4
            if (lane == 0) ((float*)(KWS + WS_SU))[2 * row + tab] = m[r] * (1.0f / 6.0f); }
    }
}

__device__ __forceinline__ void ph_prologue(Frame& F) {
    LAS float* scr = (LAS float*)(F.lds + F.wave * 16384);
    const int gw = F.gw, NGW = F.NGW, lane = pg8::fresh_lane();
    constexpr int I_G = 16 * 64, I_P = 16 * 37, I_UQ = 6 * 24, I_UKV = 4 * 32, I_O = 8 * 32, I_OUT = 16 * 32, I_WQ = 16 * 64;
    constexpr int I_L = I_G + I_P + I_UQ + I_UKV + I_O + I_OUT + I_WQ;
    for (int it = gw; it < DEPTH * I_L; it += NGW) {
        const int l = it / I_L; int r = it % I_L;
        unsigned char* wb = KWS + WS_W + (size_t)l * W_STRIDE;
        const float* w_in = (const float*)KIN(3) + (size_t)l * DM * INW;
        const float* g1 = (const float*)KIN(2) + (size_t)l * DM;
        if (r < I_G) { transpose_item(w_in, INW, 1184, 64, g1, (bf16*)(wb + WO_WIN), DM, 0, scr, r, lane); continue; } r -= I_G;
        if (r < I_P) { transpose_item(w_in, INW, 0, 37, g1, (bf16*)(wb + WO_WIN), DM, 2048, scr, r, lane); continue; } r -= I_P;
        if (r < I_UQ) { transpose_item((const float*)KIN(6) + (size_t)l * QL * 768, 768, 0, 24, (const float*)KIN(4) + l * QL, (bf16*)(wb + WO_WUQ), QL, 0, scr, r, lane); continue; } r -= I_UQ;
        if (r < I_UKV) { transpose_item((const float*)KIN(7) + (size_t)l * KVL * 1024, 1024, 0, 32, (const float*)KIN(5) + l * KVL, (bf16*)(wb + WO_WUKV), KVL, 0, scr, r, lane, 1); continue; } r -= I_UKV;
        if (r < I_O) { transpose_item((const float*)KIN(10) + (size_t)l * 512 * DM, DM, 0, 32, nullptr, (bf16*)(wb + WO_WO), 512, 0, scr, r, lane); continue; } r -= I_O;
        if (r < I_OUT) { transpose_item((const float*)KIN(15) + (size_t)l * DM * DM, DM, 0, 32, nullptr, (bf16*)(wb + WO_WOUT), DM, 0, scr, r, lane); continue; } r -= I_OUT;
        transpose_item((const float*)KIN(17) + (size_t)l * DM * 2048, 2048, 0, 64, (const float*)KIN(16) + (size_t)l * DM, (bf16*)(wb + WO_WQ), DM, 0, scr, r, lane);
    }
    for (int i = gw * 64 + lane; i < DEPTH * 96 * DM / 8; i += NGW * 64) {
        const int l = i / (96 * DM / 8), r = i % (96 * DM / 8);
        *(v4u*)((bf16*)(KWS + WS_W + (size_t)l * W_STRIDE + WO_WIN) + (size_t)INW * DM + (size_t)r * 8) = (v4u){0u, 0u, 0u, 0u};
    }
    for (int it = gw; it < DEPTH * 16 * 32; it += NGW) {
        const int l = it >> 9, cb = (it >> 5) & 15, db = it & 31, g = cb >> 2, r32 = lane & 31, hi = lane >> 5;
        const float* pw = (const float*)KIN(11) + (size_t)l * 4 * 128 * 128 + (size_t)(cb * 32 + r32) * 128 + 64 * hi;
        const float* ps = (const float*)KIN(12) + (size_t)l * 512 + g * 128 + 64 * hi;
        const float* wp = (const float*)KIN(13) + (size_t)l * 512 * DM + (size_t)(g * 128 + 64 * hi) * DM + db * 32 + r32;
        float av[64], bv[64];
#pragma unroll
        for (int j = 0; j < 16; ++j) { const f32x4 v = *(const f32x4*)(pw + 4 * j); av[4 * j] = v.x; av[4 * j + 1] = v.y; av[4 * j + 2] = v.z; av[4 * j + 3] = v.w; }
#pragma unroll
        for (int j = 0; j < 64; ++j) bv[j] = wp[(size_t)j * DM];
#pragma unroll
        for (int j = 0; j < 16; ++j) { const f32x4 s4 = *(const f32x4*)(ps + 4 * j); bv[4 * j] *= s4.x; bv[4 * j + 1] *= s4.y; bv[4 * j + 2] *= s4.z; bv[4 * j + 3] *= s4.w; }
        f32x16 acc = f32x16{};
#pragma unroll
        for (int s = 0; s < 64; ++s) acc = __builtin_amdgcn_mfma_f32_32x32x2f32(av[s], bv[s], acc, 0, 0, 0);
        bf16* dst = (bf16*)(KWS + WS_W + (size_t)l * W_STRIDE + WO_WC) + (size_t)(db * 32 + r32) * 512 + cb * 32 + 4 * hi;
#pragma unroll
        for (int q = 0; q < 4; ++q) { v2u o; o.x = pk2(acc[4 * q], acc[4 * q + 1]); o.y = pk2(acc[4 * q + 2], acc[4 * q + 3]); *(v2u*)(dst + 8 * q) = o; }
    }
    for (int i = gw * 64 + lane; i < DEPTH * 16 * 128 * 128 / 8; i += NGW * 64) {
        const int l = i / (16 * 128 * 128 / 8), r = i % (16 * 128 * 128 / 8);
        cvt8((const float*)KIN(18) + (size_t)l * 16 * 128 * 128, (bf16*)(KWS + WS_W + (size_t)l * W_STRIDE + WO_KEYS), (size_t)r);
    }
    for (int m0 = gw; m0 < MTOK; m0 += 2 * NGW) {
        f32x4 v[2][4]; float s[2];
#pragma unroll
        for (int u = 0; u < 2; ++u) { const int m = (m0 + u * NGW < MTOK) ? m0 + u * NGW : m0; const f32x4* xr = (const f32x4*)((const float*)KIN(0) + (size_t)m * DM) + lane;
#pragma unroll
            for (int j = 0; j < 4; ++j) v[u][j] = xr[64 * j]; }
#pragma unroll
        for (int u = 0; u < 2; ++u) { float ss = 0.f;
#pragma unroll
            for (int j = 0; j < 4; ++j) ss += (v[u][j].x * v[u][j].x + v[u][j].y * v[u][j].y) + (v[u][j].z * v[u][j].z + v[u][j].w * v[u][j].w);
            s[u] = ss; }
#pragma unroll
        for (int o = 1; o < 64; o <<= 1) { s[0] += __shfl_xor(s[0], o); s[1] += __shfl_xor(s[1], o); }
#pragma unroll
        for (int u = 0; u < 2; ++u) { const int m = m0 + u * NGW; if (m < MTOK) {
            v2u* o8 = (v2u*)((bf16*)(KWS + WS_XB) + (size_t)m * DM) + lane;
#pragma unroll
            for (int j = 0; j < 4; ++j) { v2u w; w.x = pk2(v[u][j].x, v[u][j].y); w.y = pk2(v[u][j].z, v[u][j].w); o8[64 * j] = w; }
            if (lane == 0) { f32x4* sp = (f32x4*)((float*)(KWS + WS_SSQN) + (size_t)m * 8); sp[0] = (f32x4){s[u], 0.f, 0.f, 0.f}; sp[1] = (f32x4){0.f, 0.f, 0.f, 0.f}; } } }
    }
}

__device__ __forceinline__ void ph_pool(Frame& F, int cw, int ncw) {
    const bf16* KP = (const bf16*)(KWS + WS_KPEP); bf16* MX = (bf16*)(KWS + WS_MIXED);
    const int lane = pg8::fresh_lane(), g = lane >> 4, half = 1 << g, c0 = lane * 8;
#define POOL_ACC(W, SGN) do { sum[0] += SGN blo(W.x); sum[1] += SGN bhi(W.x); sum[2] += SGN blo(W.y); sum[3] += SGN bhi(W.y); sum[4] += SGN blo(W.z); sum[5] += SGN bhi(W.z); sum[6] += SGN blo(W.w); sum[7] += SGN bhi(W.w); } while (0)
    for (int run = cw; run < MTOK / 8; run += ncw) {
        const int t0 = run * 8, s0 = t0 & (SEQ - 1);
        v4u row[23];
#pragma unroll
        for (int k = 0; k < 23; ++k) { const int d = k - 8; const bool ok = (d >= -half) && (d < 8 + half - 1 + 1) && (s0 + d >= 0) && (s0 + d < SEQ);
            row[k] = ok ? *(const v4u*)(KP + (size_t)(t0 + d) * KPEPW + 32 + c0) : (v4u){0u, 0u, 0u, 0u}; }
        float sum[8];
#pragma unroll
        for (int j = 0; j < 8; ++j) sum[j] = 0.f;
        int cnt = 0;
#pragma unroll
        for (int d = -8; d < 8; ++d) { const bool ok = (d >= -half) && (d < half) && (s0 + d >= 0) && (s0 + d < SEQ); if (ok) { POOL_ACC(row[d + 8], +); ++cnt; } }
#pragma unroll
        for (int i = 0; i < 8; ++i) {
            const int t = t0 + i, s = s0 + i;
            if (i > 0) {
                const bool lv_ok = (s - 1 - half >= 0), ev_ok = (s + half - 1 < SEQ);
#define POOL_CASE(H) do { if (half == (H)) { if ((i - 1 - (H) + 8) >= 0) { if (lv_ok) { POOL_ACC(row[(i - 1 - (H) + 8) >= 0 ? (i - 1 - (H) + 8) : 0], -); } } if (ev_ok) { POOL_ACC(row[i + (H) - 1 + 8], +); } } } while (0)
                POOL_CASE(1); POOL_CASE(2); POOL_CASE(4); POOL_CASE(8);
#undef POOL_CASE
                if (lv_ok) --cnt;
                if (ev_ok) ++cnt;
            }
            const v4u me = row[i + 8];
            const float ic = 1.0f / (float)cnt;
            v4u o; o.x = pk2(sum[0] * ic - blo(me.x), sum[1] * ic - bhi(me.x)); o.y = pk2(sum[2] * ic - blo(me.y), sum[3] * ic - bhi(me.y));
            o.z = pk2(sum[4] * ic - blo(me.z), sum[5] * ic - bhi(me.z)); o.w = pk2(sum[6] * ic - blo(me.w), sum[7] * ic - bhi(me.w));
            *(v4u*)(MX + (size_t)t * PW + c0) = o;
        }
    }
#undef POOL_ACC
}

__device__ __forceinline__ void ph_finalize(Frame& F, int l) {
    const bf16* QR = (const bf16*)(KWS + WS_QRAW); const float* SSQC = (const float*)(KWS + WS_SSQC);
    bf16* Q = (bf16*)(KWS + WS_Q);
    const int* pos = (const int*)KIN(1);
    const float* ghq = (const float*)KIN(8) + l * QKH;
    const int lane = pg8::fresh_lane(), h = lane >> 3, sub = lane & 7;
    const float inv0 = __builtin_amdgcn_exp2f(-(float)(2 * sub) * 0.8304820237218406f), inv1 = __builtin_amdgcn_exp2f(-(float)(2 * sub + 1) * 0.8304820237218406f);
    float gqn[8];
#pragma unroll
    for (int j = 0; j < 8; ++j) gqn[j] = ghq[8 * sub + j];
    const float gq10 = ghq[64 + 2 * sub], gq11 = ghq[65 + 2 * sub], gq20 = ghq[80 + 2 * sub], gq21 = ghq[81 + 2 * sub];
    for (int t = F.gw; t < MTOK; t += F.NGW) {
        const f32x4* sp = (const f32x4*)(SSQC + (size_t)t * 24); const f32x4 sa = sp[0], sb = sp[1], sc = sp[2];
        const float rq = 1.0f / sqrtf(((sa.x + sa.y) + (sa.z + sa.w) + (sb.x + sb.y) + (sb.z + sb.w) + (sc.x + sc.y) + (sc.z + sc.w)) * (1.f / QL) + RMS_EPS);
        const float p = (float)pos[t];
        float c0, s0, c1, s1;
        { const float a0 = p * inv0, a1 = p * inv1;
          const float n0 = rintf(a0 * 0.15915494309189535f), n1 = rintf(a1 * 0.15915494309189535f);
          float r0 = fmaf(-n0, 6.28318548202514648f, a0); r0 = fmaf(-n0, -1.7484556e-7f, r0);
          float r1 = fmaf(-n1, 6.28318548202514648f, a1); r1 = fmaf(-n1, -1.7484556e-7f, r1);
          r0 *= 0.15915494309189535f; r1 *= 0.15915494309189535f;
          s0 = __builtin_amdgcn_sinf(r0); c0 = __builtin_amdgcn_cosf(r0); s1 = __builtin_amdgcn_sinf(r1); c1 = __builtin_amdgcn_cosf(r1); }
        { const bf16* qp = QR + (size_t)t * 768 + h * QKH;
          const v4u w = *(const v4u*)(qp + 8 * sub); const unsigned wa = *(const unsigned*)(qp + 64 + 2 * sub), wb = *(const unsigned*)(qp + 80 + 2 * sub);
          float x[8] = {blo(w.x), bhi(w.x), blo(w.y), bhi(w.y), blo(w.z), bhi(w.z), blo(w.w), bhi(w.w)};
          float ss = 0.f;
#pragma unroll
          for (int j = 0; j < 8; ++j) { x[j] *= rq; ss += x[j] * x[j]; }
          const float x10 = blo(wa) * rq, x11 = bhi(wa) * rq, x20 = blo(wb) * rq, x21 = bhi(wb) * rq;
          const float y10 = x10 * c0 - x20 * s0, y20 = x10 * s0 + x20 * c0, y11 = x11 * c1 - x21 * s1, y21 = x11 * s1 + x21 * c1;
          ss += (y10 * y10 + y20 * y20) + (y11 * y11 + y21 * y21);
          ss += __shfl_xor(ss, 1); ss += __shfl_xor(ss, 2); ss += __shfl_xor(ss, 4);
          const float rn = 1.0f / sqrtf(ss * (1.f / QKH) + RMS_EPS);
          bf16* qo = Q + (size_t)t * 768 + h * QKH;
          v4u o; o.x = pk2(x[0] * rn * gqn[0], x[1] * rn * gqn[1]); o.y = pk2(x[2] * rn * gqn[2], x[3] * rn * gqn[3]); o.z = pk2(x[4] * rn * gqn[4], x[5] * rn * gqn[5]); o.w = pk2(x[6] * rn * gqn[6], x[7] * rn * gqn[7]);
          *(v4u*)(qo + 8 * sub) = o;
          *(unsigned*)(qo + 64 + 2 * sub) = pk2(y10 * rn * gq10, y11 * rn * gq11);
          *(unsigned*)(qo + 80 + 2 * sub) = pk2(y20 * rn * gq20, y21 * rn * gq21); }
    }
}

__device__ __forceinline__ void ph_attn(Frame& F, unsigned char* lds_generic, int l) {
    const att::bf16* Q = (const att::bf16*)(KWS + WS_QRAW); const att::bf16* K = (const att::bf16*)(KWS + WS_K); const att::bf16* V = (const att::bf16*)(KWS + WS_VV);
    att::bf16* O = (att::bf16*)(KWS + WS_O);
    for (int u = F.vcu; u < NB * NH * (SEQ / 256); u += F.G) {
        const int bh = u >> 3, qb = u & 7, b = bh >> 3, h = bh & 7;
        __syncthreads();
        att::attn_dense_body(Q + ((size_t)(b * SEQ + qb * 256)) * 768 + h * QKH, K + (size_t)(b * SEQ) * 768 + h * QKH, V + (size_t)(b * SEQ) * 512 + h * VHD,
                             O + ((size_t)(b * SEQ + qb * 256)) * 512 + h * VHD, SEQ, (char*)lds_generic, F.wave,
                             (const float*)(KWS + WS_SSQC) + (size_t)(b * SEQ + qb * 256) * 24, (const int*)KIN(1) + (b * SEQ + qb * 256), (const float*)KIN(8) + l * QKH);
    }
    __syncthreads();
}

__device__ __forceinline__ unsigned fkey(float f) { const unsigned b = __builtin_bit_cast(unsigned, f); return b ^ ((unsigned)((int)b >> 31) | 0x80000000u); }
__device__ __forceinline__ float funkey(unsigned u) { const unsigned b = u ^ (~(unsigned)((int)u >> 31) | 0x80000000u); return __builtin_bit_cast(float, b); }
__device__ __forceinline__ unsigned umax(unsigned a, unsigned b) { return a > b ? a : b; }
__device__ __forceinline__ unsigned umin(unsigned a, unsigned b) { return a < b ? a : b; }
#define INS16(T, x) do { unsigned _x = (x); _Pragma("unroll") for (int _i = 0; _i < 16; ++_i) { const unsigned _h = umax(T[_i], _x); _x = umin(T[_i], _x); T[_i] = _h; } } while (0)
__device__ __forceinline__ void sort16_desc(unsigned (&a)[16]) {
#pragma unroll
    for (int k = 2; k <= 16; k <<= 1)
#pragma unroll
        for (int j = k >> 1; j > 0; j >>= 1)
#pragma unroll
            for (int i = 0; i < 16; ++i) { const int l = i ^ j;
                if (l > i) { const unsigned hi = umax(a[i], a[l]), lo = umin(a[i], a[l]); if ((i & k) == 0) { a[i] = hi; a[l] = lo; } else { a[i] = lo; a[l] = hi; } } }
}
__device__ __forceinline__ void merge_top16(unsigned (&T)[16], const unsigned (&S)[16]) {
#pragma unroll
    for (int i = 0; i < 16; ++i) T[i] = umax(T[i], S[15 - i]);
#pragma unroll
    for (int j = 8; j > 0; j >>= 1)
#pragma unroll
        for (int i = 0; i < 16; ++i) { const int l = i ^ j; if (l > i) { const unsigned hi = umax(T[i], T[l]), lo = umin(T[i], T[l]); T[i] = hi; T[l] = lo; } }
}

__device__ __forceinline__ void ph_select(Frame& F, int l) {
    const bf16* QP = (const bf16*)(KWS + WS_QP); const bf16* KEYS = (const bf16*)(KWS + WS_W + (size_t)l * W_STRIDE + WO_KEYS);
    const float* SSQ = (const float*)(KWS + WS_SSQ); float* RR = (float*)(KWS + WS_RR); unsigned* EO = (unsigned*)(KWS + WS_E); float* GO = (float*)(KWS + WS_G);
    const int lane = pg8::fresh_lane(), r32 = lane & 31, hi = lane >> 5;
    LAS unsigned* TL = (LAS unsigned*)(F.lds + 65536) + (F.wave * 64 + lane);
    { const bf16* XG2 = (const bf16*)(KWS + WS_XB); unsigned char* XQ = KWS + WS_XQ; float* SX = (float*)(KWS + WS_SX); const float* g2p = (const float*)KIN(16) + (size_t)l * DM + 16 * lane;
      float g2v[16];
#pragma unroll
      for (int j = 0; j < 4; ++j) { const f32x4 gq = *(const f32x4*)(g2p + 4 * j); g2v[4 * j] = gq.x; g2v[4 * j + 1] = gq.y; g2v[4 * j + 2] = gq.z; g2v[4 * j + 3] = gq.w; }
      for (int t0 = F.gw; t0 < MTOK; t0 += 4 * F.NGW) {
          v4u ra[4], rb[4]; float m[4];
#pragma unroll
          for (int u = 0; u < 4; ++u) { const int t = (t0 + u * F.NGW < MTOK) ? t0 + u * F.NGW : t0; ra[u] = *(const v4u*)(XG2 + (size_t)t * DM + 16 * lane); rb[u] = *(const v4u*)(XG2 + (size_t)t * DM + 16 * lane + 8); }
          float xf[4][16];
#pragma unroll
          for (int u = 0; u < 4; ++u) { const v4u a = ra[u], b = rb[u];
              const float x_[16] = {blo(a.x), bhi(a.x), blo(a.y), bhi(a.y), blo(a.z), bhi(a.z), blo(a.w), bhi(a.w), blo(b.x), bhi(b.x), blo(b.y), bhi(b.y), blo(b.z), bhi(b.z), blo(b.w), bhi(b.w)};
              float mm = 0.f;
#pragma unroll
              for (int j = 0; j < 16; ++j) { xf[u][j] = x_[j] * g2v[j]; mm = fmaxf(mm, fabsf(xf[u][j])); }
              m[u] = mm; }
#pragma unroll
          for (int o = 1; o < 64; o <<= 1)
#pragma unroll
              for (int u = 0; u < 4; ++u) m[u] = fmaxf(m[u], __shfl_xor(m[u], o));
#pragma unroll
          for (int u = 0; u < 4; ++u) { const int t = t0 + u * F.NGW; if (t < MTOK) {
              const float inv = m[u] > 0.f ? 6.0f / m[u] : 0.f;
              unsigned c1[16], c2[16];
#pragma unroll
              for (int j = 0; j < 16; ++j) { const float v = xf[u][j] * inv, a = fabsf(v);
                  const float lo = rintf(2.0f * fminf(a, 2.0f)), hi2 = rintf(fminf(fmaxf(a - 2.0f, 0.0f), 2.0f)), top = a > 5.0f ? 1.0f : 0.0f;
                  c1[j] = (unsigned)(int)(lo + hi2 + top) | (v < 0.0f ? 8u : 0u);
                  const float qa = 0.5f * lo + hi2 + 2.0f * top, r = (a - qa) * 6.0f, ra = fabsf(r);
                  const float lo2 = rintf(2.0f * fminf(ra, 2.0f)), hi22 = rintf(fminf(fmaxf(ra - 2.0f, 0.0f), 2.0f)), top2 = ra > 5.0f ? 1.0f : 0.0f;
                  c2[j] = (unsigned)(int)(lo2 + hi22 + top2) | (((r < 0.0f) != (v < 0.0f)) ? 8u : 0u); }
              v2u q1, q2;
              q1.x = c1[0] | (c1[1] << 4) | (c1[2] << 8) | (c1[3] << 12) | (c1[4] << 16) | (c1[5] << 20) | (c1[6] << 24) | (c1[7] << 28);
              q1.y = c1[8] | (c1[9] << 4) | (c1[10] << 8) | (c1[11] << 12) | (c1[12] << 16) | (c1[13] << 20) | (c1[14] << 24) | (c1[15] << 28);
              q2.x = c2[0] | (c2[1] << 4) | (c2[2] << 8) | (c2[3] << 12) | (c2[4] << 16) | (c2[5] << 20) | (c2[6] << 24) | (c2[7] << 28);
              q2.y = c2[8] | (c2[9] << 4) | (c2[10] << 8) | (c2[11] << 12) | (c2[12] << 16) | (c2[13] << 20) | (c2[14] << 24) | (c2[15] << 28);
              unsigned char* xo = XQ + (size_t)(lane >> 4) * ((size_t)MTOK * 256) + (size_t)t * 256 + 8 * (lane & 15);
              *(v2u*)(xo) = q1; *(v2u*)(xo + 128) = q2;
              if (lane == 0) SX[t] = m[u] * (1.0f / 6.0f); } }
      } }
    const int h = F.vcu & 7, tbg = F.vcu >> 3, ntbg = F.G >> 3;
    { const int tid = F.wave * 64 + lane;
#pragma unroll
      for (int j = 0; j < 8; ++j) { const int idx = tid + 512 * j, p = idx >> 11, n = (idx >> 4) & 127, ch = idx & 15;
          const v4u v = *(const v4u*)(KEYS + ((size_t)(2 * h + p) * 128 + n) * 128 + ch * 8);
          *(LAS v4u*)(F.lds + p * 32768 + n * 256 + ((ch * 16) ^ ((n & 7) << 4))) = v; }
      __syncthreads(); }
    for (int tb = tbg * 8 + F.wave; tb < MTOK / 32; tb += ntbg * 8) {
        const int tok = tb * 32 + r32;
        float ssq = 0.f;
        { const f32x4* sp = (const f32x4*)(SSQ + (size_t)tok * 16);
#pragma unroll
          for (int j = 0; j < 4; ++j) { const f32x4 v = sp[j]; ssq += (v.x + v.y) + (v.z + v.w); } }
        const float rr = 1.0f / sqrtf(ssq * (1.f / DM) + RMS_EPS);
        if (h == 0 && hi == 0) RR[tok] = rr;
        unsigned C[16];
#pragma unroll
        for (int i = 0; i < 16; ++i) C[i] = 0u;
        {
        unsigned T[2][16];
        bf16x8 qfa[2][8];
#pragma unroll
        for (int p = 0; p < 2; ++p) { const bf16* qrow = QP + (size_t)tok * 2048 + (2 * h + p) * 128 + hi * 8;
#pragma unroll
            for (int s = 0; s < 8; ++s) qfa[p][s] = *(const bf16x8*)(qrow + s * 16); }
#pragma unroll
        for (int p = 0; p < 2; ++p) {
            const int hp = 2 * h + p;
            bf16x8 qf[8];
#pragma unroll
            for (int s = 0; s < 8; ++s) qf[s] = qfa[p][s];
#pragma unroll
            for (int i = 0; i < 16; ++i) T[p][i] = 0u;
#pragma unroll 1
            for (int blk = 0; blk < 4; ++blk) {
                f32x16 acc = f32x16{};
                const int n = blk * 32 + r32; const LAS unsigned char* krow = F.lds + p * 32768 + n * 256; const int sw = (n & 7) << 4;
#pragma unroll
                for (int s = 0; s < 8; ++s) { const bf16x8 a = *(const LAS bf16x8*)(krow + ((32 * s + 16 * hi) ^ sw)); acc = __builtin_amdgcn_mfma_f32_32x32x16_bf16(a, qf[s], acc, 0, 0, 0); }
                const int nb = 127 - (blk * 32 + 4 * hi);
                unsigned K[16];
#pragma unroll
                for (int r = 0; r < 16; ++r) K[r] = (fkey(acc[r]) & ~127u) | (unsigned)(nb - ((r & 3) + 8 * (r >> 2)));
                sort16_desc(K); merge_top16(T[p], K);
            }
            unsigned oth[16];
#pragma unroll
            for (int i = 0; i < 16; ++i) oth[i] = (unsigned)__shfl_xor((int)T[p][i], 32);
            merge_top16(T[p], oth);
#pragma unroll
            for (int i = 0; i < 16; ++i) TL[(p * 16 + i) * 512] = T[p][i];
        }
        float s0[16], s1[16];
#pragma unroll
        for (int i = 0; i < 16; ++i) { s0[i] = funkey((T[0][i] & ~127u) | 64u); s1[i] = funkey((T[1][i] & ~127u) | 64u); }
#define CAND(i, j) ((fkey(s0[i] + s1[j]) & ~255u) | (unsigned)((i) * 16 + (j)))
#pragma unroll
        for (int j = 0; j < 16; ++j) C[j] = CAND(0, j);
        { unsigned B[16];
#pragma unroll
          for (int j = 0; j < 8; ++j) B[j] = CAND(1, j);
#pragma unroll
          for (int j = 0; j < 5; ++j) B[8 + j] = CAND(2, j);
#pragma unroll
          for (int j = 0; j < 3; ++j) B[13 + j] = CAND(4, j);
          sort16_desc(B); merge_top16(C, B); }
        { unsigned B[16];
#pragma unroll
          for (int j = 0; j < 4; ++j) B[j] = CAND(3, j);
#pragma unroll
          for (int j = 0; j < 2; ++j) { B[4 + j] = CAND(5, j); B[6 + j] = CAND(6, j); B[8 + j] = CAND(7, j); }
#pragma unroll
          for (int i = 0; i < 6; ++i) B[10 + i] = CAND(8 + i, 0);
          sort16_desc(B); merge_top16(C, B); }
        INS16(C, CAND(14, 0)); INS16(C, CAND(15, 0));
#undef CAND
        }
        float sc[16]; unsigned ex[16];
#pragma unroll
        for (int k = 0; k < 16; ++k) {
            const unsigned code = C[k] & 255u;
            const unsigned a = TL[(code >> 4) * 512], b = TL[(16 + (code & 15u)) * 512];
            ex[k] = (127u - (a & 127u)) * 128u + (127u - (b & 127u));
            sc[k] = funkey((a & ~127u) | 64u) + funkey((b & ~127u) | 64u);
        }
        float smax = sc[0];
#pragma unroll
        for (int k = 1; k < 16; ++k) smax = fmaxf(smax, sc[k]);
        float den = 0.f;
#pragma unroll
        for (int k = 0; k < 16; ++k) { sc[k] = __builtin_amdgcn_exp2f((sc[k] - smax) * rr * 1.4426950408889634f); den += sc[k]; }
        const float iden = 1.0f / den;
        v4u* edst = (v4u*)(EO + (size_t)tok * 128 + h * 16 + hi * 8); f32x4* gdst = (f32x4*)(GO + (size_t)tok * 128 + h * 16 + hi * 8);
#pragma unroll
        for (int k = 0; k < 8; k += 4) {
            unsigned ea[4], eb[4]; float wa[4], wb2[4];
#pragma unroll
            for (int j = 0; j < 4; ++j) { ea[j] = ex[k + j]; eb[j] = ex[8 + k + j]; wa[j] = sc[k + j]; wb2[j] = sc[8 + k + j];
                asm volatile("" : "+v"(ea[j]), "+v"(eb[j]), "+v"(wa[j]), "+v"(wb2[j])); }
            edst[k >> 2] = (v4u){hi ? eb[0] : ea[0], hi ? eb[1] : ea[1], hi ? eb[2] : ea[2], hi ? eb[3] : ea[3]};
            gdst[k >> 2] = (f32x4){(hi ? wb2[0] : wa[0]) * iden, (hi ? wb2[1] : wa[1]) * iden, (hi ? wb2[2] : wa[2]) * iden, (hi ? wb2[3] : wa[3]) * iden};
        }
    }
}

__device__ __forceinline__ float gelu_tanh(float h) {
    const float z = 0.7978845608028654f * (h + 0.044715f * h * h * h);
    return h * __builtin_amdgcn_rcpf(1.0f + __builtin_amdgcn_exp2f(-2.0f * 1.4426950408889634f * z));
}
__device__ __forceinline__ float ub0(unsigned x) { return (float)(x & 0xffu); }
__device__ __forceinline__ float ub1(unsigned x) { return (float)((x >> 8) & 0xffu); }
__device__ __forceinline__ float ub2(unsigned x) { return (float)((x >> 16) & 0xffu); }
__device__ __forceinline__ float ub3(unsigned x) { return (float)(x >> 24); }
#define DPP_I(x, ctrl) __builtin_amdgcn_update_dpp(0, (x), (ctrl), 0xf, 0xf, false)
#define DPP_F(x, ctrl) __builtin_bit_cast(float, __builtin_amdgcn_update_dpp(0, __builtin_bit_cast(int, (x)), (ctrl), 0xf, 0xf, false))
#define G1_IT(i) (bx + (i) * G)
#define G1_TOK(i) ((G1_IT(i) >> 3) * 8 + wave)
__device__ __forceinline__ void ph_g1(Frame& F, int l) {
    const unsigned char* XQ = KWS + WS_XQ; const unsigned* E = (const unsigned*)(KWS + WS_E); const unsigned char* U = KWS + WS_U + (size_t)l * UV_STRIDE; float* HPF = (float*)(KWS + WS_HPI);
    const int lane = pg8::fresh_lane(), n = lane & 15, q = lane >> 4, m = n & 7, hh = n >> 3, k8 = hh * 4 + q, r8 = lane >> 3, c = lane & 7;
    const int G = F.G, bx = F.bx, wave = F.wave;
    const int nit = (4 * (MTOK / 8) - bx + G - 1) / G;
    LAS unsigned char* ldw = F.lds + wave * 16384 + lane * 16; const LAS unsigned char* ldr = F.lds + wave * 16384 + m * 128 + hh * 64 + q * 16;
    typedef int i32x8 __attribute__((ext_vector_type(8))); typedef float f32x2 __attribute__((ext_vector_type(2)));
#define F1_IT(i) (bx + (i) * G)
#define F1_TOK(i) ((F1_IT(i) >> 2) * 8 + wave)
#define F1_LOADE(EV, i) do { const unsigned* ep_ = E + (size_t)F1_TOK(i) * 128 + 16 * r8; _Pragma("unroll") for (int j_ = 0; j_ < 4; ++j_) EV[j_] = *(const v4u*)(ep_ + 4 * j_); } while (0)
#define F1_LOADB(URV, XV, EV, i) do { const size_t co_ = (size_t)(F1_IT(i) & 3) * (NEXP * 128) + 16 * c; \
        _Pragma("unroll") for (int g_ = 0; g_ < 16; ++g_) URV[g_] = *(const v4u*)(U + (size_t)(EV[g_ >> 2][g_ & 3] & (NEXP - 1)) * 128 + co_); \
        XV = *(const v4u*)(XQ + (size_t)(F1_IT(i) & 3) * ((size_t)MTOK * 256) + (size_t)F1_TOK(i) * 256 + 128 * (n & 1) + 64 * ((n >> 1) & 1) + 16 * q); } while (0)
#define F1_COMP(URV, XV, i) do { float h_[16]; \
        const i32x8 xa_ = {(int)XV.x, (int)XV.y, (int)XV.z, (int)XV.w, 0, 0, 0, 0}; \
        _Pragma("unroll") for (int g_ = 0; g_ < 16; ++g_) *(LAS v4u*)(ldw + g_ * 1024) = URV[g_]; \
        _Pragma("unroll") for (int g_ = 0; g_ < 16; ++g_) { const v4u ur_ = *(const LAS v4u*)(ldr + g_ * 1024); \
            const i32x8 ub_ = {(int)ur_.x, (int)ur_.y, (int)ur_.z, (int)ur_.w, 0, 0, 0, 0}; \
            const f32x4 d_ = __builtin_amdgcn_mfma_scale_f32_16x16x128_f8f6f4(xa_, ub_, (f32x4){0.f, 0.f, 0.f, 0.f}, 4, 4, 0, 0x7f7f7f7f, 0, 0x7f7f7f7f); \
            const float v_ = hh ? d_[2] + d_[3] * (1.0f / 6.0f) : d_[0] + d_[1] * (1.0f / 6.0f); \
            h_[g_] = v_ + DPP_F(v_, 0x128); } \
          \
        float s0_ = h_[0], s1_ = h_[1]; \
        _Pragma("unroll") for (int k_ = 1; k_ < 8; ++k_) { s0_ = k8 == k_ ? h_[2 * k_] : s0_; s1_ = k8 == k_ ? h_[2 * k_ + 1] : s1_; } \
        *(f32x2*)(HPF + ((size_t)(F1_IT(i) & 3) * MTOK + F1_TOK(i)) * 128 + 16 * m + 2 * k8) = (f32x2){s0_, s1_}; } while (0)
    v4u eA[4], eB[4], xA, xB, urA[16], urB[16];
#define F1_CL(i) ((i) < nit ? (i) : nit - 1)
    if (nit > 0) {
        F1_LOADE(eA, 0); F1_LOADE(eB, F1_CL(1)); F1_LOADB(urA, xA, eA, 0);
        for (int i = 0; i < nit; i += 2) {
            F1_LOADE(eA, F1_CL(i + 2));
            F1_LOADB(urB, xB, eB, F1_CL(i + 1));
            __builtin_amdgcn_sched_barrier(0);
            F1_COMP(urA, xA, i);
            __builtin_amdgcn_sched_barrier(0);
            F1_LOADE(eB, F1_CL(i + 3));
            F1_LOADB(urA, xA, eA, F1_CL(i + 2));
            __builtin_amdgcn_sched_barrier(0);
            F1_COMP(urB, xB, F1_CL(i + 1));
            __builtin_amdgcn_sched_barrier(0);
        }
    }
#undef F1_CL
#undef F1_IT
#undef F1_TOK
#undef F1_LOADE
#undef F1_LOADB
#undef F1_COMP
}
__device__ __forceinline__ void ph_g1b(Frame& F, int l) {
    const float* HPF = (const float*)(KWS + WS_HPI); const unsigned* E = (const unsigned*)(KWS + WS_E); const float* G = (const float*)(KWS + WS_G);
    const float* RR = (const float*)(KWS + WS_RR); const float* SX = (const float*)(KWS + WS_SX);
    typedef float f32x2s __attribute__((ext_vector_type(2)));
    const f32x2s* SUV = (const f32x2s*)(KWS + WS_SU) + (size_t)l * NEXP;
    unsigned char* WQ = KWS + WS_WF; float* SW = (float*)(KWS + WS_WSUM);
    const int lane = pg8::fresh_lane();
    typedef int i32x2 __attribute__((ext_vector_type(2))); typedef float f32x2 __attribute__((ext_vector_type(2)));
    constexpr int NU = 4;
    for (int t0 = F.gw; t0 < MTOK; t0 += NU * F.NGW) {
        f32x2 isum[NU]; v2u e2[NU]; f32x2 g2[NU]; float hs[NU];
#pragma unroll
        for (int u = 0; u < NU; ++u) { const int t = (t0 + u * F.NGW < MTOK) ? t0 + u * F.NGW : t0;
            hs[u] = RR[t] * SX[t];
            isum[u] = (f32x2){0.f, 0.f};
#pragma unroll
            for (int s = 0; s < 4; ++s) { const f32x2 w = *(const f32x2*)(HPF + ((size_t)s * MTOK + t) * 128 + 2 * lane); isum[u].x += w.x; isum[u].y += w.y; }
            e2[u] = *(const v2u*)(E + (size_t)t * 128 + 2 * lane); g2[u] = *(const f32x2*)(G + (size_t)t * 128 + 2 * lane); }
        float w0[NU], w1[NU], m[NU];
#pragma unroll
        for (int u = 0; u < NU; ++u) { const unsigned e0 = e2[u].x & (NEXP - 1), e1 = e2[u].y & (NEXP - 1);
            const f32x2s sa = SUV[e0], sb = SUV[e1];
            w0[u] = g2[u].x * gelu_tanh(isum[u].x * hs[u] * sa.x) * sa.y; w1[u] = g2[u].y * gelu_tanh(isum[u].y * hs[u] * sb.x) * sb.y;
            m[u] = fmaxf(fabsf(w0[u]), fabsf(w1[u])); }
#pragma unroll
        for (int o = 1; o < 64; o <<= 1)
#pragma unroll
            for (int u = 0; u < NU; ++u) m[u] = fmaxf(m[u], __shfl_xor(m[u], o));
#pragma unroll
        for (int u = 0; u < NU; ++u) { const int t = t0 + u * F.NGW; if (t < MTOK) {
            const float inv = m[u] > 0.f ? 6.0f / m[u] : 0.f;
            float va = w0[u] * inv, vb = w1[u] * inv, qa, qb;
#pragma unroll
            for (int term = 0; term < 3; ++term) {
                const unsigned ca = fp4_enc(va, qa), cb = fp4_enc(vb, qb);
                WQ[(size_t)t * 192 + 64 * term + lane] = (unsigned char)(ca | (cb << 4));
                va = (va < 0.0f ? qa - fabsf(va) : fabsf(va) - qa) * 6.0f; vb = (vb < 0.0f ? qb - fabsf(vb) : fabsf(vb) - qb) * 6.0f; }
            if (lane == 0) SW[t] = m[u] * (1.0f / 6.0f); } }
    }
}
template <bool LAST>
__device__ __forceinline__ void ph_g2(Frame& F, int l, bf16* Xout) {
    const unsigned* E = (const unsigned*)(KWS + WS_E); const unsigned char* WQ = KWS + WS_WF; const float* SW = (const float*)(KWS + WS_WSUM);
    const unsigned char* V = KWS + WS_V + (size_t)l * UV_STRIDE;
    const bf16* X = (const bf16*)(KWS + WS_XB); float* SSQN = (float*)(KWS + WS_SSQN); float* OUTF = KOUT;
    const int lane = pg8::fresh_lane(), n = lane & 15, q = lane >> 4, r8 = lane >> 3, c = lane & 7;
    const int G = F.G, bx = F.bx, wave = F.wave;
    const int nit = (4 * (MTOK / 8) - bx + G - 1) / G;
    LAS unsigned char* ldw = F.lds + wave * 16384 + r8 * 2048; LAS unsigned char* ldr = F.lds + wave * 16384 + (32 * q + n) * 128;
    typedef int i32x8 __attribute__((ext_vector_type(8))); typedef int i32x2 __attribute__((ext_vector_type(2)));
#define F2_IT(i) (bx + (i) * G)
#define F2_TOK(i) ((F2_IT(i) >> 2) * 8 + wave)
#define F2_LOADE(EV, i) do { const unsigned* ep_ = E + (size_t)F2_TOK(i) * 128 + 16 * r8; _Pragma("unroll") for (int j_ = 0; j_ < 4; ++j_) EV[j_] = *(const v4u*)(ep_ + 4 * j_); } while (0)
#define F2_LOADB(VRV, AV, XV, SWV, EV, i) do { const size_t co_ = (size_t)(F2_IT(i) & 3) * (NEXP * 128) + 16 * c; \
        _Pragma("unroll") for (int g_ = 0; g_ < 16; ++g_) VRV[g_] = *(const v4u*)(V + (size_t)(EV[g_ >> 2][g_ & 3] & (NEXP - 1)) * 128 + co_); \
        AV = *(const v4u*)(WQ + (size_t)F2_TOK(i) * 192 + 64 * ((n & 3) < 2 ? (n & 3) : 2) + 16 * q); SWV = SW[F2_TOK(i)]; \
        _Pragma("unroll") for (int k_ = 0; k_ < 4; ++k_) XV[k_] = (unsigned)X[(size_t)F2_TOK(i) * DM + 256 * (F2_IT(i) & 3) + 16 * (4 * q + k_) + n]; } while (0)
#define F2_COMP(VRV, AV, XV, SWV, i) do { \
        _Pragma("unroll") for (int g_ = 0; g_ < 16; ++g_) { const v4u w_ = (g_ & 1) ? (v4u){VRV[g_].z, VRV[g_].w, VRV[g_].x, VRV[g_].y} : VRV[g_]; *(LAS v4u*)(ldw + g_ * 128 + 16 * (c ^ (g_ >> 1))) = w_; } \
        const i32x8 wa_ = {(int)AV.x, (int)AV.y, (int)AV.z, (int)AV.w, 0, 0, 0, 0}; \
        float val_[16]; \
        _Pragma("unroll") for (int cg_ = 0; cg_ < 16; ++cg_) { LAS unsigned char* ad_ = ldr + 8 * (cg_ ^ n); \
            const i32x2 r0_ = __builtin_amdgcn_ds_read_tr4_b64_v2i32((LAS i32x2*)ad_), r1_ = __builtin_amdgcn_ds_read_tr4_b64_v2i32((LAS i32x2*)(ad_ + 2048)); \
            const i32x8 vb_ = {r0_.x, r0_.y, r1_.x, r1_.y, 0, 0, 0, 0}; \
            const f32x4 d_ = __builtin_amdgcn_mfma_scale_f32_16x16x128_f8f6f4(wa_, vb_, (f32x4){0.f, 0.f, 0.f, 0.f}, 4, 4, 0, 0x7f7f7f7f, 0, 0x7f7f7f7f); \
            val_[cg_] = d_[0] + d_[1] * (1.0f / 6.0f) + d_[2] * (1.0f / 36.0f); } \
          \
        const int t_ = F2_TOK(i), s_ = F2_IT(i) & 3; const float sw_ = SWV; float ss_ = 0.f; \
        _Pragma("unroll") for (int k_ = 0; k_ < 4; ++k_) { float o_ = val_[k_], o1_ = val_[4 + k_], o2_ = val_[8 + k_], o3_ = val_[12 + k_]; asm volatile("" : "+v"(o_), "+v"(o1_), "+v"(o2_), "+v"(o3_));     \
            o_ = q == 1 ? o1_ : o_; o_ = q == 2 ? o2_ : o_; o_ = q == 3 ? o3_ : o_; \
            const float xo_ = blo(XV[k_]) + o_ * sw_; const size_t col_ = (size_t)256 * s_ + 16 * (4 * q + k_) + n; \
            if (LAST) OUTF[(size_t)t_ * DM + col_] = xo_; else { Xout[(size_t)t_ * DM + col_] = (bf16)f2bf(xo_); ss_ += xo_ * xo_; } } \
        if (!LAST) { ss_ += DPP_F(ss_, 0xB1); ss_ += DPP_F(ss_, 0x4E); ss_ += DPP_F(ss_, 0x141); ss_ += DPP_F(ss_, 0x128);        \
            ss_ += __int_as_float(__builtin_amdgcn_ds_swizzle(__float_as_int(ss_), 0x401F));                                     \
            SSQN[(size_t)t_ * 8 + 2 * s_ + (lane >> 5)] = ss_; } } while (0)
    v4u eA[4], eB[4], aA, aB, vrA[16], vrB[16]; unsigned xA[4], xB[4]; float swA, swB;
#define F2_CL(i) ((i) < nit ? (i) : nit - 1)
    if (nit > 0) {
        F2_LOADE(eA, 0); F2_LOADE(eB, F2_CL(1)); F2_LOADB(vrA, aA, xA, swA, eA, 0);
        for (int i = 0; i < nit; i += 2) {
            F2_LOADE(eA, F2_CL(i + 2));
            F2_LOADB(vrB, aB, xB, swB, eB, F2_CL(i + 1));
            __builtin_amdgcn_sched_barrier(0);
            F2_COMP(vrA, aA, xA, swA, i);
            __builtin_amdgcn_sched_barrier(0);
            F2_LOADE(eB, F2_CL(i + 3));
            F2_LOADB(vrA, aA, xA, swA, eA, F2_CL(i + 2));
            __builtin_amdgcn_sched_barrier(0);
            F2_COMP(vrB, aB, xB, swB, F2_CL(i + 1));
            __builtin_amdgcn_sched_barrier(0);
        }
    }
#undef F2_CL
#undef F2_IT
#undef F2_TOK
#undef F2_LOADE
#undef F2_LOADB
#undef F2_COMP
#undef G1_IT
#undef G1_TOK
}

constexpr int PH_PER_LAYER = 11, N_PHASES = 1 + DEPTH * PH_PER_LAYER;
__global__ void __launch_bounds__(NWAVES * 64, 2) fwd_kernel(Args A) {
    extern __shared__ __attribute__((aligned(16))) unsigned char lds[];
    Frame F;
    F.lds = (LAS unsigned char*)lds;
    F.wave = __builtin_amdgcn_readfirstlane((int)threadIdx.x >> 6);
    F.G = gridDim.x; { const int bx = blockIdx.x; F.vcu = (F.G % 8 == 0) ? (bx % 8) * (F.G / 8) + bx / 8 : bx; }
    F.gw = F.vcu * NWAVES + F.wave; F.NGW = F.G * NWAVES; F.bx = (int)blockIdx.x;
    cg::grid_group grid = cg::this_grid();
    for (int u = threadIdx.x; u < 64; u += NWAVES * 64) ((LAS unsigned*)(F.lds + 131072))[u + 64] = 0u;
    __syncthreads();
    XcdBarrier bar = xcd_barrier_post((unsigned*)(KWS + WS_CTL), (volatile LAS unsigned*)(F.lds + MISC_OFF) + 8);
    const int lo = karg_int(23 * 8), hi = karg_int(23 * 8 + 4);
#ifndef PH_MASK
#define PH_MASK 0xfff
#endif
#define KIND(k) ((k) == 0 ? 0 : 1 + ((k) - 1) % PH_PER_LAYER)
#define IN(k) (((PH_MASK >> KIND(k)) & 1) && lo <= (k) && (k) < hi)
#define SEAM(k) do { if (IN(k) && IN((k) + 1)) xcd_barrier(bar); } while (0)
#ifndef PROBE_KIND
#define PROBE_KIND (-1)
#endif
#define REPS(kind) for (int rep_ = ((kind) == PROBE_KIND ? 0 : 1); rep_ < 2; ++rep_)
#define REP_SYNC() do { if (rep_ == 0) xcd_barrier(bar); } while (0)
    if (lo < 0) grid.sync();
    if (IN(0)) { REPS(0) { ph_prologue(F); REP_SYNC(); } SEAM(0); }
    for (int l = 0; l < DEPTH; ++l) {
        const int p0 = 1 + l * PH_PER_LAYER;
        if (IN(p0 + 0)) { REPS(1) { Frame Fq = fresh_frame(F);
            unsigned char* ws = KWS; unsigned char* wb = ws + WS_W + (size_t)l * W_STRIDE;
            pg8::Gemm g{(const pg8::bf16_t*)(ws + WS_XB), (const pg8::bf16_t*)(wb + WO_WIN), MTOK, INWP, DM}; pg8::StaticOrder S; S.init(MTOK, INWP, Fq.G, Fq.bx);
            pg8::EpiIn E{(pg8::bf16_t*)(ws + WS_GATES), (const float*)KIN(14) + (size_t)l * 2048, (pg8::bf16_t*)(ws + WS_CQ), (pg8::bf16_t*)(ws + WS_CKV), (pg8::bf16_t*)(ws + WS_KPEP), (const float*)(ws + WS_SSQN), (float*)(ws + WS_SSQC), (const int*)KIN(1)};
            pg8::gemm_phase<pg8::EpiIn, pg8::StaticOrder, true, true>(Fq.lds, g, S, E, Fq.wave);
            { const int nu = MTOK / 256 * (INWP / 256), nfull = nu % Fq.G;
              if (nfull == 0) convert_tables(l, Fq.gw, Fq.NGW);
              else if (Fq.bx >= nfull) convert_tables(l, (Fq.bx - nfull) * NWAVES + Fq.wave, (Fq.G - nfull) * NWAVES); }
            REP_SYNC(); }
            SEAM(p0 + 0);
        }
        if (IN(p0 + 1)) { REPS(2) { Frame Fq = fresh_frame(F);
            unsigned char* ws = KWS; unsigned char* wb = ws + WS_W + (size_t)l * W_STRIDE;
            { const int nq = (MTOK / 256) * 3;
              if (nq >= Fq.G) ph_pool(Fq, Fq.gw, Fq.NGW);
              else if (Fq.bx >= nq) ph_pool(Fq, (Fq.bx - nq) * NWAVES + Fq.wave, (Fq.G - nq) * NWAVES); }
            { pg8::Gemm g{(const pg8::bf16_t*)(ws + WS_CQ), (const pg8::bf16_t*)(wb + WO_WUQ), MTOK, 768, QL}; pg8::StaticOrder S; S.init(MTOK, 768, Fq.G, Fq.bx);
              pg8::EpiBf16<0> E{(pg8::bf16_t*)(ws + WS_QRAW), 768, nullptr, 0, 0, 1.f};
              pg8::gemm_phase<pg8::EpiBf16<0>, pg8::StaticOrder, true, true>(Fq.lds, g, S, E, Fq.wave); }
            { int kvl = KVL; asm volatile("" : "+s"(kvl));
              pg8::Gemm g{(const pg8::bf16_t*)(ws + WS_CKV), (const pg8::bf16_t*)(wb + WO_WUKV), MTOK, 1024, kvl}; pg8::StaticOrder S; S.init(MTOK, 1024, Fq.G, Fq.bx);
              pg8::EpiKV E{(pg8::bf16_t*)(ws + WS_K), (pg8::bf16_t*)(ws + WS_VV), (const pg8::bf16_t*)(ws + WS_KPEP), (const float*)(ws + WS_SSQC), (const float*)KIN(9) + l * QKH};
              pg8::gemm_phase<pg8::EpiKV, pg8::StaticOrder, true, true>(Fq.lds, g, S, E, Fq.wave); }
            REP_SYNC(); }
            SEAM(p0 + 1);
        }
        if (IN(p0 + 3)) { REPS(4) { Frame Fq = fresh_frame(F); ph_attn(Fq, lds, l); REP_SYNC(); } SEAM(p0 + 3); }
        if (IN(p0 + 4)) { REPS(5) { Frame Fq = fresh_frame(F);
            unsigned char* ws = KWS; unsigned char* wb = ws + WS_W + (size_t)l * W_STRIDE;
            { pg8::Gemm g{(const pg8::bf16_t*)(ws + WS_O), (const pg8::bf16_t*)(wb + WO_WO), MTOK, DM, 512}; pg8::StaticOrder S; S.init(MTOK, DM, Fq.G, Fq.bx);
              pg8::EpiBf16<0> E{(pg8::bf16_t*)(ws + WS_ABUF), DM, nullptr, 0, 0, 1.f};
              pg8::gemm_phase<pg8::EpiBf16<0>, pg8::StaticOrder, true, true>(Fq.lds, g, S, E, Fq.wave); }
            { pg8::Gemm g{(const pg8::bf16_t*)(ws + WS_MIXED), (const pg8::bf16_t*)(wb + WO_WC), MTOK, DM, 512}; pg8::StaticOrder S; S.init(MTOK, DM, Fq.G, Fq.bx);
              pg8::EpiMix E{(const pg8::bf16_t*)(ws + WS_ABUF), (const pg8::bf16_t*)(ws + WS_GATES), (pg8::bf16_t*)(ws + WS_MIX)};
              pg8::gemm_phase<pg8::EpiMix, pg8::StaticOrder, true, true>(Fq.lds, g, S, E, Fq.wave); }
            REP_SYNC(); }
            SEAM(p0 + 4);
        }
        if (IN(p0 + 5)) { REPS(6) { Frame Fq = fresh_frame(F);
            unsigned char* ws = KWS; unsigned char* wb = ws + WS_W + (size_t)l * W_STRIDE;
            pg8::Gemm g{(const pg8::bf16_t*)(ws + WS_MIX), (const pg8::bf16_t*)(wb + WO_WOUT), MTOK, DM, DM}; pg8::StaticOrder S; S.init(MTOK, DM, Fq.G, Fq.bx);
            pg8::EpiRes E{(const pg8::bf16_t*)(ws + WS_XB), rep_ == 0 ? (pg8::bf16_t*)(ws + WS_GATES) : (pg8::bf16_t*)(ws + WS_XB), (float*)(ws + WS_SSQ)};
            pg8::gemm_phase<pg8::EpiRes, pg8::StaticOrder, true, true>(Fq.lds, g, S, E, Fq.wave);
            REP_SYNC(); }
            SEAM(p0 + 5);
        }
        if (IN(p0 + 6)) { REPS(7) { Frame Fq = fresh_frame(F);
            unsigned char* ws = KWS; unsigned char* wb = ws + WS_W + (size_t)l * W_STRIDE;
            pg8::Gemm g{(const pg8::bf16_t*)(ws + WS_XB), (const pg8::bf16_t*)(wb + WO_WQ), MTOK, 2048, DM}; pg8::StaticOrder S; S.init(MTOK, 2048, Fq.G, Fq.bx);
            pg8::EpiBf16<0> E{(pg8::bf16_t*)(ws + WS_QP), 2048, nullptr, 0, 0, 1.f};
            pg8::gemm_phase<pg8::EpiBf16<0>, pg8::StaticOrder, true, true>(Fq.lds, g, S, E, Fq.wave);
            REP_SYNC(); }
            SEAM(p0 + 6);
        }
        if (IN(p0 + 7)) { REPS(8) { Frame Fq = fresh_frame(F); ph_select(Fq, l); REP_SYNC(); } SEAM(p0 + 7); }
        if (IN(p0 + 8)) { REPS(9) { Frame Fq = fresh_frame(F); ph_g1(Fq, l); REP_SYNC(); } SEAM(p0 + 8); }
        if (IN(p0 + 9)) { REPS(10) { Frame Fq = fresh_frame(F); ph_g1b(Fq, l); REP_SYNC(); } SEAM(p0 + 9); }
        if (IN(p0 + 10)) { REPS(11) { Frame Fq = fresh_frame(F); { bf16* xo = rep_ == 0 ? (bf16*)(KWS + WS_QP) : (bf16*)(KWS + WS_XB); if (l + 1 >= DEPTH) ph_g2<true>(Fq, l, xo); else ph_g2<false>(Fq, l, xo); } REP_SYNC(); } SEAM(p0 + 10); }
    }
#undef IN
#undef SEAM
}

extern "C" void kernel_launch(void* const* d_in, const int* in_sizes, int n_in, void* d_out, int out_size, void* d_ws, size_t ws_size, hipStream_t stream) {
    static int grid = 0;
    if (grid == 0) {
        if (n_in != 21 || in_sizes[0] != MTOK * DM || out_size != MTOK * DM || ws_size < WS_END) {
            fprintf(stderr, "kernel_launch: unexpected shapes: n_in %d in0 %d out %d ws %zu (need %zu)\n", n_in, n_in > 0 ? in_sizes[0] : -1, out_size, ws_size, (size_t)WS_END); grid = -1; return; }
        int dev = 0, cus = 0, per_cu = 0;
        if (hipGetDevice(&dev) != hipSuccess || hipDeviceGetAttribute(&cus, hipDeviceAttributeMultiprocessorCount, dev) != hipSuccess) { grid = -1; return; }
        if (hipFuncSetAttribute((const void*)fwd_kernel, hipFuncAttributeMaxDynamicSharedMemorySize, LDS_BYTES) != hipSuccess) { fprintf(stderr, "kernel_launch: hipFuncSetAttribute failed\n"); grid = -1; return; }
        if (hipOccupancyMaxActiveBlocksPerMultiprocessor(&per_cu, (const void*)fwd_kernel, NWAVES * 64, LDS_BYTES) != hipSuccess || per_cu < 1) { fprintf(stderr, "kernel_launch: occupancy query says %d blocks per CU\n", per_cu); grid = -1; return; }
        (void)hipGetLastError();
        grid = cus & ~7;
    }
    if (grid < 0) return;
    if (hipMemsetAsync((char*)d_ws + WS_CTL, 0, CTL_ZERO_BYTES, stream) != hipSuccess) { fprintf(stderr, "kernel_launch: hipMemsetAsync failed\n"); return; }
    Args a{};
    for (int i = 0; i < 21; ++i) a.in[i] = d_in[i];
    a.out = (float*)d_out; a.ws = (unsigned char*)d_ws;
#if MK_ONE_LAUNCH
    a.ph_lo = 0; a.ph_hi = N_PHASES;
    void* args[] = {&a};
    hipError_t e = hipLaunchCooperativeKernel((const void*)fwd_kernel, dim3(grid), dim3(NWAVES * 64), args, LDS_BYTES, stream);
    if (e != hipSuccess) fprintf(stderr, "kernel_launch: cooperative launch failed: %s (grid %d)\n", hipGetErrorString(e), grid);
#else
    for (int p = 0; p < N_PHASES; ++p) {
        a.ph_lo = p; a.ph_hi = p + 1;
        hipLaunchKernelGGL(fwd_kernel, dim3(grid), dim3(NWAVES * 64), LDS_BYTES, stream, a);
    }
    hipError_t e = hipPeekAtLastError();
    if (e != hipSuccess) fprintf(stderr, "kernel_launch: launch failed: %s\n", hipGetErrorName(e));
#endif
}
```

```cpp
#include <hip/hip_runtime.h>
#include <hip/hip_cooperative_groups.h>
#include <cstdio>
#include <cstdint>
namespace cg = cooperative_groups;
namespace pg8 {
#define PG8_LAS __attribute__((address_space(3)))
typedef unsigned short bf16_t;
typedef short bf16x8 __attribute__((ext_vector_type(8)));
typedef float f32x4 __attribute__((ext_vector_type(4)));
typedef unsigned u32x4 __attribute__((ext_vector_type(4)));
constexpr int BM = 256, BK = 64, HALF = 128, HTB = HALF * BK * 2  , STAGE_BYTES = 8 * HTB, NXCD = 8, WGM = 8;

__host__ __device__ __forceinline__ int lds_byte(int r, int c) { const int st = (r >> 4) * 2 + (c >> 5), rr = r & 15, cc = c & 31, ob = rr * 64 + cc * 2; return st * 1024 + (ob ^ (((ob >> 9) & 1) << 5)); }
__host__ __device__ __forceinline__ void stage_rc(int b, int& R, int& C) { const int st = b / 1024, sb = b % 1024, swz = sb ^ (((sb >> 9) & 1) << 5); R = (st >> 1) * 16 + swz / 64; C = (st & 1) * 32 + (swz % 64) / 2; }
__host__ __device__ __forceinline__ int perm32(int rho) { const int n = rho >> 4, i = rho & 15; return 8 * (i >> 2) + 4 * n + (i & 3); }

struct Unit { int pm, pn; };
struct Gemm { const bf16_t* A; const bf16_t* Bt; int M, N, K; };

struct StaticOrder {
    int nM, nN, nwg, G, c;
    __host__ __device__ void init(int M, int N, int G_, int c_) { nM = M / BM; nN = N / BM; nwg = nM * nN; G = G_; c = c_; }
    __host__ __device__ bool next(int i, Unit& u) const {
        const long L = (long)i * G + c; if (L >= nwg) return false;
        int wgid = (int)L; { const int q = nwg / NXCD, r = nwg % NXCD, xcd = wgid % NXCD, off = wgid / NXCD; wgid = (xcd < r ? xcd * (q + 1) : r * (q + 1) + (xcd - r) * q) + off; }
        const int nig = WGM * nN, gid = wgid / nig, fm = gid * WGM, gsz = (nM - fm) < WGM ? (nM - fm) : WGM;
        u.pm = fm + ((wgid % nig) % gsz); u.pn = (wgid % nig) / gsz; return true;
    }
    __device__ __forceinline__ void a_ready(const Unit&) const {}
    __device__ __forceinline__ void done(const Unit&) const {}
};

__device__ __forceinline__ unsigned cvt_pk_bf16(float lo, float hi) { unsigned r; asm volatile("v_cvt_pk_bf16_f32 %0, %1, %2" : "=v"(r) : "v"(lo), "v"(hi)); return r; }
typedef float f32x2 __attribute__((ext_vector_type(2)));
__device__ __forceinline__ f32x2 gelu_pk(f32x2 v) {
    const f32x2 av = __builtin_elementwise_abs(v), d = av * 0.2316418882f + 1.0f;
    f32x2 t; t.x = __builtin_amdgcn_rcpf(d.x); t.y = __builtin_amdgcn_rcpf(d.y);
    f32x2 q = t * 0.5307027145f + (-0.7265760135f); q = q * t + 0.7107068705f; q = q * t + (-0.142248368f); q = q * t + 0.127414796f; q = q * t;
    const f32x2 s = (v * v) * (-0.72134752044f);
    f32x2 e; e.x = __builtin_amdgcn_exp2f(s.x); e.y = __builtin_amdgcn_exp2f(s.y);
    const f32x2 m = v * (q * e), r = v - m;
    f32x2 o; o.x = v.x < 0.f ? m.x : r.x; o.y = v.y < 0.f ? m.y : r.y; return o;
}

template <int ACT  > struct EpiBf16 {
    static constexpr bool PERM = true, AFTER_DRAIN = false; static_assert(ACT == 0 || ACT == 1, "EpiBf16: ACT is 0 (none) or 1 (gelu_pk)");
    bf16_t* O; int ldc; const float* bias; int split_cols; size_t split_stride; float scale0;
    __device__ __forceinline__ void operator()(const f32x4 (&acc)[2][2][4][2], const Unit& u, int wr, int wc, int fr, int fq) const {
        const int row0 = u.pm * BM + wr * 64 + fr; int colt = u.pn * BM; bf16_t* base = O;
        float sc = 1.f; if (split_cols) { const int t = colt / split_cols; base += (size_t)t * split_stride; colt -= t * split_cols; if (t == 0) sc = scale0; }
        const int col0 = colt + wc * 32 + 8 * fq, bcol0 = u.pn * BM + wc * 32 + 8 * fq;
        f32x4 bv[2][2];
#pragma unroll
        for (int bj = 0; bj < 2; ++bj)
#pragma unroll
            for (int n = 0; n < 2; ++n) bv[bj][n] = bias ? *(const f32x4*)(bias + bcol0 + bj * HALF + 4 * n) : (f32x4){0.f, 0.f, 0.f, 0.f};
#pragma unroll
        for (int ai = 0; ai < 2; ++ai)
#pragma unroll
            for (int m = 0; m < 4; ++m) { bf16_t* rowp = base + (size_t)(row0 + ai * HALF + m * 16) * ldc + col0;
#pragma unroll
                for (int bj = 0; bj < 2; ++bj) { f32x4 v0 = acc[ai][bj][m][0] + bv[bj][0], v1 = acc[ai][bj][m][1] + bv[bj][1];
                    if (ACT == 1) { f32x2 a = gelu_pk((f32x2){v0[0], v0[1]}), b = gelu_pk((f32x2){v0[2], v0[3]}), c = gelu_pk((f32x2){v1[0], v1[1]}), d = gelu_pk((f32x2){v1[2], v1[3]});
                        v0 = (f32x4){a.x, a.y, b.x, b.y}; v1 = (f32x4){c.x, c.y, d.x, d.y}; }
                    v0 = v0 * sc; v1 = v1 * sc; u32x4 w; w.x = cvt_pk_bf16(v0[0], v0[1]); w.y = cvt_pk_bf16(v0[2], v0[3]); w.z = cvt_pk_bf16(v1[0], v1[1]); w.w = cvt_pk_bf16(v1[2], v1[3]);
                    *(u32x4*)(rowp + bj * HALF) = w; } }
    }
};
__device__ __forceinline__ int fresh_lane() { int l; asm volatile("v_mbcnt_lo_u32_b32 %0, -1, 0\n\tv_mbcnt_hi_u32_b32 %0, -1, %0" : "=v"(l)); return l; }
__device__ __forceinline__ float bflo(unsigned w) { return __builtin_bit_cast(float, w << 16); }
__device__ __forceinline__ float bfhi(unsigned w) { return __builtin_bit_cast(float, w & 0xffff0000u); }
__device__ __forceinline__ float sigmoid_f(float x) { return __builtin_amdgcn_rcpf(1.0f + __builtin_amdgcn_exp2f(-1.4426950408889634f * x)); }

struct EpiIn {
    static constexpr bool PERM = true, AFTER_DRAIN = false;
    bf16_t* gates; const float* gbias; bf16_t* cq; bf16_t* ckv; bf16_t* kpep; const float* ssqn; float* ssqc; const int* pos;
    __device__ __forceinline__ void operator()(const f32x4 (&acc)[2][2][4][2], const Unit& u, int wr, int wc, int fr, int fq) const {
        const int row0 = u.pm * BM + wr * 64 + fr;
        float rs[2][4];
#pragma unroll
        for (int ai = 0; ai < 2; ++ai)
#pragma unroll
            for (int m = 0; m < 4; ++m) { const f32x4* sp = (const f32x4*)(ssqn + (size_t)(row0 + ai * HALF + m * 16) * 8); const f32x4 a = sp[0], b = sp[1];
                rs[ai][m] = 1.0f / sqrtf(((a[0] + a[1]) + (a[2] + a[3]) + (b[0] + b[1]) + (b[2] + b[3])) * (1.0f / 1024.0f) + 1e-6f); }
#pragma unroll
        for (int bj = 0; bj < 2; ++bj) {
            const int colw = u.pn * BM + bj * HALF + wc * 32;
            bf16_t* dst; int ld; bool gate = false;
            if (colw < 2048) { dst = gates + colw; ld = 2048; gate = true; }
            else { const int pc = colw - 2048;
                if (pc < 384) { dst = cq + pc; ld = 384; }
                else if (pc < 640) { dst = ckv + (pc - 384); ld = 256; }
                else if (pc < 1184) { dst = kpep + (pc - 640); ld = 544; }
                else continue; }
            dst += 8 * fq;
            f32x4 b0 = (f32x4){0.f, 0.f, 0.f, 0.f}, b1 = b0;
            if (gate) { b0 = *(const f32x4*)(gbias + colw + 8 * fq); b1 = *(const f32x4*)(gbias + colw + 8 * fq + 4); }
#pragma unroll
            for (int ai = 0; ai < 2; ++ai)
#pragma unroll
                for (int m = 0; m < 4; ++m) {
                    f32x4 v0 = acc[ai][bj][m][0] * rs[ai][m] + b0, v1 = acc[ai][bj][m][1] * rs[ai][m] + b1;
                    if (gate) {
#pragma unroll
                        for (int j = 0; j < 4; ++j) { v0[j] = sigmoid_f(v0[j]); v1[j] = sigmoid_f(v1[j]); }
                    }
                    if (gate) {
                        typedef unsigned u32x2g __attribute__((ext_vector_type(2)));
                        u32x2g w;
                        w.x = (unsigned)(v0[0] * 255.0f + 0.5f) | ((unsigned)(v0[1] * 255.0f + 0.5f) << 8) | ((unsigned)(v0[2] * 255.0f + 0.5f) << 16) | ((unsigned)(v0[3] * 255.0f + 0.5f) << 24);
                        w.y = (unsigned)(v1[0] * 255.0f + 0.5f) | ((unsigned)(v1[1] * 255.0f + 0.5f) << 8) | ((unsigned)(v1[2] * 255.0f + 0.5f) << 16) | ((unsigned)(v1[3] * 255.0f + 0.5f) << 24);
                        *(u32x2g*)((unsigned char*)gates + (size_t)(row0 + ai * HALF + m * 16) * 2048 + colw + 8 * fq) = w;
                    } else {
                    const int pc = colw - 2048;
                    if (pc <= 640) {
                        float s = (v0[0] * v0[0] + v0[1] * v0[1]) + (v0[2] * v0[2] + v0[3] * v0[3]) + (v1[0] * v1[0] + v1[1] * v1[1]) + (v1[2] * v1[2] + v1[3] * v1[3]);
                        s += __int_as_float(__builtin_amdgcn_ds_swizzle(__float_as_int(s), 0x401F));
                    { unsigned r0_ = __float_as_uint(s), r1_ = r0_;
#if __has_builtin(__builtin_amdgcn_permlane32_swap)
                      auto r_ = __builtin_amdgcn_permlane32_swap(r0_, r1_, false, false); r0_ = r_[0]; r1_ = r_[1];
#else
                      asm volatile("v_permlane32_swap_b32 %0, %1" : "+v"(r0_), "+v"(r1_));
#endif
                      asm volatile("" : "+v"(r0_), "+v"(r1_));
                      s = __uint_as_float(r0_) + __uint_as_float(r1_); }
                        if (fq == 0) ssqc[(size_t)(row0 + ai * HALF + m * 16) * 24 + (pc >> 5)] = s;
                    }
                    if (pc == 640) {
                        const float p = (float)pos[row0 + ai * HALF + m * 16];
                        float x[8] = {v0[0], v0[1], v0[2], v0[3], v1[0], v1[1], v1[2], v1[3]};
#pragma unroll
                        for (int e8 = 0; e8 < 8; ++e8) {
                            const float other = __shfl_xor(x[e8], 32);
                            const float ang = p * __builtin_amdgcn_exp2f(-(float)(8 * (fq & 1) + e8) * 0.8304820237218406f);
                            const float nn = rintf(ang * 0.15915494309189535f);
                            float r = fmaf(-nn, 6.28318548202514648f, ang); r = fmaf(-nn, -1.7484556e-7f, r); r *= 0.15915494309189535f;
                            const float sn = __builtin_amdgcn_sinf(r), cs = __builtin_amdgcn_cosf(r);
                            x[e8] = (fq < 2) ? x[e8] * cs - other * sn : other * sn + x[e8] * cs;
                        }
                        v0 = (f32x4){x[0], x[1], x[2], x[3]}; v1 = (f32x4){x[4], x[5], x[6], x[7]};
                    }
                    u32x4 w; w.x = cvt_pk_bf16(v0[0], v0[1]); w.y = cvt_pk_bf16(v0[2], v0[3]); w.z = cvt_pk_bf16(v1[0], v1[1]); w.w = cvt_pk_bf16(v1[2], v1[3]);
                    *(u32x4*)(dst + (size_t)(row0 + ai * HALF + m * 16) * ld) = w; }
                }
        }
    }
};

struct EpiKV {
    static constexpr bool PERM = true, AFTER_DRAIN = false;
    bf16_t* K; bf16_t* V; const bf16_t* kpep; const float* ssqc; const float* gk;
    __device__ __forceinline__ void operator()(const f32x4 (&acc)[2][2][4][2], const Unit& u, int wr, int wc, int fr, int fq) const {
        { const int ln = fresh_lane(); fr = ln & 15; fq = ln >> 4; }
        const int row0 = u.pm * BM + wr * 64 + fr, head = 2 * u.pn + (wc >> 1);
        const bool isk = (wc & 1) == 0;
#pragma unroll
        for (int ai = 0; ai < 2; ++ai)
#pragma unroll
            for (int m = 0; m < 4; ++m) {
                __builtin_amdgcn_sched_barrier(0);
                const size_t row = (size_t)(row0 + ai * HALF + m * 16);
                const f32x4* sp = (const f32x4*)(ssqc + row * 24);
                const f32x4 sa = sp[3], sb = sp[4];
                const float rkv = 16.0f * __builtin_amdgcn_rsqf(((sa[0] + sa[1]) + (sa[2] + sa[3]) + (sb[0] + sb[1]) + (sb[2] + sb[3])) + 256e-6f);
                const f32x4 a0 = acc[ai][0][m][0], a1 = acc[ai][0][m][1], b0 = acc[ai][1][m][0], b1 = acc[ai][1][m][1];
                if (isk) {
                    float s = (a0[0] * a0[0] + a0[1] * a0[1]) + (a0[2] * a0[2] + a0[3] * a0[3]) + (a1[0] * a1[0] + a1[1] * a1[1]) + (a1[2] * a1[2] + a1[3] * a1[3])
                            + (b0[0] * b0[0] + b0[1] * b0[1]) + (b0[2] * b0[2] + b0[3] * b0[3]) + (b1[0] * b1[0] + b1[1] * b1[1]) + (b1[2] * b1[2] + b1[3] * b1[3]);
                    s += __int_as_float(__builtin_amdgcn_ds_swizzle(__float_as_int(s), 0x401F));
                    { unsigned r0_ = __float_as_uint(s), r1_ = r0_;
#if __has_builtin(__builtin_amdgcn_permlane32_swap)
                      auto r_ = __builtin_amdgcn_permlane32_swap(r0_, r1_, false, false); r0_ = r_[0]; r1_ = r_[1];
#else
                      asm volatile("v_permlane32_swap_b32 %0, %1" : "+v"(r0_), "+v"(r1_));
#endif
                      asm volatile("" : "+v"(r0_), "+v"(r1_));
                      s = __uint_as_float(r0_) + __uint_as_float(r1_); }
                    const float sspe = ssqc[row * 24 + 20];
                    const float rn = 9.797958971f * __builtin_amdgcn_rsqf((rkv * rkv * s + sspe) + 96e-6f), sc = rkv * rn;
                    bf16_t* kp = K + (row * 8 + head) * 96 + 8 * fq;
                    { asm volatile("" ::: "memory"); const f32x4 ga = *(const f32x4*)(gk + 8 * fq), gb = *(const f32x4*)(gk + 8 * fq + 4);
                      u32x4 w; w.x = cvt_pk_bf16(a0[0] * sc * ga[0], a0[1] * sc * ga[1]); w.y = cvt_pk_bf16(a0[2] * sc * ga[2], a0[3] * sc * ga[3]);
                      w.z = cvt_pk_bf16(a1[0] * sc * gb[0], a1[1] * sc * gb[1]); w.w = cvt_pk_bf16(a1[2] * sc * gb[2], a1[3] * sc * gb[3]);
                      *(u32x4*)(kp) = w; }
                    { asm volatile("" ::: "memory"); const f32x4 ga = *(const f32x4*)(gk + 32 + 8 * fq), gb = *(const f32x4*)(gk + 32 + 8 * fq + 4);
                      u32x4 w; w.x = cvt_pk_bf16(b0[0] * sc * ga[0], b0[1] * sc * ga[1]); w.y = cvt_pk_bf16(b0[2] * sc * ga[2], b0[3] * sc * ga[3]);
                      w.z = cvt_pk_bf16(b1[0] * sc * gb[0], b1[1] * sc * gb[1]); w.w = cvt_pk_bf16(b1[2] * sc * gb[2], b1[3] * sc * gb[3]);
                      *(u32x4*)(kp + 32) = w; }
                    { asm volatile("" ::: "memory"); const f32x4 ga = *(const f32x4*)(gk + 64 + 8 * fq), gb = *(const f32x4*)(gk + 64 + 8 * fq + 4);
                      const u32x4 pe = *(const u32x4*)(kpep + row * 544 + 8 * fq);
                      u32x4 w; w.x = cvt_pk_bf16(bflo(pe.x) * rn * ga[0], bfhi(pe.x) * rn * ga[1]); w.y = cvt_pk_bf16(bflo(pe.y) * rn * ga[2], bfhi(pe.y) * rn * ga[3]);
                      w.z = cvt_pk_bf16(bflo(pe.z) * rn * gb[0], bfhi(pe.z) * rn * gb[1]); w.w = cvt_pk_bf16(bflo(pe.w) * rn * gb[2], bfhi(pe.w) * rn * gb[3]);
                      *(u32x4*)(kp + 64) = w; }
                } else {
                    bf16_t* vp = V + (row * 8 + head) * 64 + 8 * fq;
                    u32x4 w; w.x = cvt_pk_bf16(a0[0] * rkv, a0[1] * rkv); w.y = cvt_pk_bf16(a0[2] * rkv, a0[3] * rkv); w.z = cvt_pk_bf16(a1[0] * rkv, a1[1] * rkv); w.w = cvt_pk_bf16(a1[2] * rkv, a1[3] * rkv);
                    *(u32x4*)(vp) = w;
                    w.x = cvt_pk_bf16(b0[0] * rkv, b0[1] * rkv); w.y = cvt_pk_bf16(b0[2] * rkv, b0[3] * rkv); w.z = cvt_pk_bf16(b1[0] * rkv, b1[1] * rkv); w.w = cvt_pk_bf16(b1[2] * rkv, b1[3] * rkv);
                    *(u32x4*)(vp + 32) = w;
                }
            }
    }
};

struct EpiMix {
    static constexpr bool PERM = true, AFTER_DRAIN = false;
    const bf16_t* a; const bf16_t* gates; bf16_t* mix;
    __device__ __forceinline__ void operator()(const f32x4 (&acc)[2][2][4][2], const Unit& u, int wr, int wc, int fr, int fq) const {
        const int row0 = u.pm * BM + wr * 64 + fr, col0 = u.pn * BM + wc * 32 + 8 * fq;
#pragma unroll
        for (int ai = 0; ai < 2; ++ai)
#pragma unroll
            for (int m = 0; m < 4; ++m) {
                const size_t row = (size_t)(row0 + ai * HALF + m * 16);
#pragma unroll
                for (int bj = 0; bj < 2; ++bj) {
                    const int c = col0 + bj * HALF;
                    const u32x4 av = *(const u32x4*)(a + row * 1024 + c);
                    typedef unsigned u32x2g __attribute__((ext_vector_type(2)));
                    const u32x2g g0 = *(const u32x2g*)((const unsigned char*)gates + row * 2048 + c);
                    const u32x2g g1 = *(const u32x2g*)((const unsigned char*)gates + row * 2048 + 1024 + c);
                    const float k = 1.0f / 255.0f;
                    const f32x4 v0 = acc[ai][bj][m][0] * k, v1 = acc[ai][bj][m][1] * k;
#define GB(W, B) ((float)(((W) >> (8 * (B))) & 0xffu))
                    u32x4 w;
                    w.x = cvt_pk_bf16(GB(g0.x, 0) * k * bflo(av.x) + GB(g1.x, 0) * v0[0], GB(g0.x, 1) * k * bfhi(av.x) + GB(g1.x, 1) * v0[1]);
                    w.y = cvt_pk_bf16(GB(g0.x, 2) * k * bflo(av.y) + GB(g1.x, 2) * v0[2], GB(g0.x, 3) * k * bfhi(av.y) + GB(g1.x, 3) * v0[3]);
                    w.z = cvt_pk_bf16(GB(g0.y, 0) * k * bflo(av.z) + GB(g1.y, 0) * v1[0], GB(g0.y, 1) * k * bfhi(av.z) + GB(g1.y, 1) * v1[1]);
                    w.w = cvt_pk_bf16(GB(g0.y, 2) * k * bflo(av.w) + GB(g1.y, 2) * v1[2], GB(g0.y, 3) * k * bfhi(av.w) + GB(g1.y, 3) * v1[3]);
#undef GB
                    *(u32x4*)(mix + row * 1024 + c) = w;
                }
            }
    }
};

struct EpiRes {
    static constexpr bool PERM = false, AFTER_DRAIN = false;
    const bf16_t* xin; bf16_t* xout; float* ssq;
    __device__ __forceinline__ void operator()(const f32x4 (&acc)[2][2][4][2], const Unit& u, int wr, int wc, int fr, int fq) const {
        const int row0 = u.pm * BM + wr * 64 + fr, col0 = u.pn * BM + wc * 32 + 4 * fq;
        typedef unsigned u32x2 __attribute__((ext_vector_type(2)));
#pragma unroll
        for (int ai = 0; ai < 2; ++ai)
#pragma unroll
            for (int m = 0; m < 4; ++m) {
                const size_t row = (size_t)(row0 + ai * HALF + m * 16); float s = 0.f;
#pragma unroll
                for (int bj = 0; bj < 2; ++bj)
#pragma unroll
                    for (int n = 0; n < 2; ++n) {
                        const size_t off = row * 1024 + col0 + bj * HALF + n * 16;
                        const u32x2 xi = *(const u32x2*)(xin + off);
                        const f32x4 xo = (f32x4){bflo(xi.x), bfhi(xi.x), bflo(xi.y), bfhi(xi.y)} + acc[ai][bj][m][n];
                        s += (xo[0] * xo[0] + xo[1] * xo[1]) + (xo[2] * xo[2] + xo[3] * xo[3]);
                        u32x2 w; w.x = cvt_pk_bf16(xo[0], xo[1]); w.y = cvt_pk_bf16(xo[2], xo[3]);
                        *(u32x2*)(xout + off) = w;
                    }
                s += __int_as_float(__builtin_amdgcn_ds_swizzle(__float_as_int(s), 0x401F));
                    { unsigned r0_ = __float_as_uint(s), r1_ = r0_;
#if __has_builtin(__builtin_amdgcn_permlane32_swap)
                      auto r_ = __builtin_amdgcn_permlane32_swap(r0_, r1_, false, false); r0_ = r_[0]; r1_ = r_[1];
#else
                      asm volatile("v_permlane32_swap_b32 %0, %1" : "+v"(r0_), "+v"(r1_));
#endif
                      asm volatile("" : "+v"(r0_), "+v"(r1_));
                      s = __uint_as_float(r0_) + __uint_as_float(r1_); }
                if (fq == 0) ssq[row * 16 + u.pn * 4 + wc] = s;
            }
    }
};
template <class Epi, class Sched, bool ALIGN_EPI = false, bool SP2 = false>
__device__ __forceinline__ void gemm_phase(PG8_LAS unsigned char* lds, const Gemm g, const Sched& S, const Epi& E, const int wave_id) {
    const int wid = wave_id, lane = fresh_lane(), tid = (wid << 6) | lane, wr = wid >> 2, wc = wid & 3, fr = lane & 15, fq = lane >> 4;
    const int K = g.K, nt = K / BK;
    unsigned voffA[2], voffB[2];
#pragma unroll
    for (int i = 0; i < 2; ++i) { int R, C; stage_rc(tid * 16 + i * 8192, R, C); const int Rb = Epi::PERM ? ((R & ~31) + perm32(R & 31)) : R;
        voffA[i] = (unsigned)(R * K + C) * 2u; voffB[i] = (unsigned)(Rb * K + C) * 2u; }
    const size_t kstep = (size_t)(BK * 2);
    const size_t hstep = (size_t)HALF * K * 2;
    const size_t tstep = 2 * hstep;
    const unsigned ldsw = (unsigned)wid * 1024u;
    const int aoff = lds_byte(wr * 64 + fr, fq * 8), boff = lds_byte(wc * 32 + fr, fq * 8);
#define PG8_SA(b, h) (((b) * 2 + (h)) * HTB)
#define PG8_SB(b, h) ((4 + (b) * 2 + (h)) * HTB)
#define PG8_STAGE(bufoff, gbase, voff) do { _Pragma("unroll") for (int _i = 0; _i < 2; ++_i) \
        __builtin_amdgcn_global_load_lds((const unsigned*)((const char*)(gbase) + (voff)[_i]), (PG8_LAS unsigned*)(lds + (bufoff) + ldsw + _i * 8192), 16, 0, 0); } while (0)
#define PG8_LDA(dst, b, h) do { _Pragma("unroll") for (int m = 0; m < 4; ++m) _Pragma("unroll") for (int k = 0; k < 2; ++k) dst[m][k] = *(const PG8_LAS bf16x8*)(lds + PG8_SA(b, h) + aoff + m * 2048 + k * 1024); } while (0)
#define PG8_LDB(dst, b, h) do { _Pragma("unroll") for (int n = 0; n < 2; ++n) _Pragma("unroll") for (int k = 0; k < 2; ++k) dst[n][k] = *(const PG8_LAS bf16x8*)(lds + PG8_SB(b, h) + boff + n * 2048 + k * 1024); } while (0)
#define PG8_MMA(ai, bj, At, Bt) do { __builtin_amdgcn_s_setprio(1); _Pragma("unroll") for (int m = 0; m < 4; ++m) _Pragma("unroll") for (int n = 0; n < 2; ++n) _Pragma("unroll") for (int k = 0; k < 2; ++k) \
        acc[ai][bj][m][n] = __builtin_amdgcn_mfma_f32_16x16x32_bf16(Bt[n][k], At[m][k], acc[ai][bj][m][n], 0, 0, 0); __builtin_amdgcn_s_setprio(0); } while (0)
#define PG8_WAIT_V(n) asm volatile("s_waitcnt vmcnt(" #n ")" ::: "memory")
#define PG8_WAIT_L(n) asm volatile("s_waitcnt lgkmcnt(" #n ")" ::: "memory")
#define PG8_BAR __builtin_amdgcn_s_barrier()
#define PG8_SCHED __builtin_amdgcn_sched_barrier(0)
    Unit cur, nxt; int ui = 0;
    if (!S.next(0, cur)) return;
    f32x4 acc[2][2][4][2];
#pragma unroll
    for (int a = 0; a < 2; ++a)
#pragma unroll
        for (int b = 0; b < 2; ++b)
#pragma unroll
            for (int m = 0; m < 4; ++m)
#pragma unroll
                for (int n = 0; n < 2; ++n) acc[a][b][m][n] = (f32x4){0.f, 0.f, 0.f, 0.f};
    bf16x8 At[4][2], B0[2][2], B1[2][2];
    const char* cA = (const char*)g.A + (size_t)cur.pm * tstep; const char* cB = (const char*)g.Bt + (size_t)cur.pn * tstep;
    S.a_ready(cur);
    if constexpr (SP2) {
        PG8_STAGE(PG8_SB(0, 0), cB, voffB); PG8_STAGE(PG8_SB(0, 1), cB + hstep, voffB); PG8_STAGE(PG8_SA(0, 0), cA, voffA); PG8_STAGE(PG8_SA(0, 1), cA + hstep, voffA);
        if (wr == 1) PG8_BAR;
        PG8_WAIT_V(2); PG8_BAR;
        PG8_STAGE(PG8_SB(1, 0), cB + kstep, voffB); PG8_STAGE(PG8_SA(1, 0), cA + kstep, voffA); PG8_STAGE(PG8_SB(1, 1), cB + hstep + kstep, voffB);
        PG8_WAIT_V(6); PG8_BAR;
    } else {
        PG8_STAGE(PG8_SB(0, 0), cB, voffB); PG8_STAGE(PG8_SA(0, 0), cA, voffA); PG8_STAGE(PG8_SB(0, 1), cB + hstep, voffB); PG8_STAGE(PG8_SA(0, 1), cA + hstep, voffA);
        if (wr == 1) PG8_BAR;
        PG8_WAIT_V(4); PG8_BAR;
        PG8_STAGE(PG8_SB(1, 0), cB + kstep, voffB); PG8_STAGE(PG8_SA(1, 0), cA + kstep, voffA); PG8_STAGE(PG8_SB(1, 1), cB + hstep + kstep, voffB);
        PG8_WAIT_V(6); PG8_BAR;
    }
    for (;;) {
        const bool has_next = S.next(ui + 1, nxt);
        const char* nA = has_next ? (const char*)g.A + (size_t)nxt.pm * tstep : cA; const char* nB = has_next ? (const char*)g.Bt + (size_t)nxt.pn * tstep : cB;
        for (int t = 0; t < nt; t += 2) {
            const bool last = (t == nt - 2);
            const char* a1 = cA + (size_t)(t + 1) * kstep;
            const char* a2 = last ? nA : cA + (size_t)(t + 2) * kstep; const char* b2 = last ? nB : cB + (size_t)(t + 2) * kstep;
            const char* a3 = a2 + kstep; const char* b3 = b2 + kstep;
            if (last && has_next) S.a_ready(nxt);
            if constexpr (SP2) {
            PG8_LDB(B0, 0, 0); PG8_LDB(B1, 0, 1); PG8_SCHED; PG8_LDA(At, 0, 0); PG8_STAGE(PG8_SA(1, 1), a1 + hstep, voffA);
            PG8_WAIT_V(8); PG8_WAIT_L(0); PG8_BAR; PG8_MMA(0, 0, At, B0); PG8_MMA(0, 1, At, B1); PG8_BAR; PG8_SCHED;
            PG8_LDA(At, 0, 1); PG8_STAGE(PG8_SB(0, 0), b2, voffB); PG8_STAGE(PG8_SB(0, 1), b2 + hstep, voffB); PG8_STAGE(PG8_SA(0, 0), a2, voffA);
            PG8_WAIT_V(8); PG8_WAIT_L(0); PG8_BAR; PG8_MMA(1, 0, At, B0); PG8_MMA(1, 1, At, B1); PG8_BAR; PG8_SCHED;
            PG8_LDB(B0, 1, 0); PG8_LDB(B1, 1, 1); PG8_SCHED; PG8_LDA(At, 1, 0); PG8_STAGE(PG8_SA(0, 1), a2 + hstep, voffA);
            PG8_WAIT_V(8); PG8_WAIT_L(0); PG8_BAR; PG8_MMA(0, 0, At, B0); PG8_MMA(0, 1, At, B1); PG8_BAR; PG8_SCHED;
            PG8_LDA(At, 1, 1); PG8_STAGE(PG8_SB(1, 0), b3, voffB); PG8_STAGE(PG8_SB(1, 1), b3 + hstep, voffB); PG8_STAGE(PG8_SA(1, 0), a3, voffA);
            PG8_WAIT_V(8); PG8_WAIT_L(0); PG8_BAR; PG8_MMA(1, 0, At, B0); PG8_MMA(1, 1, At, B1); PG8_BAR; PG8_SCHED;
            } else {
            PG8_LDB(B0, 0, 0); PG8_SCHED; PG8_LDA(At, 0, 0); PG8_STAGE(PG8_SA(1, 1), a1 + hstep, voffA);
            PG8_WAIT_L(8); PG8_BAR; PG8_WAIT_L(0); PG8_MMA(0, 0, At, B0); PG8_BAR; PG8_SCHED;
            PG8_LDB(B1, 0, 1); PG8_STAGE(PG8_SB(0, 0), b2, voffB);
            PG8_BAR; PG8_WAIT_L(0); PG8_MMA(0, 1, At, B1); PG8_BAR;
            PG8_LDA(At, 0, 1); PG8_STAGE(PG8_SA(0, 0), a2, voffA);
            PG8_BAR; PG8_WAIT_L(0); PG8_MMA(1, 0, At, B0); PG8_BAR; PG8_SCHED;
            PG8_STAGE(PG8_SB(0, 1), b2 + hstep, voffB);
            PG8_WAIT_V(6); PG8_BAR; PG8_MMA(1, 1, At, B1); PG8_BAR;
            PG8_LDB(B0, 1, 0); PG8_SCHED; PG8_LDA(At, 1, 0); PG8_STAGE(PG8_SA(0, 1), a2 + hstep, voffA);
            PG8_WAIT_L(8); PG8_BAR; PG8_WAIT_L(0); PG8_MMA(0, 0, At, B0); PG8_BAR; PG8_SCHED;
            PG8_LDB(B1, 1, 1); PG8_STAGE(PG8_SB(1, 0), b3, voffB);
            PG8_BAR; PG8_WAIT_L(0); PG8_MMA(0, 1, At, B1); PG8_BAR;
            PG8_LDA(At, 1, 1); PG8_STAGE(PG8_SA(1, 0), a3, voffA);
            PG8_BAR; PG8_WAIT_L(0); PG8_MMA(1, 0, At, B0); PG8_BAR; PG8_SCHED;
            PG8_STAGE(PG8_SB(1, 1), b3 + hstep, voffB);
            PG8_WAIT_V(6); PG8_BAR; PG8_MMA(1, 1, At, B1); PG8_BAR;
            }
        }
        if constexpr (ALIGN_EPI) { if (wr == 0) PG8_BAR; }
        if constexpr (!Epi::AFTER_DRAIN) { E(acc, cur, wr, wc, fr, fq); S.done(cur); }
        if (!has_next) break;
#pragma unroll
        for (int a = 0; a < 2; ++a)
#pragma unroll
            for (int b = 0; b < 2; ++b)
#pragma unroll
                for (int m = 0; m < 4; ++m)
#pragma unroll
                    for (int n = 0; n < 2; ++n) acc[a][b][m][n] = (f32x4){0.f, 0.f, 0.f, 0.f};
        cur = nxt; cA = nA; cB = nB; ++ui;
        if constexpr (ALIGN_EPI) { if (wr == 1) PG8_BAR; }
    }
    PG8_WAIT_V(0);
    if constexpr (!ALIGN_EPI) { if (wr == 0) PG8_BAR; }
    PG8_BAR;
    if constexpr (Epi::AFTER_DRAIN) { E.fused(acc, cur, wr, wc, fr, fq, lds, wid, lane); S.done(cur); }
#undef PG8_SA
#undef PG8_SB
#undef PG8_STAGE
#undef PG8_LDA
#undef PG8_LDB
#undef PG8_MMA
#undef PG8_WAIT_V
#undef PG8_WAIT_L
#undef PG8_BAR
#undef PG8_SCHED
}
}
namespace att {
typedef unsigned short bf16;
using bf16x8 = __attribute__((ext_vector_type(8))) short;
using s16x4  = __attribute__((ext_vector_type(4))) short;
using f32x16 = __attribute__((ext_vector_type(16))) float;
using u32x4  = __attribute__((ext_vector_type(4))) unsigned;
constexpr int   DQ = 96, DV = 64, NW = 8, QBLK = 32, KVBLK = 64;
constexpr int   ND0 = DQ / 16;
constexpr int   NDV = DV / 32;
constexpr float SCALE = 0.10206207261596575f;
constexpr float THR = 8.f;
constexpr int   LDQ = 768, LDK = 768, LDV = 512, LDO = 512;
constexpr size_t SHM_V = KVBLK * 128 * 2, SHM_K = KVBLK * 128 * 2, SHM_ATTN = 2 * SHM_V + 2 * SHM_K + NW * 64 * 4;
#define KSWZ(row, colB) ((row) * 256 + ((colB) ^ (((row) & 7) << 4)))
#define SBAR() __builtin_amdgcn_sched_barrier(0)
__device__ __forceinline__ int crow(int r, int hi) { return (r & 3) + 8 * (r >> 2) + 4 * hi; }
__device__ __forceinline__ unsigned cvtpk(float lo, float hi) { unsigned r; asm volatile("v_cvt_pk_bf16_f32 %0, %1, %2" : "=v"(r) : "v"(lo), "v"(hi)); return r; }

__device__ __forceinline__ void partialSM(f32x16& p0, f32x16& p1, float& m_reg, float& mn, float& alpha) {
  constexpr float C = SCALE * 1.4426950408889634f;
  float pmax = p0[0];
#pragma unroll
  for (int r = 1; r < 16; ++r) pmax = fmaxf(pmax, p0[r]);
#pragma unroll
  for (int r = 0; r < 16; ++r) pmax = fmaxf(pmax, p1[r]);
  { auto rr = __builtin_amdgcn_permlane32_swap(__float_as_uint(pmax), __float_as_uint(pmax), false, false);
    pmax = fmaxf(__uint_as_float(rr[0]), __uint_as_float(rr[1])); }
  if (__builtin_expect(__all(pmax - m_reg <= THR / SCALE), 1)) { mn = m_reg; alpha = 1.f; }
  else { mn = fmaxf(m_reg, pmax); alpha = __builtin_amdgcn_exp2f((m_reg - mn) * C); m_reg = mn; }
  float mnC = -mn * C;
#pragma unroll
  for (int r = 0; r < 16; ++r) p0[r] = fmaf(p0[r], C, mnC);
#pragma unroll
  for (int r = 0; r < 16; ++r) p1[r] = fmaf(p1[r], C, mnC);
#pragma unroll
  for (int r = 0; r < 16; ++r) p0[r] = __builtin_amdgcn_exp2f(p0[r]);
}
__device__ __forceinline__ void finishSM(f32x16& p0, f32x16& p1, float alpha, float& l_reg, bf16x8& pa0, bf16x8& pa1, bf16x8& pa2, bf16x8& pa3) {
#pragma unroll
  for (int r = 0; r < 16; ++r) p1[r] = __builtin_amdgcn_exp2f(p1[r]);
  float ps = 0;
#pragma unroll
  for (int r = 0; r < 16; ++r) ps += p0[r];
#pragma unroll
  for (int r = 0; r < 16; ++r) ps += p1[r];
  { auto rr = __builtin_amdgcn_permlane32_swap(__float_as_uint(ps), __float_as_uint(ps), false, false);
    ps = __uint_as_float(rr[0]) + __uint_as_float(rr[1]); }
  l_reg = l_reg * alpha + ps;
#define PK4(P, BASE, OUT) do { unsigned a0 = cvtpk(P[BASE + 0], P[BASE + 1]), a1 = cvtpk(P[BASE + 2], P[BASE + 3]);   \
    unsigned b0 = cvtpk(P[BASE + 4], P[BASE + 5]), b1 = cvtpk(P[BASE + 6], P[BASE + 7]);                              \
    auto r0 = __builtin_amdgcn_permlane32_swap(a0, b0, false, false); auto r1 = __builtin_amdgcn_permlane32_swap(a1, b1, false, false); \
    u32x4 w = {r0[0], r1[0], r0[1], r1[1]}; OUT = *reinterpret_cast<bf16x8*>(&w); } while (0)
  PK4(p0, 0, pa0); PK4(p0, 8, pa1); PK4(p1, 0, pa2); PK4(p1, 8, pa3);
#undef PK4
}
__device__ __forceinline__ void qkt(f32x16& p0, f32x16& p1, const bf16* Ks, const bf16x8* qr, int r32, int hi) {
  p0 = f32x16{}; p1 = f32x16{};
#pragma unroll
  for (int d0 = 0; d0 < ND0; ++d0) { int cb = (d0 * 16 + hi * 8) * 2;
    bf16x8 b0 = *reinterpret_cast<const bf16x8*>((const char*)Ks + KSWZ(r32, cb));
    bf16x8 b1 = *reinterpret_cast<const bf16x8*>((const char*)Ks + KSWZ(32 + r32, cb));
    p0 = __builtin_amdgcn_mfma_f32_32x32x16_bf16(b0, qr[d0], p0, 0, 0, 0);
    p1 = __builtin_amdgcn_mfma_f32_32x32x16_bf16(b1, qr[d0], p1, 0, 0, 0); }
}
__device__ __forceinline__ int v_st(int k, int c) { const int kk = (k & ~0xC) | ((k & 4) << 1) | ((k & 8) >> 1); return ((kk >> 3) * 4 + (c >> 5)) * 512 + ((kk & 7) * 32 + (c & 31)) * 2; }
__device__ __forceinline__ int v_rd_base(int lane) { return ((lane & 3) << 3) | (((lane >> 2) & 3) << 6) | (((lane >> 4) & 1) << 5) | (((lane >> 5) & 1) << 8); }
constexpr int v_rd_off(int d0, int ks, int half) { return d0 * 512 + ks * 4096 + half * 2048; }
template <int OFF> __device__ __forceinline__ s16x4 tr_read(int vb) {
  s16x4 r; asm volatile("ds_read_b64_tr_b16 %0, %1 offset:%2" : "=&v"(r) : "v"(vb), "i"(OFF) : "memory"); return r;
}
template <int D0> __device__ __forceinline__ void pv_one(f32x16& od, int vb, bf16x8 pa0, bf16x8 pa1, bf16x8 pa2, bf16x8 pa3) {
  const s16x4 l0 = tr_read<v_rd_off(D0, 0, 0)>(vb), h0 = tr_read<v_rd_off(D0, 0, 1)>(vb), l1 = tr_read<v_rd_off(D0, 1, 0)>(vb), h1 = tr_read<v_rd_off(D0, 1, 1)>(vb);
  const s16x4 l2 = tr_read<v_rd_off(D0, 2, 0)>(vb), h2 = tr_read<v_rd_off(D0, 2, 1)>(vb), l3 = tr_read<v_rd_off(D0, 3, 0)>(vb), h3 = tr_read<v_rd_off(D0, 3, 1)>(vb);
  asm volatile("s_waitcnt lgkmcnt(0)" ::: "memory"); SBAR();
#define PK(L, H) (bf16x8){L[0], L[1], L[2], L[3], H[0], H[1], H[2], H[3]}
  od = __builtin_amdgcn_mfma_f32_32x32x16_bf16(pa0, PK(l0, h0), od, 0, 0, 0);
  od = __builtin_amdgcn_mfma_f32_32x32x16_bf16(pa1, PK(l1, h1), od, 0, 0, 0);
  od = __builtin_amdgcn_mfma_f32_32x32x16_bf16(pa2, PK(l2, h2), od, 0, 0, 0);
  od = __builtin_amdgcn_mfma_f32_32x32x16_bf16(pa3, PK(l3, h3), od, 0, 0, 0);
#undef PK
}
__device__ __forceinline__ void pv_d0(f32x16* o, int vb, bf16x8 pa0, bf16x8 pa1, bf16x8 pa2, bf16x8 pa3) {
  pv_one<0>(o[0], vb, pa0, pa1, pa2, pa3); pv_one<1>(o[1], vb, pa0, pa1, pa2, pa3);
}

__device__ __forceinline__ void attn_dense_body(const bf16* __restrict__ Qb, const bf16* __restrict__ Kh, const bf16* __restrict__ Vh,
                                                bf16* __restrict__ Ob, int seq, char* lds, const int wave_id,
                                                const float* __restrict__ ssq, const int* __restrict__ posp, const float* __restrict__ gq) {
  const int wid = wave_id, lane = pg8::fresh_lane(), tid = (wid << 6) | lane, r32 = lane & 31, hi = lane >> 5;
  bf16* V_lds = (bf16*)lds; bf16* K_lds = (bf16*)(lds + 2 * SHM_V);
  float* ws = (float*)(lds + 2 * SHM_V + 2 * SHM_K) + wid * 64; float* li_l = ws; float* al_l = ws + 32;
  float m_reg = -1e30f, l_reg = 0; f32x16 o[NDV] = {}; bf16x8 qr[ND0];
  const bf16* Qw = Qb + (long)(wid * QBLK + r32) * LDQ + hi * 8;
#pragma unroll
  for (int d0 = 0; d0 < ND0; ++d0) qr[d0] = *reinterpret_cast<const bf16x8*>(Qw + d0 * 16);
  {
    const int rowi = wid * QBLK + r32;
    const pg8::f32x4* sp = (const pg8::f32x4*)(ssq + (long)rowi * 24); const pg8::f32x4 sa = sp[0], sb = sp[1], sc = sp[2];
    const float p = (float)posp[rowi];
    const float rq = __builtin_amdgcn_rsqf(((sa[0] + sa[1]) + (sa[2] + sa[3]) + (sb[0] + sb[1]) + (sb[2] + sb[3]) + (sc[0] + sc[1]) + (sc[2] + sc[3])) * (1.0f / 384.0f) + 1e-6f);
    float xs[ND0][8]; float ss = 0.f;
#pragma unroll
    for (int d0 = 0; d0 < 4; ++d0)
#pragma unroll
      for (int j = 0; j < 8; ++j) { const float x = __uint_as_float((unsigned)(unsigned short)qr[d0][j] << 16) * rq; xs[d0][j] = x; ss += x * x; }
#pragma unroll
    for (int j = 0; j < 8; ++j) {
      const float ang = p * __builtin_amdgcn_exp2f(-(float)(8 * hi + j) * 0.8304820237218406f);
      const float n = rintf(ang * 0.15915494309189535f);
      float r = fmaf(-n, 6.28318548202514648f, ang); r = fmaf(-n, -1.7484556e-7f, r); r *= 0.15915494309189535f;
      const float sn = __builtin_amdgcn_sinf(r), cs = __builtin_amdgcn_cosf(r);
      const float x1 = __uint_as_float((unsigned)(unsigned short)qr[4][j] << 16) * rq, x2 = __uint_as_float((unsigned)(unsigned short)qr[5][j] << 16) * rq;
      const float y1 = x1 * cs - x2 * sn, y2 = x1 * sn + x2 * cs;
      xs[4][j] = y1; xs[5][j] = y2; ss += y1 * y1 + y2 * y2; }
    { unsigned r0_ = __float_as_uint(ss), r1_ = r0_;
      auto r_ = __builtin_amdgcn_permlane32_swap(r0_, r1_, false, false); r0_ = r_[0]; r1_ = r_[1];
      asm volatile("" : "+v"(r0_), "+v"(r1_));
      ss = __uint_as_float(r0_) + __uint_as_float(r1_); }
    const float rn = __builtin_amdgcn_rsqf(ss * (1.0f / 96.0f) + 1e-6f);
#pragma unroll
    for (int d0 = 0; d0 < ND0; ++d0) {
      const pg8::f32x4 ga = *(const pg8::f32x4*)(gq + 16 * d0 + 8 * hi), gb = *(const pg8::f32x4*)(gq + 16 * d0 + 8 * hi + 4);
      u32x4 w; w.x = cvtpk(xs[d0][0] * rn * ga[0], xs[d0][1] * rn * ga[1]); w.y = cvtpk(xs[d0][2] * rn * ga[2], xs[d0][3] * rn * ga[3]);
      w.z = cvtpk(xs[d0][4] * rn * gb[0], xs[d0][5] * rn * gb[1]); w.w = cvtpk(xs[d0][6] * rn * gb[2], xs[d0][7] * rn * gb[3]);
      qr[d0] = *reinterpret_cast<bf16x8*>(&w); } }
  const int kr0 = tid / 12, kc0 = tid - kr0 * 12, kr1 = (512 + tid) / 12, kc1 = (512 + tid) - kr1 * 12, vr0 = tid >> 3, vc0 = tid & 7;
  const int kst0 = KSWZ(kr0, kc0 * 16), kst1 = KSWZ(kr1, kc1 * 16), vst0 = v_st(vr0, vc0 * 8);
  const bool k2 = wid < 4;
  const int vb0 = (int)(uintptr_t)V_lds + v_rd_base(lane);
  struct { bf16x8 vs0, ks0, ks1; } sr_[2];
#define SLOAD(i, k0) do { sr_[i].vs0 = *reinterpret_cast<const bf16x8*>(&Vh[(long)((k0) + vr0) * LDV + vc0 * 8]); \
    sr_[i].ks0 = *reinterpret_cast<const bf16x8*>(&Kh[(long)((k0) + kr0) * LDK + kc0 * 8]); \
    if (k2) sr_[i].ks1 = *reinterpret_cast<const bf16x8*>(&Kh[(long)((k0) + kr1) * LDK + kc1 * 8]); } while (0)
#define SWRITE(b, i) do { *(bf16x8*)((char*)V_lds + (b) * SHM_V + vst0) = sr_[i].vs0;          \
    *(bf16x8*)((char*)K_lds + (b) * SHM_K + kst0) = sr_[i].ks0;                       \
    if (k2) *(bf16x8*)((char*)K_lds + (b) * SHM_K + kst1) = sr_[i].ks1; } while (0)
#define SWAIT() do { if (k2) asm volatile("s_waitcnt vmcnt(3)" ::: "memory"); else asm volatile("s_waitcnt vmcnt(2)" ::: "memory"); } while (0)
#define RESC(a) do { if (__any((a) < 1.f)) { if (hi == 0) al_l[r32] = (a); asm volatile("s_waitcnt lgkmcnt(0)" ::: "memory"); \
    _Pragma("unroll") for (int d = 0; d < NDV; ++d) _Pragma("unroll") for (int r = 0; r < 16; ++r) o[d][r] *= al_l[crow(r, hi)]; } } while (0)
  f32x16 pA0, pA1, pB0, pB1; float mnA, mnB, alA, alB; bf16x8 pa0, pa1, pa2, pa3; const int NT = seq / KVBLK;
  constexpr int SE = 0, SO = 1;
  SLOAD(SE, 0); asm volatile("s_waitcnt vmcnt(0)" ::: "memory"); SWRITE(0, SE); __syncthreads();
  qkt(pA0, pA1, K_lds, qr, r32, hi); partialSM(pA0, pA1, m_reg, mnA, alA);
  SLOAD(SO, KVBLK); if (2 < NT) SLOAD(SE, 2 * KVBLK);
  SWAIT(); SWRITE(1, SO); __syncthreads();
  for (int j = 1; j + 1 < NT; j += 2) {
    SBAR(); qkt(pB0, pB1, (bf16*)((char*)K_lds + SHM_K), qr, r32, hi);
    finishSM(pA0, pA1, alA, l_reg, pa0, pa1, pa2, pa3); SBAR();
    SLOAD(SO, (j + 2) * KVBLK); SBAR();
    pv_d0(o, vb0, pa0, pa1, pa2, pa3); partialSM(pB0, pB1, m_reg, mnB, alB);
    __syncthreads(); SWAIT(); SWRITE(0, SE);
    RESC(alB); __syncthreads();
    SBAR(); qkt(pA0, pA1, K_lds, qr, r32, hi);
    finishSM(pB0, pB1, alB, l_reg, pa0, pa1, pa2, pa3); SBAR();
    if (j + 3 < NT) SLOAD(SE, (j + 3) * KVBLK); SBAR();
    pv_d0(o, vb0 + (int)SHM_V, pa0, pa1, pa2, pa3); partialSM(pA0, pA1, m_reg, mnA, alA);
    __syncthreads(); SWAIT(); SWRITE(1, SO);
    RESC(alA); __syncthreads();
  }
  SBAR(); qkt(pB0, pB1, (bf16*)((char*)K_lds + SHM_K), qr, r32, hi);
  finishSM(pA0, pA1, alA, l_reg, pa0, pa1, pa2, pa3); SBAR();
  pv_d0(o, vb0, pa0, pa1, pa2, pa3); partialSM(pB0, pB1, m_reg, mnB, alB);
  __syncthreads(); RESC(alB);
  finishSM(pB0, pB1, alB, l_reg, pa0, pa1, pa2, pa3); SBAR();
  pv_d0(o, vb0 + (int)SHM_V, pa0, pa1, pa2, pa3);
  if (hi == 0) li_l[r32] = l_reg; asm volatile("s_waitcnt lgkmcnt(0)" ::: "memory");
  float rli[16];
#pragma unroll
  for (int r = 0; r < 16; ++r) rli[r] = __builtin_amdgcn_rcpf(li_l[crow(r, hi)]);
  bf16* Ow = Ob + (long)(wid * QBLK) * LDO;
#pragma unroll
  for (int r = 0; r < 16; ++r) { int orow = crow(r, hi);
#pragma unroll
    for (int d0 = 0; d0 < NDV; ++d0) Ow[(long)orow * LDO + d0 * 32 + r32] = (bf16)(cvtpk(o[d0][r] * rli[r], 0.f) & 0xffffu); }
#undef SLOAD
#undef SWRITE
#undef SWAIT
#undef RESC
}
#undef KSWZ
#undef SBAR
}
constexpr int NWAVES = 8;
#ifndef MK_ONE_LAUNCH
#define MK_ONE_LAUNCH 1
#endif
constexpr int NB = 8, SEQ = 2048, DM = 1024, MTOK = NB * SEQ, DEPTH = 2;
constexpr int NH = 8, QL = 384, KVL = 256, NOPE = 64, ROPE = 32, QKH = 96, VHD = 64;
constexpr int PW = 512, INW = 3232, INWP = 3328, KPEPW = 544;
constexpr int NKEY = 128, NEXP = 16384, TOPK = 16;
constexpr float RMS_EPS = 1e-6f;
constexpr size_t MiB = 1u << 20;
constexpr size_t WS_CTL = 0;
constexpr size_t WS_W = 1 * MiB, W_STRIDE = 18 * MiB;
constexpr size_t WO_WIN = 0, WO_WUQ = 6656 * 1024, WO_WUKV = 7424 * 1024, WO_WO = 8 * MiB, WO_WC = 9 * MiB, WO_WOUT = 10 * MiB, WO_WQ = 12 * MiB, WO_KEYS = 16 * MiB;
constexpr size_t WS_U = 40 * MiB, WS_V = 72 * MiB, UV_STRIDE = 16 * MiB;
constexpr size_t WS_SU = 512 * 1024, WS_SV = 768 * 1024, SC_STRIDE = 64 * 1024;
constexpr size_t WS_XB = 168 * MiB;
constexpr size_t WS_GATES = 232 * MiB, WS_QP = 232 * MiB;
constexpr size_t WS_CQ = 296 * MiB, WS_CKV = 308 * MiB, WS_KPEP = 316 * MiB, WS_QRAW = 333 * MiB, WS_KVRAW = 357 * MiB;
constexpr size_t WS_ABUF = 296 * MiB, WS_MIX = 328 * MiB;
constexpr size_t WS_MIXED = 389 * MiB;
constexpr size_t WS_Q = 405 * MiB, WS_K = 429 * MiB, WS_VV = 453 * MiB;
constexpr size_t WS_E = 405 * MiB, WS_G = 413 * MiB, WS_XQ = 429 * MiB, WS_WF = 445 * MiB, WS_HPI = 232 * MiB;
constexpr size_t WS_O = 469 * MiB, WS_SSQ = 485 * MiB, WS_RR = 486 * MiB, WS_SX = WS_RR + 65536, WS_WSUM = WS_RR + 131072, WS_SSQN = WS_RR + 262144, WS_SSQC = 487 * MiB, WS_END = 489 * MiB;
static_assert(WO_WUQ >= (size_t)INWP * DM * 2 && WO_WUKV >= WO_WUQ + 768 * 384 * 2 && WO_WO >= WO_WUKV + 1024 * 256 * 2, "weight map");
static_assert(WS_KPEP + (size_t)MTOK * KPEPW * 2 <= WS_QRAW && WS_QRAW + (size_t)MTOK * 768 * 2 <= WS_KVRAW && WS_KVRAW + (size_t)MTOK * 1024 * 2 <= WS_MIXED, "ws map");

constexpr int LDS_BYTES = 147456;

#define GAS __attribute__((address_space(1)))
#define LAS __attribute__((address_space(3)))
typedef unsigned short bf16;
typedef unsigned v4u __attribute__((ext_vector_type(4)));
typedef unsigned v2u __attribute__((ext_vector_type(2)));
typedef float f32x4 __attribute__((ext_vector_type(4)));
typedef float f32x16 __attribute__((ext_vector_type(16)));
typedef short bf16x8 __attribute__((ext_vector_type(8)));
#define LDS_WAIT() asm volatile("s_waitcnt lgkmcnt(0)" ::: "memory")
__device__ __forceinline__ unsigned f2bf(float f) { unsigned u = __builtin_bit_cast(unsigned, f); return (u + 0x7fffu + ((u >> 16) & 1u)) >> 16; }
__device__ __forceinline__ unsigned pk2(float lo, float hi) { return f2bf(lo) | (f2bf(hi) << 16); }
__device__ __forceinline__ float blo(unsigned w) { return __builtin_bit_cast(float, w << 16); }
__device__ __forceinline__ float bhi(unsigned w) { return __builtin_bit_cast(float, w & 0xffff0000u); }
__device__ __forceinline__ float wave_sum(float v) {
#pragma unroll
    for (int o = 1; o < 64; o <<= 1) v += __shfl_xor(v, o);
    return v;
}

#define XB_TMO      128
#define XB_XCNT(j)  (256  + 64 * (j))
#define XB_XSUB(j)  (1280 + 64 * (j))
#define XB_XGEN(j)  (2304 + 64 * (j))
#define XB_TOP      3328
#define XB_TOPGEN   3392
#define XCD_BAR_WORDS 3456
#define XB_SPIN_CAP (1u << 18)

__device__ __forceinline__ unsigned xb_ld(unsigned* p)              { return __hip_atomic_load(p, __ATOMIC_RELAXED, __HIP_MEMORY_SCOPE_AGENT); }
__device__ __forceinline__ unsigned xb_add(unsigned* p, unsigned v) { return __hip_atomic_fetch_add(p, v, __ATOMIC_RELAXED, __HIP_MEMORY_SCOPE_AGENT); }
__device__ __forceinline__ unsigned xb_xcc_id() { return (unsigned)__builtin_amdgcn_s_getreg((3 << 11) | 20) & 0xFu; }
#define XB_SPIN(cond, bar) do { unsigned _sp = 0; while (cond) { __builtin_amdgcn_s_sleep(1); \
    if ((++_sp & 255u) == 0u) { if (xb_ld(&(bar)[XB_TMO])) break; if (_sp > XB_SPIN_CAP) { atomicAdd(&(bar)[XB_TMO], 1u); break; } } } } while (0)

struct XcdBarrier {
    unsigned* bar; unsigned x;
    volatile LAS unsigned* st;
};

__device__ __forceinline__ XcdBarrier xcd_barrier_post(unsigned* bar, volatile LAS unsigned* st) {
    XcdBarrier b; b.bar = bar; b.x = xb_xcc_id(); b.st = st;
    if (threadIdx.x == 0) (void)xb_add(&bar[XB_XCNT(b.x)], 1u);
    return b;
}
__device__ __forceinline__ void xcd_barrier_complete(unsigned* bar, unsigned x, unsigned& nloc, unsigned& nx) {
    const unsigned G = gridDim.x * gridDim.y * gridDim.z;
    unsigned sum, cnt, mine, sp = 0u;
    for (;;) {
        sum = 0u; cnt = 0u; mine = 0u;
#pragma unroll
        for (unsigned j = 0; j < 16; ++j) { const unsigned c = xb_ld(&bar[XB_XCNT(j)]); sum += c; cnt += (c > 0u) ? 1u : 0u; mine = (j == x) ? c : mine; }
        if (sum == G) break;
        __builtin_amdgcn_s_sleep(1);
        if ((++sp & 255u) == 0u) { if (xb_ld(&bar[XB_TMO])) break; if (sp > XB_SPIN_CAP) { atomicAdd(&bar[XB_TMO], 1u); break; } }
    }
    nloc = mine > 0u ? mine : 1u; nx = cnt > 0u ? cnt : 1u;
}

__device__ __forceinline__ void xcd_barrier(const XcdBarrier& b) {
    asm volatile("s_waitcnt vmcnt(0)" ::: "memory");
    __syncthreads();
    if (threadIdx.x == 0) {
        unsigned* bar = b.bar; unsigned bx_ = b.x;
        asm volatile("" : "+s"(bar), "+s"(bx_));
        __builtin_amdgcn_s_waitcnt(0);
        unsigned nloc = b.st[0], nx = b.st[1];
        if (nloc == 0u) { xcd_barrier_complete(bar, bx_, nloc, nx); b.st[0] = nloc; b.st[1] = nx; }
        const unsigned old = xb_add(&bar[XB_XSUB(bx_)], 1u);
        const unsigned gen = old / nloc;
        if (old + 1u == (gen + 1u) * nloc) {
            __builtin_amdgcn_fence(__ATOMIC_RELEASE, "agent");
            asm volatile("s_waitcnt vmcnt(0)" ::: "memory");
            const unsigned og = xb_add(&bar[XB_TOP], 1u);
            const unsigned tg = og / nx;
            if (og + 1u == (tg + 1u) * nx) xb_add(&bar[XB_TOPGEN], 1u);
            else XB_SPIN(xb_ld(&bar[XB_TOPGEN]) == tg, bar);
            __builtin_amdgcn_fence(__ATOMIC_ACQUIRE, "agent");
            xb_add(&bar[XB_XGEN(bx_)], 1u);
            asm volatile("s_waitcnt vmcnt(0)" ::: "memory");
        } else {
            XB_SPIN(xb_ld(&bar[XB_XGEN(bx_)]) == gen, bar);
            __builtin_amdgcn_fence(__ATOMIC_ACQUIRE, "agent");
            asm volatile("s_waitcnt vmcnt(0)" ::: "memory");
        }
    }
    __syncthreads();
}

constexpr int MISC_OFF = 131072 + 320;
constexpr size_t CTL_ZERO_BYTES = 65536;

struct Args { const void* in[21]; float* out; unsigned char* ws; int ph_lo, ph_hi; };
static_assert(sizeof(Args) == 23 * 8 + 8, "Args has no padding");


typedef const char __attribute__((address_space(4)))* kseg_t;
__device__ __forceinline__ const void* karg_ptr(int i) {
    kseg_t base = (kseg_t)__builtin_amdgcn_kernarg_segment_ptr();
    asm volatile("" : "+s"(base));
    return *(const void* const __attribute__((address_space(4)))*)(base + 8 * i);
}
__device__ __forceinline__ int karg_int(int byte_off) {
    kseg_t base = (kseg_t)__builtin_amdgcn_kernarg_segment_ptr();
    asm volatile("" : "+s"(base));
    return *(const int __attribute__((address_space(4)))*)(base + byte_off);
}
#define KIN(i) karg_ptr(i)
#define KOUT ((float*)karg_ptr(21))
#define KWS ((unsigned char*)karg_ptr(22))

struct Frame {
    LAS unsigned char* lds;
    int wave, vcu, G, gw, NGW, bx;
};
__device__ __forceinline__ Frame fresh_frame(const Frame& F) {
    Frame R = F;
    asm volatile("" : "+s"(R.wave), "+s"(R.vcu), "+s"(R.G), "+s"(R.gw), "+s"(R.NGW), "+s"(R.bx));
    return R;
}

__device__ __forceinline__ void transpose_item(const float* W, int ldw, int n_begin, int nblk, const float* gain, bf16* WT, int K, int row_off, LAS float* scr, int item, int lane, int permkv = 0) {
    const int kb = item / nblk, nb = item % nblk, k0 = 64 * kb, n0 = 32 * nb;
    const int nd0 = permkv ? 256 * (n0 >> 8) + 128 * ((n0 >> 5) & 1) + 32 * (2 * ((n0 >> 7) & 1) + ((n0 >> 6) & 1)) : n0;
    float tv[32];
#pragma unroll
    for (int i = 0; i < 32; ++i) tv[i] = W[(size_t)(k0 + 2 * i + (lane >> 5)) * ldw + n_begin + n0 + (lane & 31)];
    if (gain) {
#pragma unroll
        for (int i = 0; i < 32; ++i) tv[i] *= gain[k0 + 2 * i + (lane >> 5)]; }
#pragma unroll
    for (int i = 0; i < 32; ++i) scr[(2 * i + (lane >> 5)) * 33 + (lane & 31)] = tv[i];
    LDS_WAIT(); asm volatile("" ::: "memory");
    const int c = lane & 7;
#pragma unroll
    for (int j = 0; j < 4; ++j) { const int n = (lane >> 3) + 8 * j; const LAS float* s = scr + (8 * c) * 33 + n;
        v4u o; o.x = pk2(s[0 * 33], s[1 * 33]); o.y = pk2(s[2 * 33], s[3 * 33]); o.z = pk2(s[4 * 33], s[5 * 33]); o.w = pk2(s[6 * 33], s[7 * 33]);
        *(GAS v4u*)(WT + (size_t)(row_off + nd0 + n) * K + k0 + 8 * c) = o; }
    LDS_WAIT(); asm volatile("" ::: "memory");
}
__device__ __forceinline__ void rms_row_to_bf16(const float* xrow, const float* g, bf16* orow, int lane) {
    const f32x4* xr = (const f32x4*)xrow + lane; const f32x4* gr = (const f32x4*)g + lane;
    f32x4 v[4]; float s = 0.f;
#pragma unroll
    for (int j = 0; j < 4; ++j) { v[j] = xr[64 * j]; s += (v[j].x * v[j].x + v[j].y * v[j].y) + (v[j].z * v[j].z + v[j].w * v[j].w); }
    const float r = 1.0f / sqrtf(wave_sum(s) * (1.f / DM) + RMS_EPS);
    v2u* o8 = (v2u*)orow + lane;
#pragma unroll
    for (int j = 0; j < 4; ++j) { const f32x4 gv = gr[64 * j]; v2u w; w.x = pk2(v[j].x * r * gv.x, v[j].y * r * gv.y); w.y = pk2(v[j].z * r * gv.z, v[j].w * r * gv.w); o8[64 * j] = w; }
}
__device__ __forceinline__ void cvt8(const float* src, bf16* dst, size_t i8) {
    const f32x4 a = *(const f32x4*)(src + i8 * 8), b = *(const f32x4*)(src + i8 * 8 + 4);
    v4u o; o.x = pk2(a.x, a.y); o.y = pk2(a.z, a.w); o.z = pk2(b.x, b.y); o.w = pk2(b.z, b.w);
    *(v4u*)(dst + i8 * 8) = o;
}

__device__ __forceinline__ unsigned fp4_enc(float v, float& qa) {
    const float a = fabsf(v);
    const float lo = rintf(2.0f * fminf(a, 2.0f)), hi2 = rintf(fminf(fmaxf(a - 2.0f, 0.0f), 2.0f)), top = a > 5.0f ? 1.0f : 0.0f;
    qa = 0.5f * lo + hi2 + 2.0f * top;
    return (unsigned)(int)(lo + hi2 + top) | (v < 0.0f ? 8u : 0u);
}
__device__ __forceinline__ void convert_tables(int l, int cw, int ncw) {
    const int lane = pg8::fresh_lane();
    constexpr int NR = 2;
    for (int it0 = cw * NR; it0 < 2 * NEXP; it0 += ncw * NR) {
        f32x4 va[NR][4]; float m[NR];
#pragma unroll
        for (int r = 0; r < NR; ++r) { const int it = it0 + r, tab = it / NEXP, row = l * NEXP + it % NEXP;
            const f32x4* src = (const f32x4*)((const float*)(tab ? KIN(20) : KIN(19)) + (size_t)row * DM) + lane;
#pragma unroll
            for (int j = 0; j < 4; ++j) va[r][j] = __builtin_nontemporal_load(src + 64 * j); }
#pragma unroll
        for (int r = 0; r < NR; ++r) { float mm = 0.f;
#pragma unroll
            for (int j = 0; j < 4; ++j) mm = fmaxf(mm, fmaxf(fmaxf(fabsf(va[r][j].x), fabsf(va[r][j].y)), fmaxf(fabsf(va[r][j].z), fabsf(va[r][j].w))));
            m[r] = mm; }
#pragma unroll
        for (int o = 1; o < 64; o <<= 1)
#pragma unroll
            for (int r = 0; r < NR; ++r) m[r] = fmaxf(m[r], __shfl_xor(m[r], o));
#pragma unroll
        for (int r = 0; r < NR; ++r) { const int it = it0 + r, tab = it / NEXP, row = l * NEXP + it % NEXP;
            const float inv = m[r] > 0.f ? 6.0f / m[r] : 0.f;
            unsigned char* dstb = KWS + (tab ? WS_V : WS_U) + (size_t)l * UV_STRIDE + (size_t)(it % NEXP) * 128 + 2 * lane;
#pragma unroll
            for (int j = 0; j < 4; ++j) { unsigned pk = __builtin_amdgcn_cvt_scalef32_pk_fp4_f32(0u, va[r][j].x * inv, va[r][j].y * inv, 1.0f, 0);
                pk = __builtin_amdgcn_cvt_scalef32_pk_fp4_f32(pk, va[r][j].z * inv, va[r][j].w * inv, 1.0f, 1);
                *(unsigned short*)(dstb + (size_t)j * (NEXP * 128)) = (unsigned short)pk; }
            if (lane == 0) ((float*)(KWS + WS_SU))[2 * row + tab] = m[r] * (1.0f / 6.0f); }
    }
}

__device__ __forceinline__ void ph_prologue(Frame& F) {
    LAS float* scr = (LAS float*)(F.lds + F.wave * 16384);
    const int gw = F.gw, NGW = F.NGW, lane = pg8::fresh_lane();
    constexpr int I_G = 16 * 64, I_P = 16 * 37, I_UQ = 6 * 24, I_UKV = 4 * 32, I_O = 8 * 32, I_OUT = 16 * 32, I_WQ = 16 * 64;
    constexpr int I_L = I_G + I_P + I_UQ + I_UKV + I_O + I_OUT + I_WQ;
    for (int it = gw; it < DEPTH * I_L; it += NGW) {
        const int l = it / I_L; int r = it % I_L;
        unsigned char* wb = KWS + WS_W + (size_t)l * W_STRIDE;
        const float* w_in = (const float*)KIN(3) + (size_t)l * DM * INW;
        const float* g1 = (const float*)KIN(2) + (size_t)l * DM;
        if (r < I_G) { transpose_item(w_in, INW, 1184, 64, g1, (bf16*)(wb + WO_WIN), DM, 0, scr, r, lane); continue; } r -= I_G;
        if (r < I_P) { transpose_item(w_in, INW, 0, 37, g1, (bf16*)(wb + WO_WIN), DM, 2048, scr, r, lane); continue; } r -= I_P;
        if (r < I_UQ) { transpose_item((const float*)KIN(6) + (size_t)l * QL * 768, 768, 0, 24, (const float*)KIN(4) + l * QL, (bf16*)(wb + WO_WUQ), QL, 0, scr, r, lane); continue; } r -= I_UQ;
        if (r < I_UKV) { transpose_item((const float*)KIN(7) + (size_t)l * KVL * 1024, 1024, 0, 32, (const float*)KIN(5) + l * KVL, (bf16*)(wb + WO_WUKV), KVL, 0, scr, r, lane, 1); continue; } r -= I_UKV;
        if (r < I_O) { transpose_item((const float*)KIN(10) + (size_t)l * 512 * DM, DM, 0, 32, nullptr, (bf16*)(wb + WO_WO), 512, 0, scr, r, lane); continue; } r -= I_O;
        if (r < I_OUT) { transpose_item((const float*)KIN(15) + (size_t)l * DM * DM, DM, 0, 32, nullptr, (bf16*)(wb + WO_WOUT), DM, 0, scr, r, lane); continue; } r -= I_OUT;
        transpose_item((const float*)KIN(17) + (size_t)l * DM * 2048, 2048, 0, 64, (const float*)KIN(16) + (size_t)l * DM, (bf16*)(wb + WO_WQ), DM, 0, scr, r, lane);
    }
    for (int i = gw * 64 + lane; i < DEPTH * 96 * DM / 8; i += NGW * 64) {
        const int l = i / (96 * DM / 8), r = i % (96 * DM / 8);
        *(v4u*)((bf16*)(KWS + WS_W + (size_t)l * W_STRIDE + WO_WIN) + (size_t)INW * DM + (size_t)r * 8) = (v4u){0u, 0u, 0u, 0u};
    }
    for (int it = gw; it < DEPTH * 16 * 32; it += NGW) {
        const int l = it >> 9, cb = (it >> 5) & 15, db = it & 31, g = cb >> 2, r32 = lane & 31, hi = lane >> 5;
        const float* pw = (const float*)KIN(11) + (size_t)l * 4 * 128 * 128 + (size_t)(cb * 32 + r32) * 128 + 64 * hi;
        const float* ps = (const float*)KIN(12) + (size_t)l * 512 + g * 128 + 64 * hi;
        const float* wp = (const float*)KIN(13) + (size_t)l * 512 * DM + (size_t)(g * 128 + 64 * hi) * DM + db * 32 + r32;
        float av[64], bv[64];
#pragma unroll
        for (int j = 0; j < 16; ++j) { const f32x4 v = *(const f32x4*)(pw + 4 * j); av[4 * j] = v.x; av[4 * j + 1] = v.y; av[4 * j + 2] = v.z; av[4 * j + 3] = v.w; }
#pragma unroll
        for (int j = 0; j < 64; ++j) bv[j] = wp[(size_t)j * DM];
#pragma unroll
        for (int j = 0; j < 16; ++j) { const f32x4 s4 = *(const f32x4*)(ps + 4 * j); bv[4 * j] *= s4.x; bv[4 * j + 1] *= s4.y; bv[4 * j + 2] *= s4.z; bv[4 * j + 3] *= s4.w; }
        f32x16 acc = f32x16{};
#pragma unroll
        for (int s = 0; s < 64; ++s) acc = __builtin_amdgcn_mfma_f32_32x32x2f32(av[s], bv[s], acc, 0, 0, 0);
        bf16* dst = (bf16*)(KWS + WS_W + (size_t)l * W_STRIDE + WO_WC) + (size_t)(db * 32 + r32) * 512 + cb * 32 + 4 * hi;
#pragma unroll
        for (int q = 0; q < 4; ++q) { v2u o; o.x = pk2(acc[4 * q], acc[4 * q + 1]); o.y = pk2(acc[4 * q + 2], acc[4 * q + 3]); *(v2u*)(dst + 8 * q) = o; }
    }
    for (int i = gw * 64 + lane; i < DEPTH * 16 * 128 * 128 / 8; i += NGW * 64) {
        const int l = i / (16 * 128 * 128 / 8), r = i % (16 * 128 * 128 / 8);
        cvt8((const float*)KIN(18) + (size_t)l * 16 * 128 * 128, (bf16*)(KWS + WS_W + (size_t)l * W_STRIDE + WO_KEYS), (size_t)r);
    }
    for (int m0 = gw; m0 < MTOK; m0 += 2 * NGW) {
        f32x4 v[2][4]; float s[2];
#pragma unroll
        for (int u = 0; u < 2; ++u) { const int m = (m0 + u * NGW < MTOK) ? m0 + u * NGW : m0; const f32x4* xr = (const f32x4*)((const float*)KIN(0) + (size_t)m * DM) + lane;
#pragma unroll
            for (int j = 0; j < 4; ++j) v[u][j] = xr[64 * j]; }
#pragma unroll
        for (int u = 0; u < 2; ++u) { float ss = 0.f;
#pragma unroll
            for (int j = 0; j < 4; ++j) ss += (v[u][j].x * v[u][j].x + v[u][j].y * v[u][j].y) + (v[u][j].z * v[u][j].z + v[u][j].w * v[u][j].w);
            s[u] = ss; }
#pragma unroll
        for (int o = 1; o < 64; o <<= 1) { s[0] += __shfl_xor(s[0], o); s[1] += __shfl_xor(s[1], o); }
#pragma unroll
        for (int u = 0; u < 2; ++u) { const int m = m0 + u * NGW; if (m < MTOK) {
            v2u* o8 = (v2u*)((bf16*)(KWS + WS_XB) + (size_t)m * DM) + lane;
#pragma unroll
            for (int j = 0; j < 4; ++j) { v2u w; w.x = pk2(v[u][j].x, v[u][j].y); w.y = pk2(v[u][j].z, v[u][j].w); o8[64 * j] = w; }
            if (lane == 0) { f32x4* sp = (f32x4*)((float*)(KWS + WS_SSQN) + (size_t)m * 8); sp[0] = (f32x4){s[u], 0.f, 0.f, 0.f}; sp[1] = (f32x4){0.f, 0.f, 0.f, 0.f}; } } }
    }
}

__device__ __forceinline__ void ph_pool(Frame& F, int cw, int ncw) {
    const bf16* KP = (const bf16*)(KWS + WS_KPEP); bf16* MX = (bf16*)(KWS + WS_MIXED);
    const int lane = pg8::fresh_lane(), g = lane >> 4, half = 1 << g, c0 = lane * 8;
#define POOL_ACC(W, SGN) do { sum[0] += SGN blo(W.x); sum[1] += SGN bhi(W.x); sum[2] += SGN blo(W.y); sum[3] += SGN bhi(W.y); sum[4] += SGN blo(W.z); sum[5] += SGN bhi(W.z); sum[6] += SGN blo(W.w); sum[7] += SGN bhi(W.w); } while (0)
    for (int run = cw; run < MTOK / 8; run += ncw) {
        const int t0 = run * 8, s0 = t0 & (SEQ - 1);
        v4u row[23];
#pragma unroll
        for (int k = 0; k < 23; ++k) { const int d = k - 8; const bool ok = (d >= -half) && (d < 8 + half - 1 + 1) && (s0 + d >= 0) && (s0 + d < SEQ);
            row[k] = ok ? *(const v4u*)(KP + (size_t)(t0 + d) * KPEPW + 32 + c0) : (v4u){0u, 0u, 0u, 0u}; }
        float sum[8];
#pragma unroll
        for (int j = 0; j < 8; ++j) sum[j] = 0.f;
        int cnt = 0;
#pragma unroll
        for (int d = -8; d < 8; ++d) { const bool ok = (d >= -half) && (d < half) && (s0 + d >= 0) && (s0 + d < SEQ); if (ok) { POOL_ACC(row[d + 8], +); ++cnt; } }
#pragma unroll
        for (int i = 0; i < 8; ++i) {
            const int t = t0 + i, s = s0 + i;
            if (i > 0) {
                const bool lv_ok = (s - 1 - half >= 0), ev_ok = (s + half - 1 < SEQ);
#define POOL_CASE(H) do { if (half == (H)) { if ((i - 1 - (H) + 8) >= 0) { if (lv_ok) { POOL_ACC(row[(i - 1 - (H) + 8) >= 0 ? (i - 1 - (H) + 8) : 0], -); } } if (ev_ok) { POOL_ACC(row[i + (H) - 1 + 8], +); } } } while (0)
                POOL_CASE(1); POOL_CASE(2); POOL_CASE(4); POOL_CASE(8);
#undef POOL_CASE
                if (lv_ok) --cnt;
                if (ev_ok) ++cnt;
            }
            const v4u me = row[i + 8];
            const float ic = 1.0f / (float)cnt;
            v4u o; o.x = pk2(sum[0] * ic - blo(me.x), sum[1] * ic - bhi(me.x)); o.y = pk2(sum[2] * ic - blo(me.y), sum[3] * ic - bhi(me.y));
            o.z = pk2(sum[4] * ic - blo(me.z), sum[5] * ic - bhi(me.z)); o.w = pk2(sum[6] * ic - blo(me.w), sum[7] * ic - bhi(me.w));
            *(v4u*)(MX + (size_t)t * PW + c0) = o;
        }
    }
#undef POOL_ACC
}

__device__ __forceinline__ void ph_finalize(Frame& F, int l) {
    const bf16* QR = (const bf16*)(KWS + WS_QRAW); const float* SSQC = (const float*)(KWS + WS_SSQC);
    bf16* Q = (bf16*)(KWS + WS_Q);
    const int* pos = (const int*)KIN(1);
    const float* ghq = (const float*)KIN(8) + l * QKH;
    const int lane = pg8::fresh_lane(), h = lane >> 3, sub = lane & 7;
    const float inv0 = __builtin_amdgcn_exp2f(-(float)(2 * sub) * 0.8304820237218406f), inv1 = __builtin_amdgcn_exp2f(-(float)(2 * sub + 1) * 0.8304820237218406f);
    float gqn[8];
#pragma unroll
    for (int j = 0; j < 8; ++j) gqn[j] = ghq[8 * sub + j];
    const float gq10 = ghq[64 + 2 * sub], gq11 = ghq[65 + 2 * sub], gq20 = ghq[80 + 2 * sub], gq21 = ghq[81 + 2 * sub];
    for (int t = F.gw; t < MTOK; t += F.NGW) {
        const f32x4* sp = (const f32x4*)(SSQC + (size_t)t * 24); const f32x4 sa = sp[0], sb = sp[1], sc = sp[2];
        const float rq = 1.0f / sqrtf(((sa.x + sa.y) + (sa.z + sa.w) + (sb.x + sb.y) + (sb.z + sb.w) + (sc.x + sc.y) + (sc.z + sc.w)) * (1.f / QL) + RMS_EPS);
        const float p = (float)pos[t];
        float c0, s0, c1, s1;
        { const float a0 = p * inv0, a1 = p * inv1;
          const float n0 = rintf(a0 * 0.15915494309189535f), n1 = rintf(a1 * 0.15915494309189535f);
          float r0 = fmaf(-n0, 6.28318548202514648f, a0); r0 = fmaf(-n0, -1.7484556e-7f, r0);
          float r1 = fmaf(-n1, 6.28318548202514648f, a1); r1 = fmaf(-n1, -1.7484556e-7f, r1);
          r0 *= 0.15915494309189535f; r1 *= 0.15915494309189535f;
          s0 = __builtin_amdgcn_sinf(r0); c0 = __builtin_amdgcn_cosf(r0); s1 = __builtin_amdgcn_sinf(r1); c1 = __builtin_amdgcn_cosf(r1); }
        { const bf16* qp = QR + (size_t)t * 768 + h * QKH;
          const v4u w = *(const v4u*)(qp + 8 * sub); const unsigned wa = *(const unsigned*)(qp + 64 + 2 * sub), wb = *(const unsigned*)(qp + 80 + 2 * sub);
          float x[8] = {blo(w.x), bhi(w.x), blo(w.y), bhi(w.y), blo(w.z), bhi(w.z), blo(w.w), bhi(w.w)};
          float ss = 0.f;
#pragma unroll
          for (int j = 0; j < 8; ++j) { x[j] *= rq; ss += x[j] * x[j]; }
          const float x10 = blo(wa) * rq, x11 = bhi(wa) * rq, x20 = blo(wb) * rq, x21 = bhi(wb) * rq;
          const float y10 = x10 * c0 - x20 * s0, y20 = x10 * s0 + x20 * c0, y11 = x11 * c1 - x21 * s1, y21 = x11 * s1 + x21 * c1;
          ss += (y10 * y10 + y20 * y20) + (y11 * y11 + y21 * y21);
          ss += __shfl_xor(ss, 1); ss += __shfl_xor(ss, 2); ss += __shfl_xor(ss, 4);
          const float rn = 1.0f / sqrtf(ss * (1.f / QKH) + RMS_EPS);
          bf16* qo = Q + (size_t)t * 768 + h * QKH;
          v4u o; o.x = pk2(x[0] * rn * gqn[0], x[1] * rn * gqn[1]); o.y = pk2(x[2] * rn * gqn[2], x[3] * rn * gqn[3]); o.z = pk2(x[4] * rn * gqn[4], x[5] * rn * gqn[5]); o.w = pk2(x[6] * rn * gqn[6], x[7] * rn * gqn[7]);
          *(v4u*)(qo + 8 * sub) = o;
          *(unsigned*)(qo + 64 + 2 * sub) = pk2(y10 * rn * gq10, y11 * rn * gq11);
          *(unsigned*)(qo + 80 + 2 * sub) = pk2(y20 * rn * gq20, y21 * rn * gq21); }
    }
}

__device__ __forceinline__ void ph_attn(Frame& F, unsigned char* lds_generic, int l) {
    const att::bf16* Q = (const att::bf16*)(KWS + WS_QRAW); const att::bf16* K = (const att::bf16*)(KWS + WS_K); const att::bf16* V = (const att::bf16*)(KWS + WS_VV);
    att::bf16* O = (att::bf16*)(KWS + WS_O);
    for (int u = F.vcu; u < NB * NH * (SEQ / 256); u += F.G) {
        const int bh = u >> 3, qb = u & 7, b = bh >> 3, h = bh & 7;
        __syncthreads();
        att::attn_dense_body(Q + ((size_t)(b * SEQ + qb * 256)) * 768 + h * QKH, K + (size_t)(b * SEQ) * 768 + h * QKH, V + (size_t)(b * SEQ) * 512 + h * VHD,
                             O + ((size_t)(b * SEQ + qb * 256)) * 512 + h * VHD, SEQ, (char*)lds_generic, F.wave,
                             (const float*)(KWS + WS_SSQC) + (size_t)(b * SEQ + qb * 256) * 24, (const int*)KIN(1) + (b * SEQ + qb * 256), (const float*)KIN(8) + l * QKH);
    }
    __syncthreads();
}

__device__ __forceinline__ unsigned fkey(float f) { const unsigned b = __builtin_bit_cast(unsigned, f); return b ^ ((unsigned)((int)b >> 31) | 0x80000000u); }
__device__ __forceinline__ float funkey(unsigned u) { const unsigned b = u ^ (~(unsigned)((int)u >> 31) | 0x80000000u); return __builtin_bit_cast(float, b); }
__device__ __forceinline__ unsigned umax(unsigned a, unsigned b) { return a > b ? a : b; }
__device__ __forceinline__ unsigned umin(unsigned a, unsigned b) { return a < b ? a : b; }
#define INS16(T, x) do { unsigned _x = (x); _Pragma("unroll") for (int _i = 0; _i < 16; ++_i) { const unsigned _h = umax(T[_i], _x); _x = umin(T[_i], _x); T[_i] = _h; } } while (0)
__device__ __forceinline__ void sort16_desc(unsigned (&a)[16]) {
#pragma unroll
    for (int k = 2; k <= 16; k <<= 1)
#pragma unroll
        for (int j = k >> 1; j > 0; j >>= 1)
#pragma unroll
            for (int i = 0; i < 16; ++i) { const int l = i ^ j;
                if (l > i) { const unsigned hi = umax(a[i], a[l]), lo = umin(a[i], a[l]); if ((i & k) == 0) { a[i] = hi; a[l] = lo; } else { a[i] = lo; a[l] = hi; } } }
}
__device__ __forceinline__ void merge_top16(unsigned (&T)[16], const unsigned (&S)[16]) {
#pragma unroll
    for (int i = 0; i < 16; ++i) T[i] = umax(T[i], S[15 - i]);
#pragma unroll
    for (int j = 8; j > 0; j >>= 1)
#pragma unroll
        for (int i = 0; i < 16; ++i) { const int l = i ^ j; if (l > i) { const unsigned hi = umax(T[i], T[l]), lo = umin(T[i], T[l]); T[i] = hi; T[l] = lo; } }
}

__device__ __forceinline__ void ph_select(Frame& F, int l) {
    const bf16* QP = (const bf16*)(KWS + WS_QP); const bf16* KEYS = (const bf16*)(KWS + WS_W + (size_t)l * W_STRIDE + WO_KEYS);
    const float* SSQ = (const float*)(KWS + WS_SSQ); float* RR = (float*)(KWS + WS_RR); unsigned* EO = (unsigned*)(KWS + WS_E); float* GO = (float*)(KWS + WS_G);
    const int lane = pg8::fresh_lane(), r32 = lane & 31, hi = lane >> 5;
    LAS unsigned* TL = (LAS unsigned*)(F.lds + 65536) + (F.wave * 64 + lane);
    { const bf16* XG2 = (const bf16*)(KWS + WS_XB); unsigned char* XQ = KWS + WS_XQ; float* SX = (float*)(KWS + WS_SX); const float* g2p = (const float*)KIN(16) + (size_t)l * DM + 16 * lane;
      float g2v[16];
#pragma unroll
      for (int j = 0; j < 4; ++j) { const f32x4 gq = *(const f32x4*)(g2p + 4 * j); g2v[4 * j] = gq.x; g2v[4 * j + 1] = gq.y; g2v[4 * j + 2] = gq.z; g2v[4 * j + 3] = gq.w; }
      for (int t0 = F.gw; t0 < MTOK; t0 += 4 * F.NGW) {
          v4u ra[4], rb[4]; float m[4];
#pragma unroll
          for (int u = 0; u < 4; ++u) { const int t = (t0 + u * F.NGW < MTOK) ? t0 + u * F.NGW : t0; ra[u] = *(const v4u*)(XG2 + (size_t)t * DM + 16 * lane); rb[u] = *(const v4u*)(XG2 + (size_t)t * DM + 16 * lane + 8); }
          float xf[4][16];
#pragma unroll
          for (int u = 0; u < 4; ++u) { const v4u a = ra[u], b = rb[u];
              const float x_[16] = {blo(a.x), bhi(a.x), blo(a.y), bhi(a.y), blo(a.z), bhi(a.z), blo(a.w), bhi(a.w), blo(b.x), bhi(b.x), blo(b.y), bhi(b.y), blo(b.z), bhi(b.z), blo(b.w), bhi(b.w)};
              float mm = 0.f;
#pragma unroll
              for (int j = 0; j < 16; ++j) { xf[u][j] = x_[j] * g2v[j]; mm = fmaxf(mm, fabsf(xf[u][j])); }
              m[u] = mm; }
#pragma unroll
          for (int o = 1; o < 64; o <<= 1)
#pragma unroll
              for (int u = 0; u < 4; ++u) m[u] = fmaxf(m[u], __shfl_xor(m[u], o));
#pragma unroll
          for (int u = 0; u < 4; ++u) { const int t = t0 + u * F.NGW; if (t < MTOK) {
              const float inv = m[u] > 0.f ? 6.0f / m[u] : 0.f;
              unsigned q1w[2] = {0u, 0u}, q2w[2] = {0u, 0u};
              typedef float f32x2q __attribute__((ext_vector_type(2)));
#define PP_(j, w, bs) { const float v0 = xf[u][2 * (j)] * inv, v1 = xf[u][2 * (j) + 1] * inv; \
                  q1w[w] = __builtin_amdgcn_cvt_scalef32_pk_fp4_f32(q1w[w], v0, v1, 1.0f, bs); \
                  const f32x2q bk = __builtin_amdgcn_cvt_scalef32_pk_f32_fp4(q1w[w], 1.0f, bs);                         \
                  q2w[w] = __builtin_amdgcn_cvt_scalef32_pk_fp4_f32(q2w[w], (v0 - bk.x) * 6.0f, (v1 - bk.y) * 6.0f, 1.0f, bs); }
              PP_(0, 0, 0) PP_(1, 0, 1) PP_(2, 0, 2) PP_(3, 0, 3) PP_(4, 1, 0) PP_(5, 1, 1) PP_(6, 1, 2) PP_(7, 1, 3)
#undef PP_
              const v2u q1 = (v2u){q1w[0], q1w[1]}, q2 = (v2u){q2w[0], q2w[1]};
              unsigned char* xo = XQ + (size_t)(lane >> 4) * ((size_t)MTOK * 256) + (size_t)t * 256 + 8 * (lane & 15);
              *(v2u*)(xo) = q1; *(v2u*)(xo + 128) = q2;
              if (lane == 0) SX[t] = m[u] * (1.0f / 6.0f); } }
      } }
    const int h = F.vcu & 7, tbg = F.vcu >> 3, ntbg = F.G >> 3;
    { const int tid = F.wave * 64 + lane;
#pragma unroll
      for (int j = 0; j < 8; ++j) { const int idx = tid + 512 * j, p = idx >> 11, n = (idx >> 4) & 127, ch = idx & 15;
          const v4u v = *(const v4u*)(KEYS + ((size_t)(2 * h + p) * 128 + n) * 128 + ch * 8);
          *(LAS v4u*)(F.lds + p * 32768 + n * 256 + ((ch * 16) ^ ((n & 7) << 4))) = v; }
      __syncthreads(); }
    for (int tb = tbg * 8 + F.wave; tb < MTOK / 32; tb += ntbg * 8) {
        const int tok = tb * 32 + r32;
        float ssq = 0.f;
        { const f32x4* sp = (const f32x4*)(SSQ + (size_t)tok * 16);
#pragma unroll
          for (int j = 0; j < 4; ++j) { const f32x4 v = sp[j]; ssq += (v.x + v.y) + (v.z + v.w); } }
        const float rr = 1.0f / sqrtf(ssq * (1.f / DM) + RMS_EPS);
        if (h == 0 && hi == 0) RR[tok] = rr;
        unsigned C[16];
#pragma unroll
        for (int i = 0; i < 16; ++i) C[i] = 0u;
        {
        unsigned T[2][16];
        bf16x8 qfa[2][8];
#pragma unroll
        for (int p = 0; p < 2; ++p) { const bf16* qrow = QP + (size_t)tok * 2048 + (2 * h + p) * 128 + hi * 8;
#pragma unroll
            for (int s = 0; s < 8; ++s) qfa[p][s] = *(const bf16x8*)(qrow + s * 16); }
#pragma unroll
        for (int p = 0; p < 2; ++p) {
            const int hp = 2 * h + p;
            bf16x8 qf[8];
#pragma unroll
            for (int s = 0; s < 8; ++s) qf[s] = qfa[p][s];
#pragma unroll
            for (int i = 0; i < 16; ++i) T[p][i] = 0u;
#pragma unroll 1
            for (int blk = 0; blk < 4; ++blk) {
                f32x16 acc = f32x16{};
                const int n = blk * 32 + r32; const LAS unsigned char* krow = F.lds + p * 32768 + n * 256; const int sw = (n & 7) << 4;
#pragma unroll
                for (int s = 0; s < 8; ++s) { const bf16x8 a = *(const LAS bf16x8*)(krow + ((32 * s + 16 * hi) ^ sw)); acc = __builtin_amdgcn_mfma_f32_32x32x16_bf16(a, qf[s], acc, 0, 0, 0); }
                const int nb = 127 - (blk * 32 + 4 * hi);
                unsigned K[16];
#pragma unroll
                for (int r = 0; r < 16; ++r) K[r] = (fkey(acc[r]) & ~127u) | (unsigned)(nb - ((r & 3) + 8 * (r >> 2)));
                sort16_desc(K); merge_top16(T[p], K);
            }
            unsigned oth[16];
#pragma unroll
            for (int i = 0; i < 16; ++i) oth[i] = (unsigned)__shfl_xor((int)T[p][i], 32);
            merge_top16(T[p], oth);
#pragma unroll
            for (int i = 0; i < 16; ++i) TL[(p * 16 + i) * 512] = T[p][i];
        }
        float s0[16], s1[16];
#pragma unroll
        for (int i = 0; i < 16; ++i) { s0[i] = funkey((T[0][i] & ~127u) | 64u); s1[i] = funkey((T[1][i] & ~127u) | 64u); }
#define CAND(i, j) ((fkey(s0[i] + s1[j]) & ~255u) | (unsigned)((i) * 16 + (j)))
#pragma unroll
        for (int j = 0; j < 16; ++j) C[j] = CAND(0, j);
        { unsigned B[16];
#pragma unroll
          for (int j = 0; j < 8; ++j) B[j] = CAND(1, j);
#pragma unroll
          for (int j = 0; j < 5; ++j) B[8 + j] = CAND(2, j);
#pragma unroll
          for (int j = 0; j < 3; ++j) B[13 + j] = CAND(4, j);
          sort16_desc(B); merge_top16(C, B); }
        { unsigned B[16];
#pragma unroll
          for (int j = 0; j < 4; ++j) B[j] = CAND(3, j);
#pragma unroll
          for (int j = 0; j < 2; ++j) { B[4 + j] = CAND(5, j); B[6 + j] = CAND(6, j); B[8 + j] = CAND(7, j); }
#pragma unroll
          for (int i = 0; i < 6; ++i) B[10 + i] = CAND(8 + i, 0);
          sort16_desc(B); merge_top16(C, B); }
        INS16(C, CAND(14, 0)); INS16(C, CAND(15, 0));
#undef CAND
        }
        float sc[16]; unsigned ex[16];
#pragma unroll
        for (int k = 0; k < 16; ++k) {
            const unsigned code = C[k] & 255u;
            const unsigned a = TL[(code >> 4) * 512], b = TL[(16 + (code & 15u)) * 512];
            ex[k] = (127u - (a & 127u)) * 128u + (127u - (b & 127u));
            sc[k] = funkey((a & ~127u) | 64u) + funkey((b & ~127u) | 64u);
        }
        float smax = sc[0];
#pragma unroll
        for (int k = 1; k < 16; ++k) smax = fmaxf(smax, sc[k]);
        float den = 0.f;
#pragma unroll
        for (int k = 0; k < 16; ++k) { sc[k] = __builtin_amdgcn_exp2f((sc[k] - smax) * rr * 1.4426950408889634f); den += sc[k]; }
        const float iden = 1.0f / den;
        v4u* edst = (v4u*)(EO + (size_t)tok * 128 + h * 16 + hi * 8); f32x4* gdst = (f32x4*)(GO + (size_t)tok * 128 + h * 16 + hi * 8);
#pragma unroll
        for (int k = 0; k < 8; k += 4) {
            unsigned ea[4], eb[4]; float wa[4], wb2[4];
#pragma unroll
            for (int j = 0; j < 4; ++j) { ea[j] = ex[k + j]; eb[j] = ex[8 + k + j]; wa[j] = sc[k + j]; wb2[j] = sc[8 + k + j];
                asm volatile("" : "+v"(ea[j]), "+v"(eb[j]), "+v"(wa[j]), "+v"(wb2[j])); }
            edst[k >> 2] = (v4u){hi ? eb[0] : ea[0], hi ? eb[1] : ea[1], hi ? eb[2] : ea[2], hi ? eb[3] : ea[3]};
            gdst[k >> 2] = (f32x4){(hi ? wb2[0] : wa[0]) * iden, (hi ? wb2[1] : wa[1]) * iden, (hi ? wb2[2] : wa[2]) * iden, (hi ? wb2[3] : wa[3]) * iden};
        }
    }
}

__device__ __forceinline__ float gelu_tanh(float h) {
    const float z = 0.7978845608028654f * (h + 0.044715f * h * h * h);
    return h * __builtin_amdgcn_rcpf(1.0f + __builtin_amdgcn_exp2f(-2.0f * 1.4426950408889634f * z));
}
__device__ __forceinline__ float ub0(unsigned x) { return (float)(x & 0xffu); }
__device__ __forceinline__ float ub1(unsigned x) { return (float)((x >> 8) & 0xffu); }
__device__ __forceinline__ float ub2(unsigned x) { return (float)((x >> 16) & 0xffu); }
__device__ __forceinline__ float ub3(unsigned x) { return (float)(x >> 24); }
#define DPP_I(x, ctrl) __builtin_amdgcn_update_dpp(0, (x), (ctrl), 0xf, 0xf, false)
#define DPP_F(x, ctrl) __builtin_bit_cast(float, __builtin_amdgcn_update_dpp(0, __builtin_bit_cast(int, (x)), (ctrl), 0xf, 0xf, false))
#define G1_IT(i) (bx + (i) * G)
#define G1_TOK(i) ((G1_IT(i) >> 3) * 8 + wave)
__device__ __forceinline__ void ph_g1(Frame& F, int l) {
    const unsigned char* XQ = KWS + WS_XQ; const unsigned* E = (const unsigned*)(KWS + WS_E); const unsigned char* U = KWS + WS_U + (size_t)l * UV_STRIDE; float* HPF = (float*)(KWS + WS_HPI);
    const int lane = pg8::fresh_lane(), n = lane & 15, q = lane >> 4, m = n & 7, hh = n >> 3, k8 = hh * 4 + q, r8 = lane >> 3, c = lane & 7;
    const int G = F.G, bx = F.bx, wave = F.wave;
    const int nit = (4 * (MTOK / 8) - bx + G - 1) / G;
    LAS unsigned char* ldw = F.lds + wave * 16384 + lane * 16; const LAS unsigned char* ldr = F.lds + wave * 16384 + m * 128 + hh * 64 + q * 16;
    typedef int i32x8 __attribute__((ext_vector_type(8))); typedef float f32x2 __attribute__((ext_vector_type(2)));
#define F1_IT(i) (bx + (i) * G)
#define F1_TOK(i) ((F1_IT(i) >> 2) * 8 + wave)
#define F1_LOADE(EV, i) do { const unsigned* ep_ = E + (size_t)F1_TOK(i) * 128 + 16 * r8; _Pragma("unroll") for (int j_ = 0; j_ < 4; ++j_) EV[j_] = *(const v4u*)(ep_ + 4 * j_); } while (0)
#define F1_LOADB(URV, XV, EV, i) do { const size_t co_ = (size_t)(F1_IT(i) & 3) * (NEXP * 128) + 16 * c; \
        _Pragma("unroll") for (int g_ = 0; g_ < 16; ++g_) URV[g_] = *(const v4u*)(U + (size_t)(EV[g_ >> 2][g_ & 3] & (NEXP - 1)) * 128 + co_); \
        XV = *(const v4u*)(XQ + (size_t)(F1_IT(i) & 3) * ((size_t)MTOK * 256) + (size_t)F1_TOK(i) * 256 + 128 * (n & 1) + 64 * ((n >> 1) & 1) + 16 * q); } while (0)
#define F1_COMP(URV, XV, i) do { float h_[16]; \
        const i32x8 xa_ = {(int)XV.x, (int)XV.y, (int)XV.z, (int)XV.w, 0, 0, 0, 0}; \
        _Pragma("unroll") for (int g_ = 0; g_ < 16; ++g_) *(LAS v4u*)(ldw + g_ * 1024) = URV[g_]; \
        _Pragma("unroll") for (int g_ = 0; g_ < 16; ++g_) { const v4u ur_ = *(const LAS v4u*)(ldr + g_ * 1024); \
            const i32x8 ub_ = {(int)ur_.x, (int)ur_.y, (int)ur_.z, (int)ur_.w, 0, 0, 0, 0}; \
            const f32x4 d_ = __builtin_amdgcn_mfma_scale_f32_16x16x128_f8f6f4(xa_, ub_, (f32x4){0.f, 0.f, 0.f, 0.f}, 4, 4, 0, 0x7f7f7f7f, 0, 0x7f7f7f7f); \
            const float v_ = hh ? d_[2] + d_[3] * (1.0f / 6.0f) : d_[0] + d_[1] * (1.0f / 6.0f); \
            h_[g_] = v_ + DPP_F(v_, 0x128); } \
          \
        float s0_ = h_[0], s1_ = h_[1]; \
        _Pragma("unroll") for (int k_ = 1; k_ < 8; ++k_) { s0_ = k8 == k_ ? h_[2 * k_] : s0_; s1_ = k8 == k_ ? h_[2 * k_ + 1] : s1_; } \
        *(f32x2*)(HPF + ((size_t)(F1_IT(i) & 3) * MTOK + F1_TOK(i)) * 128 + 16 * m + 2 * k8) = (f32x2){s0_, s1_}; } while (0)
    v4u eA[4], eB[4], xA, xB, urA[16], urB[16];
#define F1_CL(i) ((i) < nit ? (i) : nit - 1)
    if (nit > 0) {
        F1_LOADE(eA, 0); F1_LOADE(eB, F1_CL(1)); F1_LOADB(urA, xA, eA, 0);
        for (int i = 0; i < nit; i += 2) {
            F1_LOADE(eA, F1_CL(i + 2));
            F1_LOADB(urB, xB, eB, F1_CL(i + 1));
            __builtin_amdgcn_sched_barrier(0);
            F1_COMP(urA, xA, i);
            __builtin_amdgcn_sched_barrier(0);
            F1_LOADE(eB, F1_CL(i + 3));
            F1_LOADB(urA, xA, eA, F1_CL(i + 2));
            __builtin_amdgcn_sched_barrier(0);
            F1_COMP(urB, xB, F1_CL(i + 1));
            __builtin_amdgcn_sched_barrier(0);
        }
    }
#undef F1_CL
#undef F1_IT
#undef F1_TOK
#undef F1_LOADE
#undef F1_LOADB
#undef F1_COMP
}
__device__ __forceinline__ void ph_g1b(Frame& F, int l) {
    const float* HPF = (const float*)(KWS + WS_HPI); const unsigned* E = (const unsigned*)(KWS + WS_E); const float* G = (const float*)(KWS + WS_G);
    const float* RR = (const float*)(KWS + WS_RR); const float* SX = (const float*)(KWS + WS_SX);
    typedef float f32x2s __attribute__((ext_vector_type(2)));
    const f32x2s* SUV = (const f32x2s*)(KWS + WS_SU) + (size_t)l * NEXP;
    unsigned char* WQ = KWS + WS_WF; float* SW = (float*)(KWS + WS_WSUM);
    const int lane = pg8::fresh_lane();
    typedef int i32x2 __attribute__((ext_vector_type(2))); typedef float f32x2 __attribute__((ext_vector_type(2)));
    constexpr int NU = 4;
    for (int t0 = F.gw; t0 < MTOK; t0 += NU * F.NGW) {
        f32x2 isum[NU]; v2u e2[NU]; f32x2 g2[NU]; float hs[NU];
#pragma unroll
        for (int u = 0; u < NU; ++u) { const int t = (t0 + u * F.NGW < MTOK) ? t0 + u * F.NGW : t0;
            hs[u] = RR[t] * SX[t];
            isum[u] = (f32x2){0.f, 0.f};
#pragma unroll
            for (int s = 0; s < 4; ++s) { const f32x2 w = *(const f32x2*)(HPF + ((size_t)s * MTOK + t) * 128 + 2 * lane); isum[u].x += w.x; isum[u].y += w.y; }
            e2[u] = *(const v2u*)(E + (size_t)t * 128 + 2 * lane); g2[u] = *(const f32x2*)(G + (size_t)t * 128 + 2 * lane); }
        float w0[NU], w1[NU], m[NU];
#pragma unroll
        for (int u = 0; u < NU; ++u) { const unsigned e0 = e2[u].x & (NEXP - 1), e1 = e2[u].y & (NEXP - 1);
            const f32x2s sa = SUV[e0], sb = SUV[e1];
            w0[u] = g2[u].x * gelu_tanh(isum[u].x * hs[u] * sa.x) * sa.y; w1[u] = g2[u].y * gelu_tanh(isum[u].y * hs[u] * sb.x) * sb.y;
            m[u] = fmaxf(fabsf(w0[u]), fabsf(w1[u])); }
#pragma unroll
        for (int o = 1; o < 64; o <<= 1)
#pragma unroll
            for (int u = 0; u < NU; ++u) m[u] = fmaxf(m[u], __shfl_xor(m[u], o));
#pragma unroll
        for (int u = 0; u < NU; ++u) { const int t = t0 + u * F.NGW; if (t < MTOK) {
            const float inv = m[u] > 0.f ? 6.0f / m[u] : 0.f;
            float va = w0[u] * inv, vb = w1[u] * inv;
#pragma unroll
            for (int term = 0; term < 3; ++term) {
                const unsigned pk = __builtin_amdgcn_cvt_scalef32_pk_fp4_f32(0u, va, vb, 1.0f, 0);
                WQ[(size_t)t * 192 + 64 * term + lane] = (unsigned char)pk;
                typedef float f32x2q __attribute__((ext_vector_type(2)));
                const f32x2q bk = __builtin_amdgcn_cvt_scalef32_pk_f32_fp4(pk, 1.0f, 0);
                va = (va - bk.x) * 6.0f; vb = (vb - bk.y) * 6.0f; }
            if (lane == 0) SW[t] = m[u] * (1.0f / 6.0f); } }
    }
}
template <bool LAST>
__device__ __forceinline__ void ph_g2(Frame& F, int l, bf16* Xout) {
    const unsigned* E = (const unsigned*)(KWS + WS_E); const unsigned char* WQ = KWS + WS_WF; const float* SW = (const float*)(KWS + WS_WSUM);
    const unsigned char* V = KWS + WS_V + (size_t)l * UV_STRIDE;
    const bf16* X = (const bf16*)(KWS + WS_XB); float* SSQN = (float*)(KWS + WS_SSQN); float* OUTF = KOUT;
    const int lane = pg8::fresh_lane(), n = lane & 15, q = lane >> 4, r8 = lane >> 3, c = lane & 7;
    const int G = F.G, bx = F.bx, wave = F.wave;
    const int nit = (4 * (MTOK / 8) - bx + G - 1) / G;
    LAS unsigned char* ldw = F.lds + wave * 16384 + r8 * 2048; LAS unsigned char* ldr = F.lds + wave * 16384 + (32 * q + n) * 128;
    typedef int i32x8 __attribute__((ext_vector_type(8))); typedef int i32x2 __attribute__((ext_vector_type(2)));
#define F2_IT(i) (bx + (i) * G)
#define F2_TOK(i) ((F2_IT(i) >> 2) * 8 + wave)
#define F2_LOADE(EV, i) do { const unsigned* ep_ = E + (size_t)F2_TOK(i) * 128 + 16 * r8; _Pragma("unroll") for (int j_ = 0; j_ < 4; ++j_) EV[j_] = *(const v4u*)(ep_ + 4 * j_); } while (0)
#define F2_LOADB(VRV, AV, XV, SWV, EV, i) do { const size_t co_ = (size_t)(F2_IT(i) & 3) * (NEXP * 128) + 16 * c; \
        _Pragma("unroll") for (int g_ = 0; g_ < 16; ++g_) VRV[g_] = *(const v4u*)(V + (size_t)(EV[g_ >> 2][g_ & 3] & (NEXP - 1)) * 128 + co_); \
        AV = *(const v4u*)(WQ + (size_t)F2_TOK(i) * 192 + 64 * ((n & 3) < 2 ? (n & 3) : 2) + 16 * q); SWV = SW[F2_TOK(i)]; \
        _Pragma("unroll") for (int k_ = 0; k_ < 4; ++k_) XV[k_] = (unsigned)X[(size_t)F2_TOK(i) * DM + 256 * (F2_IT(i) & 3) + 16 * (4 * q + k_) + n]; } while (0)
#define F2_COMP(VRV, AV, XV, SWV, i) do { \
        _Pragma("unroll") for (int g_ = 0; g_ < 16; ++g_) { const v4u w_ = (g_ & 1) ? (v4u){VRV[g_].z, VRV[g_].w, VRV[g_].x, VRV[g_].y} : VRV[g_]; *(LAS v4u*)(ldw + g_ * 128 + 16 * (c ^ (g_ >> 1))) = w_; } \
        const i32x8 wa_ = {(int)AV.x, (int)AV.y, (int)AV.z, (int)AV.w, 0, 0, 0, 0}; \
        float val_[16]; \
        _Pragma("unroll") for (int cg_ = 0; cg_ < 16; ++cg_) { LAS unsigned char* ad_ = ldr + 8 * (cg_ ^ n); \
            const i32x2 r0_ = __builtin_amdgcn_ds_read_tr4_b64_v2i32((LAS i32x2*)ad_), r1_ = __builtin_amdgcn_ds_read_tr4_b64_v2i32((LAS i32x2*)(ad_ + 2048)); \
            const i32x8 vb_ = {r0_.x, r0_.y, r1_.x, r1_.y, 0, 0, 0, 0}; \
            const f32x4 d_ = __builtin_amdgcn_mfma_scale_f32_16x16x128_f8f6f4(wa_, vb_, (f32x4){0.f, 0.f, 0.f, 0.f}, 4, 4, 0, 0x7f7f7f7f, 0, 0x7f7f7f7f); \
            val_[cg_] = d_[0] + d_[1] * (1.0f / 6.0f) + d_[2] * (1.0f / 36.0f); } \
          \
        const int t_ = F2_TOK(i), s_ = F2_IT(i) & 3; const float sw_ = SWV; float ss_ = 0.f; \
        _Pragma("unroll") for (int k_ = 0; k_ < 4; ++k_) { float o_ = val_[k_], o1_ = val_[4 + k_], o2_ = val_[8 + k_], o3_ = val_[12 + k_]; asm volatile("" : "+v"(o_), "+v"(o1_), "+v"(o2_), "+v"(o3_));     \
            o_ = q == 1 ? o1_ : o_; o_ = q == 2 ? o2_ : o_; o_ = q == 3 ? o3_ : o_; \
            const float xo_ = blo(XV[k_]) + o_ * sw_; const size_t col_ = (size_t)256 * s_ + 16 * (4 * q + k_) + n; \
            if (LAST) OUTF[(size_t)t_ * DM + col_] = xo_; else { Xout[(size_t)t_ * DM + col_] = (bf16)f2bf(xo_); ss_ += xo_ * xo_; } } \
        if (!LAST) { ss_ += DPP_F(ss_, 0xB1); ss_ += DPP_F(ss_, 0x4E); ss_ += DPP_F(ss_, 0x141); ss_ += DPP_F(ss_, 0x128);        \
            ss_ += __int_as_float(__builtin_amdgcn_ds_swizzle(__float_as_int(ss_), 0x401F));                                     \
            SSQN[(size_t)t_ * 8 + 2 * s_ + (lane >> 5)] = ss_; } } while (0)
    v4u eA[4], eB[4], aA, aB, vrA[16], vrB[16]; unsigned xA[4], xB[4]; float swA, swB;
#define F2_CL(i) ((i) < nit ? (i) : nit - 1)
    if (nit > 0) {
        F2_LOADE(eA, 0); F2_LOADE(eB, F2_CL(1)); F2_LOADB(vrA, aA, xA, swA, eA, 0);
        for (int i = 0; i < nit; i += 2) {
            F2_LOADE(eA, F2_CL(i + 2));
            F2_LOADB(vrB, aB, xB, swB, eB, F2_CL(i + 1));
            __builtin_amdgcn_sched_barrier(0);
            F2_COMP(vrA, aA, xA, swA, i);
            __builtin_amdgcn_sched_barrier(0);
            F2_LOADE(eB, F2_CL(i + 3));
            F2_LOADB(vrA, aA, xA, swA, eA, F2_CL(i + 2));
            __builtin_amdgcn_sched_barrier(0);
            F2_COMP(vrB, aB, xB, swB, F2_CL(i + 1));
            __builtin_amdgcn_sched_barrier(0);
        }
    }
#undef F2_CL
#undef F2_IT
#undef F2_TOK
#undef F2_LOADE
#undef F2_LOADB
#undef F2_COMP
#undef G1_IT
#undef G1_TOK
}

constexpr int PH_PER_LAYER = 11, N_PHASES = 1 + DEPTH * PH_PER_LAYER;
__global__ void __launch_bounds__(NWAVES * 64, 2) fwd_kernel(Args A) {
    extern __shared__ __attribute__((aligned(16))) unsigned char lds[];
    Frame F;
    F.lds = (LAS unsigned char*)lds;
    F.wave = __builtin_amdgcn_readfirstlane((int)threadIdx.x >> 6);
    F.G = gridDim.x; { const int bx = blockIdx.x; F.vcu = (F.G % 8 == 0) ? (bx % 8) * (F.G / 8) + bx / 8 : bx; }
    F.gw = F.vcu * NWAVES + F.wave; F.NGW = F.G * NWAVES; F.bx = (int)blockIdx.x;
    cg::grid_group grid = cg::this_grid();
    for (int u = threadIdx.x; u < 64; u += NWAVES * 64) ((LAS unsigned*)(F.lds + 131072))[u + 64] = 0u;
    __syncthreads();
    XcdBarrier bar = xcd_barrier_post((unsigned*)(KWS + WS_CTL), (volatile LAS unsigned*)(F.lds + MISC_OFF) + 8);
    const int lo = karg_int(23 * 8), hi = karg_int(23 * 8 + 4);
#ifndef PH_MASK
#define PH_MASK 0xfff
#endif
#define KIND(k) ((k) == 0 ? 0 : 1 + ((k) - 1) % PH_PER_LAYER)
#define IN(k) (((PH_MASK >> KIND(k)) & 1) && lo <= (k) && (k) < hi)
#define SEAM(k) do { if (IN(k) && IN((k) + 1)) xcd_barrier(bar); } while (0)
#ifndef PROBE_KIND
#define PROBE_KIND (-1)
#endif
#define REPS(kind) for (int rep_ = ((kind) == PROBE_KIND ? 0 : 1); rep_ < 2; ++rep_)
#define REP_SYNC() do { if (rep_ == 0) xcd_barrier(bar); } while (0)
    if (lo < 0) grid.sync();
    if (IN(0)) { REPS(0) { ph_prologue(F); REP_SYNC(); } SEAM(0); }
    for (int l = 0; l < DEPTH; ++l) {
        const int p0 = 1 + l * PH_PER_LAYER;
        if (IN(p0 + 0)) { REPS(1) { Frame Fq = fresh_frame(F);
            unsigned char* ws = KWS; unsigned char* wb = ws + WS_W + (size_t)l * W_STRIDE;
            pg8::Gemm g{(const pg8::bf16_t*)(ws + WS_XB), (const pg8::bf16_t*)(wb + WO_WIN), MTOK, INWP, DM}; pg8::StaticOrder S; S.init(MTOK, INWP, Fq.G, Fq.bx);
            pg8::EpiIn E{(pg8::bf16_t*)(ws + WS_GATES), (const float*)KIN(14) + (size_t)l * 2048, (pg8::bf16_t*)(ws + WS_CQ), (pg8::bf16_t*)(ws + WS_CKV), (pg8::bf16_t*)(ws + WS_KPEP), (const float*)(ws + WS_SSQN), (float*)(ws + WS_SSQC), (const int*)KIN(1)};
            pg8::gemm_phase<pg8::EpiIn, pg8::StaticOrder, true, true>(Fq.lds, g, S, E, Fq.wave);
            { const int nu = MTOK / 256 * (INWP / 256), nfull = nu % Fq.G;
              if (nfull == 0) convert_tables(l, Fq.gw, Fq.NGW);
              else if (Fq.bx >= nfull) convert_tables(l, (Fq.bx - nfull) * NWAVES + Fq.wave, (Fq.G - nfull) * NWAVES); }
            REP_SYNC(); }
            SEAM(p0 + 0);
        }
        if (IN(p0 + 1)) { REPS(2) { Frame Fq = fresh_frame(F);
            unsigned char* ws = KWS; unsigned char* wb = ws + WS_W + (size_t)l * W_STRIDE;
            { const int nq = (MTOK / 256) * 3;
              if (nq >= Fq.G) ph_pool(Fq, Fq.gw, Fq.NGW);
              else if (Fq.bx >= nq) ph_pool(Fq, (Fq.bx - nq) * NWAVES + Fq.wave, (Fq.G - nq) * NWAVES); }
            { pg8::Gemm g{(const pg8::bf16_t*)(ws + WS_CQ), (const pg8::bf16_t*)(wb + WO_WUQ), MTOK, 768, QL}; pg8::StaticOrder S; S.init(MTOK, 768, Fq.G, Fq.bx);
              pg8::EpiBf16<0> E{(pg8::bf16_t*)(ws + WS_QRAW), 768, nullptr, 0, 0, 1.f};
              pg8::gemm_phase<pg8::EpiBf16<0>, pg8::StaticOrder, true, true>(Fq.lds, g, S, E, Fq.wave); }
            { int kvl = KVL; asm volatile("" : "+s"(kvl));
              pg8::Gemm g{(const pg8::bf16_t*)(ws + WS_CKV), (const pg8::bf16_t*)(wb + WO_WUKV), MTOK, 1024, kvl}; pg8::StaticOrder S; S.init(MTOK, 1024, Fq.G, Fq.bx);
              pg8::EpiKV E{(pg8::bf16_t*)(ws + WS_K), (pg8::bf16_t*)(ws + WS_VV), (const pg8::bf16_t*)(ws + WS_KPEP), (const float*)(ws + WS_SSQC), (const float*)KIN(9) + l * QKH};
              pg8::gemm_phase<pg8::EpiKV, pg8::StaticOrder, true, true>(Fq.lds, g, S, E, Fq.wave); }
            REP_SYNC(); }
            SEAM(p0 + 1);
        }
        if (IN(p0 + 3)) { REPS(4) { Frame Fq = fresh_frame(F); ph_attn(Fq, lds, l); REP_SYNC(); } SEAM(p0 + 3); }
        if (IN(p0 + 4)) { REPS(5) { Frame Fq = fresh_frame(F);
            unsigned char* ws = KWS; unsigned char* wb = ws + WS_W + (size_t)l * W_STRIDE;
            { pg8::Gemm g{(const pg8::bf16_t*)(ws + WS_O), (const pg8::bf16_t*)(wb + WO_WO), MTOK, DM, 512}; pg8::StaticOrder S; S.init(MTOK, DM, Fq.G, Fq.bx);
              pg8::EpiBf16<0> E{(pg8::bf16_t*)(ws + WS_ABUF), DM, nullptr, 0, 0, 1.f};
              pg8::gemm_phase<pg8::EpiBf16<0>, pg8::StaticOrder, true, true>(Fq.lds, g, S, E, Fq.wave); }
            { pg8::Gemm g{(const pg8::bf16_t*)(ws + WS_MIXED), (const pg8::bf16_t*)(wb + WO_WC), MTOK, DM, 512}; pg8::StaticOrder S; S.init(MTOK, DM, Fq.G, Fq.bx);
              pg8::EpiMix E{(const pg8::bf16_t*)(ws + WS_ABUF), (const pg8::bf16_t*)(ws + WS_GATES), (pg8::bf16_t*)(ws + WS_MIX)};
              pg8::gemm_phase<pg8::EpiMix, pg8::StaticOrder, true, true>(Fq.lds, g, S, E, Fq.wave); }
            REP_SYNC(); }
            SEAM(p0 + 4);
        }
        if (IN(p0 + 5)) { REPS(6) { Frame Fq = fresh_frame(F);
            unsigned char* ws = KWS; unsigned char* wb = ws + WS_W + (size_t)l * W_STRIDE;
            pg8::Gemm g{(const pg8::bf16_t*)(ws + WS_MIX), (const pg8::bf16_t*)(wb + WO_WOUT), MTOK, DM, DM}; pg8::StaticOrder S; S.init(MTOK, DM, Fq.G, Fq.bx);
            pg8::EpiRes E{(const pg8::bf16_t*)(ws + WS_XB), rep_ == 0 ? (pg8::bf16_t*)(ws + WS_GATES) : (pg8::bf16_t*)(ws + WS_XB), (float*)(ws + WS_SSQ)};
            pg8::gemm_phase<pg8::EpiRes, pg8::StaticOrder, true, true>(Fq.lds, g, S, E, Fq.wave);
            REP_SYNC(); }
            SEAM(p0 + 5);
        }
        if (IN(p0 + 6)) { REPS(7) { Frame Fq = fresh_frame(F);
            unsigned char* ws = KWS; unsigned char* wb = ws + WS_W + (size_t)l * W_STRIDE;
            pg8::Gemm g{(const pg8::bf16_t*)(ws + WS_XB), (const pg8::bf16_t*)(wb + WO_WQ), MTOK, 2048, DM}; pg8::StaticOrder S; S.init(MTOK, 2048, Fq.G, Fq.bx);
            pg8::EpiBf16<0> E{(pg8::bf16_t*)(ws + WS_QP), 2048, nullptr, 0, 0, 1.f};
            pg8::gemm_phase<pg8::EpiBf16<0>, pg8::StaticOrder, true, true>(Fq.lds, g, S, E, Fq.wave);
            REP_SYNC(); }
            SEAM(p0 + 6);
        }
        if (IN(p0 + 7)) { REPS(8) { Frame Fq = fresh_frame(F); ph_select(Fq, l); REP_SYNC(); } SEAM(p0 + 7); }
        if (IN(p0 + 8)) { REPS(9) { Frame Fq = fresh_frame(F); ph_g1(Fq, l); REP_SYNC(); } SEAM(p0 + 8); }
        if (IN(p0 + 9)) { REPS(10) { Frame Fq = fresh_frame(F); ph_g1b(Fq, l); REP_SYNC(); } SEAM(p0 + 9); }
        if (IN(p0 + 10)) { REPS(11) { Frame Fq = fresh_frame(F); { bf16* xo = rep_ == 0 ? (bf16*)(KWS + WS_QP) : (bf16*)(KWS + WS_XB); if (l + 1 >= DEPTH) ph_g2<true>(Fq, l, xo); else ph_g2<false>(Fq, l, xo); } REP_SYNC(); } SEAM(p0 + 10); }
    }
#undef IN
#undef SEAM
}

extern "C" void kernel_launch(void* const* d_in, const int* in_sizes, int n_in, void* d_out, int out_size, void* d_ws, size_t ws_size, hipStream_t stream) {
    static int grid = 0;
    if (grid == 0) {
        if (n_in != 21 || in_sizes[0] != MTOK * DM || out_size != MTOK * DM || ws_size < WS_END) {
            fprintf(stderr, "kernel_launch: unexpected shapes: n_in %d in0 %d out %d ws %zu (need %zu)\n", n_in, n_in > 0 ? in_sizes[0] : -1, out_size, ws_size, (size_t)WS_END); grid = -1; return; }
        int dev = 0, cus = 0, per_cu = 0;
        if (hipGetDevice(&dev) != hipSuccess || hipDeviceGetAttribute(&cus, hipDeviceAttributeMultiprocessorCount, dev) != hipSuccess) { grid = -1; return; }
        if (hipFuncSetAttribute((const void*)fwd_kernel, hipFuncAttributeMaxDynamicSharedMemorySize, LDS_BYTES) != hipSuccess) { fprintf(stderr, "kernel_launch: hipFuncSetAttribute failed\n"); grid = -1; return; }
        if (hipOccupancyMaxActiveBlocksPerMultiprocessor(&per_cu, (const void*)fwd_kernel, NWAVES * 64, LDS_BYTES) != hipSuccess || per_cu < 1) { fprintf(stderr, "kernel_launch: occupancy query says %d blocks per CU\n", per_cu); grid = -1; return; }
        (void)hipGetLastError();
        grid = cus & ~7;
    }
    if (grid < 0) return;
    if (hipMemsetAsync((char*)d_ws + WS_CTL, 0, CTL_ZERO_BYTES, stream) != hipSuccess) { fprintf(stderr, "kernel_launch: hipMemsetAsync failed\n"); return; }
    Args a{};
    for (int i = 0; i < 21; ++i) a.in[i] = d_in[i];
    a.out = (float*)d_out; a.ws = (unsigned char*)d_ws;
#if MK_ONE_LAUNCH
    a.ph_lo = 0; a.ph_hi = N_PHASES;
    void* args[] = {&a};
    hipError_t e = hipLaunchCooperativeKernel((const void*)fwd_kernel, dim3(grid), dim3(NWAVES * 64), args, LDS_BYTES, stream);
    if (e != hipSuccess) fprintf(stderr, "kernel_launch: cooperative launch failed: %s (grid %d)\n", hipGetErrorString(e), grid);
#else
    for (int p = 0; p < N_PHASES; ++p) {
        a.ph_lo = p; a.ph_hi = p + 1;
        hipLaunchKernelGGL(fwd_kernel, dim3(grid), dim3(NWAVES * 64), LDS_BYTES, stream, a);
    }
    hipError_t e = hipPeekAtLastError();
    if (e != hipSuccess) fprintf(stderr, "kernel_launch: launch failed: %s\n", hipGetErrorName(e));
#endif
}
```

```cpp
#include <hip/hip_runtime.h>
#include <hip/hip_cooperative_groups.h>
#include <cstdio>
#include <cstdint>
namespace cg = cooperative_groups;
namespace pg8 {
#define PG8_LAS __attribute__((address_space(3)))
typedef unsigned short bf16_t;
typedef short bf16x8 __attribute__((ext_vector_type(8)));
typedef float f32x4 __attribute__((ext_vector_type(4)));
typedef unsigned u32x4 __attribute__((ext_vector_type(4)));
constexpr int BM = 256, BK = 64, HALF = 128, HTB = HALF * BK * 2  , STAGE_BYTES = 8 * HTB, NXCD = 8, WGM = 8;

__host__ __device__ __forceinline__ int lds_byte(int r, int c) { const int st = (r >> 4) * 2 + (c >> 5), rr = r & 15, cc = c & 31, ob = rr * 64 + cc * 2; return st * 1024 + (ob ^ (((ob >> 9) & 1) << 5)); }
__host__ __device__ __forceinline__ void stage_rc(int b, int& R, int& C) { const int st = b / 1024, sb = b % 1024, swz = sb ^ (((sb >> 9) & 1) << 5); R = (st >> 1) * 16 + swz / 64; C = (st & 1) * 32 + (swz % 64) / 2; }
__host__ __device__ __forceinline__ int perm32(int rho) { const int n = rho >> 4, i = rho & 15; return 8 * (i >> 2) + 4 * n + (i & 3); }

struct Unit { int pm, pn; };
struct Gemm { const bf16_t* A; const bf16_t* Bt; int M, N, K; };

struct StaticOrder {
    int nM, nN, nwg, G, c;
    __host__ __device__ void init(int M, int N, int G_, int c_) { nM = M / BM; nN = N / BM; nwg = nM * nN; G = G_; c = c_; }
    __host__ __device__ bool next(int i, Unit& u) const {
        const long L = (long)i * G + c; if (L >= nwg) return false;
        int wgid = (int)L; { const int q = nwg / NXCD, r = nwg % NXCD, xcd = wgid % NXCD, off = wgid / NXCD; wgid = (xcd < r ? xcd * (q + 1) : r * (q + 1) + (xcd - r) * q) + off; }
        const int nig = WGM * nN, gid = wgid / nig, fm = gid * WGM, gsz = (nM - fm) < WGM ? (nM - fm) : WGM;
        u.pm = fm + ((wgid % nig) % gsz); u.pn = (wgid % nig) / gsz; return true;
    }
    __device__ __forceinline__ void a_ready(const Unit&) const {}
    __device__ __forceinline__ void done(const Unit&) const {}
};

__device__ __forceinline__ unsigned cvt_pk_bf16(float lo, float hi) { unsigned r; asm volatile("v_cvt_pk_bf16_f32 %0, %1, %2" : "=v"(r) : "v"(lo), "v"(hi)); return r; }
typedef float f32x2 __attribute__((ext_vector_type(2)));
__device__ __forceinline__ f32x2 gelu_pk(f32x2 v) {
    const f32x2 av = __builtin_elementwise_abs(v), d = av * 0.2316418882f + 1.0f;
    f32x2 t; t.x = __builtin_amdgcn_rcpf(d.x); t.y = __builtin_amdgcn_rcpf(d.y);
    f32x2 q = t * 0.5307027145f + (-0.7265760135f); q = q * t + 0.7107068705f; q = q * t + (-0.142248368f); q = q * t + 0.127414796f; q = q * t;
    const f32x2 s = (v * v) * (-0.72134752044f);
    f32x2 e; e.x = __builtin_amdgcn_exp2f(s.x); e.y = __builtin_amdgcn_exp2f(s.y);
    const f32x2 m = v * (q * e), r = v - m;
    f32x2 o; o.x = v.x < 0.f ? m.x : r.x; o.y = v.y < 0.f ? m.y : r.y; return o;
}

template <int ACT  > struct EpiBf16 {
    static constexpr bool PERM = true, AFTER_DRAIN = false; static_assert(ACT == 0 || ACT == 1, "EpiBf16: ACT is 0 (none) or 1 (gelu_pk)");
    bf16_t* O; int ldc; const float* bias; int split_cols; size_t split_stride; float scale0;
    __device__ __forceinline__ void operator()(const f32x4 (&acc)[2][2][4][2], const Unit& u, int wr, int wc, int fr, int fq) const {
        const int row0 = u.pm * BM + wr * 64 + fr; int colt = u.pn * BM; bf16_t* base = O;
        float sc = 1.f; if (split_cols) { const int t = colt / split_cols; base += (size_t)t * split_stride; colt -= t * split_cols; if (t == 0) sc = scale0; }
        const int col0 = colt + wc * 32 + 8 * fq, bcol0 = u.pn * BM + wc * 32 + 8 * fq;
        f32x4 bv[2][2];
#pragma unroll
        for (int bj = 0; bj < 2; ++bj)
#pragma unroll
            for (int n = 0; n < 2; ++n) bv[bj][n] = bias ? *(const f32x4*)(bias + bcol0 + bj * HALF + 4 * n) : (f32x4){0.f, 0.f, 0.f, 0.f};
#pragma unroll
        for (int ai = 0; ai < 2; ++ai)
#pragma unroll
            for (int m = 0; m < 4; ++m) { bf16_t* rowp = base + (size_t)(row0 + ai * HALF + m * 16) * ldc + col0;
#pragma unroll
                for (int bj = 0; bj < 2; ++bj) { f32x4 v0 = acc[ai][bj][m][0] + bv[bj][0], v1 = acc[ai][bj][m][1] + bv[bj][1];
                    if (ACT == 1) { f32x2 a = gelu_pk((f32x2){v0[0], v0[1]}), b = gelu_pk((f32x2){v0[2], v0[3]}), c = gelu_pk((f32x2){v1[0], v1[1]}), d = gelu_pk((f32x2){v1[2], v1[3]});
                        v0 = (f32x4){a.x, a.y, b.x, b.y}; v1 = (f32x4){c.x, c.y, d.x, d.y}; }
                    v0 = v0 * sc; v1 = v1 * sc; u32x4 w; w.x = cvt_pk_bf16(v0[0], v0[1]); w.y = cvt_pk_bf16(v0[2], v0[3]); w.z = cvt_pk_bf16(v1[0], v1[1]); w.w = cvt_pk_bf16(v1[2], v1[3]);
                    *(u32x4*)(rowp + bj * HALF) = w; } }
    }
};
__device__ __forceinline__ int fresh_lane() { int l; asm volatile("v_mbcnt_lo_u32_b32 %0, -1, 0\n\tv_mbcnt_hi_u32_b32 %0, -1, %0" : "=v"(l)); return l; }
__device__ __forceinline__ float bflo(unsigned w) { return __builtin_bit_cast(float, w << 16); }
__device__ __forceinline__ float bfhi(unsigned w) { return __builtin_bit_cast(float, w & 0xffff0000u); }
__device__ __forceinline__ float sigmoid_f(float x) { return __builtin_amdgcn_rcpf(1.0f + __builtin_amdgcn_exp2f(-1.4426950408889634f * x)); }

struct EpiIn {
    static constexpr bool PERM = true, AFTER_DRAIN = false;
    bf16_t* gates; const float* gbias; bf16_t* cq; bf16_t* ckv; bf16_t* kpep; const float* ssqn; float* ssqc; const int* pos;
    __device__ __forceinline__ void operator()(const f32x4 (&acc)[2][2][4][2], const Unit& u, int wr, int wc, int fr, int fq) const {
        { const int ln = fresh_lane(); fr = ln & 15; fq = ln >> 4; }
        const int row0 = u.pm * BM + wr * 64 + fr;
        float rs[2][4];
#pragma unroll
        for (int ai = 0; ai < 2; ++ai)
#pragma unroll
            for (int m = 0; m < 4; ++m) { const f32x4* sp = (const f32x4*)(ssqn + (size_t)(row0 + ai * HALF + m * 16) * 8); const f32x4 a = sp[0], b = sp[1];
                rs[ai][m] = (1.0f / 8192.0f) / sqrtf(((a[0] + a[1]) + (a[2] + a[3]) + (b[0] + b[1]) + (b[2] + b[3])) * (1.0f / 1024.0f) + 1e-6f); }
#pragma unroll
        for (int bj = 0; bj < 2; ++bj) {
            const int colw = u.pn * BM + bj * HALF + wc * 32;
            bf16_t* dst; int ld; bool gate = false;
            if (colw < 2048) { dst = gates + colw; ld = 2048; gate = true; }
            else { const int pc = colw - 2048;
                if (pc < 384) { dst = cq + pc; ld = 384; }
                else if (pc < 640) { dst = ckv + (pc - 384); ld = 256; }
                else if (pc < 1184) { dst = kpep + (pc - 640); ld = 544; }
                else continue; }
            dst += 8 * fq;
            f32x4 b0 = (f32x4){0.f, 0.f, 0.f, 0.f}, b1 = b0;
            if (gate) { b0 = *(const f32x4*)(gbias + colw + 8 * fq); b1 = *(const f32x4*)(gbias + colw + 8 * fq + 4); }
#pragma unroll
            for (int ai = 0; ai < 2; ++ai)
#pragma unroll
                for (int m = 0; m < 4; ++m) {
                    f32x4 v0 = acc[ai][bj][m][0] * rs[ai][m] + b0, v1 = acc[ai][bj][m][1] * rs[ai][m] + b1;
                    if (gate) {
#pragma unroll
                        for (int j = 0; j < 4; ++j) { v0[j] = sigmoid_f(v0[j]); v1[j] = sigmoid_f(v1[j]); }
                    }
                    if (gate) {
                        typedef unsigned u32x2g __attribute__((ext_vector_type(2)));
                        u32x2g w;
                        w.x = (unsigned)(v0[0] * 255.0f + 0.5f) | ((unsigned)(v0[1] * 255.0f + 0.5f) << 8) | ((unsigned)(v0[2] * 255.0f + 0.5f) << 16) | ((unsigned)(v0[3] * 255.0f + 0.5f) << 24);
                        w.y = (unsigned)(v1[0] * 255.0f + 0.5f) | ((unsigned)(v1[1] * 255.0f + 0.5f) << 8) | ((unsigned)(v1[2] * 255.0f + 0.5f) << 16) | ((unsigned)(v1[3] * 255.0f + 0.5f) << 24);
                        *(u32x2g*)((unsigned char*)gates + (size_t)(row0 + ai * HALF + m * 16) * 2048 + colw + 8 * fq) = w;
                    } else {
                    const int pc = colw - 2048;
                    if (pc <= 640) {
                        float s = (v0[0] * v0[0] + v0[1] * v0[1]) + (v0[2] * v0[2] + v0[3] * v0[3]) + (v1[0] * v1[0] + v1[1] * v1[1]) + (v1[2] * v1[2] + v1[3] * v1[3]);
                        s += __int_as_float(__builtin_amdgcn_ds_swizzle(__float_as_int(s), 0x401F));
                    { unsigned r0_ = __float_as_uint(s), r1_ = r0_;
#if __has_builtin(__builtin_amdgcn_permlane32_swap)
                      auto r_ = __builtin_amdgcn_permlane32_swap(r0_, r1_, false, false); r0_ = r_[0]; r1_ = r_[1];
#else
                      asm volatile("v_permlane32_swap_b32 %0, %1" : "+v"(r0_), "+v"(r1_));
#endif
                      asm volatile("" : "+v"(r0_), "+v"(r1_));
                      s = __uint_as_float(r0_) + __uint_as_float(r1_); }
                        if (fq == 0) ssqc[(size_t)(row0 + ai * HALF + m * 16) * 24 + (pc >> 5)] = s;
                    }
                    if (pc == 640) {
                        const float p = (float)pos[row0 + ai * HALF + m * 16];
                        float x[8] = {v0[0], v0[1], v0[2], v0[3], v1[0], v1[1], v1[2], v1[3]};
#pragma unroll
                        for (int e8 = 0; e8 < 8; ++e8) {
                            const float other = __shfl_xor(x[e8], 32);
                            const float ang = p * __builtin_amdgcn_exp2f(-(float)(8 * (fq & 1) + e8) * 0.8304820237218406f);
                            const float nn = rintf(ang * 0.15915494309189535f);
                            float r = fmaf(-nn, 6.28318548202514648f, ang); r = fmaf(-nn, -1.7484556e-7f, r); r *= 0.15915494309189535f;
                            const float sn = __builtin_amdgcn_sinf(r), cs = __builtin_amdgcn_cosf(r);
                            x[e8] = (fq < 2) ? x[e8] * cs - other * sn : other * sn + x[e8] * cs;
                        }
                        v0 = (f32x4){x[0], x[1], x[2], x[3]}; v1 = (f32x4){x[4], x[5], x[6], x[7]};
                    }
                    u32x4 w; w.x = cvt_pk_bf16(v0[0], v0[1]); w.y = cvt_pk_bf16(v0[2], v0[3]); w.z = cvt_pk_bf16(v1[0], v1[1]); w.w = cvt_pk_bf16(v1[2], v1[3]);
                    *(u32x4*)(dst + (size_t)(row0 + ai * HALF + m * 16) * ld) = w; }
                }
        }
    }
};

struct EpiKV {
    static constexpr bool PERM = true, AFTER_DRAIN = false;
    bf16_t* K; bf16_t* V; const bf16_t* kpep; const float* ssqc; const PG8_LAS float* gk;
    __device__ __forceinline__ void operator()(const f32x4 (&acc)[2][2][4][2], const Unit& u, int wr, int wc, int fr, int fq) const {
        { const int ln = fresh_lane(); fr = ln & 15; fq = ln >> 4; }
        const int row0 = u.pm * BM + wr * 64 + fr, head = 2 * u.pn + (wc >> 1);
        const bool isk = (wc & 1) == 0;
        float rkv_[8], sspe_[8];
#pragma unroll
        for (int hf = 0; hf < 2; ++hf) { f32x4 sa_[4], sb_[4];
#pragma unroll
            for (int m = 0; m < 4; ++m) { const f32x4* sp = (const f32x4*)(ssqc + (size_t)(row0 + hf * HALF + m * 16) * 24); sa_[m] = sp[3]; sb_[m] = sp[4]; }
#pragma unroll
            for (int m = 0; m < 4; ++m) sspe_[4 * hf + m] = isk ? ssqc[(size_t)(row0 + hf * HALF + m * 16) * 24 + 20] : 0.f;
#pragma unroll
            for (int m = 0; m < 4; ++m) rkv_[4 * hf + m] = 16.0f * __builtin_amdgcn_rsqf(((sa_[m][0] + sa_[m][1]) + (sa_[m][2] + sa_[m][3]) + (sb_[m][0] + sb_[m][1]) + (sb_[m][2] + sb_[m][3])) + 256e-6f); }
        u32x4 pe_n = (u32x4){0u, 0u, 0u, 0u};
        if (isk) pe_n = *(const u32x4*)(kpep + (size_t)row0 * 544 + 8 * fq);
#pragma unroll
        for (int ai = 0; ai < 2; ++ai)
#pragma unroll
            for (int m = 0; m < 4; ++m) {
                __builtin_amdgcn_sched_barrier(0);
                const size_t row = (size_t)(row0 + ai * HALF + m * 16);
                const float rkv = rkv_[4 * ai + m];
                const u32x4 pe = pe_n;
                if (isk && (4 * ai + m) < 7) pe_n = *(const u32x4*)(kpep + (size_t)(row0 + ((4 * ai + m + 1) >> 2) * HALF + ((4 * ai + m + 1) & 3) * 16) * 544 + 8 * fq);
                const f32x4 a0 = acc[ai][0][m][0], a1 = acc[ai][0][m][1], b0 = acc[ai][1][m][0], b1 = acc[ai][1][m][1];
                if (isk) {
                    float s = (a0[0] * a0[0] + a0[1] * a0[1]) + (a0[2] * a0[2] + a0[3] * a0[3]) + (a1[0] * a1[0] + a1[1] * a1[1]) + (a1[2] * a1[2] + a1[3] * a1[3])
                            + (b0[0] * b0[0] + b0[1] * b0[1]) + (b0[2] * b0[2] + b0[3] * b0[3]) + (b1[0] * b1[0] + b1[1] * b1[1]) + (b1[2] * b1[2] + b1[3] * b1[3]);
                    s += __int_as_float(__builtin_amdgcn_ds_swizzle(__float_as_int(s), 0x401F));
                    { unsigned r0_ = __float_as_uint(s), r1_ = r0_;
#if __has_builtin(__builtin_amdgcn_permlane32_swap)
                      auto r_ = __builtin_amdgcn_permlane32_swap(r0_, r1_, false, false); r0_ = r_[0]; r1_ = r_[1];
#else
                      asm volatile("v_permlane32_swap_b32 %0, %1" : "+v"(r0_), "+v"(r1_));
#endif
                      asm volatile("" : "+v"(r0_), "+v"(r1_));
                      s = __uint_as_float(r0_) + __uint_as_float(r1_); }
                    const float sspe = sspe_[4 * ai + m];
                    const float rn = 9.797958971f * __builtin_amdgcn_rsqf((rkv * rkv * s + sspe) + 96e-6f), sc = rkv * rn;
                    bf16_t* kp = K + (row * 8 + head) * 96 + 8 * fq;
                    { asm volatile("" ::: "memory"); const f32x4 ga = *(const PG8_LAS f32x4*)(gk + 8 * fq), gb = *(const PG8_LAS f32x4*)(gk + 8 * fq + 4);
                      u32x4 w; w.x = cvt_pk_bf16(a0[0] * sc * ga[0], a0[1] * sc * ga[1]); w.y = cvt_pk_bf16(a0[2] * sc * ga[2], a0[3] * sc * ga[3]);
                      w.z = cvt_pk_bf16(a1[0] * sc * gb[0], a1[1] * sc * gb[1]); w.w = cvt_pk_bf16(a1[2] * sc * gb[2], a1[3] * sc * gb[3]);
                      *(u32x4*)(kp) = w; }
                    { asm volatile("" ::: "memory"); const f32x4 ga = *(const PG8_LAS f32x4*)(gk + 32 + 8 * fq), gb = *(const PG8_LAS f32x4*)(gk + 32 + 8 * fq + 4);
                      u32x4 w; w.x = cvt_pk_bf16(b0[0] * sc * ga[0], b0[1] * sc * ga[1]); w.y = cvt_pk_bf16(b0[2] * sc * ga[2], b0[3] * sc * ga[3]);
                      w.z = cvt_pk_bf16(b1[0] * sc * gb[0], b1[1] * sc * gb[1]); w.w = cvt_pk_bf16(b1[2] * sc * gb[2], b1[3] * sc * gb[3]);
                      *(u32x4*)(kp + 32) = w; }
                    { asm volatile("" ::: "memory"); const f32x4 ga = *(const PG8_LAS f32x4*)(gk + 64 + 8 * fq), gb = *(const PG8_LAS f32x4*)(gk + 64 + 8 * fq + 4);
                      u32x4 w; w.x = cvt_pk_bf16(bflo(pe.x) * rn * ga[0], bfhi(pe.x) * rn * ga[1]); w.y = cvt_pk_bf16(bflo(pe.y) * rn * ga[2], bfhi(pe.y) * rn * ga[3]);
                      w.z = cvt_pk_bf16(bflo(pe.z) * rn * gb[0], bfhi(pe.z) * rn * gb[1]); w.w = cvt_pk_bf16(bflo(pe.w) * rn * gb[2], bfhi(pe.w) * rn * gb[3]);
                      *(u32x4*)(kp + 64) = w; }
                } else {
                    bf16_t* vp = V + (row * 8 + head) * 64 + 8 * fq;
                    u32x4 w; w.x = cvt_pk_bf16(a0[0] * rkv, a0[1] * rkv); w.y = cvt_pk_bf16(a0[2] * rkv, a0[3] * rkv); w.z = cvt_pk_bf16(a1[0] * rkv, a1[1] * rkv); w.w = cvt_pk_bf16(a1[2] * rkv, a1[3] * rkv);
                    *(u32x4*)(vp) = w;
                    w.x = cvt_pk_bf16(b0[0] * rkv, b0[1] * rkv); w.y = cvt_pk_bf16(b0[2] * rkv, b0[3] * rkv); w.z = cvt_pk_bf16(b1[0] * rkv, b1[1] * rkv); w.w = cvt_pk_bf16(b1[2] * rkv, b1[3] * rkv);
                    *(u32x4*)(vp + 32) = w;
                }
            }
    }
};

struct EpiMix {
    static constexpr bool PERM = true, AFTER_DRAIN = false;
    const bf16_t* a; const bf16_t* gates; bf16_t* mix;
    __device__ __forceinline__ void operator()(const f32x4 (&acc)[2][2][4][2], const Unit& u, int wr, int wc, int fr, int fq) const {
        const int row0 = u.pm * BM + wr * 64 + fr, col0 = u.pn * BM + wc * 32 + 8 * fq;
#pragma unroll
        for (int ai = 0; ai < 2; ++ai)
#pragma unroll
            for (int m = 0; m < 4; ++m) {
                const size_t row = (size_t)(row0 + ai * HALF + m * 16);
#pragma unroll
                for (int bj = 0; bj < 2; ++bj) {
                    const int c = col0 + bj * HALF;
                    const u32x4 av = *(const u32x4*)(a + row * 1024 + c);
                    typedef unsigned u32x2g __attribute__((ext_vector_type(2)));
                    const u32x2g g0 = *(const u32x2g*)((const unsigned char*)gates + row * 2048 + c);
                    const u32x2g g1 = *(const u32x2g*)((const unsigned char*)gates + row * 2048 + 1024 + c);
                    const float k = 1.0f / 255.0f;
                    const f32x4 v0 = acc[ai][bj][m][0] * k, v1 = acc[ai][bj][m][1] * k;
#define GB(W, B) ((float)(((W) >> (8 * (B))) & 0xffu))
                    const float m0_ = (GB(g0.x, 0) * k * bflo(av.x) + GB(g1.x, 0) * v0[0]) * 16.f, m1_ = (GB(g0.x, 1) * k * bfhi(av.x) + GB(g1.x, 1) * v0[1]) * 16.f;
                    const float m2_ = (GB(g0.x, 2) * k * bflo(av.y) + GB(g1.x, 2) * v0[2]) * 16.f, m3_ = (GB(g0.x, 3) * k * bfhi(av.y) + GB(g1.x, 3) * v0[3]) * 16.f;
                    const float m4_ = (GB(g0.y, 0) * k * bflo(av.z) + GB(g1.y, 0) * v1[0]) * 16.f, m5_ = (GB(g0.y, 1) * k * bfhi(av.z) + GB(g1.y, 1) * v1[1]) * 16.f;
                    const float m6_ = (GB(g0.y, 2) * k * bflo(av.w) + GB(g1.y, 2) * v1[2]) * 16.f, m7_ = (GB(g0.y, 3) * k * bfhi(av.w) + GB(g1.y, 3) * v1[3]) * 16.f;
#undef GB
                    int w0_ = __builtin_amdgcn_cvt_pk_fp8_f32(m0_, m1_, 0, false); w0_ = __builtin_amdgcn_cvt_pk_fp8_f32(m2_, m3_, w0_, true);
                    int w1_ = __builtin_amdgcn_cvt_pk_fp8_f32(m4_, m5_, 0, false); w1_ = __builtin_amdgcn_cvt_pk_fp8_f32(m6_, m7_, w1_, true);
                    *(u32x2g*)((unsigned char*)mix + row * 1024 + c) = (u32x2g){(unsigned)w0_, (unsigned)w1_};
                }
            }
    }
};

struct EpiRes {
    static constexpr bool PERM = false, AFTER_DRAIN = false;
    const bf16_t* xin; bf16_t* xout; float* ssq;
    __device__ __forceinline__ void operator()(const f32x4 (&acc)[2][2][4][2], const Unit& u, int wr, int wc, int fr, int fq) const {
        { const int ln = fresh_lane(); fr = ln & 15; fq = ln >> 4; }
        const int row0 = u.pm * BM + wr * 64 + fr, col0 = u.pn * BM + wc * 32 + 4 * fq;
        typedef unsigned u32x2 __attribute__((ext_vector_type(2)));
#pragma unroll
        for (int ai = 0; ai < 2; ++ai)
#pragma unroll
            for (int m = 0; m < 4; ++m) {
                const size_t row = (size_t)(row0 + ai * HALF + m * 16); float s = 0.f;
#pragma unroll
                for (int bj = 0; bj < 2; ++bj)
#pragma unroll
                    for (int n = 0; n < 2; ++n) {
                        const size_t off = row * 1024 + col0 + bj * HALF + n * 16;
                        const u32x2 xi = *(const u32x2*)(xin + off);
                        const f32x4 xo = (f32x4){bflo(xi.x), bfhi(xi.x), bflo(xi.y), bfhi(xi.y)} + acc[ai][bj][m][n] * (1.0f / 8192.0f);
                        s += (xo[0] * xo[0] + xo[1] * xo[1]) + (xo[2] * xo[2] + xo[3] * xo[3]);
                        u32x2 w; w.x = cvt_pk_bf16(xo[0], xo[1]); w.y = cvt_pk_bf16(xo[2], xo[3]);
                        *(u32x2*)(xout + off) = w;
                    }
                s += __int_as_float(__builtin_amdgcn_ds_swizzle(__float_as_int(s), 0x401F));
                    { unsigned r0_ = __float_as_uint(s), r1_ = r0_;
#if __has_builtin(__builtin_amdgcn_permlane32_swap)
                      auto r_ = __builtin_amdgcn_permlane32_swap(r0_, r1_, false, false); r0_ = r_[0]; r1_ = r_[1];
#else
                      asm volatile("v_permlane32_swap_b32 %0, %1" : "+v"(r0_), "+v"(r1_));
#endif
                      asm volatile("" : "+v"(r0_), "+v"(r1_));
                      s = __uint_as_float(r0_) + __uint_as_float(r1_); }
                if (fq == 0) ssq[row * 16 + u.pn * 4 + wc] = s;
            }
    }
};
template <class Epi, class Sched, bool ALIGN_EPI = false, bool SP2 = false, bool FP8 = false>
__device__ __forceinline__ void gemm_phase(PG8_LAS unsigned char* lds, const Gemm g, const Sched& S, const Epi& E, const int wave_id) {
    const int wid = wave_id, lane = fresh_lane(), tid = (wid << 6) | lane, wr = wid >> 2, wc = wid & 3, fr = lane & 15, fq = lane >> 4;
    const int K = g.K, nt = K / BK;
    unsigned voffA[2], voffB[2];
#pragma unroll
    for (int i = 0; i < 2; ++i) { int R, C; stage_rc(tid * 16 + i * 8192, R, C); const int Rb = Epi::PERM ? ((R & ~31) + perm32(R & 31)) : R;
        voffA[i] = (unsigned)(R * K + C) * 2u; voffB[i] = (unsigned)(Rb * K + C) * 2u; }
    const char* voffA_base = (const char*)g.A; const char* voffB_base = (const char*)g.Bt;
    const __amdgpu_buffer_rsrc_t voffA_rs = __builtin_amdgcn_make_buffer_rsrc((void*)g.A, 0, 0x7fffffff, 0x00020000), voffB_rs = __builtin_amdgcn_make_buffer_rsrc((void*)g.Bt, 0, 0x7fffffff, 0x00020000);
    const size_t kstep = (size_t)(BK * 2);
    const size_t hstep = (size_t)HALF * K * 2;
    const size_t tstep = 2 * hstep;
    const unsigned ldsw = (unsigned)wid * 1024u;
    const int aoff = lds_byte(wr * 64 + fr, fq * 8), boff = lds_byte(wc * 32 + fr, fq * 8);
#define PG8_SA(b, h) (((b) * 2 + (h)) * HTB)
#define PG8_SB(b, h) ((4 + (b) * 2 + (h)) * HTB)
#define PG8_STAGE(bufoff, gbase, voff) do { if constexpr (FP8) { const int so_ = (int)((const char*)(gbase) - voff##_base); _Pragma("unroll") for (int _i = 0; _i < 2; ++_i) \
        __builtin_amdgcn_raw_ptr_buffer_load_lds(voff##_rs, (PG8_LAS unsigned*)(lds + (bufoff) + ldsw + _i * 8192), 16, (int)(voff)[_i], so_, 0, 0); } \
    else { _Pragma("unroll") for (int _i = 0; _i < 2; ++_i) \
        __builtin_amdgcn_global_load_lds((const unsigned*)((const char*)(gbase) + (voff)[_i]), (PG8_LAS unsigned*)(lds + (bufoff) + ldsw + _i * 8192), 16, 0, 0); } } while (0)
#define PG8_LDA(dst, b, h) do { _Pragma("unroll") for (int m = 0; m < 4; ++m) _Pragma("unroll") for (int k = 0; k < 2; ++k) dst[m][k] = *(const PG8_LAS bf16x8*)(lds + PG8_SA(b, h) + aoff + m * 2048 + k * 1024); } while (0)
#define PG8_LDB(dst, b, h) do { _Pragma("unroll") for (int n = 0; n < 2; ++n) _Pragma("unroll") for (int k = 0; k < 2; ++k) dst[n][k] = *(const PG8_LAS bf16x8*)(lds + PG8_SB(b, h) + boff + n * 2048 + k * 1024); } while (0)
#define PG8_MMA(ai, bj, At, Bt) do { __builtin_amdgcn_s_setprio(1); _Pragma("unroll") for (int m = 0; m < 4; ++m) _Pragma("unroll") for (int n = 0; n < 2; ++n) { \
        if constexpr (FP8) { typedef int i32x8_ __attribute__((ext_vector_type(8))); typedef int i32x4_ __attribute__((ext_vector_type(4))); \
            const i32x8_ bb_ = __builtin_shufflevector(__builtin_bit_cast(i32x4_, Bt[n][0]), __builtin_bit_cast(i32x4_, Bt[n][1]), 0, 1, 2, 3, 4, 5, 6, 7); \
            const i32x8_ aa_ = __builtin_shufflevector(__builtin_bit_cast(i32x4_, At[m][0]), __builtin_bit_cast(i32x4_, At[m][1]), 0, 1, 2, 3, 4, 5, 6, 7); \
            acc[ai][bj][m][n] = __builtin_amdgcn_mfma_scale_f32_16x16x128_f8f6f4(bb_, aa_, acc[ai][bj][m][n], 0, 0, 0, 0x7f7f7f7f, 0, 0x7f7f7f7f); } \
        else { _Pragma("unroll") for (int k = 0; k < 2; ++k) acc[ai][bj][m][n] = __builtin_amdgcn_mfma_f32_16x16x32_bf16(Bt[n][k], At[m][k], acc[ai][bj][m][n], 0, 0, 0); } } \
        __builtin_amdgcn_s_setprio(0); } while (0)
#define PG8_WAIT_V(n) asm volatile("s_waitcnt vmcnt(" #n ")" ::: "memory")
#define PG8_WAIT_L(n) asm volatile("s_waitcnt lgkmcnt(" #n ")" ::: "memory")
#define PG8_BAR __builtin_amdgcn_s_barrier()
#define PG8_SCHED __builtin_amdgcn_sched_barrier(0)
    Unit cur, nxt; int ui = 0;
    if (!S.next(0, cur)) return;
    f32x4 acc[2][2][4][2];
#pragma unroll
    for (int a = 0; a < 2; ++a)
#pragma unroll
        for (int b = 0; b < 2; ++b)
#pragma unroll
            for (int m = 0; m < 4; ++m)
#pragma unroll
                for (int n = 0; n < 2; ++n) acc[a][b][m][n] = (f32x4){0.f, 0.f, 0.f, 0.f};
    bf16x8 At[4][2], B0[2][2], B1[2][2];
    const char* cA = (const char*)g.A + (size_t)cur.pm * tstep; const char* cB = (const char*)g.Bt + (size_t)cur.pn * tstep;
    S.a_ready(cur);
    if constexpr (SP2) {
        PG8_STAGE(PG8_SB(0, 0), cB, voffB); PG8_STAGE(PG8_SB(0, 1), cB + hstep, voffB); PG8_STAGE(PG8_SA(0, 0), cA, voffA); PG8_STAGE(PG8_SA(0, 1), cA + hstep, voffA);
        if (wr == 1) PG8_BAR;
        PG8_WAIT_V(2); PG8_BAR;
        PG8_STAGE(PG8_SB(1, 0), cB + kstep, voffB); PG8_STAGE(PG8_SA(1, 0), cA + kstep, voffA); PG8_STAGE(PG8_SB(1, 1), cB + hstep + kstep, voffB);
        PG8_WAIT_V(6); PG8_BAR;
    } else {
        PG8_STAGE(PG8_SB(0, 0), cB, voffB); PG8_STAGE(PG8_SA(0, 0), cA, voffA); PG8_STAGE(PG8_SB(0, 1), cB + hstep, voffB); PG8_STAGE(PG8_SA(0, 1), cA + hstep, voffA);
        if (wr == 1) PG8_BAR;
        PG8_WAIT_V(4); PG8_BAR;
        PG8_STAGE(PG8_SB(1, 0), cB + kstep, voffB); PG8_STAGE(PG8_SA(1, 0), cA + kstep, voffA); PG8_STAGE(PG8_SB(1, 1), cB + hstep + kstep, voffB);
        PG8_WAIT_V(6); PG8_BAR;
    }
    for (;;) {
        const bool has_next = S.next(ui + 1, nxt);
        const char* nA = has_next ? (const char*)g.A + (size_t)nxt.pm * tstep : cA; const char* nB = has_next ? (const char*)g.Bt + (size_t)nxt.pn * tstep : cB;
        for (int t = 0; t < nt; t += 2) {
            const bool last = (t == nt - 2);
            const char* a1 = cA + (size_t)(t + 1) * kstep;
            const char* a2 = last ? nA : cA + (size_t)(t + 2) * kstep; const char* b2 = last ? nB : cB + (size_t)(t + 2) * kstep;
            const char* a3 = a2 + kstep; const char* b3 = b2 + kstep;
            if (last && has_next) S.a_ready(nxt);
            if constexpr (SP2) {
            PG8_LDB(B0, 0, 0); PG8_LDB(B1, 0, 1); PG8_SCHED; PG8_LDA(At, 0, 0); PG8_STAGE(PG8_SA(1, 1), a1 + hstep, voffA);
            PG8_WAIT_V(8); PG8_WAIT_L(0); PG8_BAR; PG8_MMA(0, 0, At, B0); PG8_MMA(0, 1, At, B1); PG8_BAR; PG8_SCHED;
            PG8_LDA(At, 0, 1); PG8_STAGE(PG8_SB(0, 0), b2, voffB); PG8_STAGE(PG8_SB(0, 1), b2 + hstep, voffB); PG8_STAGE(PG8_SA(0, 0), a2, voffA);
            PG8_WAIT_V(8); PG8_WAIT_L(0); PG8_BAR; PG8_MMA(1, 0, At, B0); PG8_MMA(1, 1, At, B1); PG8_BAR; PG8_SCHED;
            PG8_LDB(B0, 1, 0); PG8_LDB(B1, 1, 1); PG8_SCHED; PG8_LDA(At, 1, 0); PG8_STAGE(PG8_SA(0, 1), a2 + hstep, voffA);
            PG8_WAIT_V(8); PG8_WAIT_L(0); PG8_BAR; PG8_MMA(0, 0, At, B0); PG8_MMA(0, 1, At, B1); PG8_BAR; PG8_SCHED;
            PG8_LDA(At, 1, 1); PG8_STAGE(PG8_SB(1, 0), b3, voffB); PG8_STAGE(PG8_SB(1, 1), b3 + hstep, voffB); PG8_STAGE(PG8_SA(1, 0), a3, voffA);
            PG8_WAIT_V(8); PG8_WAIT_L(0); PG8_BAR; PG8_MMA(1, 0, At, B0); PG8_MMA(1, 1, At, B1); PG8_BAR; PG8_SCHED;
            } else {
            PG8_LDB(B0, 0, 0); PG8_SCHED; PG8_LDA(At, 0, 0); PG8_STAGE(PG8_SA(1, 1), a1 + hstep, voffA);
            PG8_WAIT_L(8); PG8_BAR; PG8_WAIT_L(0); PG8_MMA(0, 0, At, B0); PG8_BAR; PG8_SCHED;
            PG8_LDB(B1, 0, 1); PG8_STAGE(PG8_SB(0, 0), b2, voffB);
            PG8_BAR; PG8_WAIT_L(0); PG8_MMA(0, 1, At, B1); PG8_BAR;
            PG8_LDA(At, 0, 1); PG8_STAGE(PG8_SA(0, 0), a2, voffA);
            PG8_BAR; PG8_WAIT_L(0); PG8_MMA(1, 0, At, B0); PG8_BAR; PG8_SCHED;
            PG8_STAGE(PG8_SB(0, 1), b2 + hstep, voffB);
            PG8_WAIT_V(6); PG8_BAR; PG8_MMA(1, 1, At, B1); PG8_BAR;
            PG8_LDB(B0, 1, 0); PG8_SCHED; PG8_LDA(At, 1, 0); PG8_STAGE(PG8_SA(0, 1), a2 + hstep, voffA);
            PG8_WAIT_L(8); PG8_BAR; PG8_WAIT_L(0); PG8_MMA(0, 0, At, B0); PG8_BAR; PG8_SCHED;
            PG8_LDB(B1, 1, 1); PG8_STAGE(PG8_SB(1, 0), b3, voffB);
            PG8_BAR; PG8_WAIT_L(0); PG8_MMA(0, 1, At, B1); PG8_BAR;
            PG8_LDA(At, 1, 1); PG8_STAGE(PG8_SA(1, 0), a3, voffA);
            PG8_BAR; PG8_WAIT_L(0); PG8_MMA(1, 0, At, B0); PG8_BAR; PG8_SCHED;
            PG8_STAGE(PG8_SB(1, 1), b3 + hstep, voffB);
            PG8_WAIT_V(6); PG8_BAR; PG8_MMA(1, 1, At, B1); PG8_BAR;
            }
        }
        if constexpr (ALIGN_EPI) { if (wr == 0) PG8_BAR; }
        if constexpr (!Epi::AFTER_DRAIN) { E(acc, cur, wr, wc, fr, fq); S.done(cur); }
        if (!has_next) break;
#pragma unroll
        for (int a = 0; a < 2; ++a)
#pragma unroll
            for (int b = 0; b < 2; ++b)
#pragma unroll
                for (int m = 0; m < 4; ++m)
#pragma unroll
                    for (int n = 0; n < 2; ++n) acc[a][b][m][n] = (f32x4){0.f, 0.f, 0.f, 0.f};
        cur = nxt; cA = nA; cB = nB; ++ui;
        if constexpr (ALIGN_EPI) { if (wr == 1) PG8_BAR; }
    }
    PG8_WAIT_V(0);
    if constexpr (!ALIGN_EPI) { if (wr == 0) PG8_BAR; }
    PG8_BAR;
    if constexpr (Epi::AFTER_DRAIN) { E.fused(acc, cur, wr, wc, fr, fq, lds, wid, lane); S.done(cur); }
#undef PG8_SA
#undef PG8_SB
#undef PG8_STAGE
#undef PG8_LDA
#undef PG8_LDB
#undef PG8_MMA
#undef PG8_WAIT_V
#undef PG8_WAIT_L
#undef PG8_BAR
#undef PG8_SCHED
}
}
namespace att {
typedef unsigned short bf16;
using bf16x8 = __attribute__((ext_vector_type(8))) short;
using s16x4  = __attribute__((ext_vector_type(4))) short;
using f32x16 = __attribute__((ext_vector_type(16))) float;
using u32x4  = __attribute__((ext_vector_type(4))) unsigned;
constexpr int   DQ = 96, DV = 64, NW = 8, QBLK = 32, KVBLK = 64;
constexpr int   ND0 = DQ / 16;
constexpr int   NDV = DV / 32;
constexpr float SCALE = 0.10206207261596575f;
constexpr float THR = 8.f;
constexpr int   LDQ = 768, LDK = 768, LDV = 512, LDO = 512;
constexpr size_t SHM_V = KVBLK * 128 * 2, SHM_K = KVBLK * 128 * 2, SHM_ATTN = 2 * SHM_V + 2 * SHM_K + NW * 64 * 4;
#define KSWZ(row, colB) ((row) * 256 + ((colB) ^ (((row) & 7) << 4)))
#define SBAR() __builtin_amdgcn_sched_barrier(0)
__device__ __forceinline__ int crow(int r, int hi) { return (r & 3) + 8 * (r >> 2) + 4 * hi; }
__device__ __forceinline__ unsigned cvtpk(float lo, float hi) { unsigned r; asm volatile("v_cvt_pk_bf16_f32 %0, %1, %2" : "=v"(r) : "v"(lo), "v"(hi)); return r; }

__device__ __forceinline__ void partialSM(f32x16& p0, f32x16& p1, float& m_reg, float& mn, float& alpha) {
  float pmax = p0[0];
#pragma unroll
  for (int r = 1; r < 16; ++r) pmax = fmaxf(pmax, p0[r]);
#pragma unroll
  for (int r = 0; r < 16; ++r) pmax = fmaxf(pmax, p1[r]);
  { auto rr = __builtin_amdgcn_permlane32_swap(__float_as_uint(pmax), __float_as_uint(pmax), false, false);
    pmax = fmaxf(__uint_as_float(rr[0]), __uint_as_float(rr[1])); }
  if (__builtin_expect(__all(pmax - m_reg <= THR * 1.4426950408889634f), 1)) { mn = m_reg; alpha = 1.f; }
  else { mn = fmaxf(m_reg, pmax); alpha = __builtin_amdgcn_exp2f(m_reg - mn); m_reg = mn; }
#pragma unroll
  for (int r = 0; r < 16; ++r) p0[r] = p0[r] - mn;
#pragma unroll
  for (int r = 0; r < 16; ++r) p1[r] = p1[r] - mn;
#pragma unroll
  for (int r = 0; r < 16; ++r) p0[r] = __builtin_amdgcn_exp2f(p0[r]);
}
__device__ __forceinline__ void partialSM_fixed(f32x16& p0, f32x16& p1) {
#pragma unroll
  for (int r = 0; r < 16; ++r) p0[r] = __builtin_amdgcn_exp2f(p0[r]);
  (void)p1;
}
__device__ __forceinline__ void finishSM(f32x16& p0, f32x16& p1, float alpha, float& l_reg, bf16x8& pa0, bf16x8& pa1, bf16x8& pa2, bf16x8& pa3) {
#pragma unroll
  for (int r = 0; r < 16; ++r) p1[r] = __builtin_amdgcn_exp2f(p1[r]);
  float ps = 0;
#pragma unroll
  for (int r = 0; r < 16; ++r) ps += p0[r];
#pragma unroll
  for (int r = 0; r < 16; ++r) ps += p1[r];
  { auto rr = __builtin_amdgcn_permlane32_swap(__float_as_uint(ps), __float_as_uint(ps), false, false);
    ps = __uint_as_float(rr[0]) + __uint_as_float(rr[1]); }
  l_reg = l_reg * alpha + ps;
#define PK4(P, BASE, OUT) do { unsigned a0 = cvtpk(P[BASE + 0], P[BASE + 1]), a1 = cvtpk(P[BASE + 2], P[BASE + 3]);   \
    unsigned b0 = cvtpk(P[BASE + 4], P[BASE + 5]), b1 = cvtpk(P[BASE + 6], P[BASE + 7]);                              \
    auto r0 = __builtin_amdgcn_permlane32_swap(a0, b0, false, false); auto r1 = __builtin_amdgcn_permlane32_swap(a1, b1, false, false); \
    u32x4 w = {r0[0], r1[0], r0[1], r1[1]}; OUT = *reinterpret_cast<bf16x8*>(&w); } while (0)
  PK4(p0, 0, pa0); PK4(p0, 8, pa1); PK4(p1, 0, pa2); PK4(p1, 8, pa3);
#undef PK4
}
__device__ __forceinline__ void qkt(f32x16& p0, f32x16& p1, const bf16* Ks, const bf16x8* qr, int r32, int hi, float init) {
#pragma unroll
  for (int r = 0; r < 16; ++r) { p0[r] = init; p1[r] = init; }
#pragma unroll
  for (int d0 = 0; d0 < ND0; ++d0) { int cb = (d0 * 16 + hi * 8) * 2;
    bf16x8 b0 = *reinterpret_cast<const bf16x8*>((const char*)Ks + KSWZ(r32, cb));
    bf16x8 b1 = *reinterpret_cast<const bf16x8*>((const char*)Ks + KSWZ(32 + r32, cb));
    p0 = __builtin_amdgcn_mfma_f32_32x32x16_bf16(b0, qr[d0], p0, 0, 0, 0);
    p1 = __builtin_amdgcn_mfma_f32_32x32x16_bf16(b1, qr[d0], p1, 0, 0, 0); }
}
__device__ __forceinline__ int v_st(int k, int c) { const int kk = (k & ~0xC) | ((k & 4) << 1) | ((k & 8) >> 1); return ((kk >> 3) * 4 + (c >> 5)) * 512 + ((kk & 7) * 32 + (c & 31)) * 2; }
__device__ __forceinline__ int v_rd_base(int lane) { return ((lane & 3) << 3) | (((lane >> 2) & 3) << 6) | (((lane >> 4) & 1) << 5) | (((lane >> 5) & 1) << 8); }
constexpr int v_rd_off(int d0, int ks, int half) { return d0 * 512 + ks * 4096 + half * 2048; }
template <int OFF> __device__ __forceinline__ s16x4 tr_read(int vb) {
  s16x4 r; asm volatile("ds_read_b64_tr_b16 %0, %1 offset:%2" : "=&v"(r) : "v"(vb), "i"(OFF) : "memory"); return r;
}
template <int D0> __device__ __forceinline__ void pv_one(f32x16& od, int vb, bf16x8 pa0, bf16x8 pa1, bf16x8 pa2, bf16x8 pa3) {
  const s16x4 l0 = tr_read<v_rd_off(D0, 0, 0)>(vb), h0 = tr_read<v_rd_off(D0, 0, 1)>(vb), l1 = tr_read<v_rd_off(D0, 1, 0)>(vb), h1 = tr_read<v_rd_off(D0, 1, 1)>(vb);
  const s16x4 l2 = tr_read<v_rd_off(D0, 2, 0)>(vb), h2 = tr_read<v_rd_off(D0, 2, 1)>(vb), l3 = tr_read<v_rd_off(D0, 3, 0)>(vb), h3 = tr_read<v_rd_off(D0, 3, 1)>(vb);
  asm volatile("s_waitcnt lgkmcnt(0)" ::: "memory"); SBAR();
#define PK(L, H) (bf16x8){L[0], L[1], L[2], L[3], H[0], H[1], H[2], H[3]}
  od = __builtin_amdgcn_mfma_f32_32x32x16_bf16(pa0, PK(l0, h0), od, 0, 0, 0);
  od = __builtin_amdgcn_mfma_f32_32x32x16_bf16(pa1, PK(l1, h1), od, 0, 0, 0);
  od = __builtin_amdgcn_mfma_f32_32x32x16_bf16(pa2, PK(l2, h2), od, 0, 0, 0);
  od = __builtin_amdgcn_mfma_f32_32x32x16_bf16(pa3, PK(l3, h3), od, 0, 0, 0);
#undef PK
}
__device__ __forceinline__ void pv_d0(f32x16* o, int vb, bf16x8 pa0, bf16x8 pa1, bf16x8 pa2, bf16x8 pa3) {
  pv_one<0>(o[0], vb, pa0, pa1, pa2, pa3); pv_one<1>(o[1], vb, pa0, pa1, pa2, pa3);
}

__device__ __forceinline__ void attn_dense_body(const bf16* __restrict__ Qb, const bf16* __restrict__ Kh, const bf16* __restrict__ Vh,
                                                bf16* __restrict__ Ob, int seq, char* lds, const int wave_id,
                                                const float* __restrict__ ssq, const int* __restrict__ posp, const float* __restrict__ gq, const float* __restrict__ gkp) {
  const int wid = wave_id, lane = pg8::fresh_lane(), tid = (wid << 6) | lane, r32 = lane & 31, hi = lane >> 5;
  bf16* V_lds = (bf16*)lds; bf16* K_lds = (bf16*)(lds + 2 * SHM_V);
  float* ws = (float*)(lds + 2 * SHM_V + 2 * SHM_K) + wid * 64; float* li_l = ws; float* al_l = ws + 32;
  float m_reg = -1e30f, l_reg = 0, m_bound = 0.f; f32x16 o[NDV] = {}; bf16x8 qr[ND0];
  const bf16* Qw = Qb + (long)(wid * QBLK + r32) * LDQ + hi * 8;
#pragma unroll
  for (int d0 = 0; d0 < ND0; ++d0) qr[d0] = *reinterpret_cast<const bf16x8*>(Qw + d0 * 16);
  {
    const int rowi = wid * QBLK + r32;
    const pg8::f32x4* sp = (const pg8::f32x4*)(ssq + (long)rowi * 24); const pg8::f32x4 sa = sp[0], sb = sp[1], sc = sp[2];
    const float p = (float)posp[rowi];
    const float rq = __builtin_amdgcn_rsqf(((sa[0] + sa[1]) + (sa[2] + sa[3]) + (sb[0] + sb[1]) + (sb[2] + sb[3]) + (sc[0] + sc[1]) + (sc[2] + sc[3])) * (1.0f / 384.0f) + 1e-6f);
    float xs[ND0][8]; float ss = 0.f, qn2 = 0.f;
#pragma unroll
    for (int d0 = 0; d0 < 4; ++d0)
#pragma unroll
      for (int j = 0; j < 8; ++j) { const float x = __uint_as_float((unsigned)(unsigned short)qr[d0][j] << 16) * rq; xs[d0][j] = x; ss += x * x; }
#pragma unroll
    for (int j = 0; j < 8; ++j) {
      const float ang = p * __builtin_amdgcn_exp2f(-(float)(8 * hi + j) * 0.8304820237218406f);
      const float n = rintf(ang * 0.15915494309189535f);
      float r = fmaf(-n, 6.28318548202514648f, ang); r = fmaf(-n, -1.7484556e-7f, r); r *= 0.15915494309189535f;
      const float sn = __builtin_amdgcn_sinf(r), cs = __builtin_amdgcn_cosf(r);
      const float x1 = __uint_as_float((unsigned)(unsigned short)qr[4][j] << 16) * rq, x2 = __uint_as_float((unsigned)(unsigned short)qr[5][j] << 16) * rq;
      const float y1 = x1 * cs - x2 * sn, y2 = x1 * sn + x2 * cs;
      xs[4][j] = y1; xs[5][j] = y2; ss += y1 * y1 + y2 * y2; }
    { unsigned r0_ = __float_as_uint(ss), r1_ = r0_;
      auto r_ = __builtin_amdgcn_permlane32_swap(r0_, r1_, false, false); r0_ = r_[0]; r1_ = r_[1];
      asm volatile("" : "+v"(r0_), "+v"(r1_));
      ss = __uint_as_float(r0_) + __uint_as_float(r1_); }
    const float rn = __builtin_amdgcn_rsqf(ss * (1.0f / 96.0f) + 1e-6f);
#pragma unroll
    for (int d0 = 0; d0 < ND0; ++d0) {
      const pg8::f32x4 ga = *(const pg8::f32x4*)(gq + 16 * d0 + 8 * hi), gb = *(const pg8::f32x4*)(gq + 16 * d0 + 8 * hi + 4);
      float f_[8] = {xs[d0][0] * rn * ga[0], xs[d0][1] * rn * ga[1], xs[d0][2] * rn * ga[2], xs[d0][3] * rn * ga[3], xs[d0][4] * rn * gb[0], xs[d0][5] * rn * gb[1], xs[d0][6] * rn * gb[2], xs[d0][7] * rn * gb[3]};
#pragma unroll
      for (int j = 0; j < 8; ++j) { qn2 += f_[j] * f_[j]; f_[j] *= SCALE * 1.4426950408889634f; }
      u32x4 w; w.x = cvtpk(f_[0], f_[1]); w.y = cvtpk(f_[2], f_[3]); w.z = cvtpk(f_[4], f_[5]); w.w = cvtpk(f_[6], f_[7]);
      qr[d0] = *reinterpret_cast<bf16x8*>(&w); }
    { unsigned r0_ = __float_as_uint(qn2), r1_ = r0_;
      auto r_ = __builtin_amdgcn_permlane32_swap(r0_, r1_, false, false); r0_ = r_[0]; r1_ = r_[1];
      asm volatile("" : "+v"(r0_), "+v"(r1_));
      qn2 = __uint_as_float(r0_) + __uint_as_float(r1_); }
    { float gm = fmaxf(fabsf(gkp[lane]), lane < 32 ? fabsf(gkp[64 + lane]) : 0.f);
#pragma unroll
      for (int o = 1; o < 64; o <<= 1) gm = fmaxf(gm, __shfl_xor(gm, o));
      m_bound = sqrtf(qn2) * 9.797958971f * gm * 1.02f * (SCALE * 1.4426950408889634f); } }
  const int kr0 = tid / 12, kc0 = tid - kr0 * 12, kr1 = (512 + tid) / 12, kc1 = (512 + tid) - kr1 * 12, vr0 = tid >> 3, vc0 = tid & 7;
  const int kst0 = KSWZ(kr0, kc0 * 16), kst1 = KSWZ(kr1, kc1 * 16), vst0 = v_st(vr0, vc0 * 8);
  const bool k2 = wid < 4;
  const int vb0 = (int)(uintptr_t)V_lds + v_rd_base(lane);
  struct { bf16x8 vs0, ks0, ks1; } sr_[2];
#define SLOAD(i, k0) do { sr_[i].vs0 = *reinterpret_cast<const bf16x8*>(&Vh[(long)((k0) + vr0) * LDV + vc0 * 8]); \
    sr_[i].ks0 = *reinterpret_cast<const bf16x8*>(&Kh[(long)((k0) + kr0) * LDK + kc0 * 8]); \
    if (k2) sr_[i].ks1 = *reinterpret_cast<const bf16x8*>(&Kh[(long)((k0) + kr1) * LDK + kc1 * 8]); } while (0)
#define SWRITE(b, i) do { *(bf16x8*)((char*)V_lds + (b) * SHM_V + vst0) = sr_[i].vs0;          \
    *(bf16x8*)((char*)K_lds + (b) * SHM_K + kst0) = sr_[i].ks0;                       \
    if (k2) *(bf16x8*)((char*)K_lds + (b) * SHM_K + kst1) = sr_[i].ks1; } while (0)
#define SWAIT() do { if (k2) asm volatile("s_waitcnt vmcnt(3)" ::: "memory"); else asm volatile("s_waitcnt vmcnt(2)" ::: "memory"); } while (0)
#define RESC(a) do { if (__any((a) < 1.f)) { if (hi == 0) al_l[r32] = (a); asm volatile("s_waitcnt lgkmcnt(0)" ::: "memory"); \
    _Pragma("unroll") for (int d = 0; d < NDV; ++d) _Pragma("unroll") for (int r = 0; r < 16; ++r) o[d][r] *= al_l[crow(r, hi)]; } } while (0)
  f32x16 pA0, pA1, pB0, pB1; float mnA, mnB, alA, alB; bf16x8 pa0, pa1, pa2, pa3; const int NT = seq / KVBLK;
  constexpr int SE = 0, SO = 1;
  SLOAD(SE, 0); asm volatile("s_waitcnt vmcnt(0)" ::: "memory"); SWRITE(0, SE); __syncthreads();
  const bool fixedm = __all(m_bound <= 40.f * 1.4426950408889634f);
  const float qinit = fixedm ? -m_bound : 0.f;
  qkt(pA0, pA1, K_lds, qr, r32, hi, qinit); if (fixedm) { partialSM_fixed(pA0, pA1); alA = 1.f; } else partialSM(pA0, pA1, m_reg, mnA, alA);
  SLOAD(SO, KVBLK); if (2 < NT) SLOAD(SE, 2 * KVBLK);
  SWAIT(); SWRITE(1, SO); __syncthreads();
  for (int j = 1; j + 1 < NT; j += 2) {
    SBAR(); qkt(pB0, pB1, (bf16*)((char*)K_lds + SHM_K), qr, r32, hi, qinit);
    finishSM(pA0, pA1, alA, l_reg, pa0, pa1, pa2, pa3); SBAR();
    SLOAD(SO, (j + 2) * KVBLK); SBAR();
    pv_d0(o, vb0, pa0, pa1, pa2, pa3); if (fixedm) { partialSM_fixed(pB0, pB1); alB = 1.f; } else partialSM(pB0, pB1, m_reg, mnB, alB);
    __syncthreads(); SWAIT(); SWRITE(0, SE);
    if (!fixedm) RESC(alB); __syncthreads();
    SBAR(); qkt(pA0, pA1, K_lds, qr, r32, hi, qinit);
    finishSM(pB0, pB1, alB, l_reg, pa0, pa1, pa2, pa3); SBAR();
    if (j + 3 < NT) SLOAD(SE, (j + 3) * KVBLK); SBAR();
    pv_d0(o, vb0 + (int)SHM_V, pa0, pa1, pa2, pa3); if (fixedm) { partialSM_fixed(pA0, pA1); alA = 1.f; } else partialSM(pA0, pA1, m_reg, mnA, alA);
    __syncthreads(); SWAIT(); SWRITE(1, SO);
    if (!fixedm) RESC(alA); __syncthreads();
  }
  SBAR(); qkt(pB0, pB1, (bf16*)((char*)K_lds + SHM_K), qr, r32, hi, qinit);
  finishSM(pA0, pA1, alA, l_reg, pa0, pa1, pa2, pa3); SBAR();
  pv_d0(o, vb0, pa0, pa1, pa2, pa3); if (fixedm) { partialSM_fixed(pB0, pB1); alB = 1.f; } else partialSM(pB0, pB1, m_reg, mnB, alB);
  __syncthreads(); if (!fixedm) RESC(alB);
  finishSM(pB0, pB1, alB, l_reg, pa0, pa1, pa2, pa3); SBAR();
  pv_d0(o, vb0 + (int)SHM_V, pa0, pa1, pa2, pa3);
  if (hi == 0) li_l[r32] = l_reg; asm volatile("s_waitcnt lgkmcnt(0)" ::: "memory");
  float rli[16];
#pragma unroll
  for (int r = 0; r < 16; ++r) rli[r] = __builtin_amdgcn_rcpf(li_l[crow(r, hi)]);
  bf16* Ow = Ob + (long)(wid * QBLK) * LDO;
#pragma unroll
  for (int r = 0; r < 16; ++r) { int orow = crow(r, hi);
#pragma unroll
    for (int d0 = 0; d0 < NDV; ++d0) Ow[(long)orow * LDO + d0 * 32 + r32] = (bf16)(cvtpk(o[d0][r] * rli[r], 0.f) & 0xffffu); }
#undef SLOAD
#undef SWRITE
#undef SWAIT
#undef RESC
}
#undef KSWZ
#undef SBAR
}
constexpr int NWAVES = 8;
#ifndef MK_ONE_LAUNCH
#define MK_ONE_LAUNCH 1
#endif
constexpr int NB = 8, SEQ = 2048, DM = 1024, MTOK = NB * SEQ, DEPTH = 2;
constexpr int NH = 8, QL = 384, KVL = 256, NOPE = 64, ROPE = 32, QKH = 96, VHD = 64;
constexpr int PW = 512, INW = 3232, INWP = 3328, KPEPW = 544;
constexpr int NKEY = 128, NEXP = 16384, TOPK = 16;
constexpr float RMS_EPS = 1e-6f;
constexpr size_t MiB = 1u << 20;
constexpr size_t WS_CTL = 0;
constexpr size_t WS_W = 1 * MiB, W_STRIDE = 18 * MiB;
constexpr size_t WO_WIN = 0, WO_WUQ = 6656 * 1024, WO_WUKV = 7424 * 1024, WO_WO = 8 * MiB, WO_WC = 9 * MiB, WO_WOUT = 10 * MiB, WO_WQ = 12 * MiB, WO_KEYS = 16 * MiB;
constexpr size_t WS_U = 40 * MiB, WS_V = 72 * MiB, UV_STRIDE = 16 * MiB;
constexpr size_t WS_SU = 512 * 1024, WS_SV = 768 * 1024, SC_STRIDE = 64 * 1024;
constexpr size_t WS_XB = 168 * MiB;
constexpr size_t WS_GATES = 232 * MiB, WS_QP = 232 * MiB;
constexpr size_t WS_CQ = 296 * MiB, WS_CKV = 308 * MiB, WS_KPEP = 316 * MiB, WS_QRAW = 333 * MiB, WS_KVRAW = 357 * MiB;
constexpr size_t WS_ABUF = 296 * MiB, WS_MIX = 328 * MiB;
constexpr size_t WS_MIXED = 389 * MiB;
constexpr size_t WS_Q = 405 * MiB, WS_K = 429 * MiB, WS_VV = 453 * MiB;
constexpr size_t WS_E = 405 * MiB, WS_G = 413 * MiB, WS_XQ = 429 * MiB, WS_WF = 445 * MiB, WS_HPI = 232 * MiB;
constexpr size_t WS_SUO = 453 * MiB;
constexpr size_t WS_O = 469 * MiB, WS_SSQ = 485 * MiB, WS_RR = 486 * MiB, WS_SX = WS_RR + 65536, WS_WSUM = WS_RR + 131072, WS_SSQN = WS_RR + 262144, WS_SSQC = 487 * MiB, WS_XB8 = 489 * MiB, WS_END = 505 * MiB;
static_assert(WO_WUQ >= (size_t)INWP * DM * 2 && WO_WUKV >= WO_WUQ + 768 * 384 * 2 && WO_WO >= WO_WUKV + 1024 * 256 * 2, "weight map");
static_assert(WS_KPEP + (size_t)MTOK * KPEPW * 2 <= WS_QRAW && WS_QRAW + (size_t)MTOK * 768 * 2 <= WS_KVRAW && WS_KVRAW + (size_t)MTOK * 1024 * 2 <= WS_MIXED, "ws map");

constexpr int LDS_BYTES = 147456;

#define GAS __attribute__((address_space(1)))
#define LAS __attribute__((address_space(3)))
typedef unsigned short bf16;
typedef unsigned v4u __attribute__((ext_vector_type(4)));
typedef unsigned v2u __attribute__((ext_vector_type(2)));
typedef float f32x4 __attribute__((ext_vector_type(4)));
typedef float f32x16 __attribute__((ext_vector_type(16)));
typedef short bf16x8 __attribute__((ext_vector_type(8)));
#define LDS_WAIT() asm volatile("s_waitcnt lgkmcnt(0)" ::: "memory")
__device__ __forceinline__ unsigned f2bf(float f) { unsigned u = __builtin_bit_cast(unsigned, f); return (u + 0x7fffu + ((u >> 16) & 1u)) >> 16; }
__device__ __forceinline__ unsigned pk2(float lo, float hi) { return f2bf(lo) | (f2bf(hi) << 16); }
__device__ __forceinline__ float blo(unsigned w) { return __builtin_bit_cast(float, w << 16); }
__device__ __forceinline__ float bhi(unsigned w) { return __builtin_bit_cast(float, w & 0xffff0000u); }
__device__ __forceinline__ float wave_sum(float v) {
#pragma unroll
    for (int o = 1; o < 64; o <<= 1) v += __shfl_xor(v, o);
    return v;
}

#define XB_TMO      128
#define XB_XCNT(j)  (256  + 64 * (j))
#define XB_XSUB(j)  (1280 + 64 * (j))
#define XB_XGEN(j)  (2304 + 64 * (j))
#define XB_TOP      3328
#define XB_TOPGEN   3392
#define XCD_BAR_WORDS 3456
#define XB_SPIN_CAP (1u << 18)

__device__ __forceinline__ unsigned xb_ld(unsigned* p)              { return __hip_atomic_load(p, __ATOMIC_RELAXED, __HIP_MEMORY_SCOPE_AGENT); }
__device__ __forceinline__ unsigned xb_add(unsigned* p, unsigned v) { return __hip_atomic_fetch_add(p, v, __ATOMIC_RELAXED, __HIP_MEMORY_SCOPE_AGENT); }
__device__ __forceinline__ unsigned xb_xcc_id() { return (unsigned)__builtin_amdgcn_s_getreg((3 << 11) | 20) & 0xFu; }
#define XB_SPIN(cond, bar) do { unsigned _sp = 0; while (cond) { __builtin_amdgcn_s_sleep(1); \
    if ((++_sp & 255u) == 0u) { if (xb_ld(&(bar)[XB_TMO])) break; if (_sp > XB_SPIN_CAP) { atomicAdd(&(bar)[XB_TMO], 1u); break; } } } } while (0)

struct XcdBarrier {
    unsigned* bar; unsigned x;
    volatile LAS unsigned* st;
};

__device__ __forceinline__ XcdBarrier xcd_barrier_post(unsigned* bar, volatile LAS unsigned* st) {
    XcdBarrier b; b.bar = bar; b.x = xb_xcc_id(); b.st = st;
    if (threadIdx.x == 0) (void)xb_add(&bar[XB_XCNT(b.x)], 1u);
    return b;
}
__device__ __forceinline__ void xcd_barrier_complete(unsigned* bar, unsigned x, unsigned& nloc, unsigned& nx) {
    const unsigned G = gridDim.x * gridDim.y * gridDim.z;
    unsigned sum, cnt, mine, sp = 0u;
    for (;;) {
        sum = 0u; cnt = 0u; mine = 0u;
#pragma unroll
        for (unsigned j = 0; j < 16; ++j) { const unsigned c = xb_ld(&bar[XB_XCNT(j)]); sum += c; cnt += (c > 0u) ? 1u : 0u; mine = (j == x) ? c : mine; }
        if (sum == G) break;
        __builtin_amdgcn_s_sleep(1);
        if ((++sp & 255u) == 0u) { if (xb_ld(&bar[XB_TMO])) break; if (sp > XB_SPIN_CAP) { atomicAdd(&bar[XB_TMO], 1u); break; } }
    }
    nloc = mine > 0u ? mine : 1u; nx = cnt > 0u ? cnt : 1u;
}

__device__ __forceinline__ void xcd_barrier(const XcdBarrier& b) {
    asm volatile("s_waitcnt vmcnt(0)" ::: "memory");
    __syncthreads();
    if (threadIdx.x == 0) {
        unsigned* bar = b.bar; unsigned bx_ = b.x;
        asm volatile("" : "+s"(bar), "+s"(bx_));
        __builtin_amdgcn_s_waitcnt(0);
        unsigned nloc = b.st[0], nx = b.st[1];
        if (nloc == 0u) { xcd_barrier_complete(bar, bx_, nloc, nx); b.st[0] = nloc; b.st[1] = nx; }
        const unsigned old = xb_add(&bar[XB_XSUB(bx_)], 1u);
        const unsigned gen = old / nloc;
        if (old + 1u == (gen + 1u) * nloc) {
            __builtin_amdgcn_fence(__ATOMIC_RELEASE, "agent");
            asm volatile("s_waitcnt vmcnt(0)" ::: "memory");
            const unsigned og = xb_add(&bar[XB_TOP], 1u);
            const unsigned tg = og / nx;
            if (og + 1u == (tg + 1u) * nx) xb_add(&bar[XB_TOPGEN], 1u);
            else XB_SPIN(xb_ld(&bar[XB_TOPGEN]) == tg, bar);
            __builtin_amdgcn_fence(__ATOMIC_ACQUIRE, "agent");
            xb_add(&bar[XB_XGEN(bx_)], 1u);
            asm volatile("s_waitcnt vmcnt(0)" ::: "memory");
        } else {
            XB_SPIN(xb_ld(&bar[XB_XGEN(bx_)]) == gen, bar);
            __builtin_amdgcn_fence(__ATOMIC_ACQUIRE, "agent");
            asm volatile("s_waitcnt vmcnt(0)" ::: "memory");
        }
    }
    __syncthreads();
}

constexpr int MISC_OFF = 131072 + 320;
constexpr size_t CTL_ZERO_BYTES = 65536;

struct Args { const void* in[21]; float* out; unsigned char* ws; int ph_lo, ph_hi; };
static_assert(sizeof(Args) == 23 * 8 + 8, "Args has no padding");


typedef const char __attribute__((address_space(4)))* kseg_t;
__device__ __forceinline__ const void* karg_ptr(int i) {
    kseg_t base = (kseg_t)__builtin_amdgcn_kernarg_segment_ptr();
    asm volatile("" : "+s"(base));
    return *(const void* const __attribute__((address_space(4)))*)(base + 8 * i);
}
__device__ __forceinline__ int karg_int(int byte_off) {
    kseg_t base = (kseg_t)__builtin_amdgcn_kernarg_segment_ptr();
    asm volatile("" : "+s"(base));
    return *(const int __attribute__((address_space(4)))*)(base + byte_off);
}
#define KIN(i) karg_ptr(i)
#define KOUT ((float*)karg_ptr(21))
#define KWS ((unsigned char*)karg_ptr(22))

struct Frame {
    LAS unsigned char* lds;
    int wave, vcu, G, gw, NGW, bx;
};
__device__ __forceinline__ Frame fresh_frame(const Frame& F) {
    Frame R = F;
    asm volatile("" : "+s"(R.wave), "+s"(R.vcu), "+s"(R.G), "+s"(R.gw), "+s"(R.NGW), "+s"(R.bx));
    return R;
}

__device__ __forceinline__ void transpose_item(const float* W, int ldw, int n_begin, int nblk, const float* gain, bf16* WT, int K, int row_off, LAS float* scr, int item, int lane, int permkv = 0, float fp8s = 0.f) {
    const int kb = item / nblk, nb = item % nblk, k0 = 64 * kb, n0 = 32 * nb;
    const int nd0 = permkv ? 256 * (n0 >> 8) + 128 * ((n0 >> 5) & 1) + 32 * (2 * ((n0 >> 7) & 1) + ((n0 >> 6) & 1)) : n0;
    float tv[32];
#pragma unroll
    for (int i = 0; i < 32; ++i) tv[i] = W[(size_t)(k0 + 2 * i + (lane >> 5)) * ldw + n_begin + n0 + (lane & 31)];
    if (gain) {
#pragma unroll
        for (int i = 0; i < 32; ++i) tv[i] *= gain[k0 + 2 * i + (lane >> 5)]; }
#pragma unroll
    for (int i = 0; i < 32; ++i) scr[(2 * i + (lane >> 5)) * 33 + (lane & 31)] = tv[i];
    LDS_WAIT(); asm volatile("" ::: "memory");
    const int c = lane & 7;
#pragma unroll
    for (int j = 0; j < 4; ++j) { const int n = (lane >> 3) + 8 * j; const LAS float* s = scr + (8 * c) * 33 + n;
        if (fp8s > 0.f) { v2u o; int w0 = __builtin_amdgcn_cvt_pk_fp8_f32(s[0 * 33] * fp8s, s[1 * 33] * fp8s, 0, false); w0 = __builtin_amdgcn_cvt_pk_fp8_f32(s[2 * 33] * fp8s, s[3 * 33] * fp8s, w0, true);
            int w1 = __builtin_amdgcn_cvt_pk_fp8_f32(s[4 * 33] * fp8s, s[5 * 33] * fp8s, 0, false); w1 = __builtin_amdgcn_cvt_pk_fp8_f32(s[6 * 33] * fp8s, s[7 * 33] * fp8s, w1, true);
            o.x = (unsigned)w0; o.y = (unsigned)w1; *(GAS v2u*)((unsigned char*)WT + (size_t)(row_off + nd0 + n) * K + k0 + 8 * c) = o; continue; }
        v4u o; o.x = pk2(s[0 * 33], s[1 * 33]); o.y = pk2(s[2 * 33], s[3 * 33]); o.z = pk2(s[4 * 33], s[5 * 33]); o.w = pk2(s[6 * 33], s[7 * 33]);
        *(GAS v4u*)(WT + (size_t)(row_off + nd0 + n) * K + k0 + 8 * c) = o; }
    LDS_WAIT(); asm volatile("" ::: "memory");
}
__device__ __forceinline__ void rms_row_to_bf16(const float* xrow, const float* g, bf16* orow, int lane) {
    const f32x4* xr = (const f32x4*)xrow + lane; const f32x4* gr = (const f32x4*)g + lane;
    f32x4 v[4]; float s = 0.f;
#pragma unroll
    for (int j = 0; j < 4; ++j) { v[j] = xr[64 * j]; s += (v[j].x * v[j].x + v[j].y * v[j].y) + (v[j].z * v[j].z + v[j].w * v[j].w); }
    const float r = 1.0f / sqrtf(wave_sum(s) * (1.f / DM) + RMS_EPS);
    v2u* o8 = (v2u*)orow + lane;
#pragma unroll
    for (int j = 0; j < 4; ++j) { const f32x4 gv = gr[64 * j]; v2u w; w.x = pk2(v[j].x * r * gv.x, v[j].y * r * gv.y); w.y = pk2(v[j].z * r * gv.z, v[j].w * r * gv.w); o8[64 * j] = w; }
}
__device__ __forceinline__ void cvt8(const float* src, bf16* dst, size_t i8) {
    const f32x4 a = *(const f32x4*)(src + i8 * 8), b = *(const f32x4*)(src + i8 * 8 + 4);
    v4u o; o.x = pk2(a.x, a.y); o.y = pk2(a.z, a.w); o.z = pk2(b.x, b.y); o.w = pk2(b.z, b.w);
    *(v4u*)(dst + i8 * 8) = o;
}

__device__ __forceinline__ unsigned fp4_enc(float v, float& qa) {
    const float a = fabsf(v);
    const float lo = rintf(2.0f * fminf(a, 2.0f)), hi2 = rintf(fminf(fmaxf(a - 2.0f, 0.0f), 2.0f)), top = a > 5.0f ? 1.0f : 0.0f;
    qa = 0.5f * lo + hi2 + 2.0f * top;
    return (unsigned)(int)(lo + hi2 + top) | (v < 0.0f ? 8u : 0u);
}
__device__ __forceinline__ void convert_tables(int l, int cw, int ncw) {
    const int lane = pg8::fresh_lane();
    constexpr int NR = 2;
    for (int it0 = cw * NR; it0 < 2 * NEXP; it0 += ncw * NR) {
        f32x4 va[NR][4]; float m[NR];
        __builtin_amdgcn_s_setprio(2);
#pragma unroll
        for (int r = 0; r < NR; ++r) { const int it = it0 + r, tab = it / NEXP, row = l * NEXP + it % NEXP;
            const f32x4* src = (const f32x4*)((const float*)(tab ? KIN(20) : KIN(19)) + (size_t)row * DM) + lane;
#pragma unroll
            for (int j = 0; j < 4; ++j) va[r][j] = __builtin_nontemporal_load(src + 64 * j); }
        __builtin_amdgcn_sched_barrier(0); __builtin_amdgcn_s_setprio(0);
#pragma unroll
        for (int r = 0; r < NR; ++r) { float mm = 0.f;
#pragma unroll
            for (int j = 0; j < 4; ++j) mm = fmaxf(mm, fmaxf(fmaxf(fabsf(va[r][j].x), fabsf(va[r][j].y)), fmaxf(fabsf(va[r][j].z), fabsf(va[r][j].w))));
            m[r] = mm; }
#pragma unroll
        for (int o = 1; o < 64; o <<= 1)
#pragma unroll
            for (int r = 0; r < NR; ++r) m[r] = fmaxf(m[r], __shfl_xor(m[r], o));
#pragma unroll
        for (int r = 0; r < NR; ++r) { const int it = it0 + r, tab = it / NEXP, row = l * NEXP + it % NEXP;
            const float inv = m[r] > 0.f ? 6.0f / m[r] : 0.f;
            unsigned char* dstb = KWS + (tab ? WS_V : WS_U) + (size_t)l * UV_STRIDE + (size_t)(it % NEXP) * 128 + 2 * lane;
#pragma unroll
            for (int j = 0; j < 4; ++j) { unsigned pk = __builtin_amdgcn_cvt_scalef32_pk_fp4_f32(0u, va[r][j].x * inv, va[r][j].y * inv, 1.0f, 0);
                pk = __builtin_amdgcn_cvt_scalef32_pk_fp4_f32(pk, va[r][j].z * inv, va[r][j].w * inv, 1.0f, 1);
                *(unsigned short*)(dstb + (size_t)j * (NEXP * 128)) = (unsigned short)pk; }
            if (lane == 0) ((float*)(KWS + WS_SU))[2 * row + tab] = m[r] * (1.0f / 6.0f); }
    }
}

__device__ __forceinline__ void ph_prologue(Frame& F) {
    LAS float* scr = (LAS float*)(F.lds + F.wave * 16384);
    const int gw = F.gw, NGW = F.NGW, lane = pg8::fresh_lane();
    constexpr int I_G = 16 * 64, I_P = 16 * 37, I_UQ = 6 * 24, I_UKV = 4 * 32, I_O = 8 * 32, I_OUT = 16 * 32, I_WQ = 16 * 64;
    constexpr int I_L = I_G + I_P + I_UQ + I_UKV + I_O + I_OUT + I_WQ;
    for (int it = gw; it < DEPTH * I_L; it += NGW) {
        const int l = it / I_L; int r = it % I_L;
        unsigned char* wb = KWS + WS_W + (size_t)l * W_STRIDE;
        const float* w_in = (const float*)KIN(3) + (size_t)l * DM * INW;
        const float* g1 = (const float*)KIN(2) + (size_t)l * DM;
        if (r < I_G) { transpose_item(w_in, INW, 1184, 64, g1, (bf16*)(wb + WO_WIN), DM, 0, scr, r, lane, 0, 512.f); continue; } r -= I_G;
        if (r < I_P) { transpose_item(w_in, INW, 0, 37, g1, (bf16*)(wb + WO_WIN), DM, 2048, scr, r, lane, 0, 512.f); continue; } r -= I_P;
        if (r < I_UQ) { transpose_item((const float*)KIN(6) + (size_t)l * QL * 768, 768, 0, 24, (const float*)KIN(4) + l * QL, (bf16*)(wb + WO_WUQ), QL, 0, scr, r, lane); continue; } r -= I_UQ;
        if (r < I_UKV) { transpose_item((const float*)KIN(7) + (size_t)l * KVL * 1024, 1024, 0, 32, (const float*)KIN(5) + l * KVL, (bf16*)(wb + WO_WUKV), KVL, 0, scr, r, lane, 1); continue; } r -= I_UKV;
        if (r < I_O) { transpose_item((const float*)KIN(10) + (size_t)l * 512 * DM, DM, 0, 32, nullptr, (bf16*)(wb + WO_WO), 512, 0, scr, r, lane); continue; } r -= I_O;
        if (r < I_OUT) { transpose_item((const float*)KIN(15) + (size_t)l * DM * DM, DM, 0, 32, nullptr, (bf16*)(wb + WO_WOUT), DM, 0, scr, r, lane, 0, 512.f); continue; } r -= I_OUT;
        transpose_item((const float*)KIN(17) + (size_t)l * DM * 2048, 2048, 0, 64, (const float*)KIN(16) + (size_t)l * DM, (bf16*)(wb + WO_WQ), DM, 0, scr, r, lane);
    }
    for (int i = gw * 64 + lane; i < DEPTH * 96 * DM / 16; i += NGW * 64) {
        const int l = i / (96 * DM / 16), r = i % (96 * DM / 16);
        *(v4u*)(KWS + WS_W + (size_t)l * W_STRIDE + WO_WIN + (size_t)INW * DM + (size_t)r * 16) = (v4u){0u, 0u, 0u, 0u};
    }
    for (int it = gw; it < DEPTH * 16 * 32; it += NGW) {
        const int l = it >> 9, cb = (it >> 5) & 15, db = it & 31, g = cb >> 2, r32 = lane & 31, hi = lane >> 5;
        const float* pw = (const float*)KIN(11) + (size_t)l * 4 * 128 * 128 + (size_t)(cb * 32 + r32) * 128 + 64 * hi;
        const float* ps = (const float*)KIN(12) + (size_t)l * 512 + g * 128 + 64 * hi;
        const float* wp = (const float*)KIN(13) + (size_t)l * 512 * DM + (size_t)(g * 128 + 64 * hi) * DM + db * 32 + r32;
        float av[64], bv[64];
#pragma unroll
        for (int j = 0; j < 16; ++j) { const f32x4 v = *(const f32x4*)(pw + 4 * j); av[4 * j] = v.x; av[4 * j + 1] = v.y; av[4 * j + 2] = v.z; av[4 * j + 3] = v.w; }
#pragma unroll
        for (int j = 0; j < 64; ++j) bv[j] = wp[(size_t)j * DM];
#pragma unroll
        for (int j = 0; j < 16; ++j) { const f32x4 s4 = *(const f32x4*)(ps + 4 * j); bv[4 * j] *= s4.x; bv[4 * j + 1] *= s4.y; bv[4 * j + 2] *= s4.z; bv[4 * j + 3] *= s4.w; }
        f32x16 acc = f32x16{};
#pragma unroll
        for (int s = 0; s < 64; ++s) acc = __builtin_amdgcn_mfma_f32_32x32x2f32(av[s], bv[s], acc, 0, 0, 0);
        bf16* dst = (bf16*)(KWS + WS_W + (size_t)l * W_STRIDE + WO_WC) + (size_t)(db * 32 + r32) * 512 + cb * 32 + 4 * hi;
#pragma unroll
        for (int q = 0; q < 4; ++q) { v2u o; o.x = pk2(acc[4 * q], acc[4 * q + 1]); o.y = pk2(acc[4 * q + 2], acc[4 * q + 3]); *(v2u*)(dst + 8 * q) = o; }
    }
    for (int i = gw * 64 + lane; i < DEPTH * 16 * 128 * 128 / 8; i += NGW * 64) {
        const int l = i / (16 * 128 * 128 / 8), r = i % (16 * 128 * 128 / 8);
        cvt8((const float*)KIN(18) + (size_t)l * 16 * 128 * 128, (bf16*)(KWS + WS_W + (size_t)l * W_STRIDE + WO_KEYS), (size_t)r);
    }
    for (int m0 = gw; m0 < MTOK; m0 += 2 * NGW) {
        f32x4 v[2][4]; float s[2];
#pragma unroll
        for (int u = 0; u < 2; ++u) { const int m = (m0 + u * NGW < MTOK) ? m0 + u * NGW : m0; const f32x4* xr = (const f32x4*)((const float*)KIN(0) + (size_t)m * DM) + lane;
#pragma unroll
            for (int j = 0; j < 4; ++j) v[u][j] = xr[64 * j]; }
#pragma unroll
        for (int u = 0; u < 2; ++u) { float ss = 0.f;
#pragma unroll
            for (int j = 0; j < 4; ++j) ss += (v[u][j].x * v[u][j].x + v[u][j].y * v[u][j].y) + (v[u][j].z * v[u][j].z + v[u][j].w * v[u][j].w);
            s[u] = ss; }
#pragma unroll
        for (int o = 1; o < 64; o <<= 1) { s[0] += __shfl_xor(s[0], o); s[1] += __shfl_xor(s[1], o); }
#pragma unroll
        for (int u = 0; u < 2; ++u) { const int m = m0 + u * NGW; if (m < MTOK) {
            v2u* o8 = (v2u*)((bf16*)(KWS + WS_XB) + (size_t)m * DM) + lane;
#pragma unroll
            for (int j = 0; j < 4; ++j) { v2u w; w.x = pk2(v[u][j].x, v[u][j].y); w.y = pk2(v[u][j].z, v[u][j].w); o8[64 * j] = w;
                int f8 = __builtin_amdgcn_cvt_pk_fp8_f32(v[u][j].x * 16.f, v[u][j].y * 16.f, 0, false); f8 = __builtin_amdgcn_cvt_pk_fp8_f32(v[u][j].z * 16.f, v[u][j].w * 16.f, f8, true);
                *(unsigned*)(KWS + WS_XB8 + (size_t)m * DM + 256 * j + 4 * lane) = (unsigned)f8; }
            if (lane == 0) { f32x4* sp = (f32x4*)((float*)(KWS + WS_SSQN) + (size_t)m * 8); sp[0] = (f32x4){s[u], 0.f, 0.f, 0.f}; sp[1] = (f32x4){0.f, 0.f, 0.f, 0.f}; } } }
    }
}

__device__ __forceinline__ void ph_pool(Frame& F, int cw, int ncw) {
    const bf16* KP = (const bf16*)(KWS + WS_KPEP); bf16* MX = (bf16*)(KWS + WS_MIXED);
    const int lane = pg8::fresh_lane(), g = lane >> 4, half = 1 << g, c0 = lane * 8;
#define POOL_ACC(W, SGN) do { sum[0] += SGN blo(W.x); sum[1] += SGN bhi(W.x); sum[2] += SGN blo(W.y); sum[3] += SGN bhi(W.y); sum[4] += SGN blo(W.z); sum[5] += SGN bhi(W.z); sum[6] += SGN blo(W.w); sum[7] += SGN bhi(W.w); } while (0)
    for (int run = cw; run < MTOK / 8; run += ncw) {
        const int t0 = run * 8, s0 = t0 & (SEQ - 1);
        v4u row[23];
#pragma unroll
        for (int k = 0; k < 23; ++k) { const int d = k - 8; const bool ok = (d >= -half) && (d < 8 + half - 1 + 1) && (s0 + d >= 0) && (s0 + d < SEQ);
            row[k] = ok ? *(const v4u*)(KP + (size_t)(t0 + d) * KPEPW + 32 + c0) : (v4u){0u, 0u, 0u, 0u}; }
        float sum[8];
#pragma unroll
        for (int j = 0; j < 8; ++j) sum[j] = 0.f;
        int cnt = 0;
#pragma unroll
        for (int d = -8; d < 8; ++d) { const bool ok = (d >= -half) && (d < half) && (s0 + d >= 0) && (s0 + d < SEQ); if (ok) { POOL_ACC(row[d + 8], +); ++cnt; } }
#pragma unroll
        for (int i = 0; i < 8; ++i) {
            const int t = t0 + i, s = s0 + i;
            if (i > 0) {
                const bool lv_ok = (s - 1 - half >= 0), ev_ok = (s + half - 1 < SEQ);
#define POOL_CASE(H) do { if (half == (H)) { if ((i - 1 - (H) + 8) >= 0) { if (lv_ok) { POOL_ACC(row[(i - 1 - (H) + 8) >= 0 ? (i - 1 - (H) + 8) : 0], -); } } if (ev_ok) { POOL_ACC(row[i + (H) - 1 + 8], +); } } } while (0)
                POOL_CASE(1); POOL_CASE(2); POOL_CASE(4); POOL_CASE(8);
#undef POOL_CASE
                if (lv_ok) --cnt;
                if (ev_ok) ++cnt;
            }
            const v4u me = row[i + 8];
            const float ic = 1.0f / (float)cnt;
            v4u o; o.x = pk2(sum[0] * ic - blo(me.x), sum[1] * ic - bhi(me.x)); o.y = pk2(sum[2] * ic - blo(me.y), sum[3] * ic - bhi(me.y));
            o.z = pk2(sum[4] * ic - blo(me.z), sum[5] * ic - bhi(me.z)); o.w = pk2(sum[6] * ic - blo(me.w), sum[7] * ic - bhi(me.w));
            *(v4u*)(MX + (size_t)t * PW + c0) = o;
        }
    }
#undef POOL_ACC
}

__device__ __forceinline__ void ph_finalize(Frame& F, int l) {
    const bf16* QR = (const bf16*)(KWS + WS_QRAW); const float* SSQC = (const float*)(KWS + WS_SSQC);
    bf16* Q = (bf16*)(KWS + WS_Q);
    const int* pos = (const int*)KIN(1);
    const float* ghq = (const float*)KIN(8) + l * QKH;
    const int lane = pg8::fresh_lane(), h = lane >> 3, sub = lane & 7;
    const float inv0 = __builtin_amdgcn_exp2f(-(float)(2 * sub) * 0.8304820237218406f), inv1 = __builtin_amdgcn_exp2f(-(float)(2 * sub + 1) * 0.8304820237218406f);
    float gqn[8];
#pragma unroll
    for (int j = 0; j < 8; ++j) gqn[j] = ghq[8 * sub + j];
    const float gq10 = ghq[64 + 2 * sub], gq11 = ghq[65 + 2 * sub], gq20 = ghq[80 + 2 * sub], gq21 = ghq[81 + 2 * sub];
    for (int t = F.gw; t < MTOK; t += F.NGW) {
        const f32x4* sp = (const f32x4*)(SSQC + (size_t)t * 24); const f32x4 sa = sp[0], sb = sp[1], sc = sp[2];
        const float rq = 1.0f / sqrtf(((sa.x + sa.y) + (sa.z + sa.w) + (sb.x + sb.y) + (sb.z + sb.w) + (sc.x + sc.y) + (sc.z + sc.w)) * (1.f / QL) + RMS_EPS);
        const float p = (float)pos[t];
        float c0, s0, c1, s1;
        { const float a0 = p * inv0, a1 = p * inv1;
          const float n0 = rintf(a0 * 0.15915494309189535f), n1 = rintf(a1 * 0.15915494309189535f);
          float r0 = fmaf(-n0, 6.28318548202514648f, a0); r0 = fmaf(-n0, -1.7484556e-7f, r0);
          float r1 = fmaf(-n1, 6.28318548202514648f, a1); r1 = fmaf(-n1, -1.7484556e-7f, r1);
          r0 *= 0.15915494309189535f; r1 *= 0.15915494309189535f;
          s0 = __builtin_amdgcn_sinf(r0); c0 = __builtin_amdgcn_cosf(r0); s1 = __builtin_amdgcn_sinf(r1); c1 = __builtin_amdgcn_cosf(r1); }
        { const bf16* qp = QR + (size_t)t * 768 + h * QKH;
          const v4u w = *(const v4u*)(qp + 8 * sub); const unsigned wa = *(const unsigned*)(qp + 64 + 2 * sub), wb = *(const unsigned*)(qp + 80 + 2 * sub);
          float x[8] = {blo(w.x), bhi(w.x), blo(w.y), bhi(w.y), blo(w.z), bhi(w.z), blo(w.w), bhi(w.w)};
          float ss = 0.f;
#pragma unroll
          for (int j = 0; j < 8; ++j) { x[j] *= rq; ss += x[j] * x[j]; }
          const float x10 = blo(wa) * rq, x11 = bhi(wa) * rq, x20 = blo(wb) * rq, x21 = bhi(wb) * rq;
          const float y10 = x10 * c0 - x20 * s0, y20 = x10 * s0 + x20 * c0, y11 = x11 * c1 - x21 * s1, y21 = x11 * s1 + x21 * c1;
          ss += (y10 * y10 + y20 * y20) + (y11 * y11 + y21 * y21);
          ss += __shfl_xor(ss, 1); ss += __shfl_xor(ss, 2); ss += __shfl_xor(ss, 4);
          const float rn = 1.0f / sqrtf(ss * (1.f / QKH) + RMS_EPS);
          bf16* qo = Q + (size_t)t * 768 + h * QKH;
          v4u o; o.x = pk2(x[0] * rn * gqn[0], x[1] * rn * gqn[1]); o.y = pk2(x[2] * rn * gqn[2], x[3] * rn * gqn[3]); o.z = pk2(x[4] * rn * gqn[4], x[5] * rn * gqn[5]); o.w = pk2(x[6] * rn * gqn[6], x[7] * rn * gqn[7]);
          *(v4u*)(qo + 8 * sub) = o;
          *(unsigned*)(qo + 64 + 2 * sub) = pk2(y10 * rn * gq10, y11 * rn * gq11);
          *(unsigned*)(qo + 80 + 2 * sub) = pk2(y20 * rn * gq20, y21 * rn * gq21); }
    }
}

__device__ __forceinline__ void ph_attn(Frame& F, unsigned char* lds_generic, int l) {
    const att::bf16* Q = (const att::bf16*)(KWS + WS_QRAW); const att::bf16* K = (const att::bf16*)(KWS + WS_K); const att::bf16* V = (const att::bf16*)(KWS + WS_VV);
    att::bf16* O = (att::bf16*)(KWS + WS_O);
    for (int u = F.vcu; u < NB * NH * (SEQ / 256); u += F.G) {
        const int bh = u >> 3, qb = u & 7, b = bh >> 3, h = bh & 7;
        __syncthreads();
        att::attn_dense_body(Q + ((size_t)(b * SEQ + qb * 256)) * 768 + h * QKH, K + (size_t)(b * SEQ) * 768 + h * QKH, V + (size_t)(b * SEQ) * 512 + h * VHD,
                             O + ((size_t)(b * SEQ + qb * 256)) * 512 + h * VHD, SEQ, (char*)lds_generic, F.wave,
                             (const float*)(KWS + WS_SSQC) + (size_t)(b * SEQ + qb * 256) * 24, (const int*)KIN(1) + (b * SEQ + qb * 256), (const float*)KIN(8) + l * QKH, (const float*)KIN(9) + l * QKH);
    }
    __syncthreads();
}

__device__ __forceinline__ unsigned fkey(float f) { const unsigned b = __builtin_bit_cast(unsigned, f); return b ^ ((unsigned)((int)b >> 31) | 0x80000000u); }
__device__ __forceinline__ float funkey(unsigned u) { const unsigned b = u ^ (~(unsigned)((int)u >> 31) | 0x80000000u); return __builtin_bit_cast(float, b); }
__device__ __forceinline__ unsigned umax(unsigned a, unsigned b) { return a > b ? a : b; }
__device__ __forceinline__ unsigned umin(unsigned a, unsigned b) { return a < b ? a : b; }
#define INS16(T, x) do { unsigned _x = (x); _Pragma("unroll") for (int _i = 0; _i < 16; ++_i) { const unsigned _h = umax(T[_i], _x); _x = umin(T[_i], _x); T[_i] = _h; } } while (0)
__device__ __forceinline__ void sort16_desc(unsigned (&a)[16]) {
#define CE_(i, j) do { const unsigned hi_ = umax(a[i], a[j]), lo_ = umin(a[i], a[j]); a[i] = hi_; a[j] = lo_; } while (0)
    CE_(0, 1); CE_(2, 3); CE_(4, 5); CE_(6, 7); CE_(8, 9); CE_(10, 11); CE_(12, 13); CE_(14, 15); CE_(0, 2); CE_(1, 3); CE_(4, 6); CE_(5, 7); CE_(8, 10); CE_(9, 11); CE_(12, 14); CE_(13, 15); CE_(1, 2); CE_(5, 6); CE_(9, 10); CE_(13, 14); CE_(0, 4); CE_(1, 5); CE_(2, 6); CE_(3, 7); CE_(8, 12); CE_(9, 13); CE_(10, 14); CE_(11, 15); CE_(2, 4); CE_(3, 5); CE_(10, 12); CE_(11, 13); CE_(1, 2); CE_(3, 4); CE_(5, 6); CE_(9, 10); CE_(11, 12); CE_(13, 14); CE_(0, 8); CE_(1, 9); CE_(2, 10); CE_(3, 11); CE_(4, 12); CE_(5, 13); CE_(6, 14); CE_(7, 15); CE_(4, 8); CE_(5, 9); CE_(6, 10); CE_(7, 11); CE_(2, 4); CE_(3, 5); CE_(6, 8); CE_(7, 9); CE_(10, 12); CE_(11, 13); CE_(1, 2); CE_(3, 4); CE_(5, 6); CE_(7, 8); CE_(9, 10); CE_(11, 12); CE_(13, 14);
#undef CE_
}
__device__ __forceinline__ void merge_top16(unsigned (&T)[16], const unsigned (&S)[16]) {
#pragma unroll
    for (int i = 0; i < 16; ++i) T[i] = umax(T[i], S[15 - i]);
#pragma unroll
    for (int j = 8; j > 0; j >>= 1)
#pragma unroll
        for (int i = 0; i < 16; ++i) { const int l = i ^ j; if (l > i) { const unsigned hi = umax(T[i], T[l]), lo = umin(T[i], T[l]); T[i] = hi; T[l] = lo; } }
}

__device__ __forceinline__ void ph_select(Frame& F, int l) {
    const bf16* QP = (const bf16*)(KWS + WS_QP); const bf16* KEYS = (const bf16*)(KWS + WS_W + (size_t)l * W_STRIDE + WO_KEYS);
    const float* SSQ = (const float*)(KWS + WS_SSQ); float* RR = (float*)(KWS + WS_RR); unsigned* EO = (unsigned*)(KWS + WS_E); float* GO = (float*)(KWS + WS_G);
    const int lane = pg8::fresh_lane(), r32 = lane & 31, hi = lane >> 5;
    LAS unsigned* TL = (LAS unsigned*)(F.lds + 65536) + (F.wave * 64 + lane);
    { const bf16* XG2 = (const bf16*)(KWS + WS_XB); unsigned char* XQ = KWS + WS_XQ; float* SX = (float*)(KWS + WS_SX); const float* g2p = (const float*)KIN(16) + (size_t)l * DM + 16 * lane;
      float g2v[16];
#pragma unroll
      for (int j = 0; j < 4; ++j) { const f32x4 gq = *(const f32x4*)(g2p + 4 * j); g2v[4 * j] = gq.x; g2v[4 * j + 1] = gq.y; g2v[4 * j + 2] = gq.z; g2v[4 * j + 3] = gq.w; }
      for (int t0 = F.gw; t0 < MTOK; t0 += 4 * F.NGW) {
          v4u ra[4], rb[4]; float m[4];
#pragma unroll
          for (int u = 0; u < 4; ++u) { const int t = (t0 + u * F.NGW < MTOK) ? t0 + u * F.NGW : t0; ra[u] = *(const v4u*)(XG2 + (size_t)t * DM + 16 * lane); rb[u] = *(const v4u*)(XG2 + (size_t)t * DM + 16 * lane + 8); }
          float xf[4][16];
#pragma unroll
          for (int u = 0; u < 4; ++u) { const v4u a = ra[u], b = rb[u];
              const float x_[16] = {blo(a.x), bhi(a.x), blo(a.y), bhi(a.y), blo(a.z), bhi(a.z), blo(a.w), bhi(a.w), blo(b.x), bhi(b.x), blo(b.y), bhi(b.y), blo(b.z), bhi(b.z), blo(b.w), bhi(b.w)};
              float mm = 0.f;
#pragma unroll
              for (int j = 0; j < 16; ++j) { xf[u][j] = x_[j] * g2v[j]; mm = fmaxf(mm, fabsf(xf[u][j])); }
              m[u] = mm; }
#pragma unroll
          for (int o = 1; o < 64; o <<= 1)
#pragma unroll
              for (int u = 0; u < 4; ++u) m[u] = fmaxf(m[u], __shfl_xor(m[u], o));
#pragma unroll
          for (int u = 0; u < 4; ++u) { const int t = t0 + u * F.NGW; if (t < MTOK) {
              const float inv = m[u] > 0.f ? 6.0f / m[u] : 0.f;
              unsigned q1w[2] = {0u, 0u}, q2w[2] = {0u, 0u};
              typedef float f32x2q __attribute__((ext_vector_type(2)));
#define PP_(j, w, bs) { const float v0 = xf[u][2 * (j)] * inv, v1 = xf[u][2 * (j) + 1] * inv; \
                  q1w[w] = __builtin_amdgcn_cvt_scalef32_pk_fp4_f32(q1w[w], v0, v1, 1.0f, bs); \
                  const f32x2q bk = __builtin_amdgcn_cvt_scalef32_pk_f32_fp4(q1w[w], 1.0f, bs);                         \
                  q2w[w] = __builtin_amdgcn_cvt_scalef32_pk_fp4_f32(q2w[w], (v0 - bk.x) * 6.0f, (v1 - bk.y) * 6.0f, 1.0f, bs); }
              PP_(0, 0, 0) PP_(1, 0, 1) PP_(2, 0, 2) PP_(3, 0, 3) PP_(4, 1, 0) PP_(5, 1, 1) PP_(6, 1, 2) PP_(7, 1, 3)
#undef PP_
              const v2u q1 = (v2u){q1w[0], q1w[1]}, q2 = (v2u){q2w[0], q2w[1]};
              unsigned char* xo = XQ + (size_t)(lane >> 4) * ((size_t)MTOK * 256) + (size_t)t * 256 + 8 * (lane & 15);
              *(v2u*)(xo) = q1; *(v2u*)(xo + 128) = q2;
              if (lane == 0) SX[t] = m[u] * (1.0f / 6.0f); } }
      } }
    const int h = F.vcu & 7, tbg = F.vcu >> 3, ntbg = F.G >> 3;
    { const int tid = F.wave * 64 + lane;
#pragma unroll
      for (int j = 0; j < 8; ++j) { const int idx = tid + 512 * j, p = idx >> 11, n = (idx >> 4) & 127, ch = idx & 15;
          const v4u v = *(const v4u*)(KEYS + ((size_t)(2 * h + p) * 128 + n) * 128 + ch * 8);
          *(LAS v4u*)(F.lds + p * 32768 + n * 256 + ((ch * 16) ^ ((n & 7) << 4))) = v; }
      __syncthreads(); }
    for (int tb = tbg * 8 + F.wave; tb < MTOK / 32; tb += ntbg * 8) {
        const int tok = tb * 32 + r32;
        float ssq = 0.f;
        { const f32x4* sp = (const f32x4*)(SSQ + (size_t)tok * 16);
#pragma unroll
          for (int j = 0; j < 4; ++j) { const f32x4 v = sp[j]; ssq += (v.x + v.y) + (v.z + v.w); } }
        const float rr = 1.0f / sqrtf(ssq * (1.f / DM) + RMS_EPS);
        if (h == 0 && hi == 0) RR[tok] = rr;
        unsigned C[16];
#pragma unroll
        for (int i = 0; i < 16; ++i) C[i] = 0u;
        {
        unsigned T[2][16];
        bf16x8 qfa[2][8];
#pragma unroll
        for (int p = 0; p < 2; ++p) { const bf16* qrow = QP + (size_t)tok * 2048 + (2 * h + p) * 128 + hi * 8;
#pragma unroll
            for (int s = 0; s < 8; ++s) qfa[p][s] = *(const bf16x8*)(qrow + s * 16); }
#pragma unroll
        for (int p = 0; p < 2; ++p) {
            const int hp = 2 * h + p;
            bf16x8 qf[8];
#pragma unroll
            for (int s = 0; s < 8; ++s) qf[s] = qfa[p][s];
#pragma unroll
            for (int i = 0; i < 16; ++i) T[p][i] = 0u;
#pragma unroll 1
            for (int blk = 0; blk < 4; ++blk) {
                f32x16 acc = f32x16{};
                const int n = blk * 32 + r32; const LAS unsigned char* krow = F.lds + p * 32768 + n * 256; const int sw = (n & 7) << 4;
#pragma unroll
                for (int s = 0; s < 8; ++s) { const bf16x8 a = *(const LAS bf16x8*)(krow + ((32 * s + 16 * hi) ^ sw)); acc = __builtin_amdgcn_mfma_f32_32x32x16_bf16(a, qf[s], acc, 0, 0, 0); }
                const int nb = 127 - (blk * 32 + 4 * hi);
                unsigned K[16];
#pragma unroll
                for (int r = 0; r < 16; ++r) K[r] = (fkey(acc[r]) & ~127u) | (unsigned)(nb - ((r & 3) + 8 * (r >> 2)));
                sort16_desc(K); merge_top16(T[p], K);
            }
            unsigned oth[16];
#pragma unroll
            for (int i = 0; i < 16; ++i) oth[i] = (unsigned)__shfl_xor((int)T[p][i], 32);
            merge_top16(T[p], oth);
#pragma unroll
            for (int i = 0; i < 16; ++i) TL[(p * 16 + i) * 512] = T[p][i];
        }
        float s0[16], s1[16];
#pragma unroll
        for (int i = 0; i < 16; ++i) { s0[i] = funkey((T[0][i] & ~127u) | 64u); s1[i] = funkey((T[1][i] & ~127u) | 64u); }
#define CAND(i, j) ((fkey(s0[i] + s1[j]) & ~255u) | (unsigned)((i) * 16 + (j)))
#pragma unroll
        for (int j = 0; j < 16; ++j) C[j] = CAND(0, j);
        { unsigned B[16];
#pragma unroll
          for (int j = 0; j < 8; ++j) B[j] = CAND(1, j);
#pragma unroll
          for (int j = 0; j < 5; ++j) B[8 + j] = CAND(2, j);
#pragma unroll
          for (int j = 0; j < 3; ++j) B[13 + j] = CAND(4, j);
          sort16_desc(B); merge_top16(C, B); }
        { unsigned B[16];
#pragma unroll
          for (int j = 0; j < 4; ++j) B[j] = CAND(3, j);
#pragma unroll
          for (int j = 0; j < 2; ++j) { B[4 + j] = CAND(5, j); B[6 + j] = CAND(6, j); B[8 + j] = CAND(7, j); }
#pragma unroll
          for (int i = 0; i < 6; ++i) B[10 + i] = CAND(8 + i, 0);
          sort16_desc(B); merge_top16(C, B); }
        INS16(C, CAND(14, 0)); INS16(C, CAND(15, 0));
#undef CAND
        }
        float sc[16]; unsigned ex[16];
#pragma unroll
        for (int k = 0; k < 16; ++k) {
            const unsigned code = C[k] & 255u;
            const unsigned a = TL[(code >> 4) * 512], b = TL[(16 + (code & 15u)) * 512];
            ex[k] = (127u - (a & 127u)) * 128u + (127u - (b & 127u));
            sc[k] = funkey((a & ~127u) | 64u) + funkey((b & ~127u) | 64u);
        }
        typedef float f32x2h __attribute__((ext_vector_type(2)));
        const f32x2h* SUVh = (const f32x2h*)(KWS + WS_SU) + (size_t)l * NEXP;
        unsigned es[8]; f32x2h sg[8];
#pragma unroll
        for (int j = 0; j < 8; ++j) { unsigned a_ = ex[j], b_ = ex[8 + j]; asm volatile("" : "+v"(a_), "+v"(b_)); es[j] = hi ? b_ : a_; }
#pragma unroll
        for (int j = 0; j < 8; ++j) sg[j] = SUVh[es[j] & (NEXP - 1)];
        float smax = sc[0];
#pragma unroll
        for (int k = 1; k < 16; ++k) smax = fmaxf(smax, sc[k]);
        float den = 0.f;
#pragma unroll
        for (int k = 0; k < 16; ++k) { sc[k] = __builtin_amdgcn_exp2f((sc[k] - smax) * rr * 1.4426950408889634f); den += sc[k]; }
        const float iden = 1.0f / den;
        v4u* edst = (v4u*)((unsigned short*)EO + (size_t)tok * 128 + h * 16 + hi * 8); f32x4* gdst = (f32x4*)(GO + (size_t)tok * 128 + h * 16 + hi * 8);
#pragma unroll
        for (int k = 0; k < 8; k += 4) {
            float wa[4], wb2[4];
#pragma unroll
            for (int j = 0; j < 4; ++j) { wa[j] = sc[k + j]; wb2[j] = sc[8 + k + j]; asm volatile("" : "+v"(wa[j]), "+v"(wb2[j])); }
            ((v4u*)gdst)[k >> 2] = (v4u){pk2((hi ? wb2[0] : wa[0]) * iden * sg[k].y, (hi ? wb2[1] : wa[1]) * iden * sg[k + 1].y), pk2(sg[k].x * rr, sg[k + 1].x * rr), pk2((hi ? wb2[2] : wa[2]) * iden * sg[k + 2].y, (hi ? wb2[3] : wa[3]) * iden * sg[k + 3].y), pk2(sg[k + 2].x * rr, sg[k + 3].x * rr)};
        }
        edst[0] = (v4u){es[0] | (es[1] << 16), es[2] | (es[3] << 16), es[4] | (es[5] << 16), es[6] | (es[7] << 16)};
    }
}

__device__ __forceinline__ float gelu_tanh(float h) {
    const float z = 0.7978845608028654f * (h + 0.044715f * h * h * h);
    return h * __builtin_amdgcn_rcpf(1.0f + __builtin_amdgcn_exp2f(-2.0f * 1.4426950408889634f * z));
}
__device__ __forceinline__ float ub0(unsigned x) { return (float)(x & 0xffu); }
__device__ __forceinline__ float ub1(unsigned x) { return (float)((x >> 8) & 0xffu); }
__device__ __forceinline__ float ub2(unsigned x) { return (float)((x >> 16) & 0xffu); }
__device__ __forceinline__ float ub3(unsigned x) { return (float)(x >> 24); }
#define DPP_I(x, ctrl) __builtin_amdgcn_update_dpp(0, (x), (ctrl), 0xf, 0xf, false)
#define DPP_F(x, ctrl) __builtin_bit_cast(float, __builtin_amdgcn_update_dpp(0, __builtin_bit_cast(int, (x)), (ctrl), 0xf, 0xf, false))
#define G1_IT(i) (bx + (i) * G)
#define G1_TOK(i) ((G1_IT(i) >> 3) * 8 + wave)
__device__ __forceinline__ void ph_g1(Frame& F, int l) {
    const unsigned char* XQ = KWS + WS_XQ; const unsigned* E = (const unsigned*)(KWS + WS_E); const unsigned char* U = KWS + WS_U + (size_t)l * UV_STRIDE; float* HPF = (float*)(KWS + WS_HPI);
    const int lane = pg8::fresh_lane(), n = lane & 15, q = lane >> 4, m = n & 7, hh = n >> 3, k8 = hh * 4 + q, r8 = lane >> 3, c = lane & 7;
    const int G = F.G, bx = F.bx, wave = F.wave;
    const int nit = (4 * (MTOK / 8) - bx + G - 1) / G;
    LAS unsigned char* ldw = F.lds + wave * 16384 + lane * 16; const LAS unsigned char* ldr = F.lds + wave * 16384 + m * 128 + hh * 64 + q * 16;
    typedef int i32x8 __attribute__((ext_vector_type(8))); typedef float f32x2 __attribute__((ext_vector_type(2))); typedef _Float16 h16x2 __attribute__((ext_vector_type(2)));
#define F1_IT(i) (bx + (i) * G)
#define F1_TOK(i) ((F1_IT(i) >> 2) * 8 + wave)
#define F1_LOADE(EV, i) do { const unsigned short* ep_ = (const unsigned short*)E + (size_t)F1_TOK(i) * 128 + 16 * r8; EV[0] = *(const v4u*)(ep_); EV[1] = *(const v4u*)(ep_ + 8); } while (0)
#define EID(EV, g) ((EV[(g) >> 3][((g) >> 1) & 3] >> (16 * ((g) & 1))) & 0xffffu)
#define F1_LOADB(URV, XV, EV, i) do { const size_t co_ = (size_t)(F1_IT(i) & 3) * (NEXP * 128) + 16 * c; \
        _Pragma("unroll") for (int g_ = 0; g_ < 16; ++g_) URV[g_] = *(const v4u*)(U + (size_t)(EID(EV, g_) & (NEXP - 1)) * 128 + co_); \
        XV = *(const v4u*)(XQ + (size_t)(F1_IT(i) & 3) * ((size_t)MTOK * 256) + (size_t)F1_TOK(i) * 256 + 128 * (n & 1) + 64 * ((n >> 1) & 1) + 16 * q); } while (0)
#define F1_COMP(URV, XV, i) do { float h_[16]; \
        const i32x8 xa_ = {(int)XV.x, (int)XV.y, (int)XV.z, (int)XV.w, 0, 0, 0, 0}; \
        _Pragma("unroll") for (int g_ = 0; g_ < 16; ++g_) *(LAS v4u*)(ldw + g_ * 1024) = URV[g_]; \
        _Pragma("unroll") for (int g_ = 0; g_ < 16; ++g_) { const v4u ur_ = *(const LAS v4u*)(ldr + g_ * 1024); \
            const i32x8 ub_ = {(int)ur_.x, (int)ur_.y, (int)ur_.z, (int)ur_.w, 0, 0, 0, 0}; \
            const f32x4 d_ = __builtin_amdgcn_mfma_scale_f32_16x16x128_f8f6f4(xa_, ub_, (f32x4){0.f, 0.f, 0.f, 0.f}, 4, 4, 0, 0x7f7f7f7f, 0, 0x7f7f7f7f); \
            const float v_ = hh ? d_[2] + d_[3] * (1.0f / 6.0f) : d_[0] + d_[1] * (1.0f / 6.0f); \
            h_[g_] = v_ + DPP_F(v_, 0x128); } \
          \
        float s0_ = h_[0], s1_ = h_[1]; \
        _Pragma("unroll") for (int k_ = 1; k_ < 8; ++k_) { s0_ = k8 == k_ ? h_[2 * k_] : s0_; s1_ = k8 == k_ ? h_[2 * k_ + 1] : s1_; } \
        *(h16x2*)((_Float16*)HPF + ((size_t)F1_TOK(i) * 64 + 8 * m + k8) * 8 + 2 * (F1_IT(i) & 3)) = (h16x2){(_Float16)s0_, (_Float16)s1_}; } while (0)
    v4u eA[2], eB[2], xA, xB, urA[16], urB[16];
#define F1_CL(i) ((i) < nit ? (i) : nit - 1)
    if (nit > 0) {
        F1_LOADE(eA, 0); F1_LOADE(eB, F1_CL(1)); F1_LOADB(urA, xA, eA, 0);
        for (int i = 0; i < nit; i += 2) {
            __builtin_amdgcn_s_setprio(2);
            F1_LOADE(eA, F1_CL(i + 2));
            F1_LOADB(urB, xB, eB, F1_CL(i + 1));
            __builtin_amdgcn_sched_barrier(0);
            __builtin_amdgcn_s_setprio(0);
            F1_COMP(urA, xA, i);
            __builtin_amdgcn_sched_barrier(0);
            __builtin_amdgcn_s_setprio(2);
            F1_LOADE(eB, F1_CL(i + 3));
            F1_LOADB(urA, xA, eA, F1_CL(i + 2));
            __builtin_amdgcn_sched_barrier(0);
            __builtin_amdgcn_s_setprio(0);
            F1_COMP(urB, xB, F1_CL(i + 1));
            __builtin_amdgcn_sched_barrier(0);
        }
    }
#undef F1_CL
#undef F1_IT
#undef F1_TOK
#undef F1_LOADE
#undef F1_LOADB
#undef F1_COMP
}
__device__ __forceinline__ void ph_g1b(Frame& F, int l) {
    const float* HPF = (const float*)(KWS + WS_HPI); const unsigned* E = (const unsigned*)(KWS + WS_E); const float* G = (const float*)(KWS + WS_G);
    const float* RR = (const float*)(KWS + WS_RR); const float* SX = (const float*)(KWS + WS_SX);
    typedef float f32x2s __attribute__((ext_vector_type(2)));
    const f32x2s* SUV = (const f32x2s*)(KWS + WS_SU) + (size_t)l * NEXP;
    unsigned char* WQ = KWS + WS_WF; float* SW = (float*)(KWS + WS_WSUM);
    const int lane = pg8::fresh_lane();
    typedef int i32x2 __attribute__((ext_vector_type(2))); typedef float f32x2 __attribute__((ext_vector_type(2)));
    constexpr int NU = 4;
    for (int t0 = F.gw; t0 < MTOK; t0 += NU * F.NGW) {
        f32x2 isum[NU]; v2u e2[NU]; f32x2 g2[NU]; float hs[NU];
#pragma unroll
        for (int u = 0; u < NU; ++u) { const int t = (t0 + u * F.NGW < MTOK) ? t0 + u * F.NGW : t0;
            hs[u] = RR[t] * SX[t];
            isum[u] = (f32x2){0.f, 0.f};
#pragma unroll
            for (int s = 0; s < 4; ++s) { typedef _Float16 h16x2 __attribute__((ext_vector_type(2))); const h16x2 w = *(const h16x2*)((const _Float16*)HPF + ((size_t)s * MTOK + t) * 128 + 2 * lane); isum[u].x += (float)w.x; isum[u].y += (float)w.y; }
            { const unsigned ew = *(const unsigned*)((const unsigned short*)E + (size_t)t * 128 + 2 * lane); e2[u] = (v2u){ew & 0xffffu, ew >> 16}; } g2[u] = *(const f32x2*)(G + (size_t)t * 128 + 2 * lane); }
        float w0[NU], w1[NU], m[NU];
#pragma unroll
        for (int u = 0; u < NU; ++u) { const unsigned e0 = e2[u].x & (NEXP - 1), e1 = e2[u].y & (NEXP - 1);
            const f32x2s sa = SUV[e0], sb = SUV[e1];
            w0[u] = g2[u].x * gelu_tanh(isum[u].x * hs[u] * sa.x) * sa.y; w1[u] = g2[u].y * gelu_tanh(isum[u].y * hs[u] * sb.x) * sb.y;
            m[u] = fmaxf(fabsf(w0[u]), fabsf(w1[u])); }
#pragma unroll
        for (int o = 1; o < 64; o <<= 1)
#pragma unroll
            for (int u = 0; u < NU; ++u) m[u] = fmaxf(m[u], __shfl_xor(m[u], o));
#pragma unroll
        for (int u = 0; u < NU; ++u) { const int t = t0 + u * F.NGW; if (t < MTOK) {
            const float inv = m[u] > 0.f ? 6.0f / m[u] : 0.f;
            float va = w0[u] * inv, vb = w1[u] * inv;
#pragma unroll
            for (int term = 0; term < 3; ++term) {
                const unsigned pk = __builtin_amdgcn_cvt_scalef32_pk_fp4_f32(0u, va, vb, 1.0f, 0);
                WQ[(size_t)t * 192 + 64 * term + lane] = (unsigned char)pk;
                typedef float f32x2q __attribute__((ext_vector_type(2)));
                const f32x2q bk = __builtin_amdgcn_cvt_scalef32_pk_f32_fp4(pk, 1.0f, 0);
                va = (va - bk.x) * 6.0f; vb = (vb - bk.y) * 6.0f; }
            if (lane == 0) SW[t] = m[u] * (1.0f / 6.0f); } }
    }
}
template <bool LAST>
__device__ __forceinline__ void ph_g2(Frame& F, int l, bf16* Xout) {
    const unsigned* E = (const unsigned*)(KWS + WS_E); const unsigned char* WQ = KWS + WS_WF; const float* SW = (const float*)(KWS + WS_WSUM);
    const unsigned char* V = KWS + WS_V + (size_t)l * UV_STRIDE;
    const bf16* X = (const bf16*)(KWS + WS_XB); float* SSQN = (float*)(KWS + WS_SSQN); float* OUTF = KOUT; float* DUMP = (float*)(KWS + WS_HPI + 32 * MiB);
    const _Float16* HPF = (const _Float16*)(KWS + WS_HPI); const float* GW = (const float*)(KWS + WS_G); const float* SUO = (const float*)(KWS + WS_SUO); const float* RR = (const float*)(KWS + WS_RR); const float* SX = (const float*)(KWS + WS_SX);
    const int lane = pg8::fresh_lane(), n = lane & 15, q = lane >> 4, r8 = lane >> 3, c = lane & 7;
    const int G = F.G, bx = F.bx, wave = F.wave;
    const int nit = (4 * (MTOK / 8) - bx + G - 1) / G;
    LAS unsigned char* ldw = F.lds + wave * 16384 + r8 * 2048; LAS unsigned char* ldr = F.lds + wave * 16384 + (32 * q + n) * 128;
    LAS unsigned char* ldx = F.lds + wave * 16384 + 4 * (64 * q + n); const LAS unsigned char* ldy = F.lds + wave * 16384 + 16 * lane;
    typedef float f32x2 __attribute__((ext_vector_type(2))); typedef _Float16 h16x2 __attribute__((ext_vector_type(2)));
    LAS unsigned char* wql = F.lds + 131072 + 2048 + wave * 256 + lane; const LAS unsigned char* wqr = F.lds + 131072 + 2048 + wave * 256 + 64 * ((n & 3) < 2 ? (n & 3) : 2) + 16 * q;
    unsigned char* X8 = KWS + WS_XB8;
    typedef int i32x8 __attribute__((ext_vector_type(8))); typedef int i32x2 __attribute__((ext_vector_type(2)));
#define F2_IT(i) (bx + (i) * G)
#define F2_TOK(i) ((F2_IT(i) >> 2) * 8 + wave)
#define F2_LOADE(EV, i) do { const unsigned short* ep_ = (const unsigned short*)E + (size_t)F2_TOK(i) * 128 + 16 * r8; EV[0] = *(const v4u*)(ep_); EV[1] = *(const v4u*)(ep_ + 8); } while (0)
#define F2_LOADB(VRV, AV, XV, SWV, EV, i) do { const size_t co_ = (size_t)(F2_IT(i) & 3) * (NEXP * 128) + 16 * c; \
        _Pragma("unroll") for (int g_ = 0; g_ < 16; ++g_) VRV[g_] = *(const v4u*)(V + (size_t)(EID(EV, g_) & (NEXP - 1)) * 128 + co_); \
          \
        { const size_t to_ = (size_t)F2_TOK(i) * 128 + 2 * lane; \
          AV = *(const v4u*)(HPF + 4 * to_); \
          SWV = *(const v2u*)(GW + to_); SWV##x = SX[F2_TOK(i)]; } \
        XV = *(const v2u*)(X + (size_t)F2_TOK(i) * DM + 256 * (F2_IT(i) & 3) + 4 * lane); } while (0)
#define F2_COMP(VRV, AV, XV, SWV, i, valid) do { \
        _Pragma("unroll") for (int g_ = 0; g_ < 16; ++g_) { const v4u w_ = (g_ & 1) ? (v4u){VRV[g_].z, VRV[g_].w, VRV[g_].x, VRV[g_].y} : VRV[g_]; *(LAS v4u*)(ldw + g_ * 128 + 16 * (c ^ (g_ >> 1))) = w_; } \
          \
        float sw_; v4u aq_; \
        { const float hs_ = SWV##x; float i0_ = 0.f, i1_ = 0.f;     \
          { const unsigned a0_ = AV.x, a1_ = AV.y, a2_ = AV.z, a3_ = AV.w;     \
            const h16x2 p0_ = __builtin_bit_cast(h16x2, a0_), p1_ = __builtin_bit_cast(h16x2, a1_), p2_ = __builtin_bit_cast(h16x2, a2_), p3_ = __builtin_bit_cast(h16x2, a3_); \
            i0_ = (((float)p0_.x + (float)p1_.x) + (float)p2_.x) + (float)p3_.x; i1_ = (((float)p0_.y + (float)p1_.y) + (float)p2_.y) + (float)p3_.y; } \
          const float w0_ = blo(SWV.x) * gelu_tanh(i0_ * hs_ * blo(SWV.y)), w1_ = bhi(SWV.x) * gelu_tanh(i1_ * hs_ * bhi(SWV.y)); \
          float m_ = fmaxf(fabsf(w0_), fabsf(w1_)); \
          m_ = fmaxf(m_, DPP_F(m_, 0xB1)); m_ = fmaxf(m_, DPP_F(m_, 0x4E)); m_ = fmaxf(m_, DPP_F(m_, 0x141)); m_ = fmaxf(m_, DPP_F(m_, 0x128)); \
          m_ = fmaxf(m_, __int_as_float(__builtin_amdgcn_ds_swizzle(__float_as_int(m_), 0x401F))); m_ = fmaxf(m_, __shfl_xor(m_, 32)); \
          const float inv_ = m_ > 0.f ? 6.0f * __builtin_amdgcn_rcpf(m_) : 0.f; float va_ = w0_ * inv_, vb_ = w1_ * inv_; \
          _Pragma("unroll") for (int term_ = 0; term_ < 3; ++term_) { const unsigned pk_ = __builtin_amdgcn_cvt_scalef32_pk_fp4_f32(0u, va_, vb_, 1.0f, 0); \
              *(wql + 64 * term_) = (unsigned char)pk_; \
              const f32x2 bk_ = __builtin_amdgcn_cvt_scalef32_pk_f32_fp4(pk_, 1.0f, 0); va_ = (va_ - bk_.x) * 6.0f; vb_ = (vb_ - bk_.y) * 6.0f; } \
          aq_ = *(const LAS v4u*)(wqr); sw_ = m_ * (1.0f / 6.0f); } \
        const i32x8 wa_ = {(int)aq_.x, (int)aq_.y, (int)aq_.z, (int)aq_.w, 0, 0, 0, 0}; \
        float val_[16]; \
        _Pragma("unroll") for (int cg_ = 0; cg_ < 16; ++cg_) { LAS unsigned char* ad_ = ldr + 8 * (cg_ ^ n); \
            const i32x2 r0_ = __builtin_amdgcn_ds_read_tr4_b64_v2i32((LAS i32x2*)ad_), r1_ = __builtin_amdgcn_ds_read_tr4_b64_v2i32((LAS i32x2*)(ad_ + 2048)); \
            const i32x8 vb_ = {r0_.x, r0_.y, r1_.x, r1_.y, 0, 0, 0, 0}; \
            const f32x4 d_ = __builtin_amdgcn_mfma_scale_f32_16x16x128_f8f6f4(wa_, vb_, (f32x4){0.f, 0.f, 0.f, 0.f}, 4, 4, 0, 0x7f7f7f7f, 0, 0x7f7f7f7f); \
            val_[cg_] = d_[0] + d_[1] * (1.0f / 6.0f) + d_[2] * (1.0f / 36.0f); } \
          \
        const int t_ = F2_TOK(i), s_ = F2_IT(i) & 3; float ss_ = 0.f; \
          \
        _Pragma("unroll") for (int k_ = 0; k_ < 4; ++k_) { float o_ = val_[k_], o1_ = val_[4 + k_], o2_ = val_[8 + k_], o3_ = val_[12 + k_]; asm volatile("" : "+v"(o_), "+v"(o1_), "+v"(o2_), "+v"(o3_));     \
            o_ = q == 1 ? o1_ : o_; o_ = q == 2 ? o2_ : o_; o_ = q == 3 ? o3_ : o_; \
            *(LAS float*)(ldx + 64 * k_) = o_; } \
        const f32x4 ov_ = *(const LAS f32x4*)(ldy); \
        float xo_[4] = {blo(XV.x) + ov_[0] * sw_, bhi(XV.x) + ov_[1] * sw_, blo(XV.y) + ov_[2] * sw_, bhi(XV.y) + ov_[3] * sw_}; \
        _Pragma("unroll") for (int k_ = 0; k_ < 4; ++k_) ss_ += xo_[k_] * xo_[k_]; \
        const size_t col_ = (size_t)256 * s_ + 4 * lane; \
        if (LAST) { f32x4* o1p_ = (valid) ? (f32x4*)(OUTF + (size_t)t_ * DM + col_) : (f32x4*)(DUMP + 4 * lane); *o1p_ = (f32x4){xo_[0], xo_[1], xo_[2], xo_[3]}; } \
        else { v2u* o2p_ = (valid) ? (v2u*)(Xout + (size_t)t_ * DM + col_) : (v2u*)(DUMP + 4 * lane); *o2p_ = (v2u){pk2(xo_[0], xo_[1]), pk2(xo_[2], xo_[3])}; \
            int f8_ = __builtin_amdgcn_cvt_pk_fp8_f32(xo_[0] * 16.f, xo_[1] * 16.f, 0, false); f8_ = __builtin_amdgcn_cvt_pk_fp8_f32(xo_[2] * 16.f, xo_[3] * 16.f, f8_, true); \
            unsigned* o4p_ = (valid) ? (unsigned*)(X8 + (size_t)t_ * DM + col_) : (unsigned*)(DUMP + 512 + lane); *o4p_ = (unsigned)f8_; } \
        if (!LAST) { ss_ += DPP_F(ss_, 0xB1); ss_ += DPP_F(ss_, 0x4E); ss_ += DPP_F(ss_, 0x141); ss_ += DPP_F(ss_, 0x128);        \
            ss_ += __int_as_float(__builtin_amdgcn_ds_swizzle(__float_as_int(ss_), 0x401F));                                     \
            float* o3_ = (valid) ? SSQN + (size_t)t_ * 8 + 2 * s_ + (lane >> 5) : DUMP + 2048 + (lane >> 5); *o3_ = ss_; } } while (0)
    v4u eA[2], eB[2], aA, aB, vrA[16], vrB[16]; v2u xA, xB; v2u swA, swB; float swAx, swBx;
#define F2_CL(i) ((i) < nit ? (i) : nit - 1)
    if (nit > 0) {
        F2_LOADE(eA, 0); F2_LOADE(eB, F2_CL(1)); F2_LOADB(vrA, aA, xA, swA, eA, 0);
        for (int i = 0; i < nit; i += 2) {
            __builtin_amdgcn_s_setprio(2);
            F2_LOADE(eA, F2_CL(i + 2));
            F2_LOADB(vrB, aB, xB, swB, eB, F2_CL(i + 1));
            __builtin_amdgcn_sched_barrier(0);
            __builtin_amdgcn_s_setprio(0);
            F2_COMP(vrA, aA, xA, swA, i, true);
            __builtin_amdgcn_sched_barrier(0);
            __builtin_amdgcn_s_setprio(2);
            F2_LOADE(eB, F2_CL(i + 3));
            F2_LOADB(vrA, aA, xA, swA, eA, F2_CL(i + 2));
            __builtin_amdgcn_sched_barrier(0);
            __builtin_amdgcn_s_setprio(0);
            F2_COMP(vrB, aB, xB, swB, F2_CL(i + 1), i + 1 < nit);
            __builtin_amdgcn_sched_barrier(0);
        }
    }
#undef F2_CL
#undef F2_IT
#undef F2_TOK
#undef F2_LOADE
#undef F2_LOADB
#undef F2_COMP
#undef G1_IT
#undef G1_TOK
}

constexpr int PH_PER_LAYER = 11, N_PHASES = 1 + DEPTH * PH_PER_LAYER;
__global__ void __launch_bounds__(NWAVES * 64, 2) fwd_kernel(Args A) {
    extern __shared__ __attribute__((aligned(16))) unsigned char lds[];
    Frame F;
    F.lds = (LAS unsigned char*)lds;
    F.wave = __builtin_amdgcn_readfirstlane((int)threadIdx.x >> 6);
    F.G = gridDim.x; { const int bx = blockIdx.x; F.vcu = (F.G % 8 == 0) ? (bx % 8) * (F.G / 8) + bx / 8 : bx; }
    F.gw = F.vcu * NWAVES + F.wave; F.NGW = F.G * NWAVES; F.bx = (int)blockIdx.x;
    cg::grid_group grid = cg::this_grid();
    for (int u = threadIdx.x; u < 64; u += NWAVES * 64) ((LAS unsigned*)(F.lds + 131072))[u + 64] = 0u;
    __syncthreads();
    XcdBarrier bar = xcd_barrier_post((unsigned*)(KWS + WS_CTL), (volatile LAS unsigned*)(F.lds + MISC_OFF) + 8);
    const int lo = karg_int(23 * 8), hi = karg_int(23 * 8 + 4);
#ifndef PH_MASK
#define PH_MASK 0xfff
#endif
#define KIND(k) ((k) == 0 ? 0 : 1 + ((k) - 1) % PH_PER_LAYER)
#define IN(k) (((PH_MASK >> KIND(k)) & 1) && lo <= (k) && (k) < hi)
#define SEAM(k) do { if (IN(k) && IN((k) + 1)) xcd_barrier(bar); } while (0)
#ifndef PROBE_KIND
#define PROBE_KIND (-1)
#endif
#define REPS(kind) for (int rep_ = ((kind) == PROBE_KIND ? 0 : 1); rep_ < 2; ++rep_)
#define REP_SYNC() do { if (rep_ == 0) xcd_barrier(bar); } while (0)
    if (lo < 0) grid.sync();
    if (IN(0)) { REPS(0) { ph_prologue(F); REP_SYNC(); } SEAM(0); }
    for (int l = 0; l < DEPTH; ++l) {
        const int p0 = 1 + l * PH_PER_LAYER;
        if (IN(p0 + 0)) { REPS(1) { Frame Fq = fresh_frame(F);
            unsigned char* ws = KWS; unsigned char* wb = ws + WS_W + (size_t)l * W_STRIDE;
            int kin = DM / 2; asm volatile("" : "+s"(kin));
            pg8::Gemm g{(const pg8::bf16_t*)(ws + WS_XB8), (const pg8::bf16_t*)(wb + WO_WIN), MTOK, INWP, kin}; pg8::StaticOrder S; S.init(MTOK, INWP, Fq.G, Fq.bx);
            pg8::EpiIn E{(pg8::bf16_t*)(ws + WS_GATES), (const float*)KIN(14) + (size_t)l * 2048, (pg8::bf16_t*)(ws + WS_CQ), (pg8::bf16_t*)(ws + WS_CKV), (pg8::bf16_t*)(ws + WS_KPEP), (const float*)(ws + WS_SSQN), (float*)(ws + WS_SSQC), (const int*)KIN(1)};
            pg8::gemm_phase<pg8::EpiIn, pg8::StaticOrder, true, true, true>(Fq.lds, g, S, E, Fq.wave);
            { const int nu = MTOK / 256 * (INWP / 256), nfull = nu % Fq.G;
              if (nfull == 0) convert_tables(l, Fq.gw, Fq.NGW);
              else if (Fq.bx >= nfull) convert_tables(l, (Fq.bx - nfull) * NWAVES + Fq.wave, (Fq.G - nfull) * NWAVES); }
            REP_SYNC(); }
            SEAM(p0 + 0);
        }
        if (IN(p0 + 1)) { REPS(2) { Frame Fq = fresh_frame(F);
            unsigned char* ws = KWS; unsigned char* wb = ws + WS_W + (size_t)l * W_STRIDE;
            { const int nq = (MTOK / 256) * 3;
              if (nq >= Fq.G) ph_pool(Fq, Fq.gw, Fq.NGW);
              else if (Fq.bx >= nq) ph_pool(Fq, (Fq.bx - nq) * NWAVES + Fq.wave, (Fq.G - nq) * NWAVES); }
            { pg8::Gemm g{(const pg8::bf16_t*)(ws + WS_CQ), (const pg8::bf16_t*)(wb + WO_WUQ), MTOK, 768, QL}; pg8::StaticOrder S; S.init(MTOK, 768, Fq.G, Fq.bx);
              pg8::EpiBf16<0> E{(pg8::bf16_t*)(ws + WS_QRAW), 768, nullptr, 0, 0, 1.f};
              pg8::gemm_phase<pg8::EpiBf16<0>, pg8::StaticOrder, true, true>(Fq.lds, g, S, E, Fq.wave); }
            { int kvl = KVL; asm volatile("" : "+s"(kvl));
              pg8::Gemm g{(const pg8::bf16_t*)(ws + WS_CKV), (const pg8::bf16_t*)(wb + WO_WUKV), MTOK, 1024, kvl}; pg8::StaticOrder S; S.init(MTOK, 1024, Fq.G, Fq.bx);
              LAS float* gkl = (LAS float*)(Fq.lds + 131072 + 1024);
              { const int tid_ = Fq.wave * 64 + pg8::fresh_lane(); if (tid_ < QKH) gkl[tid_] = ((const float*)KIN(9))[l * QKH + tid_]; }
              __syncthreads();
              pg8::EpiKV E{(pg8::bf16_t*)(ws + WS_K), (pg8::bf16_t*)(ws + WS_VV), (const pg8::bf16_t*)(ws + WS_KPEP), (const float*)(ws + WS_SSQC), gkl};
              pg8::gemm_phase<pg8::EpiKV, pg8::StaticOrder, true, true>(Fq.lds, g, S, E, Fq.wave); }
            REP_SYNC(); }
            SEAM(p0 + 1);
        }
        if (IN(p0 + 3)) { REPS(4) { Frame Fq = fresh_frame(F); ph_attn(Fq, lds, l); REP_SYNC(); } SEAM(p0 + 3); }
        if (IN(p0 + 4)) { REPS(5) { Frame Fq = fresh_frame(F);
            unsigned char* ws = KWS; unsigned char* wb = ws + WS_W + (size_t)l * W_STRIDE;
            { pg8::Gemm g{(const pg8::bf16_t*)(ws + WS_O), (const pg8::bf16_t*)(wb + WO_WO), MTOK, DM, 512}; pg8::StaticOrder S; S.init(MTOK, DM, Fq.G, Fq.bx);
              pg8::EpiBf16<0> E{(pg8::bf16_t*)(ws + WS_ABUF), DM, nullptr, 0, 0, 1.f};
              pg8::gemm_phase<pg8::EpiBf16<0>, pg8::StaticOrder, true, true>(Fq.lds, g, S, E, Fq.wave); }
            { pg8::Gemm g{(const pg8::bf16_t*)(ws + WS_MIXED), (const pg8::bf16_t*)(wb + WO_WC), MTOK, DM, 512}; pg8::StaticOrder S; S.init(MTOK, DM, Fq.G, Fq.bx);
              pg8::EpiMix E{(const pg8::bf16_t*)(ws + WS_ABUF), (const pg8::bf16_t*)(ws + WS_GATES), (pg8::bf16_t*)(ws + WS_MIX)};
              pg8::gemm_phase<pg8::EpiMix, pg8::StaticOrder, true, true>(Fq.lds, g, S, E, Fq.wave); }
            REP_SYNC(); }
            SEAM(p0 + 4);
        }
        if (IN(p0 + 5)) { REPS(6) { Frame Fq = fresh_frame(F);
            unsigned char* ws = KWS; unsigned char* wb = ws + WS_W + (size_t)l * W_STRIDE;
            int kin = DM / 2; asm volatile("" : "+s"(kin));
            pg8::Gemm g{(const pg8::bf16_t*)(ws + WS_MIX), (const pg8::bf16_t*)(wb + WO_WOUT), MTOK, DM, kin}; pg8::StaticOrder S; S.init(MTOK, DM, Fq.G, Fq.bx);
            pg8::EpiRes E{(const pg8::bf16_t*)(ws + WS_XB), rep_ == 0 ? (pg8::bf16_t*)(ws + WS_GATES) : (pg8::bf16_t*)(ws + WS_XB), (float*)(ws + WS_SSQ)};
            pg8::gemm_phase<pg8::EpiRes, pg8::StaticOrder, true, true, true>(Fq.lds, g, S, E, Fq.wave);
            REP_SYNC(); }
            SEAM(p0 + 5);
        }
        if (IN(p0 + 6)) { REPS(7) { Frame Fq = fresh_frame(F);
            unsigned char* ws = KWS; unsigned char* wb = ws + WS_W + (size_t)l * W_STRIDE;
            pg8::Gemm g{(const pg8::bf16_t*)(ws + WS_XB), (const pg8::bf16_t*)(wb + WO_WQ), MTOK, 2048, DM}; pg8::StaticOrder S; S.init(MTOK, 2048, Fq.G, Fq.bx);
            pg8::EpiBf16<0> E{(pg8::bf16_t*)(ws + WS_QP), 2048, nullptr, 0, 0, 1.f};
            pg8::gemm_phase<pg8::EpiBf16<0>, pg8::StaticOrder, true, true>(Fq.lds, g, S, E, Fq.wave);
            REP_SYNC(); }
            SEAM(p0 + 6);
        }
        if (IN(p0 + 7)) { REPS(8) { Frame Fq = fresh_frame(F); ph_select(Fq, l); REP_SYNC(); } SEAM(p0 + 7); }
        if (IN(p0 + 8)) { REPS(9) { Frame Fq = fresh_frame(F); ph_g1(Fq, l); REP_SYNC(); } SEAM(p0 + 8); }
        if (IN(p0 + 10)) { REPS(11) { Frame Fq = fresh_frame(F); { bf16* xo = rep_ == 0 ? (bf16*)(KWS + WS_QP) : (bf16*)(KWS + WS_XB); if (l + 1 >= DEPTH) ph_g2<true>(Fq, l, xo); else ph_g2<false>(Fq, l, xo); } REP_SYNC(); } SEAM(p0 + 10); }
    }
#undef IN
#undef SEAM
}

extern "C" void kernel_launch(void* const* d_in, const int* in_sizes, int n_in, void* d_out, int out_size, void* d_ws, size_t ws_size, hipStream_t stream) {
    static int grid = 0;
    if (grid == 0) {
        if (n_in != 21 || in_sizes[0] != MTOK * DM || out_size != MTOK * DM || ws_size < WS_END) {
            fprintf(stderr, "kernel_launch: unexpected shapes: n_in %d in0 %d out %d ws %zu (need %zu)\n", n_in, n_in > 0 ? in_sizes[0] : -1, out_size, ws_size, (size_t)WS_END); grid = -1; return; }
        int dev = 0, cus = 0, per_cu = 0;
        if (hipGetDevice(&dev) != hipSuccess || hipDeviceGetAttribute(&cus, hipDeviceAttributeMultiprocessorCount, dev) != hipSuccess) { grid = -1; return; }
        if (hipFuncSetAttribute((const void*)fwd_kernel, hipFuncAttributeMaxDynamicSharedMemorySize, LDS_BYTES) != hipSuccess) { fprintf(stderr, "kernel_launch: hipFuncSetAttribute failed\n"); grid = -1; return; }
        if (hipOccupancyMaxActiveBlocksPerMultiprocessor(&per_cu, (const void*)fwd_kernel, NWAVES * 64, LDS_BYTES) != hipSuccess || per_cu < 1) { fprintf(stderr, "kernel_launch: occupancy query says %d blocks per CU\n", per_cu); grid = -1; return; }
        (void)hipGetLastError();
        grid = cus & ~7;
    }
    if (grid < 0) return;
    if (hipMemsetAsync((char*)d_ws + WS_CTL, 0, CTL_ZERO_BYTES, stream) != hipSuccess) { fprintf(stderr, "kernel_launch: hipMemsetAsync failed\n"); return; }
    Args a{};
    for (int i = 0; i < 21; ++i) a.in[i] = d_in[i];
    a.out = (float*)d_out; a.ws = (unsigned char*)d_ws;
#if MK_ONE_LAUNCH
    a.ph_lo = 0; a.ph_hi = N_PHASES;
    void* args[] = {&a};
    hipError_t e = hipLaunchCooperativeKernel((const void*)fwd_kernel, dim3(grid), dim3(NWAVES * 64), args, LDS_BYTES, stream);
    if (e != hipSuccess) fprintf(stderr, "kernel_launch: cooperative launch failed: %s (grid %d)\n", hipGetErrorString(e), grid);
#else
    for (int p = 0; p < N_PHASES; ++p) {
        a.ph_lo = p; a.ph_hi = p + 1;
        hipLaunchKernelGGL(fwd_kernel, dim3(grid), dim3(NWAVES * 64), LDS_BYTES, stream, a);
    }
    hipError_t e = hipPeekAtLastError();
    if (e != hipSuccess) fprintf(stderr, "kernel_launch: launch failed: %s\n", hipGetErrorName(e));
#endif
}
```
